# Optimizing an MI355X kernel written in HIP

```python
import jax, jax.numpy as jnp
from jax import lax
import numpy as np

D_MODEL = 1024
BATCH = 16
SEQ = 2048
DEPTH = 2

GRID_W = 64
CTX_LEN = 256
N_HEADS = 8
N_KV_HEADS = 2
HEAD_DIM = 64
ATTN_WIDTH = N_HEADS * HEAD_DIM
KV_WIDTH = N_KV_HEADS * HEAD_DIM
Q_BLOCK = 128
ROPE_THETA = 10000.0
POOL_WINDOWS = (2, 4, 8, 16)
POOL_GROUPS = 4
POOL_GROUP_DIM = 64
POOL_WIDTH = POOL_GROUPS * POOL_GROUP_DIM
SGU_GROUPS = 4
SGU_GROUP_DIM = 64
SGU_WIDTH = SGU_GROUPS * SGU_GROUP_DIM
CHUNK = 128
N_BRANCHES = 3
D_FF = 2816
EPS = 1e-6
N_MOD = 9
OFF_Q = 0
OFF_K = OFF_Q + ATTN_WIDTH
OFF_V = OFF_K + KV_WIDTH
OFF_POOL = OFF_V + KV_WIDTH
OFF_SGU = OFF_POOL + POOL_WIDTH
OFF_GATE = OFF_SGU + 2 * SGU_WIDTH
IN_COLS = OFF_GATE + N_BRANCHES * D_MODEL

kernel_name = 'hybrid_pool_gqa_sgu_macaron_dit'


def rms_norm(x, g):
    xf = x.astype(jnp.float32)
    y = xf * lax.rsqrt(jnp.mean(xf * xf, axis=-1, keepdims=True) + EPS)
    return (y * g.astype(jnp.float32)).astype(x.dtype)


def modulate(x, g, shift, scale):
    return rms_norm(x, g) * (1 + scale) + shift


def adaln(cond, w, b):
    mod = jax.nn.silu(cond) @ w + b
    return jnp.split(mod[..., None, :], N_MOD, axis=-1)


def swiglu(x, w13, w2):
    a, b = jnp.split(x @ w13, 2, axis=-1)
    return (jax.nn.silu(a) * b) @ w2


def split_cols(p):
    return (p[..., OFF_Q:OFF_K], p[..., OFF_K:OFF_V], p[..., OFF_V:OFF_POOL],
            p[..., OFF_POOL:OFF_SGU], p[..., OFF_SGU:OFF_GATE], p[..., OFF_GATE:IN_COLS])


def axial_rope_tables(L):
    rows = L // GRID_W
    row = jnp.broadcast_to(jnp.arange(rows, dtype=jnp.int32)[:, None], (rows, GRID_W)).reshape(-1)
    col = jnp.broadcast_to(jnp.arange(GRID_W, dtype=jnp.int32)[None, :], (rows, GRID_W)).reshape(-1)
    half = HEAD_DIM // 2
    inv_freq = ROPE_THETA ** (-jnp.arange(0, half, 2, dtype=jnp.float32) / half)
    ang = jnp.stack([row.astype(jnp.float32)[:, None] * inv_freq[None, :],
                     col.astype(jnp.float32)[:, None] * inv_freq[None, :]])
    return jnp.cos(ang), jnp.sin(ang)


def rope_1d(x, cos, sin):
    cos = cos.astype(x.dtype)[None, :, None, :]
    sin = sin.astype(x.dtype)[None, :, None, :]
    x1, x2 = jnp.split(x, 2, axis=-1)
    return jnp.concatenate([x1 * cos - x2 * sin, x2 * cos + x1 * sin], axis=-1)


def apply_axial_rope(x, cos, sin):
    xr, xc = jnp.split(x, 2, axis=-1)
    return jnp.concatenate([rope_1d(xr, cos[0], sin[0]), rope_1d(xc, cos[1], sin[1])], axis=-1)


def gqa_softmax(q, k, v):
    s = jnp.einsum('bqkgd,bskd->bkgqs', q, k).astype(jnp.float32) * (HEAD_DIM ** -0.5)
    p = jax.nn.softmax(s, axis=-1).astype(v.dtype)
    return jnp.einsum('bkgqs,bskd->bqkgd', p, v)


def latent_attention(q, k_lat, v_lat, k_ctx, v_ctx):
    B, L = q.shape[0], q.shape[1]
    G = N_HEADS // N_KV_HEADS
    k_all = jnp.concatenate([k_lat, k_ctx], axis=1)
    v_all = jnp.concatenate([v_lat, v_ctx], axis=1)
    nblk = L // Q_BLOCK
    qb = q.reshape(B, nblk, Q_BLOCK, N_KV_HEADS, G, HEAD_DIM).transpose(1, 0, 2, 3, 4, 5)
    out = lax.map(lambda qblk: gqa_softmax(qblk, k_all, v_all), qb)
    return out.transpose(1, 0, 2, 3, 4, 5).reshape(B, L, ATTN_WIDTH)


def context_attention(q, k, v):
    B, C = q.shape[0], q.shape[1]
    G = N_HEADS // N_KV_HEADS
    out = gqa_softmax(q.reshape(B, C, N_KV_HEADS, G, HEAD_DIM), k, v)
    return out.reshape(B, C, ATTN_WIDTH)


def pool_mix(x, w, scale):
    B, L = x.shape[0], x.shape[1]
    xg = x.reshape(B, L, POOL_GROUPS, POOL_GROUP_DIM)
    xf = xg.astype(jnp.float32)
    cs = jnp.concatenate([jnp.zeros((B, 1, POOL_GROUPS, POOL_GROUP_DIM), jnp.float32),
                          jnp.cumsum(xf, axis=1)], axis=1)
    t = jnp.arange(L, dtype=jnp.int32)
    means = []
    for gi, win in enumerate(POOL_WINDOWS):
        lo = jnp.clip(t - win // 2, 0, L)
        hi = jnp.clip(t + win // 2, 0, L)
        cnt = (hi - lo).astype(jnp.float32)[None, :, None]
        means.append((cs[:, hi, gi] - cs[:, lo, gi]) / cnt)
    pooled = (jnp.stack(means, axis=2) - xf).astype(x.dtype)
    y = jnp.einsum('blgc,gcd->blgd', pooled, w).reshape(B, L, POOL_WIDTH)
    return y * scale


def sgu_mix(uv, norm_g, w_s, b_s):
    B, L = uv.shape[0], uv.shape[1]
    u, v = jnp.split(jax.nn.gelu(uv), 2, axis=-1)
    v = rms_norm(v, norm_g)
    vc = v.reshape(B, L // CHUNK, CHUNK, SGU_GROUPS, SGU_GROUP_DIM)
    s = jnp.einsum('gts,bnsgc->bntgc', w_s, vc) + b_s.T[None, None, :, :, None]
    return u * s.reshape(B, L, SGU_WIDTH)


def merge_branches(pool_out, attn_out, sgu_out, gate_logits, w_br_pool, w_br_attn, w_br_sgu, w_out):
    g = jax.nn.sigmoid(gate_logits)
    merged = (g[..., :D_MODEL] * (pool_out @ w_br_pool)
              + g[..., D_MODEL:2 * D_MODEL] * (attn_out @ w_br_attn)
              + g[..., 2 * D_MODEL:] * (sgu_out @ w_br_sgu))
    return merged @ w_out


def setup_inputs(seed: int = 0) -> dict:
    key = jax.random.key(seed)
    ks = jax.random.split(key, 26)
    f32 = jnp.float32

    def nrm(k, shape, scale):
        return jax.random.normal(k, shape, f32) * scale

    def gain(k, shape):
        return 1.0 + 0.05 * jax.random.normal(k, shape, f32)

    D = D_MODEL
    return {
        'x': nrm(ks[0], (BATCH, SEQ, D), 1.0),
        'c': nrm(ks[1], (BATCH, D), 1.0),
        'ctx': nrm(ks[2], (BATCH, CTX_LEN, D), 1.0),
        'c_ctx': nrm(ks[3], (D,), 1.0),
        'w_ada': nrm(ks[4], (DEPTH, D, N_MOD * D), 0.5 * D ** -0.5),
        'b_ada': nrm(ks[5], (DEPTH, N_MOD * D), 0.02),
        'norm_ffn1': gain(ks[6], (DEPTH, D)),
        'ffn1_w13': nrm(ks[7], (DEPTH, D, 2 * D_FF), D ** -0.5),
        'ffn1_w2': nrm(ks[8], (DEPTH, D_FF, D), D_FF ** -0.5),
        'norm_mix': gain(ks[9], (DEPTH, D)),
        'w_in': nrm(ks[10], (DEPTH, D, IN_COLS), D ** -0.5),
        'q_norm': gain(ks[11], (DEPTH, HEAD_DIM)),
        'k_norm': gain(ks[12], (DEPTH, HEAD_DIM)),
        'pool_w': nrm(ks[13], (DEPTH, POOL_GROUPS, POOL_GROUP_DIM, POOL_GROUP_DIM), POOL_GROUP_DIM ** -0.5),
        'pool_scale': gain(ks[14], (DEPTH, POOL_WIDTH)),
        'sgu_norm': gain(ks[15], (DEPTH, SGU_WIDTH)),
        'sgu_w': nrm(ks[16], (DEPTH, SGU_GROUPS, CHUNK, CHUNK), CHUNK ** -0.5),
        'sgu_b': 1.0 + nrm(ks[17], (DEPTH, SGU_GROUPS, CHUNK), 0.02),
        'w_br_pool': nrm(ks[18], (DEPTH, POOL_WIDTH, D), POOL_WIDTH ** -0.5),
        'w_br_attn': nrm(ks[19], (DEPTH, ATTN_WIDTH, D), ATTN_WIDTH ** -0.5),
        'w_br_sgu': nrm(ks[20], (DEPTH, SGU_WIDTH, D), SGU_WIDTH ** -0.5),
        'w_out': nrm(ks[21], (DEPTH, D, D), D ** -0.5),
        'norm_ffn2': gain(ks[22], (DEPTH, D)),
        'ffn2_w13': nrm(ks[23], (DEPTH, D, 2 * D_FF), D ** -0.5),
        'ffn2_w2': nrm(ks[24], (DEPTH, D_FF, D), D_FF ** -0.5),
        'final_norm': gain(ks[25], (D,)),
    }


def reference(x, c, ctx, c_ctx, w_ada, b_ada, norm_ffn1, ffn1_w13, ffn1_w2, norm_mix, w_in,
              q_norm, k_norm, pool_w, pool_scale, sgu_norm, sgu_w, sgu_b, w_br_pool, w_br_attn,
              w_br_sgu, w_out, norm_ffn2, ffn2_w13, ffn2_w2, final_norm):
    B, L = x.shape[0], x.shape[1]
    C = ctx.shape[1]
    cos, sin = axial_rope_tables(L)
    h, hc = x, ctx
    for l in range(DEPTH):
        last = l == DEPTH - 1
        m = adaln(c, w_ada[l], b_ada[l])
        mc = adaln(c_ctx, w_ada[l], b_ada[l])

        h = h + 0.5 * m[2] * swiglu(modulate(h, norm_ffn1[l], m[0], m[1]), ffn1_w13[l], ffn1_w2[l])
        hc = hc + 0.5 * mc[2] * swiglu(modulate(hc, norm_ffn1[l], mc[0], mc[1]), ffn1_w13[l], ffn1_w2[l])

        hn = modulate(h, norm_mix[l], m[3], m[4])
        hnc = modulate(hc, norm_mix[l], mc[3], mc[4])
        q, k, v, pool_in, sgu_in, gate_logits = split_cols(hn @ w_in[l])
        q = apply_axial_rope(rms_norm(q.reshape(B, L, N_HEADS, HEAD_DIM), q_norm[l]), cos, sin)
        k = apply_axial_rope(rms_norm(k.reshape(B, L, N_KV_HEADS, HEAD_DIM), k_norm[l]), cos, sin)
        v = v.reshape(B, L, N_KV_HEADS, HEAD_DIM)
        if last:
            kv_c = hnc @ w_in[l][:, OFF_K:OFF_POOL]
            k_c, v_c = kv_c[..., :KV_WIDTH], kv_c[..., KV_WIDTH:]
        else:
            q_c, k_c, v_c, pool_c, sgu_c, gate_c = split_cols(hnc @ w_in[l])
        k_c = rms_norm(k_c.reshape(B, C, N_KV_HEADS, HEAD_DIM), k_norm[l])
        v_c = v_c.reshape(B, C, N_KV_HEADS, HEAD_DIM)

        attn = latent_attention(q, k, v, k_c, v_c)
        out = merge_branches(pool_mix(pool_in, pool_w[l], pool_scale[l]), attn,
                             sgu_mix(sgu_in, sgu_norm[l], sgu_w[l], sgu_b[l]), gate_logits,
                             w_br_pool[l], w_br_attn[l], w_br_sgu[l], w_out[l])
        h = h + m[5] * out

        if not last:
            q_c = rms_norm(q_c.reshape(B, C, N_HEADS, HEAD_DIM), q_norm[l])
            attn_c = context_attention(q_c, k_c, v_c)
            out_c = merge_branches(pool_mix(pool_c, pool_w[l], pool_scale[l]), attn_c,
                                   sgu_mix(sgu_c, sgu_norm[l], sgu_w[l], sgu_b[l]), gate_c,
                                   w_br_pool[l], w_br_attn[l], w_br_sgu[l], w_out[l])
            hc = hc + mc[5] * out_c
            hc = hc + 0.5 * mc[8] * swiglu(modulate(hc, norm_ffn2[l], mc[6], mc[7]), ffn2_w13[l], ffn2_w2[l])

        h = h + 0.5 * m[8] * swiglu(modulate(h, norm_ffn2[l], m[6], m[7]), ffn2_w13[l], ffn2_w2[l])
    return rms_norm(h, final_norm)
```

```cpp
#include <hip/hip_runtime.h>
#include <hip/hip_cooperative_groups.h>
#include <cstdio>
#include <cstdint>
namespace cg = cooperative_groups;

#ifndef MK_ONE_LAUNCH
#define MK_ONE_LAUNCH 1
#endif

#define LAS __attribute__((address_space(3)))
typedef unsigned short bf16_t;
typedef short bf16x8 __attribute__((ext_vector_type(8)));
typedef float f32x4 __attribute__((ext_vector_type(4)));
typedef float f32x16 __attribute__((ext_vector_type(16)));
typedef unsigned u32x4 __attribute__((ext_vector_type(4)));
typedef unsigned u32x2 __attribute__((ext_vector_type(2)));
typedef float f32x2_t __attribute__((ext_vector_type(2)));
typedef __bf16 bf16x2_t __attribute__((ext_vector_type(2)));

constexpr int DM = 1024, NBATCH = 16, SEQ = 2048, CTXL = 256;
constexpr int TL = NBATCH * SEQ;
constexpr int TC = NBATCH * CTXL;
constexpr int TT = TL + TC;
constexpr int DFF = 2816, NIN = 4608, NPC = 1536, NGC = 3072, NMOD = 9 * DM;
constexpr int KVPOS = SEQ + CTXL;
constexpr float EPS = 1e-6f;
constexpr float QSCALE = 0.125f * 1.4426950408889634f;

constexpr size_t MiB = 1u << 20;
constexpr size_t al256(size_t x) { return (x + 255) & ~(size_t)255; }
constexpr size_t SZ_W13 = (size_t)2 * DFF * DM * 2, SZ_W2 = (size_t)DM * DFF * 2, SZ_WIN = (size_t)NIN * DM * 2, SZ_WSQ = (size_t)DM * DM * 2;
constexpr size_t WS_W13A = 0;
constexpr size_t WS_W2A = WS_W13A + SZ_W13;
constexpr size_t WS_WIN = WS_W2A + SZ_W2;
constexpr size_t WS_WCAT = WS_WIN + SZ_WIN;
constexpr size_t WS_WOUT = WS_WCAT + SZ_WSQ;
constexpr size_t WS_W13B = WS_WOUT + SZ_WSQ;
constexpr size_t WS_W2B = WS_W13B + SZ_W13;
constexpr size_t WS_SGUW = WS_W2B + SZ_W2;
constexpr size_t WS_MOD = al256(WS_SGUW + 4 * 128 * 128 * 2);
constexpr size_t WS_B13A = al256(WS_MOD + (size_t)2 * 17 * NMOD * 4);
constexpr size_t WS_BIN = al256(WS_B13A + (size_t)17 * 2 * DFF * 4);
constexpr size_t WS_B13B = al256(WS_BIN + (size_t)17 * NIN * 4);
constexpr size_t WS_SSQ = al256(WS_B13B + (size_t)17 * 2 * DFF * 4);
constexpr size_t WS_ROPE = al256(WS_SSQ + (size_t)7 * TT * 4);
constexpr size_t WS_HCTX = al256(WS_ROPE + (size_t)SEQ * 32 * 8);
constexpr size_t WS_AP = al256(WS_HCTX + (size_t)TC * DM * 4);
constexpr size_t WS_KB = al256(WS_AP + (size_t)TT * DM * 2);
constexpr size_t WS_VT = al256(WS_KB + (size_t)TT * 128 * 2);
constexpr size_t WS_P = al256(WS_VT + (size_t)NBATCH * 2 * 64 * KVPOS * 2);
constexpr size_t WS_G = al256(WS_P + (size_t)TT * NPC * 2);
constexpr size_t WS_END = al256(WS_G + (size_t)TT * NGC * 2);

constexpr int LDS_BYTES = 147456;
constexpr int NPHASES = 23;

__device__ __forceinline__ unsigned cvtpk(float lo, float hi) { f32x2_t v = {lo, hi}; bf16x2_t b = __builtin_convertvector(v, bf16x2_t); return __builtin_bit_cast(unsigned, b); }
__device__ __forceinline__ float bflo(unsigned u) { return __uint_as_float(u << 16); }
__device__ __forceinline__ float bfhi(unsigned u) { return __uint_as_float(u & 0xffff0000u); }
__device__ __forceinline__ float fexp(float x) { return __builtin_amdgcn_exp2f(x * 1.4426950408889634f); }
__device__ __forceinline__ float frcp(float x) { return __builtin_amdgcn_rcpf(x); }
__device__ __forceinline__ float sigm(float x) { return frcp(1.f + fexp(-x)); }
__device__ __forceinline__ float gelu_t(float x) { const float z = 0.7978845608028654f * (x + 0.044715f * x * x * x); return x * frcp(1.f + fexp(-2.f * z)); }
#define LDS_WAIT() asm volatile("s_waitcnt lgkmcnt(0)" ::: "memory")
__device__ __forceinline__ uintptr_t uni64(uintptr_t v) { const unsigned lo = __builtin_amdgcn_readfirstlane((unsigned)v), hi = __builtin_amdgcn_readfirstlane((unsigned)(v >> 32)); return ((uintptr_t)hi << 32) | lo; }

namespace pg8 {
constexpr int BM = 256, BK = 64, HALF = 128, HTB = HALF * BK * 2, STAGE_BYTES = 8 * HTB, NXCD = 8, WGM = 8;
__device__ __forceinline__ int lds_byte(int r, int c) { const int st = (r >> 4) * 2 + (c >> 5), rr = r & 15, cc = c & 31, ob = rr * 64 + cc * 2; return st * 1024 + (ob ^ (((ob >> 9) & 1) << 5)); }
__device__ __forceinline__ void stage_rc(int b, int& R, int& C) { const int st = b / 1024, sb = b % 1024, swz = sb ^ (((sb >> 9) & 1) << 5); R = (st >> 1) * 16 + swz / 64; C = (st & 1) * 32 + (swz % 64) / 2; }
__device__ __forceinline__ int perm32(int rho) { const int n = rho >> 4, i = rho & 15; return 8 * (i >> 2) + 4 * n + (i & 3); }

struct Unit { int pm, pn, k0, nt, tag; };

struct TileSched {
    int c, G, nM1, nN1, n1, pn0_1, n2, pm0_2, pn0_2, nb, ntk;
    __device__ __forceinline__ bool next(int i, Unit& u) const {
        int ti = i, br = 0;
        if (nb == 3) { ti = i / 3; br = i - ti * 3; }
        const int L = ti * G + c;
        if (L < n1) {
            int wgid; { const int q = n1 / NXCD, r = n1 % NXCD, xcd = L % NXCD, off = L / NXCD; wgid = (xcd < r ? xcd * (q + 1) : r * (q + 1) + (xcd - r) * q) + off; }
            const int nig = WGM * nN1, gid = wgid / nig, fm = gid * WGM, gsz = (nM1 - fm) < WGM ? (nM1 - fm) : WGM;
            u.pm = fm + ((wgid % nig) % gsz); u.pn = pn0_1 + (wgid % nig) / gsz;
        } else if (L - n1 < n2) { u.pm = pm0_2 + (L - n1); u.pn = pn0_2; }
        else return false;
        if (nb == 3) { u.k0 = br * 256 + (br >> 1) * 256; u.nt = 4 + 4 * (br & 1); }
        else { u.k0 = 0; u.nt = ntk; }
        u.tag = br;
        return true;
    }
};
__device__ __forceinline__ TileSched make_sched(int nM1, int nN1, int K) {
    TileSched s; s.c = blockIdx.x; s.G = gridDim.x; s.nM1 = nM1; s.nN1 = nN1; s.n1 = nM1 * nN1; s.pn0_1 = 0; s.n2 = 0; s.pm0_2 = 0; s.pn0_2 = 0; s.nb = 1;
    s.ntk = K / BK; return s;
}

__device__ __forceinline__ int unit_mb(const Unit& u) { return u.pm < 128 ? (u.pm >> 3) : 16; }

struct EpiSwiGLU {
    bf16_t* act; const float* bias; const float* ssq;
    __device__ __forceinline__ void operator()(const f32x4 (&acc)[2][2][4][2], const Unit& u, int wr, int wc, int fr, int fq) const {
        const int mb = unit_mb(u);
        const float* bp = bias + (size_t)mb * (2 * DFF) + u.pn * 256 + wc * 32 + 8 * fq;
        f32x4 ba[2], bb[2];
#pragma unroll
        for (int n = 0; n < 2; ++n) { ba[n] = *(const f32x4*)(bp + 4 * n); bb[n] = *(const f32x4*)(bp + 128 + 4 * n); }
        const int row0 = u.pm * 256 + wr * 64 + fr;
        bf16_t* op = act + (size_t)row0 * DFF + u.pn * 128 + wc * 32 + 8 * fq;
#pragma unroll
        for (int ai = 0; ai < 2; ++ai)
#pragma unroll
            for (int m = 0; m < 4; ++m) {
                const int ro = ai * 128 + m * 16;
                const float r = __builtin_amdgcn_rsqf(ssq[row0 + ro] * (1.f / DM) + EPS);
                f32x4 a0 = acc[ai][0][m][0] * r + ba[0], a1 = acc[ai][0][m][1] * r + ba[1], b0 = acc[ai][1][m][0] * r + bb[0], b1 = acc[ai][1][m][1] * r + bb[1];
                f32x4 o0, o1;
#pragma unroll
                for (int i = 0; i < 4; ++i) { o0[i] = a0[i] * b0[i] * sigm(a0[i]); o1[i] = a1[i] * b1[i] * sigm(a1[i]); }
                u32x4 w; w.x = cvtpk(o0[0], o0[1]); w.y = cvtpk(o0[2], o0[3]); w.z = cvtpk(o1[0], o1[1]); w.w = cvtpk(o1[2], o1[3]);
                *(u32x4*)(op + (size_t)ro * DFF) = w;
            }
    }
};
struct EpiIn {
    bf16_t* P; bf16_t* G; const float* bias; const float* ssq;
    __device__ __forceinline__ void operator()(const f32x4 (&acc)[2][2][4][2], const Unit& u, int wr, int wc, int fr, int fq) const {
        const int mb = unit_mb(u);
        const int colt = u.pn * 256, cw = wc * 32 + 8 * fq;
        const float* bp = bias + (size_t)mb * NIN + colt + cw;
        f32x4 bv[2][2];
#pragma unroll
        for (int bj = 0; bj < 2; ++bj)
#pragma unroll
            for (int n = 0; n < 2; ++n) bv[bj][n] = *(const f32x4*)(bp + bj * 128 + 4 * n);
        const int row0 = u.pm * 256 + wr * 64 + fr;
        const bool gate = u.pn >= 6;
        bf16_t* base = gate ? G + (size_t)row0 * NGC + (colt - NPC) + cw : P + (size_t)row0 * NPC + colt + cw;
        const size_t ld = gate ? NGC : NPC;
#pragma unroll
        for (int ai = 0; ai < 2; ++ai)
#pragma unroll
            for (int m = 0; m < 4; ++m) {
                const int ro = ai * 128 + m * 16;
                const float r = __builtin_amdgcn_rsqf(ssq[row0 + ro] * (1.f / DM) + EPS);
#pragma unroll
                for (int bj = 0; bj < 2; ++bj) {
                    f32x4 v0 = acc[ai][bj][m][0] * r + bv[bj][0], v1 = acc[ai][bj][m][1] * r + bv[bj][1];
                    if (gate) {
#pragma unroll
                        for (int i = 0; i < 4; ++i) { v0[i] = sigm(v0[i]); v1[i] = sigm(v1[i]); }
                    }
                    u32x4 w; w.x = cvtpk(v0[0], v0[1]); w.y = cvtpk(v0[2], v0[3]); w.z = cvtpk(v1[0], v1[1]); w.w = cvtpk(v1[2], v1[3]);
                    *(u32x4*)(base + (size_t)ro * ld + bj * 128) = w;
                }
            }
    }
};
struct EpiRes {
    uintptr_t hin_l, hin_cd, hout_l, hout_cd; const float* gate; float coef; const float* nrm; const float* scl; float* ssq; bf16_t* Ap;
    __device__ __forceinline__ void operator()(const f32x4 (&acc)[2][2][4][2], const Unit& u, int wr, int wc, int fr, int fq) const {
        const int mb = unit_mb(u);
        const bool lat = u.pm < 128;
        uintptr_t hin_l = this->hin_l, hin_cd = this->hin_cd, hout_l = this->hout_l, hout_cd = this->hout_cd; const float* gate = this->gate; float coef = this->coef;
        const float* nrm = this->nrm; const float* scl = this->scl; float* ssq = this->ssq; bf16_t* Ap = this->Ap;
        hin_l = uni64(hin_l); hin_cd = uni64(hin_cd); hout_l = uni64(hout_l); hout_cd = uni64(hout_cd); gate = (const float*)uni64((uintptr_t)gate); coef = __uint_as_float(__builtin_amdgcn_readfirstlane(__float_as_uint(coef)));
        nrm = (const float*)uni64((uintptr_t)nrm); scl = (const float*)uni64((uintptr_t)scl); ssq = (float*)uni64((uintptr_t)ssq); Ap = (bf16_t*)uni64((uintptr_t)Ap);
        const int col0 = u.pn * 256 + wc * 32 + 8 * fq, row0 = u.pm * 256 + wr * 64 + fr, rowl = lat ? row0 : row0 - TL;
        const float* hi = (const float*)(hin_l + (lat ? (uintptr_t)0 : hin_cd)) + (size_t)rowl * DM + col0;
        float* ho = (float*)(hout_l + (lat ? (uintptr_t)0 : hout_cd)) + (size_t)rowl * DM + col0;
        f32x4 gc[2][2], gs[2][2];
#pragma unroll
        for (int bj = 0; bj < 2; ++bj)
#pragma unroll
            for (int n = 0; n < 2; ++n) {
                gc[bj][n] = *(const f32x4*)(gate + (size_t)mb * NMOD + col0 + 128 * bj + 4 * n) * coef;
                if (Ap) gs[bj][n] = *(const f32x4*)(nrm + col0 + 128 * bj + 4 * n) * (*(const f32x4*)(scl + (size_t)mb * NMOD + col0 + 128 * bj + 4 * n) + 1.f);
                else gs[bj][n] = (f32x4){0.f, 0.f, 0.f, 0.f};
            }
#pragma unroll
        for (int ai = 0; ai < 2; ++ai)
#pragma unroll
            for (int m = 0; m < 4; ++m) {
                const int ro = ai * 128 + m * 16; const size_t off = (size_t)ro * DM;
                float ss = 0.f;
#pragma unroll
                for (int bj = 0; bj < 2; ++bj) {
                    f32x4 h0 = *(const f32x4*)(hi + off + 128 * bj), h1 = *(const f32x4*)(hi + off + 128 * bj + 4);
                    h0 += gc[bj][0] * acc[ai][bj][m][0]; h1 += gc[bj][1] * acc[ai][bj][m][1];
                    *(f32x4*)(ho + off + 128 * bj) = h0; *(f32x4*)(ho + off + 128 * bj + 4) = h1;
                    ss += (h0[0] * h0[0] + h0[1] * h0[1]) + (h0[2] * h0[2] + h0[3] * h0[3]) + (h1[0] * h1[0] + h1[1] * h1[1]) + (h1[2] * h1[2] + h1[3] * h1[3]);
                    if (Ap) { const f32x4 a0 = h0 * gs[bj][0], a1 = h1 * gs[bj][1];
                        u32x4 w; w.x = cvtpk(a0[0], a0[1]); w.y = cvtpk(a0[2], a0[3]); w.z = cvtpk(a1[0], a1[1]); w.w = cvtpk(a1[2], a1[3]);
                        *(u32x4*)(Ap + (size_t)(row0 + ro) * DM + col0 + 128 * bj) = w; }
                }
                ss += __shfl_xor(ss, 16); ss += __shfl_xor(ss, 32);
                if (fq == 0) atomicAdd(ssq + row0 + ro, ss);
            }
    }
};
struct EpiMerge {
    const bf16_t* G; bf16_t* Mg;
    __device__ __forceinline__ void operator()(const f32x4 (&acc)[2][2][4][2], const Unit& u, int wr, int wc, int fr, int fq) const {
        const int br = u.tag, col0 = u.pn * 256 + wc * 32 + 8 * fq, row0 = u.pm * 256 + wr * 64 + fr;
#pragma unroll
        for (int ai = 0; ai < 2; ++ai)
#pragma unroll
            for (int m = 0; m < 4; ++m) {
                const int row = row0 + ai * 128 + m * 16;
#pragma unroll
                for (int bj = 0; bj < 2; ++bj) {
                    const u32x4 g = *(const u32x4*)(G + (size_t)row * NGC + br * 1024 + col0 + 128 * bj);
                    const f32x4 c0 = acc[ai][bj][m][0], c1 = acc[ai][bj][m][1];
                    f32x4 v0, v1;
                    v0[0] = bflo(g.x) * c0[0]; v0[1] = bfhi(g.x) * c0[1]; v0[2] = bflo(g.y) * c0[2]; v0[3] = bfhi(g.y) * c0[3];
                    v1[0] = bflo(g.z) * c1[0]; v1[1] = bfhi(g.z) * c1[1]; v1[2] = bflo(g.w) * c1[2]; v1[3] = bfhi(g.w) * c1[3];
                    bf16_t* mp = Mg + (size_t)row * DM + col0 + 128 * bj;
                    if (br > 0) {
                        const unsigned long long p0 = __hip_atomic_load((const unsigned long long*)mp, __ATOMIC_RELAXED, __HIP_MEMORY_SCOPE_AGENT);
                        const unsigned long long p1 = __hip_atomic_load((const unsigned long long*)mp + 1, __ATOMIC_RELAXED, __HIP_MEMORY_SCOPE_AGENT);
                        const unsigned a = (unsigned)p0, b = (unsigned)(p0 >> 32), c = (unsigned)p1, d = (unsigned)(p1 >> 32);
                        v0[0] += bflo(a); v0[1] += bfhi(a); v0[2] += bflo(b); v0[3] += bfhi(b);
                        v1[0] += bflo(c); v1[1] += bfhi(c); v1[2] += bflo(d); v1[3] += bfhi(d);
                    }
                    u32x4 w; w.x = cvtpk(v0[0], v0[1]); w.y = cvtpk(v0[2], v0[3]); w.z = cvtpk(v1[0], v1[1]); w.w = cvtpk(v1[2], v1[3]);
                    *(u32x4*)mp = w;
                }
            }
    }
};

template <class Epi>
__device__ __forceinline__ void gemm_phase(const int tid, LAS unsigned char* lds, const bf16_t* Ab, int lda, const bf16_t* Bb, int ldb, const TileSched& S, const Epi& E) {
    const int wid = __builtin_amdgcn_readfirstlane(tid >> 6), lane = tid & 63, wr = wid >> 2, wc = wid & 3, fr = lane & 15, fq = lane >> 4;
    unsigned voffA[2], voffB[2];
#pragma unroll
    for (int i = 0; i < 2; ++i) { int R, C; stage_rc(tid * 16 + i * 8192, R, C); const int Rb = (R & ~31) + perm32(R & 31);
        voffA[i] = (unsigned)(R * lda + C) * 2u; voffB[i] = (unsigned)(Rb * ldb + C) * 2u; }
    const size_t kstep = (size_t)(BK * 2);
    const size_t hsA = (size_t)HALF * lda * 2, hsB = (size_t)HALF * ldb * 2;
    const unsigned ldsw = (unsigned)wid * 1024u;
    const int aoff = lds_byte(wr * 64 + fr, fq * 8), boff = lds_byte(wc * 32 + fr, fq * 8);
#define PG8_SA(b, h) (((b) * 2 + (h)) * HTB)
#define PG8_SB(b, h) ((4 + (b) * 2 + (h)) * HTB)
#define PG8_STAGE(bufoff, gbase, voff) do { _Pragma("unroll") for (int _i = 0; _i < 2; ++_i) \
        __builtin_amdgcn_global_load_lds((const unsigned*)((const char*)(gbase) + (voff)[_i]), (LAS unsigned*)(lds + (bufoff) + ldsw + _i * 8192), 16, 0, 0); } while (0)
#define PG8_LDA(dst, b, h) do { _Pragma("unroll") for (int m = 0; m < 4; ++m) _Pragma("unroll") for (int k = 0; k < 2; ++k) dst[m][k] = *(const LAS bf16x8*)(lds + PG8_SA(b, h) + aoff + m * 2048 + k * 1024); } while (0)
#define PG8_LDB(dst, b, h) do { _Pragma("unroll") for (int n = 0; n < 2; ++n) _Pragma("unroll") for (int k = 0; k < 2; ++k) dst[n][k] = *(const LAS bf16x8*)(lds + PG8_SB(b, h) + boff + n * 2048 + k * 1024); } while (0)
#define PG8_MMA(ai, bj, At, Bt) do { __builtin_amdgcn_s_setprio(1); _Pragma("unroll") for (int m = 0; m < 4; ++m) _Pragma("unroll") for (int n = 0; n < 2; ++n) _Pragma("unroll") for (int k = 0; k < 2; ++k) \
        acc[ai][bj][m][n] = __builtin_amdgcn_mfma_f32_16x16x32_bf16(Bt[n][k], At[m][k], acc[ai][bj][m][n], 0, 0, 0); __builtin_amdgcn_s_setprio(0); } while (0)
#define PG8_WAIT_V(n) asm volatile("s_waitcnt vmcnt(" #n ")" ::: "memory")
#define PG8_WAIT_L(n) asm volatile("s_waitcnt lgkmcnt(" #n ")" ::: "memory")
#define PG8_BAR __builtin_amdgcn_s_barrier()
#define PG8_SCHED __builtin_amdgcn_sched_barrier(0)
    Unit cur, nxt; int ui = 0;
    if (!S.next(0, cur)) return;
    f32x4 acc[2][2][4][2];
#pragma unroll
    for (int a = 0; a < 2; ++a)
#pragma unroll
        for (int b = 0; b < 2; ++b)
#pragma unroll
            for (int m = 0; m < 4; ++m)
#pragma unroll
                for (int n = 0; n < 2; ++n) acc[a][b][m][n] = (f32x4){0.f, 0.f, 0.f, 0.f};
    bf16x8 At[4][2], B0[2][2], B1[2][2];
    const char* cA = (const char*)Ab + (size_t)cur.pm * 2 * hsA + (size_t)cur.k0 * 2; const char* cB = (const char*)Bb + (size_t)cur.pn * 2 * hsB + (size_t)cur.k0 * 2;
    PG8_STAGE(PG8_SB(0, 0), cB, voffB); PG8_STAGE(PG8_SB(0, 1), cB + hsB, voffB); PG8_STAGE(PG8_SA(0, 0), cA, voffA); PG8_STAGE(PG8_SA(0, 1), cA + hsA, voffA);
    if (wr == 1) PG8_BAR;
    PG8_WAIT_V(2); PG8_BAR;
    PG8_STAGE(PG8_SB(1, 0), cB + kstep, voffB); PG8_STAGE(PG8_SA(1, 0), cA + kstep, voffA); PG8_STAGE(PG8_SB(1, 1), cB + hsB + kstep, voffB);
    PG8_WAIT_V(6); PG8_BAR;
    for (;;) {
        const bool has_next = S.next(ui + 1, nxt);
        const char* nA = has_next ? (const char*)Ab + (size_t)nxt.pm * 2 * hsA + (size_t)nxt.k0 * 2 : cA;
        const char* nB = has_next ? (const char*)Bb + (size_t)nxt.pn * 2 * hsB + (size_t)nxt.k0 * 2 : cB;
        const int nt = cur.nt;
        for (int t = 0; t < nt; t += 2) {
            const bool last = (t == nt - 2);
            const char* a1 = cA + (size_t)(t + 1) * kstep;
            const char* a2 = last ? nA : cA + (size_t)(t + 2) * kstep; const char* b2 = last ? nB : cB + (size_t)(t + 2) * kstep;
            const char* a3 = a2 + kstep; const char* b3 = b2 + kstep;
            PG8_LDB(B0, 0, 0); PG8_LDB(B1, 0, 1); PG8_SCHED; PG8_LDA(At, 0, 0); PG8_STAGE(PG8_SA(1, 1), a1 + hsA, voffA);
            PG8_WAIT_V(8); PG8_WAIT_L(0); PG8_BAR; PG8_MMA(0, 0, At, B0); PG8_MMA(0, 1, At, B1); PG8_BAR; PG8_SCHED;
            PG8_LDA(At, 0, 1); PG8_STAGE(PG8_SB(0, 0), b2, voffB); PG8_STAGE(PG8_SB(0, 1), b2 + hsB, voffB); PG8_STAGE(PG8_SA(0, 0), a2, voffA);
            PG8_WAIT_V(8); PG8_WAIT_L(0); PG8_BAR; PG8_MMA(1, 0, At, B0); PG8_MMA(1, 1, At, B1); PG8_BAR; PG8_SCHED;
            PG8_LDB(B0, 1, 0); PG8_LDB(B1, 1, 1); PG8_SCHED; PG8_LDA(At, 1, 0); PG8_STAGE(PG8_SA(0, 1), a2 + hsA, voffA);
            PG8_WAIT_V(8); PG8_WAIT_L(0); PG8_BAR; PG8_MMA(0, 0, At, B0); PG8_MMA(0, 1, At, B1); PG8_BAR; PG8_SCHED;
            PG8_LDA(At, 1, 1); PG8_STAGE(PG8_SB(1, 0), b3, voffB); PG8_STAGE(PG8_SB(1, 1), b3 + hsB, voffB); PG8_STAGE(PG8_SA(1, 0), a3, voffA);
            PG8_WAIT_V(8); PG8_WAIT_L(0); PG8_BAR; PG8_MMA(1, 0, At, B0); PG8_MMA(1, 1, At, B1); PG8_BAR; PG8_SCHED;
        }
        if (wr == 0) PG8_BAR;
        E(acc, cur, wr, wc, fr, fq);
        if (!has_next) break;
#pragma unroll
        for (int a = 0; a < 2; ++a)
#pragma unroll
            for (int b = 0; b < 2; ++b)
#pragma unroll
                for (int m = 0; m < 4; ++m)
#pragma unroll
                    for (int n = 0; n < 2; ++n) acc[a][b][m][n] = (f32x4){0.f, 0.f, 0.f, 0.f};
        cur = nxt; cA = nA; cB = nB; ++ui;
        if (wr == 1) PG8_BAR;
    }
    PG8_WAIT_V(0);
    PG8_BAR;
#undef PG8_SA
#undef PG8_SB
#undef PG8_STAGE
#undef PG8_LDA
#undef PG8_LDB
#undef PG8_MMA
#undef PG8_WAIT_V
#undef PG8_WAIT_L
#undef PG8_BAR
#undef PG8_SCHED
}
}

struct Args {
    const float* in[26];
    float* out; unsigned char* ws;
    int ph_lo, ph_hi;
};
enum { I_X = 0, I_C, I_CTX, I_CCTX, I_WADA, I_BADA, I_NFFN1, I_F1W13, I_F1W2, I_NMIX, I_WIN, I_QN, I_KN, I_POOLW, I_POOLS, I_SGUN, I_SGUW, I_SGUB,
       I_WBRP, I_WBRA, I_WBRS, I_WOUT, I_NFFN2, I_F2W13, I_F2W2, I_FNORM };

__device__ __forceinline__ float wave_sum(float v) {
#pragma unroll
    for (int o = 1; o < 64; o <<= 1) v += __shfl_xor(v, o);
    return v;
}

__device__ __forceinline__ void tr_item(const float* W, int N, bf16_t* WT, int ldt, int coloff, int mode13, float* scr, int item, int lane) {
    const int nblk = N / 32, kb = item / nblk, nb = item - kb * nblk, k0 = 64 * kb, n0 = 32 * nb;
#pragma unroll 8
    for (int i = 0; i < 32; ++i) { const int kk = 2 * i + (lane >> 5); scr[kk * 33 + (lane & 31)] = W[(size_t)(k0 + kk) * N + n0 + (lane & 31)]; }
    LDS_WAIT();
    int r0 = n0;
    if (mode13) { const int s = n0 / DFF, rem = n0 - s * DFF, t = rem >> 7, j = rem & 127; r0 = 256 * t + 128 * s + j; }
    const int c = lane & 7;
#pragma unroll
    for (int j = 0; j < 4; ++j) { const int n = (lane >> 3) + 8 * j; const float* s = scr + (8 * c) * 33 + n;
        u32x4 o; o.x = cvtpk(s[0 * 33], s[1 * 33]); o.y = cvtpk(s[2 * 33], s[3 * 33]); o.z = cvtpk(s[4 * 33], s[5 * 33]); o.w = cvtpk(s[6 * 33], s[7 * 33]);
        *(u32x4*)(WT + (size_t)(r0 + n) * ldt + coloff + k0 + 8 * c) = o; }
    LDS_WAIT();
}

__device__ __forceinline__ void convert_weights(const int tid, const Args& a, int l, unsigned char* lds) {
    const int lane = tid & 63, wave = tid >> 6;
    float* scr = (float*)(lds + wave * 8704);
    const int gw = blockIdx.x * 8 + wave, NGW = gridDim.x * 8;
    unsigned char* ws = a.ws;
    constexpr int I13 = (DM / 64) * (2 * DFF / 32), I2 = (DFF / 64) * (DM / 32), IIN = (DM / 64) * (NIN / 32), IOUT = (DM / 64) * (DM / 32), IBA = (512 / 64) * (DM / 32), IBS = (256 / 64) * (DM / 32);
    constexpr int NITEMS = 2 * I13 + 2 * I2 + IIN + IOUT + IBA + IBS;
    for (int it = gw; it < NITEMS; it += NGW) {
        int r = it; const float* W; int N; bf16_t* WT; int ldt = DM, coloff = 0, m13 = 0;
        if (r < 2 * I13) { const bool second = r >= I13; r -= second ? I13 : 0; W = a.in[second ? I_F2W13 : I_F1W13] + (size_t)l * DM * 2 * DFF; N = 2 * DFF; WT = (bf16_t*)(ws + (second ? WS_W13B : WS_W13A)); m13 = 1; }
        else if (r < 2 * I13 + 2 * I2) { r -= 2 * I13; const bool second = r >= I2; r -= second ? I2 : 0; W = a.in[second ? I_F2W2 : I_F1W2] + (size_t)l * DFF * DM; N = DM; WT = (bf16_t*)(ws + (second ? WS_W2B : WS_W2A)); ldt = DFF; }
        else if (r < 2 * I13 + 2 * I2 + IIN) { r -= 2 * I13 + 2 * I2; W = a.in[I_WIN] + (size_t)l * DM * NIN; N = NIN; WT = (bf16_t*)(ws + WS_WIN); }
        else if (r < 2 * I13 + 2 * I2 + IIN + IOUT) { r -= 2 * I13 + 2 * I2 + IIN; W = a.in[I_WOUT] + (size_t)l * DM * DM; N = DM; WT = (bf16_t*)(ws + WS_WOUT); }
        else if (r < 2 * I13 + 2 * I2 + IIN + IOUT + IBA) { r -= 2 * I13 + 2 * I2 + IIN + IOUT; W = a.in[I_WBRA] + (size_t)l * 512 * DM; N = DM; WT = (bf16_t*)(ws + WS_WCAT); coloff = 256; }
        else { r -= 2 * I13 + 2 * I2 + IIN + IOUT + IBA; W = a.in[I_WBRS] + (size_t)l * 256 * DM; N = DM; WT = (bf16_t*)(ws + WS_WCAT); coloff = 768; }
        tr_item(W, N, WT, ldt, coloff, m13, scr, r, lane);
    }
    {
        const float* pw = a.in[I_POOLW] + (size_t)l * 4 * 64 * 64; const float* ps = a.in[I_POOLS] + (size_t)l * 256; const float* wb = a.in[I_WBRP] + (size_t)l * 256 * DM;
        bf16_t* wcat = (bf16_t*)(ws + WS_WCAT);
        for (int it = blockIdx.x * 512 + tid; it < 1024 * 32; it += gridDim.x * 512) {
            const int n = it & 1023, kg = it >> 10, g = kg >> 3, c0 = (kg & 7) * 8;
            float s[8];
#pragma unroll
            for (int i = 0; i < 8; ++i) s[i] = 0.f;
            for (int d = 0; d < 64; ++d) {
                const float wv = wb[(size_t)(g * 64 + d) * DM + n] * ps[g * 64 + d];
#pragma unroll
                for (int i = 0; i < 8; ++i) s[i] += pw[(g * 64 + c0 + i) * 64 + d] * wv;
            }
            u32x4 o; o.x = cvtpk(s[0], s[1]); o.y = cvtpk(s[2], s[3]); o.z = cvtpk(s[4], s[5]); o.w = cvtpk(s[6], s[7]);
            *(u32x4*)(wcat + (size_t)n * DM + kg * 8) = o;
        }
    }
    {
        const float* sw = a.in[I_SGUW] + (size_t)l * 4 * 128 * 128; unsigned* dst = (unsigned*)(ws + WS_SGUW);
        for (int it = blockIdx.x * 512 + tid; it < 4 * 128 * 64; it += gridDim.x * 512) dst[it] = cvtpk(sw[2 * it], sw[2 * it + 1]);
    }
}

__device__ __forceinline__ void compute_biases(const int tid, const Args& a, int l, unsigned char* lds) {
    const int lane = tid & 63, wave = tid >> 6;
    float* sh = (float*)lds;
    const float* modl = (const float*)(a.ws + WS_MOD) + (size_t)l * 17 * NMOD;
    const int gw = blockIdx.x * 8 + wave, NGW = gridDim.x * 8;
    for (int j = 0; j < 3; ++j) {
        __syncthreads();
        for (int i = tid; i < 17 * DM; i += 512) sh[i] = modl[(size_t)(i >> 10) * NMOD + (3 * j) * DM + (i & 1023)];
        __syncthreads();
        const bf16_t* Wt = (const bf16_t*)(a.ws + (j == 0 ? WS_W13A : (j == 1 ? WS_WIN : WS_W13B)));
        float* bo = (float*)(a.ws + (j == 0 ? WS_B13A : (j == 1 ? WS_BIN : WS_B13B)));
        const int N = (j == 1) ? NIN : 2 * DFF;
        for (int n = gw; n < N; n += NGW) {
            float w[16];
#pragma unroll
            for (int c = 0; c < 4; ++c) { const u32x2 v = *(const u32x2*)(Wt + (size_t)n * DM + c * 256 + lane * 4); w[4 * c] = bflo(v.x); w[4 * c + 1] = bfhi(v.x); w[4 * c + 2] = bflo(v.y); w[4 * c + 3] = bfhi(v.y); }
            float mine = 0.f;
#pragma unroll 1
            for (int mb = 0; mb < 17; ++mb) {
                float p = 0.f;
#pragma unroll
                for (int c = 0; c < 4; ++c) { const f32x4 s = *(const f32x4*)(sh + mb * DM + c * 256 + lane * 4); p += w[4 * c] * s[0] + w[4 * c + 1] * s[1] + w[4 * c + 2] * s[2] + w[4 * c + 3] * s[3]; }
                p = wave_sum(p);
                if (lane == mb) mine = p;
            }
            if (lane < 17) bo[(size_t)lane * N + n] = mine;
        }
    }
}

__device__ __forceinline__ void post_phase(const int tid, const Args& a, int l, unsigned char* lds) {
    const int lane = tid & 63, wave = tid >> 6;
    unsigned char* ws = a.ws;
    const bf16_t* P = (const bf16_t*)(ws + WS_P);
    bf16_t* Bcat = (bf16_t*)(ws + WS_AP); bf16_t* kbuf = (bf16_t*)(ws + WS_KB); bf16_t* Vt = (bf16_t*)(ws + WS_VT);
    const float* rope = (const float*)(ws + WS_ROPE);
    const float* qn = a.in[I_QN] + l * 64; const float* kn = a.in[I_KN] + l * 64;
    for (int ch = blockIdx.x; ch < 288; ch += gridDim.x) {
        const bool lat = ch < 256;
        const int b = lat ? (ch >> 4) : ((ch - 256) >> 1), t0 = lat ? (ch & 15) * 128 : ((ch - 256) & 1) * 128, L = lat ? SEQ : CTXL;
        const int Rb = lat ? b * SEQ : TL + b * CTXL, R0 = Rb + t0;
        const bool full = lat || (l == 0);
        {
            const int nh = full ? 10 : 2, hbase = full ? 0 : 8;
            for (int it = tid; it < 128 * nh * 8; it += 512) {
                const int l8 = it & 7, hr = it >> 3, tok = hr / nh, hh = hbase + (hr - tok * nh);
                const int R = R0 + tok; const bool isq = hh < 8;
                const bf16_t* src = P + (size_t)R * NPC + (isq ? hh * 64 : 512 + (hh - 8) * 64) + l8 * 8;
                const u32x4 raw = *(const u32x4*)src;
                float x[8] = {bflo(raw.x), bfhi(raw.x), bflo(raw.y), bfhi(raw.y), bflo(raw.z), bfhi(raw.z), bflo(raw.w), bfhi(raw.w)};
                float ss = 0.f;
#pragma unroll
                for (int i = 0; i < 8; ++i) ss += x[i] * x[i];
                ss += __shfl_xor(ss, 1); ss += __shfl_xor(ss, 2); ss += __shfl_xor(ss, 4);
                const float rinv = __builtin_amdgcn_rsqf(ss * (1.f / 64.f) + EPS);
                const float* gn = (isq ? qn : kn) + l8 * 8;
                float y[8], o[8];
#pragma unroll
                for (int i = 0; i < 8; ++i) y[i] = x[i] * rinv * gn[i];
                const int t = t0 + tok;
                const int half = l8 >> 2, second = (l8 >> 1) & 1, fi0 = (l8 & 1) * 8;
#pragma unroll
                for (int i = 0; i < 8; ++i) {
                    const float partner = __shfl_xor(y[i], 2);
                    if (lat) { const f32x2_t cs = *(const f32x2_t*)(rope + ((size_t)t * 32 + half * 16 + fi0 + i) * 2);
                        o[i] = second ? (y[i] * cs.x + partner * cs.y) : (y[i] * cs.x - partner * cs.y); }
                    else o[i] = y[i];
                }
                const float sc = isq ? QSCALE : 1.f;
                u32x4 w; w.x = cvtpk(o[0] * sc, o[1] * sc); w.y = cvtpk(o[2] * sc, o[3] * sc); w.z = cvtpk(o[4] * sc, o[5] * sc); w.w = cvtpk(o[6] * sc, o[7] * sc);
                bf16_t* dst = isq ? Bcat + (size_t)R * DM + 256 + hh * 64 + l8 * 8 : kbuf + (size_t)R * 128 + (hh - 8) * 64 + l8 * 8;
                *(u32x4*)dst = w;
            }
        }
        {
            bf16_t* vs = (bf16_t*)lds;
            for (int it = tid; it < 128 * 16; it += 512) { const int tok = it >> 4, c = it & 15;
                *(u32x4*)(vs + tok * 136 + c * 8) = *(const u32x4*)(P + (size_t)(R0 + tok) * NPC + 640 + c * 8); }
            __syncthreads();
            const int posbase = lat ? t0 : SEQ + t0;
            for (int it = tid; it < 128 * 16; it += 512) { const int vr = it & 127, pg = it >> 7;
                unsigned short e[8];
#pragma unroll
                for (int i = 0; i < 8; ++i) { const int p = pg * 8 + i; const int kap = (p & ~12) | ((p & 4) << 1) | ((p & 8) >> 1); e[i] = vs[kap * 136 + vr]; }
                u32x4 w; w.x = e[0] | ((unsigned)e[1] << 16); w.y = e[2] | ((unsigned)e[3] << 16); w.z = e[4] | ((unsigned)e[5] << 16); w.w = e[6] | ((unsigned)e[7] << 16);
                *(u32x4*)(Vt + ((size_t)(b * 2 + (vr >> 6)) * 64 + (vr & 63)) * KVPOS + posbase + pg * 8) = w; }
            __syncthreads();
        }
        if (full) {
            {
                unsigned* xs = (unsigned*)lds;
                for (int it = tid; it < 144 * 32; it += 512) { const int rr = it >> 5, c = it & 31; const int s = t0 - 8 + rr;
                    u32x4 v = (u32x4){0u, 0u, 0u, 0u};
                    if (s >= 0 && s < L) v = *(const u32x4*)(P + (size_t)(Rb + s) * NPC + 768 + c * 8);
                    *(u32x4*)(xs + rr * 128 + c * 4) = v; }
                __syncthreads();
                const int cp = tid & 127, tg = tid >> 7, hw = 1 << (cp >> 5);
                for (int tt = tg * 32; tt < tg * 32 + 32; ++tt) {
                    const int t = t0 + tt; const int lo = (t - hw) < 0 ? 0 : (t - hw), hi = (t + hw) > L ? L : (t + hw);
                    float s0 = 0.f, s1 = 0.f;
                    for (int s = lo; s < hi; ++s) { const unsigned v = xs[(s - t0 + 8) * 128 + cp]; s0 += bflo(v); s1 += bfhi(v); }
                    const float ic = 1.f / (float)(hi - lo); const unsigned xv = xs[(tt + 8) * 128 + cp];
                    *(unsigned*)(Bcat + (size_t)(R0 + tt) * DM + 2 * cp) = cvtpk(s0 * ic - bflo(xv), s1 * ic - bfhi(xv));
                }
                __syncthreads();
            }
            {
                bf16_t* vT = (bf16_t*)lds;
                bf16_t* Ws = (bf16_t*)(lds + 69632);
                const float* sn = a.in[I_SGUN] + l * 256;
                for (int it = tid; it < 128 * 32; it += 512) { const int l32 = it & 31, tok = it >> 5;
                    const u32x4 raw = *(const u32x4*)(P + (size_t)(R0 + tok) * NPC + 1280 + l32 * 8);
                    float x[8] = {bflo(raw.x), bfhi(raw.x), bflo(raw.y), bfhi(raw.y), bflo(raw.z), bfhi(raw.z), bflo(raw.w), bfhi(raw.w)};
                    float ss = 0.f;
#pragma unroll
                    for (int i = 0; i < 8; ++i) { x[i] = gelu_t(x[i]); ss += x[i] * x[i]; }
                    ss += __shfl_xor(ss, 1); ss += __shfl_xor(ss, 2); ss += __shfl_xor(ss, 4); ss += __shfl_xor(ss, 8); ss += __shfl_xor(ss, 16);
                    const float rinv = __builtin_amdgcn_rsqf(ss * (1.f / 256.f) + EPS);
#pragma unroll
                    for (int i = 0; i < 8; i += 2) { const unsigned pk = cvtpk(x[i] * rinv * sn[l32 * 8 + i], x[i + 1] * rinv * sn[l32 * 8 + i + 1]);
                        vT[(l32 * 8 + i) * 136 + tok] = (bf16_t)(pk & 0xffffu); vT[(l32 * 8 + i + 1) * 136 + tok] = (bf16_t)(pk >> 16); }
                }
                const int q32 = lane & 31, hi = lane >> 5, cblk = wave & 1, tblk = wave >> 1;
                const float* sb = a.in[I_SGUB] + (size_t)l * 4 * 128;
                for (int g = 0; g < 4; ++g) {
                    __syncthreads();
                    const bf16_t* wsrc = (const bf16_t*)(ws + WS_SGUW) + g * 128 * 128;
                    for (int it = tid; it < 128 * 16; it += 512) { const int r = it >> 4, c = it & 15; *(u32x4*)(Ws + r * 136 + c * 8) = *(const u32x4*)(wsrc + r * 128 + c * 8); }
                    __syncthreads();
                    f32x16 acc;
#pragma unroll
                    for (int r = 0; r < 16; ++r) acc[r] = 0.f;
#pragma unroll
                    for (int ks = 0; ks < 8; ++ks) {
                        const bf16x8 af = *(const bf16x8*)(vT + (g * 64 + cblk * 32 + q32) * 136 + ks * 16 + hi * 8);
                        const bf16x8 bf = *(const bf16x8*)(Ws + (tblk * 32 + q32) * 136 + ks * 16 + hi * 8);
                        acc = __builtin_amdgcn_mfma_f32_32x32x16_bf16(af, bf, acc, 0, 0, 0);
                    }
                    const int tok = tblk * 32 + q32, R = R0 + tok; const float bias = sb[g * 128 + tok];
#pragma unroll
                    for (int rg = 0; rg < 4; ++rg) {
                        const int c4 = g * 64 + cblk * 32 + 8 * rg + 4 * hi;
                        const u32x2 ur = *(const u32x2*)(P + (size_t)R * NPC + 1024 + c4);
                        const float u0 = gelu_t(bflo(ur.x)), u1 = gelu_t(bfhi(ur.x)), u2 = gelu_t(bflo(ur.y)), u3 = gelu_t(bfhi(ur.y));
                        u32x2 w; w.x = cvtpk(u0 * (acc[4 * rg] + bias), u1 * (acc[4 * rg + 1] + bias)); w.y = cvtpk(u2 * (acc[4 * rg + 2] + bias), u3 * (acc[4 * rg + 3] + bias));
                        *(u32x2*)(Bcat + (size_t)R * DM + 768 + c4) = w;
                    }
                }
                __syncthreads();
            }
        }
    }
}

__device__ __forceinline__ void attn_phase(const int tid, const Args& a, int l, unsigned char* lds) {
    const int lane = tid & 63, w = tid >> 6, q32 = lane & 31, hi = lane >> 5;
    bf16_t* Bcat = (bf16_t*)(a.ws + WS_AP); const bf16_t* kbuf = (const bf16_t*)(a.ws + WS_KB); const bf16_t* Vt = (const bf16_t*)(a.ws + WS_VT);
    const int G = gridDim.x, c = blockIdx.x;
    const int per = (1024 + G - 1) / G;
    const int nlat = (c * per >= 1024) ? 0 : ((c + 1) * per > 1024 ? 1024 - c * per : per);
    const int nctx = (l == 0) ? ((128 - c + G - 1) / G > 0 && c < 128 ? (128 - c + G - 1) / G : 0) : 0;
    const int kr = tid >> 3, kc = tid & 7;
    for (int ui = 0; ui < nlat + nctx; ++ui) {
        int b, kvh, qrow0, jt0, NT;
        if (ui < nlat) { const int u = c * per + ui; const int bk = u >> 5, qb = u & 31; b = bk >> 1; kvh = bk & 1; qrow0 = b * SEQ + qb * 64; jt0 = 0; NT = 36; }
        else { const int u = c + (ui - nlat) * G; const int bk = u >> 2, qb = u & 3; b = bk >> 1; kvh = bk & 1; qrow0 = TL + b * CTXL + qb * 64; jt0 = 32; NT = 4; }
        const int head = kvh * 4 + (w >> 1); const int myrow = qrow0 + 32 * (w & 1) + q32;
        bf16_t* qp = Bcat + (size_t)myrow * DM + 256 + head * 64;
        bf16x8 qf[4];
#pragma unroll
        for (int ds = 0; ds < 4; ++ds) qf[ds] = *(const bf16x8*)(qp + 16 * ds + hi * 8);
        const bf16_t* vsrc = Vt + ((size_t)(b * 2 + kvh) * 64 + kr) * KVPOS + kc * 8;
#define KSRC(jt) (kbuf + (size_t)(((jt) < 32 ? b * SEQ + 64 * (jt) : TL + b * CTXL + 64 * ((jt) - 32)) + kr) * 128 + kvh * 64 + kc * 8)
        u32x4 kreg = *(const u32x4*)KSRC(jt0), vreg = *(const u32x4*)(vsrc + 64 * jt0);
        *(u32x4*)(lds + kr * 144 + kc * 16) = kreg; *(u32x4*)(lds + 18432 + kr * 144 + kc * 16) = vreg;
        __syncthreads();
        f32x16 o0, o1;
#pragma unroll
        for (int r = 0; r < 16; ++r) { o0[r] = 0.f; o1[r] = 0.f; }
        float mrun = -1e30f, lrun = 0.f;
        for (int j = 0; j < NT; ++j) {
            if (j + 1 < NT) { kreg = *(const u32x4*)KSRC(jt0 + j + 1); vreg = *(const u32x4*)(vsrc + 64 * (jt0 + j + 1)); }
            const unsigned char* Kb = lds + (j & 1) * 9216; const unsigned char* Vb = lds + 18432 + (j & 1) * 9216;
            f32x16 p0, p1;
#pragma unroll
            for (int r = 0; r < 16; ++r) { p0[r] = 0.f; p1[r] = 0.f; }
#pragma unroll
            for (int ds = 0; ds < 4; ++ds) {
                const bf16x8 k0 = *(const bf16x8*)(Kb + q32 * 144 + ds * 32 + hi * 16);
                const bf16x8 k1 = *(const bf16x8*)(Kb + (32 + q32) * 144 + ds * 32 + hi * 16);
                p0 = __builtin_amdgcn_mfma_f32_32x32x16_bf16(k0, qf[ds], p0, 0, 0, 0);
                p1 = __builtin_amdgcn_mfma_f32_32x32x16_bf16(k1, qf[ds], p1, 0, 0, 0);
            }
            float mx = fmaxf(p0[0], p1[0]);
#pragma unroll
            for (int r = 1; r < 16; ++r) mx = fmaxf(mx, fmaxf(p0[r], p1[r]));
            mx = fmaxf(mx, __shfl_xor(mx, 32));
            const float mnew = fmaxf(mrun, mx); const float alpha = __builtin_amdgcn_exp2f(mrun - mnew); mrun = mnew;
            float ls = 0.f;
#pragma unroll
            for (int r = 0; r < 16; ++r) { p0[r] = __builtin_amdgcn_exp2f(p0[r] - mnew); p1[r] = __builtin_amdgcn_exp2f(p1[r] - mnew); ls += p0[r] + p1[r]; }
            lrun = lrun * alpha + ls;
#pragma unroll
            for (int r = 0; r < 16; ++r) { o0[r] *= alpha; o1[r] *= alpha; }
            u32x4 pw[4];
            pw[0] = (u32x4){cvtpk(p0[0], p0[1]), cvtpk(p0[2], p0[3]), cvtpk(p0[4], p0[5]), cvtpk(p0[6], p0[7])};
            pw[1] = (u32x4){cvtpk(p0[8], p0[9]), cvtpk(p0[10], p0[11]), cvtpk(p0[12], p0[13]), cvtpk(p0[14], p0[15])};
            pw[2] = (u32x4){cvtpk(p1[0], p1[1]), cvtpk(p1[2], p1[3]), cvtpk(p1[4], p1[5]), cvtpk(p1[6], p1[7])};
            pw[3] = (u32x4){cvtpk(p1[8], p1[9]), cvtpk(p1[10], p1[11]), cvtpk(p1[12], p1[13]), cvtpk(p1[14], p1[15])};
#pragma unroll
            for (int s = 0; s < 4; ++s) {
                const bf16x8 v0 = *(const bf16x8*)(Vb + q32 * 144 + s * 32 + hi * 16);
                const bf16x8 v1 = *(const bf16x8*)(Vb + (32 + q32) * 144 + s * 32 + hi * 16);
                const bf16x8 pa = __builtin_bit_cast(bf16x8, pw[s]);
                o0 = __builtin_amdgcn_mfma_f32_32x32x16_bf16(v0, pa, o0, 0, 0, 0);
                o1 = __builtin_amdgcn_mfma_f32_32x32x16_bf16(v1, pa, o1, 0, 0, 0);
            }
            if (j + 1 < NT) { unsigned char* Kn = lds + ((j + 1) & 1) * 9216; *(u32x4*)(Kn + kr * 144 + kc * 16) = kreg; *(u32x4*)(Kn + 18432 + kr * 144 + kc * 16) = vreg; }
            __syncthreads();
        }
#undef KSRC
        lrun += __shfl_xor(lrun, 32);
        const float inv = 1.f / lrun;
#pragma unroll
        for (int rg = 0; rg < 4; ++rg) {
            u32x2 w0; w0.x = cvtpk(o0[4 * rg] * inv, o0[4 * rg + 1] * inv); w0.y = cvtpk(o0[4 * rg + 2] * inv, o0[4 * rg + 3] * inv);
            u32x2 w1; w1.x = cvtpk(o1[4 * rg] * inv, o1[4 * rg + 1] * inv); w1.y = cvtpk(o1[4 * rg + 2] * inv, o1[4 * rg + 3] * inv);
            *(u32x2*)(qp + 8 * rg + 4 * hi) = w0; *(u32x2*)(qp + 32 + 8 * rg + 4 * hi) = w1;
        }
    }
}

__global__ void __launch_bounds__(512, 2) fwd_megakernel(Args a) {
    extern __shared__ __attribute__((aligned(16))) unsigned char lds[];
    cg::grid_group grid = cg::this_grid();
    unsigned char* ws = a.ws;
    float* modraw = (float*)(ws + WS_MOD);
    float* ssq = (float*)(ws + WS_SSQ);
    bf16_t* Ap = (bf16_t*)(ws + WS_AP);
    float* hctx = (float*)(ws + WS_HCTX);
    LAS unsigned char* ldsl = (LAS unsigned char*)lds;

    for (int ph = a.ph_lo; ph < a.ph_hi; ++ph) {
        int tid = threadIdx.x; asm volatile("" : "+v"(tid));
        const int lane = tid & 63, wave = tid >> 6;
        if (ph == 0 || ph == 11) {
          if (ph == 0) {
            for (int i = blockIdx.x * 512 + tid; i < 6 * TT; i += gridDim.x * 512) ssq[TT + i] = 0.f;
            {
                float* rope = (float*)(ws + WS_ROPE);
                for (int i = blockIdx.x * 512 + tid; i < SEQ * 32; i += gridDim.x * 512) {
                    const int t = i >> 5, j = i & 31, fi = j & 15; const float pos = (float)((j < 16) ? (t >> 6) : (t & 63));
                    const float invf = __builtin_amdgcn_exp2f(-(float)fi * (13.287712379549449f / 16.f));
                    const float ang = pos * invf;
                    rope[2 * i] = __cosf(ang); rope[2 * i + 1] = __sinf(ang);
                }
            }
            {
                float* sc = (float*)lds;
                float* red = (float*)(lds + 69632);
                for (int i = tid; i < 17 * DM; i += 512) { const int mb = i >> 10, k = i & 1023; const float cv = mb < 16 ? a.in[I_C][mb * DM + k] : a.in[I_CCTX][k]; sc[i] = cv * sigm(cv); }
                __syncthreads();
                for (int item = blockIdx.x; item < 288; item += gridDim.x) {
                    const int l = item / 144, n0 = (item - l * 144) * 64;
                    const float* wp = a.in[I_WADA] + ((size_t)l * DM + wave * 128) * NMOD + n0 + lane;
                    float acc[17];
#pragma unroll
                    for (int mb = 0; mb < 17; ++mb) acc[mb] = 0.f;
#pragma unroll 4
                    for (int k = 0; k < 128; ++k) { const float wv = wp[(size_t)k * NMOD];
#pragma unroll
                        for (int mb = 0; mb < 17; ++mb) acc[mb] += sc[mb * DM + wave * 128 + k] * wv; }
#pragma unroll
                    for (int mb = 0; mb < 17; ++mb) red[(wave * 17 + mb) * 64 + lane] = acc[mb];
                    __syncthreads();
                    for (int i = tid; i < 17 * 64; i += 512) { const int mb = i >> 6, col = i & 63; float s = a.in[I_BADA][l * NMOD + n0 + col];
#pragma unroll
                        for (int w8 = 0; w8 < 8; ++w8) s += red[(w8 * 17 + mb) * 64 + col];
                        modraw[((size_t)l * 17 + mb) * NMOD + n0 + col] = s; }
                    __syncthreads();
                }
            }
            __syncthreads();
          }
            convert_weights(tid, a, ph == 0 ? 0 : 1, lds);
        } else if (ph == 1 || ph == 12) {
            const int l = ph == 1 ? 0 : 1;
            compute_biases(tid, a, l, lds);
            if (l == 0) {
                const float* nrm = a.in[I_NFFN1]; const int gw = blockIdx.x * 8 + wave, NGW = gridDim.x * 8;
                for (int R = gw; R < TT; R += NGW) {
                    const float* xr = R < TL ? a.in[I_X] + (size_t)R * DM : a.in[I_CTX] + (size_t)(R - TL) * DM;
                    const int mb = R < TL ? (R >> 11) : 16; const float* scl = modraw + (size_t)mb * NMOD + DM;
                    float ss = 0.f;
#pragma unroll
                    for (int c4 = 0; c4 < 4; ++c4) { const int col = c4 * 256 + lane * 4; const f32x4 v = *(const f32x4*)(xr + col);
                        ss += (v[0] * v[0] + v[1] * v[1]) + (v[2] * v[2] + v[3] * v[3]);
                        const f32x4 g = *(const f32x4*)(nrm + col) * (*(const f32x4*)(scl + col) + 1.f), y = v * g;
                        u32x2 w; w.x = cvtpk(y[0], y[1]); w.y = cvtpk(y[2], y[3]); *(u32x2*)(Ap + (size_t)R * DM + col) = w; }
                    ss = wave_sum(ss);
                    if (lane == 0) ssq[R] = ss;
                }
            }
        } else if (ph == 22) {
            const float* fn = a.in[I_FNORM]; const int gw = blockIdx.x * 8 + wave, NGW = gridDim.x * 8;
            for (int R = gw; R < TL; R += NGW) {
                const float r = __builtin_amdgcn_rsqf(ssq[(size_t)6 * TT + R] * (1.f / DM) + EPS);
                float* orow = a.out + (size_t)R * DM;
#pragma unroll
                for (int c4 = 0; c4 < 4; ++c4) { const int col = c4 * 256 + lane * 4; const f32x4 v = *(const f32x4*)(orow + col) * r * *(const f32x4*)(fn + col); *(f32x4*)(orow + col) = v; }
            }
        } else {
            const int l = ph < 11 ? 0 : 1, sp = ph < 11 ? ph - 2 : ph - 13;
            const float* modl = modraw + (size_t)l * 17 * NMOD;
            const int nMall = TT / 256, nMlat = TL / 256;
            const float* hin_l = (l == 0 && sp <= 1) ? a.in[I_X] : a.out; const float* hin_c = (l == 0 && sp <= 1) ? a.in[I_CTX] : hctx;
            if (sp == 0 || sp == 7) {
                const bool f1 = sp == 0; const int nM = (f1 || l == 0) ? nMall : nMlat;
                pg8::TileSched S = pg8::make_sched(nM, 2 * DFF / 256, DM);
                pg8::EpiSwiGLU E{(bf16_t*)(ws + WS_G), (const float*)(ws + (f1 ? WS_B13A : WS_B13B)), ssq + (size_t)(3 * l + (f1 ? 0 : 2)) * TT};
                pg8::gemm_phase(tid, ldsl, Ap, DM, (const bf16_t*)(ws + (f1 ? WS_W13A : WS_W13B)), DM, S, E);
            } else if (sp == 1 || sp == 8 || sp == 6) {
                const int nM = (sp == 1 || l == 0) ? nMall : nMlat;
                const int j = sp == 1 ? 0 : (sp == 6 ? 1 : 2);
                const bool lastg = (l == 1 && sp == 8);
                const int ln = (sp == 8) ? l + 1 : l, jn = (sp == 8) ? 0 : j + 1;
                const float* nrm = lastg ? nullptr : (jn == 0 ? a.in[I_NFFN1] : (jn == 1 ? a.in[I_NMIX] : a.in[I_NFFN2])) + (size_t)ln * DM;
                const float* scl = lastg ? nullptr : modraw + (size_t)ln * 17 * NMOD + (3 * jn + 1) * DM;
                float* ssqn = ssq + (size_t)(3 * l + j + 1) * TT;
                pg8::EpiRes E{(uintptr_t)hin_l, (uintptr_t)hin_c - (uintptr_t)hin_l, (uintptr_t)a.out, (uintptr_t)hctx - (uintptr_t)a.out, modl + (3 * j + 2) * DM, sp == 6 ? 1.0f : 0.5f, nrm, scl, ssqn, lastg ? nullptr : Ap};
                const bool wo = sp == 6; const int Kd = wo ? DM : DFF;
                pg8::TileSched S = pg8::make_sched(nM, DM / 256, Kd);
                pg8::gemm_phase(tid, ldsl, (const bf16_t*)(ws + (wo ? WS_P : WS_G)), Kd, (const bf16_t*)(ws + (wo ? WS_WOUT : (sp == 1 ? WS_W2A : WS_W2B))), Kd, S, E);
            } else if (sp == 2) {
                pg8::TileSched S = pg8::make_sched(l == 0 ? nMall : nMlat, NIN / 256, DM);
                if (l == 1) { S.n2 = TC / 256; S.pm0_2 = nMlat; S.pn0_2 = 2; }
                pg8::EpiIn E{(bf16_t*)(ws + WS_P), (bf16_t*)(ws + WS_G), (const float*)(ws + WS_BIN), ssq + (size_t)(3 * l + 1) * TT};
                pg8::gemm_phase(tid, ldsl, Ap, DM, (const bf16_t*)(ws + WS_WIN), DM, S, E);
            } else if (sp == 3) {
                post_phase(tid, a, l, lds);
            } else if (sp == 4) {
                attn_phase(tid, a, l, lds);
            } else if (sp == 5) {
                pg8::TileSched S = pg8::make_sched(l == 0 ? nMall : nMlat, DM / 256, DM);
                S.nb = 3;
                pg8::EpiMerge E{(const bf16_t*)(ws + WS_G), (bf16_t*)(ws + WS_P)};
                pg8::gemm_phase(tid, ldsl, Ap, DM, (const bf16_t*)(ws + WS_WCAT), DM, S, E);
            }
        }
        if (ph + 1 < a.ph_hi) { __threadfence(); grid.sync(); __threadfence(); }
    }
}

extern "C" void kernel_launch(void* const* d_in, const int* in_sizes, int n_in, void* d_out, int out_size, void* d_ws, size_t ws_size, hipStream_t stream) {
    static int grid = 0;
    if (grid == 0) {
        if (n_in != 26 || out_size != TL * DM || ws_size < WS_END) { fprintf(stderr, "kernel_launch: unexpected shapes (n_in %d out %d ws %zu need %zu)\n", n_in, out_size, ws_size, (size_t)WS_END); grid = -1; return; }
        int dev = 0, cus = 0, per_cu = 0;
        if (hipGetDevice(&dev) != hipSuccess || hipDeviceGetAttribute(&cus, hipDeviceAttributeMultiprocessorCount, dev) != hipSuccess) { grid = -1; return; }
        if (hipFuncSetAttribute((const void*)fwd_megakernel, hipFuncAttributeMaxDynamicSharedMemorySize, LDS_BYTES) != hipSuccess) { fprintf(stderr, "kernel_launch: hipFuncSetAttribute failed\n"); grid = -1; return; }
        if (hipOccupancyMaxActiveBlocksPerMultiprocessor(&per_cu, (const void*)fwd_megakernel, 512, LDS_BYTES) != hipSuccess || per_cu < 1) per_cu = 1;
        (void)hipGetLastError();
        grid = cus * per_cu;
    }
    if (grid < 0) return;
    Args a{};
    for (int i = 0; i < 26; ++i) a.in[i] = (const float*)d_in[i];
    a.out = (float*)d_out; a.ws = (unsigned char*)d_ws;
#if MK_ONE_LAUNCH
    a.ph_lo = 0; a.ph_hi = NPHASES;
    void* args[] = {&a};
    hipError_t e = hipLaunchCooperativeKernel((const void*)fwd_megakernel, dim3(grid), dim3(512), args, LDS_BYTES, stream);
    if (e != hipSuccess) fprintf(stderr, "cooperative launch failed: %s (grid %d)\n", hipGetErrorString(e), grid);
#else
    for (int ph = 0; ph < NPHASES; ++ph) {
        a.ph_lo = ph; a.ph_hi = ph + 1;
        hipLaunchKernelGGL(fwd_megakernel, dim3(grid), dim3(512), LDS_BYTES, stream, a);
    }
#endif
}
```

```cpp
#include <hip/hip_runtime.h>
#include <hip/hip_cooperative_groups.h>
#include <cstdio>
#include <cstdint>
namespace cg = cooperative_groups;

#ifndef MK_ONE_LAUNCH
#define MK_ONE_LAUNCH 1
#endif

#define LAS __attribute__((address_space(3)))
typedef unsigned short bf16_t;
typedef short bf16x8 __attribute__((ext_vector_type(8)));
typedef float f32x4 __attribute__((ext_vector_type(4)));
typedef float f32x16 __attribute__((ext_vector_type(16)));
typedef unsigned u32x4 __attribute__((ext_vector_type(4)));
typedef unsigned u32x2 __attribute__((ext_vector_type(2)));
typedef float f32x2_t __attribute__((ext_vector_type(2)));
typedef __bf16 bf16x2_t __attribute__((ext_vector_type(2)));

constexpr int DM = 1024, NBATCH = 16, SEQ = 2048, CTXL = 256;
constexpr int TL = NBATCH * SEQ;
constexpr int TC = NBATCH * CTXL;
constexpr int TT = TL + TC;
constexpr int DFF = 2816, NIN = 4608, NPC = 1536, NGC = 3072, NMOD = 9 * DM;
constexpr int KVPOS = SEQ + CTXL;
constexpr float EPS = 1e-6f;
constexpr float QSCALE = 0.125f * 1.4426950408889634f;

constexpr size_t MiB = 1u << 20;
constexpr size_t al256(size_t x) { return (x + 255) & ~(size_t)255; }
constexpr size_t SZ_W13 = (size_t)2 * DFF * DM * 2, SZ_W2 = (size_t)DM * DFF * 2, SZ_WIN = (size_t)NIN * DM * 2, SZ_WSQ = (size_t)DM * DM * 2;
constexpr size_t WS_W13A = 0;
constexpr size_t WS_W2A = WS_W13A + SZ_W13;
constexpr size_t WS_WIN = WS_W2A + SZ_W2;
constexpr size_t WS_WCAT = WS_WIN + SZ_WIN;
constexpr size_t WS_WOUT = WS_WCAT + SZ_WSQ;
constexpr size_t WS_W13B = WS_WOUT + SZ_WSQ;
constexpr size_t WS_W2B = WS_W13B + SZ_W13;
constexpr size_t WS_SGUW = WS_W2B + SZ_W2;
constexpr size_t WS_MOD = al256(WS_SGUW + 4 * 128 * 128 * 2);
constexpr size_t WS_B13A = al256(WS_MOD + (size_t)2 * 17 * NMOD * 4);
constexpr size_t WS_BIN = al256(WS_B13A + (size_t)17 * 2 * DFF * 4);
constexpr size_t WS_B13B = al256(WS_BIN + (size_t)17 * NIN * 4);
constexpr size_t WS_SSQ = al256(WS_B13B + (size_t)17 * 2 * DFF * 4);
constexpr size_t WS_ROPE = al256(WS_SSQ + (size_t)7 * TT * 4);
constexpr size_t WS_HCTX = al256(WS_ROPE + (size_t)SEQ * 32 * 8);
constexpr size_t WS_AP = al256(WS_HCTX + (size_t)TC * DM * 4);
constexpr size_t WS_KB = al256(WS_AP + (size_t)TT * DM * 2);
constexpr size_t WS_VT = al256(WS_KB + (size_t)TT * 128 * 2);
constexpr size_t WS_P = al256(WS_VT + (size_t)NBATCH * 2 * 64 * KVPOS * 2);
constexpr size_t WS_G = al256(WS_P + (size_t)TT * NPC * 2);
constexpr size_t WS_CTL = al256(WS_G + (size_t)TT * NGC * 2);
constexpr size_t WS_END = WS_CTL + 4096;

constexpr int LDS_BYTES = 147456;
constexpr int NPHASES = 23;

__device__ __forceinline__ unsigned cvtpk(float lo, float hi) { f32x2_t v = {lo, hi}; bf16x2_t b = __builtin_convertvector(v, bf16x2_t); return __builtin_bit_cast(unsigned, b); }
__device__ __forceinline__ float bflo(unsigned u) { return __uint_as_float(u << 16); }
__device__ __forceinline__ float bfhi(unsigned u) { return __uint_as_float(u & 0xffff0000u); }
__device__ __forceinline__ float fexp(float x) { return __builtin_amdgcn_exp2f(x * 1.4426950408889634f); }
__device__ __forceinline__ float frcp(float x) { return __builtin_amdgcn_rcpf(x); }
__device__ __forceinline__ float sigm(float x) { return frcp(1.f + fexp(-x)); }
__device__ __forceinline__ float gelu_t(float x) { const float z = 0.7978845608028654f * (x + 0.044715f * x * x * x); return x * frcp(1.f + fexp(-2.f * z)); }
#define LDS_WAIT() asm volatile("s_waitcnt lgkmcnt(0)" ::: "memory")
__device__ __forceinline__ uintptr_t uni64(uintptr_t v) { const unsigned lo = __builtin_amdgcn_readfirstlane((unsigned)v), hi = __builtin_amdgcn_readfirstlane((unsigned)(v >> 32)); return ((uintptr_t)hi << 32) | lo; }

namespace pg8 {
constexpr int BM = 256, BK = 64, HALF = 128, HTB = HALF * BK * 2, STAGE_BYTES = 8 * HTB, NXCD = 8, WGM = 8;
__device__ __forceinline__ int lds_byte(int r, int c) { const int st = (r >> 4) * 2 + (c >> 5), rr = r & 15, cc = c & 31, ob = rr * 64 + cc * 2; return st * 1024 + (ob ^ (((ob >> 9) & 1) << 5)); }
__device__ __forceinline__ void stage_rc(int b, int& R, int& C) { const int st = b / 1024, sb = b % 1024, swz = sb ^ (((sb >> 9) & 1) << 5); R = (st >> 1) * 16 + swz / 64; C = (st & 1) * 32 + (swz % 64) / 2; }
__device__ __forceinline__ int perm32(int rho) { const int n = rho >> 4, i = rho & 15; return 8 * (i >> 2) + 4 * n + (i & 3); }

struct Unit { int pm, pn, k0, nt, tag; };

struct TileSched {
    int c, G, nM1, nN1, n1, pn0_1, n2, pm0_2, pn0_2, nb, ntk;
    __device__ __forceinline__ bool next(int i, Unit& u) const {
        int ti = i, br = 0;
        if (nb == 3) { ti = i / 3; br = i - ti * 3; }
        const int L = ti * G + c;
        if (L < n1) {
            int wgid; { const int q = n1 / NXCD, r = n1 % NXCD, xcd = L % NXCD, off = L / NXCD; wgid = (xcd < r ? xcd * (q + 1) : r * (q + 1) + (xcd - r) * q) + off; }
            const int nig = WGM * nN1, gid = wgid / nig, fm = gid * WGM, gsz = (nM1 - fm) < WGM ? (nM1 - fm) : WGM;
            u.pm = fm + ((wgid % nig) % gsz); u.pn = pn0_1 + (wgid % nig) / gsz;
        } else if (L - n1 < n2) { u.pm = pm0_2 + (L - n1); u.pn = pn0_2; }
        else return false;
        if (nb == 3) { u.k0 = br * 256 + (br >> 1) * 256; u.nt = 4 + 4 * (br & 1); }
        else { u.k0 = 0; u.nt = ntk; }
        u.tag = br;
        return true;
    }
};
__device__ __forceinline__ TileSched make_sched(int nM1, int nN1, int K) {
    TileSched s; s.c = blockIdx.x; s.G = gridDim.x; s.nM1 = nM1; s.nN1 = nN1; s.n1 = nM1 * nN1; s.pn0_1 = 0; s.n2 = 0; s.pm0_2 = 0; s.pn0_2 = 0; s.nb = 1;
    s.ntk = K / BK; return s;
}

__device__ __forceinline__ int unit_mb(const Unit& u) { return u.pm < 128 ? (u.pm >> 3) : 16; }

struct EpiSwiGLU {
    bf16_t* act; const float* bias; const float* ssq;
    __device__ __forceinline__ void operator()(const f32x4 (&acc)[2][2][4][2], const Unit& u, int wr, int wc, int fr, int fq) const {
        const int mb = unit_mb(u);
        const float* bp = bias + (size_t)mb * (2 * DFF) + u.pn * 256 + wc * 32 + 8 * fq;
        f32x4 ba[2], bb[2];
#pragma unroll
        for (int n = 0; n < 2; ++n) { ba[n] = *(const f32x4*)(bp + 4 * n); bb[n] = *(const f32x4*)(bp + 128 + 4 * n); }
        const int row0 = u.pm * 256 + wr * 64 + fr;
        bf16_t* op = act + (size_t)row0 * DFF + u.pn * 128 + wc * 32 + 8 * fq;
#pragma unroll
        for (int ai = 0; ai < 2; ++ai)
#pragma unroll
            for (int m = 0; m < 4; ++m) {
                const int ro = ai * 128 + m * 16;
                const float r = __builtin_amdgcn_rsqf(ssq[row0 + ro] * (1.f / DM) + EPS);
                f32x4 a0 = acc[ai][0][m][0] * r + ba[0], a1 = acc[ai][0][m][1] * r + ba[1], b0 = acc[ai][1][m][0] * r + bb[0], b1 = acc[ai][1][m][1] * r + bb[1];
                f32x4 o0, o1;
#pragma unroll
                for (int i = 0; i < 4; ++i) { o0[i] = a0[i] * b0[i] * sigm(a0[i]); o1[i] = a1[i] * b1[i] * sigm(a1[i]); }
                u32x4 w; w.x = cvtpk(o0[0], o0[1]); w.y = cvtpk(o0[2], o0[3]); w.z = cvtpk(o1[0], o1[1]); w.w = cvtpk(o1[2], o1[3]);
                *(u32x4*)(op + (size_t)ro * DFF) = w;
            }
    }
};
struct EpiIn {
    bf16_t* P; bf16_t* G; const float* bias; const float* ssq;
    __device__ __forceinline__ void operator()(const f32x4 (&acc)[2][2][4][2], const Unit& u, int wr, int wc, int fr, int fq) const {
        const int mb = unit_mb(u);
        const int colt = u.pn * 256, cw = wc * 32 + 8 * fq;
        const float* bp = bias + (size_t)mb * NIN + colt + cw;
        f32x4 bv[2][2];
#pragma unroll
        for (int bj = 0; bj < 2; ++bj)
#pragma unroll
            for (int n = 0; n < 2; ++n) bv[bj][n] = *(const f32x4*)(bp + bj * 128 + 4 * n);
        const int row0 = u.pm * 256 + wr * 64 + fr;
        const bool gate = u.pn >= 6;
        bf16_t* base = gate ? G + (size_t)row0 * NGC + (colt - NPC) + cw : P + (size_t)row0 * NPC + colt + cw;
        const size_t ld = gate ? NGC : NPC;
#pragma unroll
        for (int ai = 0; ai < 2; ++ai)
#pragma unroll
            for (int m = 0; m < 4; ++m) {
                const int ro = ai * 128 + m * 16;
                const float r = __builtin_amdgcn_rsqf(ssq[row0 + ro] * (1.f / DM) + EPS);
#pragma unroll
                for (int bj = 0; bj < 2; ++bj) {
                    f32x4 v0 = acc[ai][bj][m][0] * r + bv[bj][0], v1 = acc[ai][bj][m][1] * r + bv[bj][1];
                    if (gate) {
#pragma unroll
                        for (int i = 0; i < 4; ++i) { v0[i] = sigm(v0[i]); v1[i] = sigm(v1[i]); }
                    }
                    u32x4 w; w.x = cvtpk(v0[0], v0[1]); w.y = cvtpk(v0[2], v0[3]); w.z = cvtpk(v1[0], v1[1]); w.w = cvtpk(v1[2], v1[3]);
                    *(u32x4*)(base + (size_t)ro * ld + bj * 128) = w;
                }
            }
    }
};
struct EpiRes {
    uintptr_t hin_l, hin_cd, hout_l, hout_cd; const float* gate; float coef; const float* nrm; const float* scl; float* ssq; bf16_t* Ap;
    __device__ __forceinline__ void operator()(const f32x4 (&acc)[2][2][4][2], const Unit& u, int wr, int wc, int fr, int fq) const {
        const int mb = unit_mb(u);
        const bool lat = u.pm < 128;
        uintptr_t hin_l = this->hin_l, hin_cd = this->hin_cd, hout_l = this->hout_l, hout_cd = this->hout_cd; const float* gate = this->gate; float coef = this->coef;
        const float* nrm = this->nrm; const float* scl = this->scl; float* ssq = this->ssq; bf16_t* Ap = this->Ap;
        hin_l = uni64(hin_l); hin_cd = uni64(hin_cd); hout_l = uni64(hout_l); hout_cd = uni64(hout_cd); gate = (const float*)uni64((uintptr_t)gate); coef = __uint_as_float(__builtin_amdgcn_readfirstlane(__float_as_uint(coef)));
        nrm = (const float*)uni64((uintptr_t)nrm); scl = (const float*)uni64((uintptr_t)scl); ssq = (float*)uni64((uintptr_t)ssq); Ap = (bf16_t*)uni64((uintptr_t)Ap);
        const int col0 = u.pn * 256 + wc * 32 + 8 * fq, row0 = u.pm * 256 + wr * 64 + fr, rowl = lat ? row0 : row0 - TL;
        const float* hi = (const float*)(hin_l + (lat ? (uintptr_t)0 : hin_cd)) + (size_t)rowl * DM + col0;
        float* ho = (float*)(hout_l + (lat ? (uintptr_t)0 : hout_cd)) + (size_t)rowl * DM + col0;
        f32x4 gc[2][2], gs[2][2];
#pragma unroll
        for (int bj = 0; bj < 2; ++bj)
#pragma unroll
            for (int n = 0; n < 2; ++n) {
                gc[bj][n] = *(const f32x4*)(gate + (size_t)mb * NMOD + col0 + 128 * bj + 4 * n) * coef;
                if (Ap) gs[bj][n] = *(const f32x4*)(nrm + col0 + 128 * bj + 4 * n) * (*(const f32x4*)(scl + (size_t)mb * NMOD + col0 + 128 * bj + 4 * n) + 1.f);
                else gs[bj][n] = (f32x4){0.f, 0.f, 0.f, 0.f};
            }
#pragma unroll
        for (int ai = 0; ai < 2; ++ai)
#pragma unroll
            for (int m = 0; m < 4; ++m) {
                const int ro = ai * 128 + m * 16; const size_t off = (size_t)ro * DM;
                float ss = 0.f;
#pragma unroll
                for (int bj = 0; bj < 2; ++bj) {
                    f32x4 h0 = *(const f32x4*)(hi + off + 128 * bj), h1 = *(const f32x4*)(hi + off + 128 * bj + 4);
                    h0 += gc[bj][0] * acc[ai][bj][m][0]; h1 += gc[bj][1] * acc[ai][bj][m][1];
                    *(f32x4*)(ho + off + 128 * bj) = h0; *(f32x4*)(ho + off + 128 * bj + 4) = h1;
                    ss += (h0[0] * h0[0] + h0[1] * h0[1]) + (h0[2] * h0[2] + h0[3] * h0[3]) + (h1[0] * h1[0] + h1[1] * h1[1]) + (h1[2] * h1[2] + h1[3] * h1[3]);
                    if (Ap) { const f32x4 a0 = h0 * gs[bj][0], a1 = h1 * gs[bj][1];
                        u32x4 w; w.x = cvtpk(a0[0], a0[1]); w.y = cvtpk(a0[2], a0[3]); w.z = cvtpk(a1[0], a1[1]); w.w = cvtpk(a1[2], a1[3]);
                        *(u32x4*)(Ap + (size_t)(row0 + ro) * DM + col0 + 128 * bj) = w; }
                }
                ss += __shfl_xor(ss, 16); ss += __shfl_xor(ss, 32);
                if (fq == 0) atomicAdd(ssq + row0 + ro, ss);
            }
    }
};
struct EpiMerge {
    const bf16_t* G; bf16_t* Mg;
    __device__ __forceinline__ void operator()(const f32x4 (&acc)[2][2][4][2], const Unit& u, int wr, int wc, int fr, int fq) const {
        const int br = u.tag, col0 = u.pn * 256 + wc * 32 + 8 * fq, row0 = u.pm * 256 + wr * 64 + fr;
#pragma unroll
        for (int ai = 0; ai < 2; ++ai)
#pragma unroll
            for (int m = 0; m < 4; ++m) {
                const int row = row0 + ai * 128 + m * 16;
#pragma unroll
                for (int bj = 0; bj < 2; ++bj) {
                    const u32x4 g = *(const u32x4*)(G + (size_t)row * NGC + br * 1024 + col0 + 128 * bj);
                    const f32x4 c0 = acc[ai][bj][m][0], c1 = acc[ai][bj][m][1];
                    f32x4 v0, v1;
                    v0[0] = bflo(g.x) * c0[0]; v0[1] = bfhi(g.x) * c0[1]; v0[2] = bflo(g.y) * c0[2]; v0[3] = bfhi(g.y) * c0[3];
                    v1[0] = bflo(g.z) * c1[0]; v1[1] = bfhi(g.z) * c1[1]; v1[2] = bflo(g.w) * c1[2]; v1[3] = bfhi(g.w) * c1[3];
                    bf16_t* mp = Mg + (size_t)row * DM + col0 + 128 * bj;
                    if (br > 0) {
                        const unsigned long long p0 = __hip_atomic_load((const unsigned long long*)mp, __ATOMIC_RELAXED, __HIP_MEMORY_SCOPE_AGENT);
                        const unsigned long long p1 = __hip_atomic_load((const unsigned long long*)mp + 1, __ATOMIC_RELAXED, __HIP_MEMORY_SCOPE_AGENT);
                        const unsigned a = (unsigned)p0, b = (unsigned)(p0 >> 32), c = (unsigned)p1, d = (unsigned)(p1 >> 32);
                        v0[0] += bflo(a); v0[1] += bfhi(a); v0[2] += bflo(b); v0[3] += bfhi(b);
                        v1[0] += bflo(c); v1[1] += bfhi(c); v1[2] += bflo(d); v1[3] += bfhi(d);
                    }
                    u32x4 w; w.x = cvtpk(v0[0], v0[1]); w.y = cvtpk(v0[2], v0[3]); w.z = cvtpk(v1[0], v1[1]); w.w = cvtpk(v1[2], v1[3]);
                    *(u32x4*)mp = w;
                }
            }
    }
};

template <class Epi>
__device__ __forceinline__ void gemm_phase(const int tid, LAS unsigned char* lds, const bf16_t* Ab, int lda, const bf16_t* Bb, int ldb, const TileSched& S, const Epi& E) {
    const int wid = __builtin_amdgcn_readfirstlane(tid >> 6), lane = tid & 63, wr = wid >> 2, wc = wid & 3, fr = lane & 15, fq = lane >> 4;
    unsigned voffA[2], voffB[2];
#pragma unroll
    for (int i = 0; i < 2; ++i) { int R, C; stage_rc(tid * 16 + i * 8192, R, C); const int Rb = (R & ~31) + perm32(R & 31);
        voffA[i] = (unsigned)(R * lda + C) * 2u; voffB[i] = (unsigned)(Rb * ldb + C) * 2u; }
    const size_t kstep = (size_t)(BK * 2);
    const size_t hsA = (size_t)HALF * lda * 2, hsB = (size_t)HALF * ldb * 2;
    const unsigned ldsw = (unsigned)wid * 1024u;
    const int aoff = lds_byte(wr * 64 + fr, fq * 8), boff = lds_byte(wc * 32 + fr, fq * 8);
#define PG8_SA(b, h) (((b) * 2 + (h)) * HTB)
#define PG8_SB(b, h) ((4 + (b) * 2 + (h)) * HTB)
#define PG8_STAGE(bufoff, gbase, voff) do { _Pragma("unroll") for (int _i = 0; _i < 2; ++_i) \
        __builtin_amdgcn_global_load_lds((const unsigned*)((const char*)(gbase) + (voff)[_i]), (LAS unsigned*)(lds + (bufoff) + ldsw + _i * 8192), 16, 0, 0); } while (0)
#define PG8_LDA(dst, b, h) do { _Pragma("unroll") for (int m = 0; m < 4; ++m) _Pragma("unroll") for (int k = 0; k < 2; ++k) dst[m][k] = *(const LAS bf16x8*)(lds + PG8_SA(b, h) + aoff + m * 2048 + k * 1024); } while (0)
#define PG8_LDB(dst, b, h) do { _Pragma("unroll") for (int n = 0; n < 2; ++n) _Pragma("unroll") for (int k = 0; k < 2; ++k) dst[n][k] = *(const LAS bf16x8*)(lds + PG8_SB(b, h) + boff + n * 2048 + k * 1024); } while (0)
#define PG8_MMA(ai, bj, At, Bt) do { __builtin_amdgcn_s_setprio(1); _Pragma("unroll") for (int m = 0; m < 4; ++m) _Pragma("unroll") for (int n = 0; n < 2; ++n) _Pragma("unroll") for (int k = 0; k < 2; ++k) \
        acc[ai][bj][m][n] = __builtin_amdgcn_mfma_f32_16x16x32_bf16(Bt[n][k], At[m][k], acc[ai][bj][m][n], 0, 0, 0); __builtin_amdgcn_s_setprio(0); } while (0)
#define PG8_WAIT_V(n) asm volatile("s_waitcnt vmcnt(" #n ")" ::: "memory")
#define PG8_WAIT_L(n) asm volatile("s_waitcnt lgkmcnt(" #n ")" ::: "memory")
#define PG8_BAR __builtin_amdgcn_s_barrier()
#define PG8_SCHED __builtin_amdgcn_sched_barrier(0)
    Unit cur, nxt; int ui = 0;
    if (!S.next(0, cur)) return;
    f32x4 acc[2][2][4][2];
#pragma unroll
    for (int a = 0; a < 2; ++a)
#pragma unroll
        for (int b = 0; b < 2; ++b)
#pragma unroll
            for (int m = 0; m < 4; ++m)
#pragma unroll
                for (int n = 0; n < 2; ++n) acc[a][b][m][n] = (f32x4){0.f, 0.f, 0.f, 0.f};
    bf16x8 At[4][2], B0[2][2], B1[2][2];
    const char* cA = (const char*)Ab + (size_t)cur.pm * 2 * hsA + (size_t)cur.k0 * 2; const char* cB = (const char*)Bb + (size_t)cur.pn * 2 * hsB + (size_t)cur.k0 * 2;
    PG8_STAGE(PG8_SB(0, 0), cB, voffB); PG8_STAGE(PG8_SB(0, 1), cB + hsB, voffB); PG8_STAGE(PG8_SA(0, 0), cA, voffA); PG8_STAGE(PG8_SA(0, 1), cA + hsA, voffA);
    if (wr == 1) PG8_BAR;
    PG8_WAIT_V(2); PG8_BAR;
    PG8_STAGE(PG8_SB(1, 0), cB + kstep, voffB); PG8_STAGE(PG8_SA(1, 0), cA + kstep, voffA); PG8_STAGE(PG8_SB(1, 1), cB + hsB + kstep, voffB);
    PG8_WAIT_V(6); PG8_BAR;
    for (;;) {
        const bool has_next = S.next(ui + 1, nxt);
        const char* nA = has_next ? (const char*)Ab + (size_t)nxt.pm * 2 * hsA + (size_t)nxt.k0 * 2 : cA;
        const char* nB = has_next ? (const char*)Bb + (size_t)nxt.pn * 2 * hsB + (size_t)nxt.k0 * 2 : cB;
        const int nt = cur.nt;
        for (int t = 0; t < nt; t += 2) {
            const bool last = (t == nt - 2);
            const char* a1 = cA + (size_t)(t + 1) * kstep;
            const char* a2 = last ? nA : cA + (size_t)(t + 2) * kstep; const char* b2 = last ? nB : cB + (size_t)(t + 2) * kstep;
            const char* a3 = a2 + kstep; const char* b3 = b2 + kstep;
            PG8_LDB(B0, 0, 0); PG8_LDB(B1, 0, 1); PG8_SCHED; PG8_LDA(At, 0, 0); PG8_STAGE(PG8_SA(1, 1), a1 + hsA, voffA);
            PG8_WAIT_V(8); PG8_WAIT_L(0); PG8_BAR; PG8_MMA(0, 0, At, B0); PG8_MMA(0, 1, At, B1); PG8_BAR; PG8_SCHED;
            PG8_LDA(At, 0, 1); PG8_STAGE(PG8_SB(0, 0), b2, voffB); PG8_STAGE(PG8_SB(0, 1), b2 + hsB, voffB); PG8_STAGE(PG8_SA(0, 0), a2, voffA);
            PG8_WAIT_V(8); PG8_WAIT_L(0); PG8_BAR; PG8_MMA(1, 0, At, B0); PG8_MMA(1, 1, At, B1); PG8_BAR; PG8_SCHED;
            PG8_LDB(B0, 1, 0); PG8_LDB(B1, 1, 1); PG8_SCHED; PG8_LDA(At, 1, 0); PG8_STAGE(PG8_SA(0, 1), a2 + hsA, voffA);
            PG8_WAIT_V(8); PG8_WAIT_L(0); PG8_BAR; PG8_MMA(0, 0, At, B0); PG8_MMA(0, 1, At, B1); PG8_BAR; PG8_SCHED;
            PG8_LDA(At, 1, 1); PG8_STAGE(PG8_SB(1, 0), b3, voffB); PG8_STAGE(PG8_SB(1, 1), b3 + hsB, voffB); PG8_STAGE(PG8_SA(1, 0), a3, voffA);
            PG8_WAIT_V(8); PG8_WAIT_L(0); PG8_BAR; PG8_MMA(1, 0, At, B0); PG8_MMA(1, 1, At, B1); PG8_BAR; PG8_SCHED;
        }
        if (wr == 0) PG8_BAR;
        E(acc, cur, wr, wc, fr, fq);
        if (!has_next) break;
#pragma unroll
        for (int a = 0; a < 2; ++a)
#pragma unroll
            for (int b = 0; b < 2; ++b)
#pragma unroll
                for (int m = 0; m < 4; ++m)
#pragma unroll
                    for (int n = 0; n < 2; ++n) acc[a][b][m][n] = (f32x4){0.f, 0.f, 0.f, 0.f};
        cur = nxt; cA = nA; cB = nB; ++ui;
        if (wr == 1) PG8_BAR;
    }
    PG8_WAIT_V(0);
    PG8_BAR;
#undef PG8_SA
#undef PG8_SB
#undef PG8_STAGE
#undef PG8_LDA
#undef PG8_LDB
#undef PG8_MMA
#undef PG8_WAIT_V
#undef PG8_WAIT_L
#undef PG8_BAR
#undef PG8_SCHED
}
}

struct Args {
    const float* in[26];
    float* out; unsigned char* ws;
    int ph_lo, ph_hi;
};
enum { I_X = 0, I_C, I_CTX, I_CCTX, I_WADA, I_BADA, I_NFFN1, I_F1W13, I_F1W2, I_NMIX, I_WIN, I_QN, I_KN, I_POOLW, I_POOLS, I_SGUN, I_SGUW, I_SGUB,
       I_WBRP, I_WBRA, I_WBRS, I_WOUT, I_NFFN2, I_F2W13, I_F2W2, I_FNORM };

__device__ __forceinline__ float wave_sum(float v) {
#pragma unroll
    for (int o = 1; o < 64; o <<= 1) v += __shfl_xor(v, o);
    return v;
}

__device__ __forceinline__ void tr_item(const float* W, int N, bf16_t* WT, int ldt, int coloff, int mode13, float* scr, int item, int lane) {
    const int nblk = N / 32, kb = item / nblk, nb = item - kb * nblk, k0 = 64 * kb, n0 = 32 * nb;
#pragma unroll 8
    for (int i = 0; i < 32; ++i) { const int kk = 2 * i + (lane >> 5); scr[kk * 33 + (lane & 31)] = W[(size_t)(k0 + kk) * N + n0 + (lane & 31)]; }
    LDS_WAIT();
    int r0 = n0;
    if (mode13) { const int s = n0 / DFF, rem = n0 - s * DFF, t = rem >> 7, j = rem & 127; r0 = 256 * t + 128 * s + j; }
    const int c = lane & 7;
#pragma unroll
    for (int j = 0; j < 4; ++j) { const int n = (lane >> 3) + 8 * j; const float* s = scr + (8 * c) * 33 + n;
        u32x4 o; o.x = cvtpk(s[0 * 33], s[1 * 33]); o.y = cvtpk(s[2 * 33], s[3 * 33]); o.z = cvtpk(s[4 * 33], s[5 * 33]); o.w = cvtpk(s[6 * 33], s[7 * 33]);
        *(u32x4*)(WT + (size_t)(r0 + n) * ldt + coloff + k0 + 8 * c) = o; }
    LDS_WAIT();
}

__device__ __forceinline__ void convert_weights(const int tid, const Args& a, int l, unsigned char* lds) {
    const int lane = tid & 63, wave = tid >> 6;
    float* scr = (float*)(lds + wave * 8704);
    const int gw = blockIdx.x * 8 + wave, NGW = gridDim.x * 8;
    unsigned char* ws = a.ws;
    constexpr int I13 = (DM / 64) * (2 * DFF / 32), I2 = (DFF / 64) * (DM / 32), IIN = (DM / 64) * (NIN / 32), IOUT = (DM / 64) * (DM / 32), IBA = (512 / 64) * (DM / 32), IBS = (256 / 64) * (DM / 32);
    constexpr int NITEMS = 2 * I13 + 2 * I2 + IIN + IOUT + IBA + IBS;
    for (int it = gw; it < NITEMS; it += NGW) {
        int r = it; const float* W; int N; bf16_t* WT; int ldt = DM, coloff = 0, m13 = 0;
        if (r < 2 * I13) { const bool second = r >= I13; r -= second ? I13 : 0; W = a.in[second ? I_F2W13 : I_F1W13] + (size_t)l * DM * 2 * DFF; N = 2 * DFF; WT = (bf16_t*)(ws + (second ? WS_W13B : WS_W13A)); m13 = 1; }
        else if (r < 2 * I13 + 2 * I2) { r -= 2 * I13; const bool second = r >= I2; r -= second ? I2 : 0; W = a.in[second ? I_F2W2 : I_F1W2] + (size_t)l * DFF * DM; N = DM; WT = (bf16_t*)(ws + (second ? WS_W2B : WS_W2A)); ldt = DFF; }
        else if (r < 2 * I13 + 2 * I2 + IIN) { r -= 2 * I13 + 2 * I2; W = a.in[I_WIN] + (size_t)l * DM * NIN; N = NIN; WT = (bf16_t*)(ws + WS_WIN); }
        else if (r < 2 * I13 + 2 * I2 + IIN + IOUT) { r -= 2 * I13 + 2 * I2 + IIN; W = a.in[I_WOUT] + (size_t)l * DM * DM; N = DM; WT = (bf16_t*)(ws + WS_WOUT); }
        else if (r < 2 * I13 + 2 * I2 + IIN + IOUT + IBA) { r -= 2 * I13 + 2 * I2 + IIN + IOUT; W = a.in[I_WBRA] + (size_t)l * 512 * DM; N = DM; WT = (bf16_t*)(ws + WS_WCAT); coloff = 256; }
        else { r -= 2 * I13 + 2 * I2 + IIN + IOUT + IBA; W = a.in[I_WBRS] + (size_t)l * 256 * DM; N = DM; WT = (bf16_t*)(ws + WS_WCAT); coloff = 768; }
        tr_item(W, N, WT, ldt, coloff, m13, scr, r, lane);
    }
    {
        const float* pw = a.in[I_POOLW] + (size_t)l * 4 * 64 * 64; const float* ps = a.in[I_POOLS] + (size_t)l * 256; const float* wb = a.in[I_WBRP] + (size_t)l * 256 * DM;
        bf16_t* wcat = (bf16_t*)(ws + WS_WCAT);
        for (int it = blockIdx.x * 512 + tid; it < 1024 * 32; it += gridDim.x * 512) {
            const int n = it & 1023, kg = it >> 10, g = kg >> 3, c0 = (kg & 7) * 8;
            float s[8];
#pragma unroll
            for (int i = 0; i < 8; ++i) s[i] = 0.f;
            for (int d = 0; d < 64; ++d) {
                const float wv = wb[(size_t)(g * 64 + d) * DM + n] * ps[g * 64 + d];
#pragma unroll
                for (int i = 0; i < 8; ++i) s[i] += pw[(g * 64 + c0 + i) * 64 + d] * wv;
            }
            u32x4 o; o.x = cvtpk(s[0], s[1]); o.y = cvtpk(s[2], s[3]); o.z = cvtpk(s[4], s[5]); o.w = cvtpk(s[6], s[7]);
            *(u32x4*)(wcat + (size_t)n * DM + kg * 8) = o;
        }
    }
    {
        const float* sw = a.in[I_SGUW] + (size_t)l * 4 * 128 * 128; unsigned* dst = (unsigned*)(ws + WS_SGUW);
        for (int it = blockIdx.x * 512 + tid; it < 4 * 128 * 64; it += gridDim.x * 512) dst[it] = cvtpk(sw[2 * it], sw[2 * it + 1]);
    }
}

__device__ __forceinline__ void compute_biases(const int tid, const Args& a, int l, unsigned char* lds) {
    const int lane = tid & 63, wave = tid >> 6;
    float* sh = (float*)lds;
    const float* modl = (const float*)(a.ws + WS_MOD) + (size_t)l * 17 * NMOD;
    const int gw = blockIdx.x * 8 + wave, NGW = gridDim.x * 8;
    for (int j = 0; j < 3; ++j) {
        __syncthreads();
        for (int i = tid; i < 17 * DM; i += 512) sh[i] = modl[(size_t)(i >> 10) * NMOD + (3 * j) * DM + (i & 1023)];
        __syncthreads();
        const bf16_t* Wt = (const bf16_t*)(a.ws + (j == 0 ? WS_W13A : (j == 1 ? WS_WIN : WS_W13B)));
        float* bo = (float*)(a.ws + (j == 0 ? WS_B13A : (j == 1 ? WS_BIN : WS_B13B)));
        const int N = (j == 1) ? NIN : 2 * DFF;
        for (int n = gw; n < N; n += NGW) {
            float w[16];
#pragma unroll
            for (int c = 0; c < 4; ++c) { const u32x2 v = *(const u32x2*)(Wt + (size_t)n * DM + c * 256 + lane * 4); w[4 * c] = bflo(v.x); w[4 * c + 1] = bfhi(v.x); w[4 * c + 2] = bflo(v.y); w[4 * c + 3] = bfhi(v.y); }
            float mine = 0.f;
#pragma unroll 1
            for (int mb = 0; mb < 17; ++mb) {
                float p = 0.f;
#pragma unroll
                for (int c = 0; c < 4; ++c) { const f32x4 s = *(const f32x4*)(sh + mb * DM + c * 256 + lane * 4); p += w[4 * c] * s[0] + w[4 * c + 1] * s[1] + w[4 * c + 2] * s[2] + w[4 * c + 3] * s[3]; }
                p = wave_sum(p);
                if (lane == mb) mine = p;
            }
            if (lane < 17) bo[(size_t)lane * N + n] = mine;
        }
    }
}

__device__ __forceinline__ void post_phase(const int tid, const Args& a, int l, unsigned char* lds) {
    const int lane = tid & 63, wave = tid >> 6;
    unsigned char* ws = a.ws;
    const bf16_t* P = (const bf16_t*)(ws + WS_P);
    bf16_t* Bcat = (bf16_t*)(ws + WS_AP); bf16_t* kbuf = (bf16_t*)(ws + WS_KB); bf16_t* Vt = (bf16_t*)(ws + WS_VT);
    const float* rope = (const float*)(ws + WS_ROPE);
    const float* qn = a.in[I_QN] + l * 64; const float* kn = a.in[I_KN] + l * 64;
    for (int ch = blockIdx.x; ch < 288; ch += gridDim.x) {
        const bool lat = ch < 256;
        const int b = lat ? (ch >> 4) : ((ch - 256) >> 1), t0 = lat ? (ch & 15) * 128 : ((ch - 256) & 1) * 128, L = lat ? SEQ : CTXL;
        const int Rb = lat ? b * SEQ : TL + b * CTXL, R0 = Rb + t0;
        const bool full = lat || (l == 0);
        {
            const int nh = full ? 10 : 2, hbase = full ? 0 : 8;
            for (int it = tid; it < 128 * nh * 8; it += 512) {
                const int l8 = it & 7, hr = it >> 3, tok = hr / nh, hh = hbase + (hr - tok * nh);
                const int R = R0 + tok; const bool isq = hh < 8;
                const bf16_t* src = P + (size_t)R * NPC + (isq ? hh * 64 : 512 + (hh - 8) * 64) + l8 * 8;
                const u32x4 raw = *(const u32x4*)src;
                float x[8] = {bflo(raw.x), bfhi(raw.x), bflo(raw.y), bfhi(raw.y), bflo(raw.z), bfhi(raw.z), bflo(raw.w), bfhi(raw.w)};
                float ss = 0.f;
#pragma unroll
                for (int i = 0; i < 8; ++i) ss += x[i] * x[i];
                ss += __shfl_xor(ss, 1); ss += __shfl_xor(ss, 2); ss += __shfl_xor(ss, 4);
                const float rinv = __builtin_amdgcn_rsqf(ss * (1.f / 64.f) + EPS);
                const float* gn = (isq ? qn : kn) + l8 * 8;
                float y[8], o[8];
#pragma unroll
                for (int i = 0; i < 8; ++i) y[i] = x[i] * rinv * gn[i];
                const int t = t0 + tok;
                const int half = l8 >> 2, second = (l8 >> 1) & 1, fi0 = (l8 & 1) * 8;
#pragma unroll
                for (int i = 0; i < 8; ++i) {
                    const float partner = __shfl_xor(y[i], 2);
                    if (lat) { const f32x2_t cs = *(const f32x2_t*)(rope + ((size_t)t * 32 + half * 16 + fi0 + i) * 2);
                        o[i] = second ? (y[i] * cs.x + partner * cs.y) : (y[i] * cs.x - partner * cs.y); }
                    else o[i] = y[i];
                }
                const float sc = isq ? QSCALE : 1.f;
                u32x4 w; w.x = cvtpk(o[0] * sc, o[1] * sc); w.y = cvtpk(o[2] * sc, o[3] * sc); w.z = cvtpk(o[4] * sc, o[5] * sc); w.w = cvtpk(o[6] * sc, o[7] * sc);
                bf16_t* dst = isq ? Bcat + (size_t)R * DM + 256 + hh * 64 + l8 * 8 : kbuf + (size_t)R * 128 + (hh - 8) * 64 + l8 * 8;
                *(u32x4*)dst = w;
            }
        }
        {
            bf16_t* vs = (bf16_t*)lds;
            for (int it = tid; it < 128 * 16; it += 512) { const int tok = it >> 4, c = it & 15;
                *(u32x4*)(vs + tok * 136 + c * 8) = *(const u32x4*)(P + (size_t)(R0 + tok) * NPC + 640 + c * 8); }
            __syncthreads();
            const int posbase = lat ? t0 : SEQ + t0;
            for (int it = tid; it < 128 * 16; it += 512) { const int vr = it & 127, pg = it >> 7;
                unsigned short e[8];
#pragma unroll
                for (int i = 0; i < 8; ++i) { const int p = pg * 8 + i; const int kap = (p & ~12) | ((p & 4) << 1) | ((p & 8) >> 1); e[i] = vs[kap * 136 + vr]; }
                u32x4 w; w.x = e[0] | ((unsigned)e[1] << 16); w.y = e[2] | ((unsigned)e[3] << 16); w.z = e[4] | ((unsigned)e[5] << 16); w.w = e[6] | ((unsigned)e[7] << 16);
                *(u32x4*)(Vt + ((size_t)(b * 2 + (vr >> 6)) * 64 + (vr & 63)) * KVPOS + posbase + pg * 8) = w; }
            __syncthreads();
        }
        if (full) {
            {
                unsigned* xs = (unsigned*)lds;
                for (int it = tid; it < 144 * 32; it += 512) { const int rr = it >> 5, c = it & 31; const int s = t0 - 8 + rr;
                    u32x4 v = (u32x4){0u, 0u, 0u, 0u};
                    if (s >= 0 && s < L) v = *(const u32x4*)(P + (size_t)(Rb + s) * NPC + 768 + c * 8);
                    *(u32x4*)(xs + rr * 128 + c * 4) = v; }
                __syncthreads();
                const int cp = tid & 127, tg = tid >> 7, hw = 1 << (cp >> 5);
                for (int tt = tg * 32; tt < tg * 32 + 32; ++tt) {
                    const int t = t0 + tt; const int lo = (t - hw) < 0 ? 0 : (t - hw), hi = (t + hw) > L ? L : (t + hw);
                    float s0 = 0.f, s1 = 0.f;
                    for (int s = lo; s < hi; ++s) { const unsigned v = xs[(s - t0 + 8) * 128 + cp]; s0 += bflo(v); s1 += bfhi(v); }
                    const float ic = 1.f / (float)(hi - lo); const unsigned xv = xs[(tt + 8) * 128 + cp];
                    *(unsigned*)(Bcat + (size_t)(R0 + tt) * DM + 2 * cp) = cvtpk(s0 * ic - bflo(xv), s1 * ic - bfhi(xv));
                }
                __syncthreads();
            }
            {
                bf16_t* vT = (bf16_t*)lds;
                bf16_t* Ws = (bf16_t*)(lds + 69632);
                const float* sn = a.in[I_SGUN] + l * 256;
                for (int it = tid; it < 128 * 32; it += 512) { const int l32 = it & 31, tok = it >> 5;
                    const u32x4 raw = *(const u32x4*)(P + (size_t)(R0 + tok) * NPC + 1280 + l32 * 8);
                    float x[8] = {bflo(raw.x), bfhi(raw.x), bflo(raw.y), bfhi(raw.y), bflo(raw.z), bfhi(raw.z), bflo(raw.w), bfhi(raw.w)};
                    float ss = 0.f;
#pragma unroll
                    for (int i = 0; i < 8; ++i) { x[i] = gelu_t(x[i]); ss += x[i] * x[i]; }
                    ss += __shfl_xor(ss, 1); ss += __shfl_xor(ss, 2); ss += __shfl_xor(ss, 4); ss += __shfl_xor(ss, 8); ss += __shfl_xor(ss, 16);
                    const float rinv = __builtin_amdgcn_rsqf(ss * (1.f / 256.f) + EPS);
#pragma unroll
                    for (int i = 0; i < 8; i += 2) { const unsigned pk = cvtpk(x[i] * rinv * sn[l32 * 8 + i], x[i + 1] * rinv * sn[l32 * 8 + i + 1]);
                        vT[(l32 * 8 + i) * 136 + tok] = (bf16_t)(pk & 0xffffu); vT[(l32 * 8 + i + 1) * 136 + tok] = (bf16_t)(pk >> 16); }
                }
                const int q32 = lane & 31, hi = lane >> 5, cblk = wave & 1, tblk = wave >> 1;
                const float* sb = a.in[I_SGUB] + (size_t)l * 4 * 128;
                for (int g = 0; g < 4; ++g) {
                    __syncthreads();
                    const bf16_t* wsrc = (const bf16_t*)(ws + WS_SGUW) + g * 128 * 128;
                    for (int it = tid; it < 128 * 16; it += 512) { const int r = it >> 4, c = it & 15; *(u32x4*)(Ws + r * 136 + c * 8) = *(const u32x4*)(wsrc + r * 128 + c * 8); }
                    __syncthreads();
                    f32x16 acc;
#pragma unroll
                    for (int r = 0; r < 16; ++r) acc[r] = 0.f;
#pragma unroll
                    for (int ks = 0; ks < 8; ++ks) {
                        const bf16x8 af = *(const bf16x8*)(vT + (g * 64 + cblk * 32 + q32) * 136 + ks * 16 + hi * 8);
                        const bf16x8 bf = *(const bf16x8*)(Ws + (tblk * 32 + q32) * 136 + ks * 16 + hi * 8);
                        acc = __builtin_amdgcn_mfma_f32_32x32x16_bf16(af, bf, acc, 0, 0, 0);
                    }
                    const int tok = tblk * 32 + q32, R = R0 + tok; const float bias = sb[g * 128 + tok];
#pragma unroll
                    for (int rg = 0; rg < 4; ++rg) {
                        const int c4 = g * 64 + cblk * 32 + 8 * rg + 4 * hi;
                        const u32x2 ur = *(const u32x2*)(P + (size_t)R * NPC + 1024 + c4);
                        const float u0 = gelu_t(bflo(ur.x)), u1 = gelu_t(bfhi(ur.x)), u2 = gelu_t(bflo(ur.y)), u3 = gelu_t(bfhi(ur.y));
                        u32x2 w; w.x = cvtpk(u0 * (acc[4 * rg] + bias), u1 * (acc[4 * rg + 1] + bias)); w.y = cvtpk(u2 * (acc[4 * rg + 2] + bias), u3 * (acc[4 * rg + 3] + bias));
                        *(u32x2*)(Bcat + (size_t)R * DM + 768 + c4) = w;
                    }
                }
                __syncthreads();
            }
        }
    }
}

__device__ __forceinline__ void attn_phase(const int tid, const Args& a, int l, unsigned char* lds) {
    const int lane = tid & 63, w = tid >> 6, q32 = lane & 31, hi = lane >> 5;
    bf16_t* Bcat = (bf16_t*)(a.ws + WS_AP); const bf16_t* kbuf = (const bf16_t*)(a.ws + WS_KB); const bf16_t* Vt = (const bf16_t*)(a.ws + WS_VT);
    const int G = gridDim.x, c = blockIdx.x;
    const int per = (1024 + G - 1) / G;
    const int nlat = (c * per >= 1024) ? 0 : ((c + 1) * per > 1024 ? 1024 - c * per : per);
    const int nctx = (l == 0) ? ((128 - c + G - 1) / G > 0 && c < 128 ? (128 - c + G - 1) / G : 0) : 0;
    const int kr = tid >> 3, kc = tid & 7;
    for (int ui = 0; ui < nlat + nctx; ++ui) {
        int b, kvh, qrow0, jt0, NT;
        if (ui < nlat) { const int u = c * per + ui; const int bk = u >> 5, qb = u & 31; b = bk >> 1; kvh = bk & 1; qrow0 = b * SEQ + qb * 64; jt0 = 0; NT = 36; }
        else { const int u = c + (ui - nlat) * G; const int bk = u >> 2, qb = u & 3; b = bk >> 1; kvh = bk & 1; qrow0 = TL + b * CTXL + qb * 64; jt0 = 32; NT = 4; }
        const int head = kvh * 4 + (w >> 1); const int myrow = qrow0 + 32 * (w & 1) + q32;
        bf16_t* qp = Bcat + (size_t)myrow * DM + 256 + head * 64;
        bf16x8 qf[4];
#pragma unroll
        for (int ds = 0; ds < 4; ++ds) qf[ds] = *(const bf16x8*)(qp + 16 * ds + hi * 8);
        const bf16_t* vsrc = Vt + ((size_t)(b * 2 + kvh) * 64 + kr) * KVPOS + kc * 8;
#define KSRC(jt) (kbuf + (size_t)(((jt) < 32 ? b * SEQ + 64 * (jt) : TL + b * CTXL + 64 * ((jt) - 32)) + kr) * 128 + kvh * 64 + kc * 8)
        u32x4 kreg = *(const u32x4*)KSRC(jt0), vreg = *(const u32x4*)(vsrc + 64 * jt0);
        *(u32x4*)(lds + kr * 144 + kc * 16) = kreg; *(u32x4*)(lds + 18432 + kr * 144 + kc * 16) = vreg;
        __syncthreads();
        f32x16 o0, o1;
#pragma unroll
        for (int r = 0; r < 16; ++r) { o0[r] = 0.f; o1[r] = 0.f; }
        float mrun = -1e30f, lrun = 0.f;
        for (int j = 0; j < NT; ++j) {
            if (j + 1 < NT) { kreg = *(const u32x4*)KSRC(jt0 + j + 1); vreg = *(const u32x4*)(vsrc + 64 * (jt0 + j + 1)); }
            const unsigned char* Kb = lds + (j & 1) * 9216; const unsigned char* Vb = lds + 18432 + (j & 1) * 9216;
            f32x16 p0, p1;
#pragma unroll
            for (int r = 0; r < 16; ++r) { p0[r] = 0.f; p1[r] = 0.f; }
#pragma unroll
            for (int ds = 0; ds < 4; ++ds) {
                const bf16x8 k0 = *(const bf16x8*)(Kb + q32 * 144 + ds * 32 + hi * 16);
                const bf16x8 k1 = *(const bf16x8*)(Kb + (32 + q32) * 144 + ds * 32 + hi * 16);
                p0 = __builtin_amdgcn_mfma_f32_32x32x16_bf16(k0, qf[ds], p0, 0, 0, 0);
                p1 = __builtin_amdgcn_mfma_f32_32x32x16_bf16(k1, qf[ds], p1, 0, 0, 0);
            }
            float mx = fmaxf(p0[0], p1[0]);
#pragma unroll
            for (int r = 1; r < 16; ++r) mx = fmaxf(mx, fmaxf(p0[r], p1[r]));
            mx = fmaxf(mx, __shfl_xor(mx, 32));
            const float mnew = fmaxf(mrun, mx); const float alpha = __builtin_amdgcn_exp2f(mrun - mnew); mrun = mnew;
            float ls = 0.f;
#pragma unroll
            for (int r = 0; r < 16; ++r) { p0[r] = __builtin_amdgcn_exp2f(p0[r] - mnew); p1[r] = __builtin_amdgcn_exp2f(p1[r] - mnew); ls += p0[r] + p1[r]; }
            lrun = lrun * alpha + ls;
#pragma unroll
            for (int r = 0; r < 16; ++r) { o0[r] *= alpha; o1[r] *= alpha; }
            u32x4 pw[4];
            pw[0] = (u32x4){cvtpk(p0[0], p0[1]), cvtpk(p0[2], p0[3]), cvtpk(p0[4], p0[5]), cvtpk(p0[6], p0[7])};
            pw[1] = (u32x4){cvtpk(p0[8], p0[9]), cvtpk(p0[10], p0[11]), cvtpk(p0[12], p0[13]), cvtpk(p0[14], p0[15])};
            pw[2] = (u32x4){cvtpk(p1[0], p1[1]), cvtpk(p1[2], p1[3]), cvtpk(p1[4], p1[5]), cvtpk(p1[6], p1[7])};
            pw[3] = (u32x4){cvtpk(p1[8], p1[9]), cvtpk(p1[10], p1[11]), cvtpk(p1[12], p1[13]), cvtpk(p1[14], p1[15])};
#pragma unroll
            for (int s = 0; s < 4; ++s) {
                const bf16x8 v0 = *(const bf16x8*)(Vb + q32 * 144 + s * 32 + hi * 16);
                const bf16x8 v1 = *(const bf16x8*)(Vb + (32 + q32) * 144 + s * 32 + hi * 16);
                const bf16x8 pa = __builtin_bit_cast(bf16x8, pw[s]);
                o0 = __builtin_amdgcn_mfma_f32_32x32x16_bf16(v0, pa, o0, 0, 0, 0);
                o1 = __builtin_amdgcn_mfma_f32_32x32x16_bf16(v1, pa, o1, 0, 0, 0);
            }
            if (j + 1 < NT) { unsigned char* Kn = lds + ((j + 1) & 1) * 9216; *(u32x4*)(Kn + kr * 144 + kc * 16) = kreg; *(u32x4*)(Kn + 18432 + kr * 144 + kc * 16) = vreg; }
            __syncthreads();
        }
#undef KSRC
        lrun += __shfl_xor(lrun, 32);
        const float inv = 1.f / lrun;
#pragma unroll
        for (int rg = 0; rg < 4; ++rg) {
            u32x2 w0; w0.x = cvtpk(o0[4 * rg] * inv, o0[4 * rg + 1] * inv); w0.y = cvtpk(o0[4 * rg + 2] * inv, o0[4 * rg + 3] * inv);
            u32x2 w1; w1.x = cvtpk(o1[4 * rg] * inv, o1[4 * rg + 1] * inv); w1.y = cvtpk(o1[4 * rg + 2] * inv, o1[4 * rg + 3] * inv);
            *(u32x2*)(qp + 8 * rg + 4 * hi) = w0; *(u32x2*)(qp + 32 + 8 * rg + 4 * hi) = w1;
        }
    }
}

__global__ void __launch_bounds__(512, 2) fwd_megakernel(Args a) {
    extern __shared__ __attribute__((aligned(16))) unsigned char lds[];
    cg::grid_group grid = cg::this_grid();
    unsigned char* ws = a.ws;
    float* modraw = (float*)(ws + WS_MOD);
    float* ssq = (float*)(ws + WS_SSQ);
    bf16_t* Ap = (bf16_t*)(ws + WS_AP);
    float* hctx = (float*)(ws + WS_HCTX);
    LAS unsigned char* ldsl = (LAS unsigned char*)lds;

    for (int ph = a.ph_lo; ph < a.ph_hi; ++ph) {
        int tid = threadIdx.x; asm volatile("" : "+v"(tid));
        const int lane = tid & 63, wave = tid >> 6;
        if (ph == 0 || ph == 11) {
          if (ph == 0) {
            for (int i = blockIdx.x * 512 + tid; i < 6 * TT; i += gridDim.x * 512) ssq[TT + i] = 0.f;
            {
                float* rope = (float*)(ws + WS_ROPE);
                for (int i = blockIdx.x * 512 + tid; i < SEQ * 32; i += gridDim.x * 512) {
                    const int t = i >> 5, j = i & 31, fi = j & 15; const float pos = (float)((j < 16) ? (t >> 6) : (t & 63));
                    const float invf = __builtin_amdgcn_exp2f(-(float)fi * (13.287712379549449f / 16.f));
                    const float ang = pos * invf;
                    rope[2 * i] = __cosf(ang); rope[2 * i + 1] = __sinf(ang);
                }
            }
            {
                float* sc = (float*)lds;
                float* red = (float*)(lds + 69632);
                for (int i = tid; i < 17 * DM; i += 512) { const int mb = i >> 10, k = i & 1023; const float cv = mb < 16 ? a.in[I_C][mb * DM + k] : a.in[I_CCTX][k]; sc[i] = cv * sigm(cv); }
                __syncthreads();
                for (int item = blockIdx.x; item < 288; item += gridDim.x) {
                    const int l = item / 144, n0 = (item - l * 144) * 64;
                    const float* wp = a.in[I_WADA] + ((size_t)l * DM + wave * 128) * NMOD + n0 + lane;
                    float acc[17];
#pragma unroll
                    for (int mb = 0; mb < 17; ++mb) acc[mb] = 0.f;
#pragma unroll 4
                    for (int k = 0; k < 128; ++k) { const float wv = wp[(size_t)k * NMOD];
#pragma unroll
                        for (int mb = 0; mb < 17; ++mb) acc[mb] += sc[mb * DM + wave * 128 + k] * wv; }
#pragma unroll
                    for (int mb = 0; mb < 17; ++mb) red[(wave * 17 + mb) * 64 + lane] = acc[mb];
                    __syncthreads();
                    for (int i = tid; i < 17 * 64; i += 512) { const int mb = i >> 6, col = i & 63; float s = a.in[I_BADA][l * NMOD + n0 + col];
#pragma unroll
                        for (int w8 = 0; w8 < 8; ++w8) s += red[(w8 * 17 + mb) * 64 + col];
                        modraw[((size_t)l * 17 + mb) * NMOD + n0 + col] = s; }
                    __syncthreads();
                }
            }
            __syncthreads();
          }
            convert_weights(tid, a, ph == 0 ? 0 : 1, lds);
        } else if (ph == 1 || ph == 12) {
            const int l = ph == 1 ? 0 : 1;
            compute_biases(tid, a, l, lds);
            if (l == 0) {
                const float* nrm = a.in[I_NFFN1]; const int gw = blockIdx.x * 8 + wave, NGW = gridDim.x * 8;
                for (int R = gw; R < TT; R += NGW) {
                    const float* xr = R < TL ? a.in[I_X] + (size_t)R * DM : a.in[I_CTX] + (size_t)(R - TL) * DM;
                    const int mb = R < TL ? (R >> 11) : 16; const float* scl = modraw + (size_t)mb * NMOD + DM;
                    float ss = 0.f;
#pragma unroll
                    for (int c4 = 0; c4 < 4; ++c4) { const int col = c4 * 256 + lane * 4; const f32x4 v = *(const f32x4*)(xr + col);
                        ss += (v[0] * v[0] + v[1] * v[1]) + (v[2] * v[2] + v[3] * v[3]);
                        const f32x4 g = *(const f32x4*)(nrm + col) * (*(const f32x4*)(scl + col) + 1.f), y = v * g;
                        u32x2 w; w.x = cvtpk(y[0], y[1]); w.y = cvtpk(y[2], y[3]); *(u32x2*)(Ap + (size_t)R * DM + col) = w; }
                    ss = wave_sum(ss);
                    if (lane == 0) ssq[R] = ss;
                }
            }
        } else if (ph == 22) {
            const float* fn = a.in[I_FNORM]; const int gw = blockIdx.x * 8 + wave, NGW = gridDim.x * 8;
            for (int R = gw; R < TL; R += NGW) {
                const float r = __builtin_amdgcn_rsqf(ssq[(size_t)6 * TT + R] * (1.f / DM) + EPS);
                float* orow = a.out + (size_t)R * DM;
#pragma unroll
                for (int c4 = 0; c4 < 4; ++c4) { const int col = c4 * 256 + lane * 4; const f32x4 v = *(const f32x4*)(orow + col) * r * *(const f32x4*)(fn + col); *(f32x4*)(orow + col) = v; }
            }
        } else {
            const int l = ph < 11 ? 0 : 1, sp = ph < 11 ? ph - 2 : ph - 13;
            const float* modl = modraw + (size_t)l * 17 * NMOD;
            const int nMall = TT / 256, nMlat = TL / 256;
            const float* hin_l = (l == 0 && sp <= 1) ? a.in[I_X] : a.out; const float* hin_c = (l == 0 && sp <= 1) ? a.in[I_CTX] : hctx;
            if (sp == 0 || sp == 7) {
                const bool f1 = sp == 0; const int nM = (f1 || l == 0) ? nMall : nMlat;
                pg8::TileSched S = pg8::make_sched(nM, 2 * DFF / 256, DM);
                pg8::EpiSwiGLU E{(bf16_t*)(ws + WS_G), (const float*)(ws + (f1 ? WS_B13A : WS_B13B)), ssq + (size_t)(3 * l + (f1 ? 0 : 2)) * TT};
                pg8::gemm_phase(tid, ldsl, Ap, DM, (const bf16_t*)(ws + (f1 ? WS_W13A : WS_W13B)), DM, S, E);
            } else if (sp == 1 || sp == 8 || sp == 6) {
                const int nM = (sp == 1 || l == 0) ? nMall : nMlat;
                const int j = sp == 1 ? 0 : (sp == 6 ? 1 : 2);
                const bool lastg = (l == 1 && sp == 8);
                const int ln = (sp == 8) ? l + 1 : l, jn = (sp == 8) ? 0 : j + 1;
                const float* nrm = lastg ? nullptr : (jn == 0 ? a.in[I_NFFN1] : (jn == 1 ? a.in[I_NMIX] : a.in[I_NFFN2])) + (size_t)ln * DM;
                const float* scl = lastg ? nullptr : modraw + (size_t)ln * 17 * NMOD + (3 * jn + 1) * DM;
                float* ssqn = ssq + (size_t)(3 * l + j + 1) * TT;
                pg8::EpiRes E{(uintptr_t)hin_l, (uintptr_t)hin_c - (uintptr_t)hin_l, (uintptr_t)a.out, (uintptr_t)hctx - (uintptr_t)a.out, modl + (3 * j + 2) * DM, sp == 6 ? 1.0f : 0.5f, nrm, scl, ssqn, lastg ? nullptr : Ap};
                const bool wo = sp == 6; const int Kd = wo ? DM : DFF;
                pg8::TileSched S = pg8::make_sched(nM, DM / 256, Kd);
                pg8::gemm_phase(tid, ldsl, (const bf16_t*)(ws + (wo ? WS_P : WS_G)), Kd, (const bf16_t*)(ws + (wo ? WS_WOUT : (sp == 1 ? WS_W2A : WS_W2B))), Kd, S, E);
            } else if (sp == 2) {
                pg8::TileSched S = pg8::make_sched(l == 0 ? nMall : nMlat, NIN / 256, DM);
                if (l == 1) { S.n2 = TC / 256; S.pm0_2 = nMlat; S.pn0_2 = 2; }
                pg8::EpiIn E{(bf16_t*)(ws + WS_P), (bf16_t*)(ws + WS_G), (const float*)(ws + WS_BIN), ssq + (size_t)(3 * l + 1) * TT};
                pg8::gemm_phase(tid, ldsl, Ap, DM, (const bf16_t*)(ws + WS_WIN), DM, S, E);
            } else if (sp == 3) {
                post_phase(tid, a, l, lds);
            } else if (sp == 4) {
                attn_phase(tid, a, l, lds);
            } else if (sp == 5) {
                pg8::TileSched S = pg8::make_sched(l == 0 ? nMall : nMlat, DM / 256, DM);
                S.nb = 3;
                pg8::EpiMerge E{(const bf16_t*)(ws + WS_G), (bf16_t*)(ws + WS_P)};
                pg8::gemm_phase(tid, ldsl, Ap, DM, (const bf16_t*)(ws + WS_WCAT), DM, S, E);
            }
        }
        if (ph + 1 < a.ph_hi) {
            asm volatile("s_waitcnt vmcnt(0) lgkmcnt(0)" ::: "memory");
            __syncthreads();
            if (ph == a.ph_lo) { if (threadIdx.x == 0) __builtin_amdgcn_fence(__ATOMIC_RELEASE, "agent"); grid.sync(); if (threadIdx.x == 0) __builtin_amdgcn_fence(__ATOMIC_ACQUIRE, "agent"); }
            else if (threadIdx.x == 0) {
                unsigned* ctr = (unsigned*)(ws + WS_CTL);
                __builtin_amdgcn_fence(__ATOMIC_RELEASE, "agent");
                __hip_atomic_fetch_add(ctr, 1u, __ATOMIC_RELAXED, __HIP_MEMORY_SCOPE_AGENT);
                const unsigned target = (unsigned)(ph - a.ph_lo) * gridDim.x;
                while (__hip_atomic_load(ctr, __ATOMIC_RELAXED, __HIP_MEMORY_SCOPE_AGENT) < target) __builtin_amdgcn_s_sleep(2);
                __builtin_amdgcn_fence(__ATOMIC_ACQUIRE, "agent");
            }
            asm volatile("s_waitcnt vmcnt(0)" ::: "memory");
            __syncthreads();
        }
    }
}

extern "C" void kernel_launch(void* const* d_in, const int* in_sizes, int n_in, void* d_out, int out_size, void* d_ws, size_t ws_size, hipStream_t stream) {
    static int grid = 0;
    if (grid == 0) {
        if (n_in != 26 || out_size != TL * DM || ws_size < WS_END) { fprintf(stderr, "kernel_launch: unexpected shapes (n_in %d out %d ws %zu need %zu)\n", n_in, out_size, ws_size, (size_t)WS_END); grid = -1; return; }
        int dev = 0, cus = 0, per_cu = 0;
        if (hipGetDevice(&dev) != hipSuccess || hipDeviceGetAttribute(&cus, hipDeviceAttributeMultiprocessorCount, dev) != hipSuccess) { grid = -1; return; }
        if (hipFuncSetAttribute((const void*)fwd_megakernel, hipFuncAttributeMaxDynamicSharedMemorySize, LDS_BYTES) != hipSuccess) { fprintf(stderr, "kernel_launch: hipFuncSetAttribute failed\n"); grid = -1; return; }
        if (hipOccupancyMaxActiveBlocksPerMultiprocessor(&per_cu, (const void*)fwd_megakernel, 512, LDS_BYTES) != hipSuccess || per_cu < 1) per_cu = 1;
        (void)hipGetLastError();
        grid = cus * per_cu;
    }
    if (grid < 0) return;
    Args a{};
    for (int i = 0; i < 26; ++i) a.in[i] = (const float*)d_in[i];
    a.out = (float*)d_out; a.ws = (unsigned char*)d_ws;
#if MK_ONE_LAUNCH
    a.ph_lo = 0; a.ph_hi = NPHASES;
    if (hipMemsetAsync((char*)d_ws + WS_CTL, 0, 4096, stream) != hipSuccess) { fprintf(stderr, "memset failed\n"); return; }
    void* args[] = {&a};
    hipError_t e = hipLaunchCooperativeKernel((const void*)fwd_megakernel, dim3(grid), dim3(512), args, LDS_BYTES, stream);
    if (e != hipSuccess) fprintf(stderr, "cooperative launch failed: %s (grid %d)\n", hipGetErrorString(e), grid);
#else
    for (int ph = 0; ph < NPHASES; ++ph) {
        a.ph_lo = ph; a.ph_hi = ph + 1;
        hipLaunchKernelGGL(fwd_megakernel, dim3(grid), dim3(512), LDS_BYTES, stream, a);
    }
#endif
}
```

```cpp
#include <hip/hip_runtime.h>
#include <hip/hip_cooperative_groups.h>
#include <cstdio>
#include <cstdint>
namespace cg = cooperative_groups;

#ifndef REPEAT_MASK
#define REPEAT_MASK 0
#endif
#ifndef EXTRA_BAR
#define EXTRA_BAR 0
#endif
#ifndef MK_ONE_LAUNCH
#define MK_ONE_LAUNCH 1
#endif

#define LAS __attribute__((address_space(3)))
typedef unsigned short bf16_t;
typedef short bf16x8 __attribute__((ext_vector_type(8)));
typedef float f32x4 __attribute__((ext_vector_type(4)));
typedef float f32x16 __attribute__((ext_vector_type(16)));
typedef unsigned u32x4 __attribute__((ext_vector_type(4)));
typedef unsigned u32x2 __attribute__((ext_vector_type(2)));
typedef float f32x2_t __attribute__((ext_vector_type(2)));
typedef __bf16 bf16x2_t __attribute__((ext_vector_type(2)));

constexpr int DM = 1024, NBATCH = 16, SEQ = 2048, CTXL = 256;
constexpr int TL = NBATCH * SEQ;
constexpr int TC = NBATCH * CTXL;
constexpr int TT = TL + TC;
constexpr int DFF = 2816, NIN = 4608, NPC = 1536, NGC = 3072, NMOD = 9 * DM;
constexpr int KVPOS = SEQ + CTXL;
constexpr float EPS = 1e-6f;
constexpr float QSCALE = 0.125f * 1.4426950408889634f;

constexpr size_t MiB = 1u << 20;
constexpr size_t al256(size_t x) { return (x + 255) & ~(size_t)255; }
constexpr size_t SZ_W13 = (size_t)2 * DFF * DM * 2, SZ_W2 = (size_t)DM * DFF * 2, SZ_WIN = (size_t)NIN * DM * 2, SZ_WSQ = (size_t)DM * DM * 2;
constexpr size_t WS_W13A = 0;
constexpr size_t WS_W2A = WS_W13A + SZ_W13;
constexpr size_t WS_WIN = WS_W2A + SZ_W2;
constexpr size_t WS_WCAT = WS_WIN + SZ_WIN;
constexpr size_t WS_WOUT = WS_WCAT + SZ_WSQ;
constexpr size_t WS_W13B = WS_WOUT + SZ_WSQ;
constexpr size_t WS_W2B = WS_W13B + SZ_W13;
constexpr size_t WS_SGUW = WS_W2B + SZ_W2;
constexpr size_t WS_MOD = al256(WS_SGUW + 4 * 128 * 128 * 2);
constexpr size_t WS_B13A = al256(WS_MOD + (size_t)2 * 17 * NMOD * 4);
constexpr size_t WS_BIN = al256(WS_B13A + (size_t)17 * 2 * DFF * 4);
constexpr size_t WS_B13B = al256(WS_BIN + (size_t)17 * NIN * 4);
constexpr size_t WS_SSQ = al256(WS_B13B + (size_t)17 * 2 * DFF * 4);
constexpr size_t WS_ROPE = al256(WS_SSQ + (size_t)7 * TT * 4);
constexpr size_t WS_HCTX = al256(WS_ROPE + (size_t)SEQ * 32 * 8);
constexpr size_t WS_AP = al256(WS_HCTX + (size_t)TC * DM * 4);
constexpr size_t WS_KB = al256(WS_AP + (size_t)TT * DM * 2);
constexpr size_t WS_VT = al256(WS_KB + (size_t)TT * 128 * 2);
constexpr size_t WS_P = al256(WS_VT + (size_t)NBATCH * 2 * 64 * KVPOS * 2);
constexpr size_t WS_G = al256(WS_P + (size_t)TT * NPC * 2);
constexpr size_t WS_CTL = al256(WS_G + (size_t)TT * NGC * 2);
constexpr size_t WS_END = WS_CTL + 16384;

constexpr int LDS_BYTES = 147456;
constexpr int NPHASES = 23;

__device__ __forceinline__ unsigned cvtpk(float lo, float hi) { f32x2_t v = {lo, hi}; bf16x2_t b = __builtin_convertvector(v, bf16x2_t); return __builtin_bit_cast(unsigned, b); }
__device__ __forceinline__ float bflo(unsigned u) { return __uint_as_float(u << 16); }
__device__ __forceinline__ float bfhi(unsigned u) { return __uint_as_float(u & 0xffff0000u); }
__device__ __forceinline__ float fexp(float x) { return __builtin_amdgcn_exp2f(x * 1.4426950408889634f); }
__device__ __forceinline__ float frcp(float x) { return __builtin_amdgcn_rcpf(x); }
__device__ __forceinline__ float sigm(float x) { return frcp(1.f + fexp(-x)); }
__device__ __forceinline__ float gelu_t(float x) { const float z = 0.7978845608028654f * (x + 0.044715f * x * x * x); return x * frcp(1.f + fexp(-2.f * z)); }
#define LDS_WAIT() asm volatile("s_waitcnt lgkmcnt(0)" ::: "memory")
__device__ __forceinline__ uintptr_t uni64(uintptr_t v) { const unsigned lo = __builtin_amdgcn_readfirstlane((unsigned)v), hi = __builtin_amdgcn_readfirstlane((unsigned)(v >> 32)); return ((uintptr_t)hi << 32) | lo; }

namespace pg8 {
constexpr int BM = 256, BK = 64, HALF = 128, HTB = HALF * BK * 2, STAGE_BYTES = 8 * HTB, NXCD = 8, WGM = 8;
__device__ __forceinline__ int lds_byte(int r, int c) { const int st = (r >> 4) * 2 + (c >> 5), rr = r & 15, cc = c & 31, ob = rr * 64 + cc * 2; return st * 1024 + (ob ^ (((ob >> 9) & 1) << 5)); }
__device__ __forceinline__ void stage_rc(int b, int& R, int& C) { const int st = b / 1024, sb = b % 1024, swz = sb ^ (((sb >> 9) & 1) << 5); R = (st >> 1) * 16 + swz / 64; C = (st & 1) * 32 + (swz % 64) / 2; }
__device__ __forceinline__ int perm32(int rho) { const int n = rho >> 4, i = rho & 15; return 8 * (i >> 2) + 4 * n + (i & 3); }

struct Unit { int pm, pn, k0, nt, tag, te; };

struct TileSched {
    int c, G, nM1, nN1, n1, pn0_1, n2, pm0_2, pn0_2, nb, ntk;
    int sk, P, R, s, e, ttot; float* slots; unsigned* flags; unsigned epoch;
    __device__ __forceinline__ void map_tile(int L, Unit& u) const {
        int wgid; { const int q = n1 / NXCD, r = n1 % NXCD, xcd = L % NXCD, off = L / NXCD; wgid = (xcd < r ? xcd * (q + 1) : r * (q + 1) + (xcd - r) * q) + off; }
        const int nig = WGM * nN1, gid = wgid / nig, fm = gid * WGM, gsz = (nM1 - fm) < WGM ? (nM1 - fm) : WGM;
        u.pm = fm + ((wgid % nig) % gsz); u.pn = pn0_1 + (wgid % nig) / gsz;
    }
    __device__ __forceinline__ bool next(int i, Unit& u) const {
        if (sk) {
            if (i < R) { map_tile(i * G + c, u); u.k0 = 0; u.nt = ntk; u.tag = 0; u.te = 0; return true; }
            const int T = s / P + (i - R), base = T * P;
            const int p0 = (i == R) ? s - base : 0; int p1 = e - base; if (p1 > P) p1 = P;
            if (p1 <= p0) return false;
            map_tile(R * G + T, u);
            u.k0 = p0 * 128; u.nt = 2 * (p1 - p0); u.tag = (p0 > 0) ? 1 : (p1 < P ? 2 : 0); u.te = base + P;
            return true;
        }
        int ti = i, br = 0;
        if (nb == 3) { ti = i / 3; br = i - ti * 3; }
        const int L = ti * G + c;
        if (L < n1) {
            map_tile(L, u);
        } else if (L - n1 < n2) { u.pm = pm0_2 + (L - n1); u.pn = pn0_2; }
        else return false;
        if (nb == 3) { u.k0 = br * 256 + (br >> 1) * 256; u.nt = 4 + 4 * (br & 1); }
        else { u.k0 = 0; u.nt = ntk; }
        u.tag = (nb == 3) ? br : 0; u.te = 0;
        return true;
    }
};
__device__ __forceinline__ TileSched make_sched(int nM1, int nN1, int K) {
    TileSched s; s.c = blockIdx.x; s.G = gridDim.x; s.nM1 = nM1; s.nN1 = nN1; s.n1 = nM1 * nN1; s.pn0_1 = 0; s.n2 = 0; s.pm0_2 = 0; s.pn0_2 = 0; s.nb = 1;
    s.ntk = K / BK; s.sk = 0; s.P = 1; s.R = 0; s.s = 0; s.e = 0; s.ttot = 0; s.slots = nullptr; s.flags = nullptr; s.epoch = 0; return s;
}
__device__ __forceinline__ TileSched make_streamk(int nM1, int nN1, int K, float* slots, unsigned* flags, unsigned epoch) {
    TileSched s = make_sched(nM1, nN1, K);
    s.sk = 1; s.P = K / (2 * BK); s.R = s.n1 / s.G; s.ttot = (s.n1 - s.R * s.G) * s.P;
    s.s = (int)((long long)s.c * s.ttot / s.G); s.e = (int)((long long)(s.c + 1) * s.ttot / s.G);
    s.slots = slots; s.flags = flags; s.epoch = epoch;
    return s;
}

__device__ __forceinline__ int unit_mb(const Unit& u) { return u.pm < 128 ? (u.pm >> 3) : 16; }

struct EpiSwiGLU {
    bf16_t* act; const float* bias; const float* ssq;
    __device__ __forceinline__ void operator()(const f32x4 (&acc)[2][2][4][2], const Unit& u, int wr, int wc, int fr, int fq) const {
        const int mb = unit_mb(u);
        const float* bp = bias + (size_t)mb * (2 * DFF) + u.pn * 256 + wc * 32 + 8 * fq;
        f32x4 ba[2], bb[2];
#pragma unroll
        for (int n = 0; n < 2; ++n) { ba[n] = *(const f32x4*)(bp + 4 * n); bb[n] = *(const f32x4*)(bp + 128 + 4 * n); }
        const int row0 = u.pm * 256 + wr * 64 + fr;
        bf16_t* op = act + (size_t)row0 * DFF + u.pn * 128 + wc * 32 + 8 * fq;
#pragma unroll
        for (int ai = 0; ai < 2; ++ai)
#pragma unroll
            for (int m = 0; m < 4; ++m) {
                const int ro = ai * 128 + m * 16;
                const float r = __builtin_amdgcn_rsqf(ssq[row0 + ro] * (1.f / DM) + EPS);
                f32x4 a0 = acc[ai][0][m][0] * r + ba[0], a1 = acc[ai][0][m][1] * r + ba[1], b0 = acc[ai][1][m][0] * r + bb[0], b1 = acc[ai][1][m][1] * r + bb[1];
                f32x4 o0, o1;
#pragma unroll
                for (int i = 0; i < 4; ++i) { o0[i] = a0[i] * b0[i] * sigm(a0[i]); o1[i] = a1[i] * b1[i] * sigm(a1[i]); }
                u32x4 w; w.x = cvtpk(o0[0], o0[1]); w.y = cvtpk(o0[2], o0[3]); w.z = cvtpk(o1[0], o1[1]); w.w = cvtpk(o1[2], o1[3]);
                *(u32x4*)(op + (size_t)ro * DFF) = w;
            }
    }
};
struct EpiIn {
    bf16_t* P; bf16_t* G; const float* bias; const float* ssq;
    __device__ __forceinline__ void operator()(const f32x4 (&acc)[2][2][4][2], const Unit& u, int wr, int wc, int fr, int fq) const {
        const int mb = unit_mb(u);
        const int colt = u.pn * 256, cw = wc * 32 + 8 * fq;
        const float* bp = bias + (size_t)mb * NIN + colt + cw;
        f32x4 bv[2][2];
#pragma unroll
        for (int bj = 0; bj < 2; ++bj)
#pragma unroll
            for (int n = 0; n < 2; ++n) bv[bj][n] = *(const f32x4*)(bp + bj * 128 + 4 * n);
        const int row0 = u.pm * 256 + wr * 64 + fr;
        const bool gate = u.pn >= 6;
        bf16_t* base = gate ? G + (size_t)row0 * NGC + (colt - NPC) + cw : P + (size_t)row0 * NPC + colt + cw;
        const size_t ld = gate ? NGC : NPC;
#pragma unroll
        for (int ai = 0; ai < 2; ++ai)
#pragma unroll
            for (int m = 0; m < 4; ++m) {
                const int ro = ai * 128 + m * 16;
                const float r = __builtin_amdgcn_rsqf(ssq[row0 + ro] * (1.f / DM) + EPS);
#pragma unroll
                for (int bj = 0; bj < 2; ++bj) {
                    f32x4 v0 = acc[ai][bj][m][0] * r + bv[bj][0], v1 = acc[ai][bj][m][1] * r + bv[bj][1];
                    if (gate) {
#pragma unroll
                        for (int i = 0; i < 4; ++i) { v0[i] = sigm(v0[i]); v1[i] = sigm(v1[i]); }
                    }
                    u32x4 w; w.x = cvtpk(v0[0], v0[1]); w.y = cvtpk(v0[2], v0[3]); w.z = cvtpk(v1[0], v1[1]); w.w = cvtpk(v1[2], v1[3]);
                    *(u32x4*)(base + (size_t)ro * ld + bj * 128) = w;
                }
            }
    }
};
struct EpiRes {
    uintptr_t hin_l, hin_cd, hout_l, hout_cd; const float* gate; float coef; const float* nrm; const float* scl; float* ssq; bf16_t* Ap; int dry;
    __device__ __forceinline__ void operator()(const f32x4 (&acc)[2][2][4][2], const Unit& u, int wr, int wc, int fr, int fq) const {
        const int mb = unit_mb(u);
        const bool lat = u.pm < 128;
        uintptr_t hin_l = this->hin_l, hin_cd = this->hin_cd, hout_l = this->hout_l, hout_cd = this->hout_cd; const float* gate = this->gate; float coef = this->coef;
        const float* nrm = this->nrm; const float* scl = this->scl; float* ssq = this->ssq; bf16_t* Ap = this->Ap;
        hin_l = uni64(hin_l); hin_cd = uni64(hin_cd); hout_l = uni64(hout_l); hout_cd = uni64(hout_cd); gate = (const float*)uni64((uintptr_t)gate); coef = __uint_as_float(__builtin_amdgcn_readfirstlane(__float_as_uint(coef)));
        nrm = (const float*)uni64((uintptr_t)nrm); scl = (const float*)uni64((uintptr_t)scl); ssq = (float*)uni64((uintptr_t)ssq); Ap = (bf16_t*)uni64((uintptr_t)Ap);
        const int col0 = u.pn * 256 + wc * 32 + 8 * fq, row0 = u.pm * 256 + wr * 64 + fr, rowl = lat ? row0 : row0 - TL;
        const float* hi = (const float*)(hin_l + (lat ? (uintptr_t)0 : hin_cd)) + (size_t)rowl * DM + col0;
        float* ho = (float*)(hout_l + (lat ? (uintptr_t)0 : hout_cd)) + (size_t)rowl * DM + col0;
        f32x4 gc[2][2], gs[2][2];
#pragma unroll
        for (int bj = 0; bj < 2; ++bj)
#pragma unroll
            for (int n = 0; n < 2; ++n) {
                gc[bj][n] = *(const f32x4*)(gate + (size_t)mb * NMOD + col0 + 128 * bj + 4 * n) * (dry ? 0.f : coef);
                if (Ap) gs[bj][n] = *(const f32x4*)(nrm + col0 + 128 * bj + 4 * n) * (*(const f32x4*)(scl + (size_t)mb * NMOD + col0 + 128 * bj + 4 * n) + 1.f);
                else gs[bj][n] = (f32x4){0.f, 0.f, 0.f, 0.f};
            }
#pragma unroll
        for (int ai = 0; ai < 2; ++ai)
#pragma unroll
            for (int m = 0; m < 4; ++m) {
                const int ro = ai * 128 + m * 16; const size_t off = (size_t)ro * DM;
                float ss = 0.f;
#pragma unroll
                for (int bj = 0; bj < 2; ++bj) {
                    f32x4 h0 = *(const f32x4*)(hi + off + 128 * bj), h1 = *(const f32x4*)(hi + off + 128 * bj + 4);
                    h0 += gc[bj][0] * acc[ai][bj][m][0]; h1 += gc[bj][1] * acc[ai][bj][m][1];
                    *(f32x4*)(ho + off + 128 * bj) = h0; *(f32x4*)(ho + off + 128 * bj + 4) = h1;
                    ss += (h0[0] * h0[0] + h0[1] * h0[1]) + (h0[2] * h0[2] + h0[3] * h0[3]) + (h1[0] * h1[0] + h1[1] * h1[1]) + (h1[2] * h1[2] + h1[3] * h1[3]);
                    if (Ap) { const f32x4 a0 = h0 * gs[bj][0], a1 = h1 * gs[bj][1];
                        u32x4 w; w.x = cvtpk(a0[0], a0[1]); w.y = cvtpk(a0[2], a0[3]); w.z = cvtpk(a1[0], a1[1]); w.w = cvtpk(a1[2], a1[3]);
                        *(u32x4*)(Ap + (size_t)(row0 + ro) * DM + col0 + 128 * bj) = w; }
                }
                ss += __shfl_xor(ss, 16); ss += __shfl_xor(ss, 32);
                if (fq == 0) atomicAdd(ssq + row0 + ro, dry ? 0.f : ss);
            }
    }
};
struct EpiMerge {
    const bf16_t* G; bf16_t* Mg;
    __device__ __forceinline__ void operator()(const f32x4 (&acc)[2][2][4][2], const Unit& u, int wr, int wc, int fr, int fq) const {
        const int br = u.tag, col0 = u.pn * 256 + wc * 32 + 8 * fq, row0 = u.pm * 256 + wr * 64 + fr;
#pragma unroll
        for (int ai = 0; ai < 2; ++ai)
#pragma unroll
            for (int m = 0; m < 4; ++m) {
                const int row = row0 + ai * 128 + m * 16;
#pragma unroll
                for (int bj = 0; bj < 2; ++bj) {
                    const u32x4 g = *(const u32x4*)(G + (size_t)row * NGC + br * 1024 + col0 + 128 * bj);
                    const f32x4 c0 = acc[ai][bj][m][0], c1 = acc[ai][bj][m][1];
                    f32x4 v0, v1;
                    v0[0] = bflo(g.x) * c0[0]; v0[1] = bfhi(g.x) * c0[1]; v0[2] = bflo(g.y) * c0[2]; v0[3] = bfhi(g.y) * c0[3];
                    v1[0] = bflo(g.z) * c1[0]; v1[1] = bfhi(g.z) * c1[1]; v1[2] = bflo(g.w) * c1[2]; v1[3] = bfhi(g.w) * c1[3];
                    bf16_t* mp = Mg + (size_t)row * DM + col0 + 128 * bj;
                    if (br > 0) {
                        const unsigned long long p0 = __hip_atomic_load((const unsigned long long*)mp, __ATOMIC_RELAXED, __HIP_MEMORY_SCOPE_AGENT);
                        const unsigned long long p1 = __hip_atomic_load((const unsigned long long*)mp + 1, __ATOMIC_RELAXED, __HIP_MEMORY_SCOPE_AGENT);
                        const unsigned a = (unsigned)p0, b = (unsigned)(p0 >> 32), c = (unsigned)p1, d = (unsigned)(p1 >> 32);
                        v0[0] += bflo(a); v0[1] += bfhi(a); v0[2] += bflo(b); v0[3] += bfhi(b);
                        v1[0] += bflo(c); v1[1] += bfhi(c); v1[2] += bflo(d); v1[3] += bfhi(d);
                    }
                    u32x4 w; w.x = cvtpk(v0[0], v0[1]); w.y = cvtpk(v0[2], v0[3]); w.z = cvtpk(v1[0], v1[1]); w.w = cvtpk(v1[2], v1[3]);
                    *(u32x4*)mp = w;
                }
            }
    }
};

template <class Epi>
__device__ __forceinline__ void gemm_phase(const int tid, LAS unsigned char* lds, const bf16_t* Ab, int lda, const bf16_t* Bb, int ldb, const TileSched& S, const Epi& E) {
    const int wid = __builtin_amdgcn_readfirstlane(tid >> 6), lane = tid & 63, wr = wid >> 2, wc = wid & 3, fr = lane & 15, fq = lane >> 4;
    unsigned voffA[2], voffB[2];
#pragma unroll
    for (int i = 0; i < 2; ++i) { int R, C; stage_rc(tid * 16 + i * 8192, R, C); const int Rb = (R & ~31) + perm32(R & 31);
        voffA[i] = (unsigned)(R * lda + C) * 2u; voffB[i] = (unsigned)(Rb * ldb + C) * 2u; }
    const size_t kstep = (size_t)(BK * 2);
    const size_t hsA = (size_t)HALF * lda * 2, hsB = (size_t)HALF * ldb * 2;
    const unsigned ldsw = (unsigned)wid * 1024u;
    const int aoff = lds_byte(wr * 64 + fr, fq * 8), boff = lds_byte(wc * 32 + fr, fq * 8);
#define PG8_SA(b, h) (((b) * 2 + (h)) * HTB)
#define PG8_SB(b, h) ((4 + (b) * 2 + (h)) * HTB)
#define PG8_STAGE(bufoff, gbase, voff) do { _Pragma("unroll") for (int _i = 0; _i < 2; ++_i) \
        __builtin_amdgcn_global_load_lds((const unsigned*)((const char*)(gbase) + (voff)[_i]), (LAS unsigned*)(lds + (bufoff) + ldsw + _i * 8192), 16, 0, 0); } while (0)
#define PG8_LDA(dst, b, h) do { _Pragma("unroll") for (int m = 0; m < 4; ++m) _Pragma("unroll") for (int k = 0; k < 2; ++k) dst[m][k] = *(const LAS bf16x8*)(lds + PG8_SA(b, h) + aoff + m * 2048 + k * 1024); } while (0)
#define PG8_LDB(dst, b, h) do { _Pragma("unroll") for (int n = 0; n < 2; ++n) _Pragma("unroll") for (int k = 0; k < 2; ++k) dst[n][k] = *(const LAS bf16x8*)(lds + PG8_SB(b, h) + boff + n * 2048 + k * 1024); } while (0)
#define PG8_MMA(ai, bj, At, Bt) do { __builtin_amdgcn_s_setprio(1); _Pragma("unroll") for (int m = 0; m < 4; ++m) _Pragma("unroll") for (int n = 0; n < 2; ++n) _Pragma("unroll") for (int k = 0; k < 2; ++k) \
        acc[ai][bj][m][n] = __builtin_amdgcn_mfma_f32_16x16x32_bf16(Bt[n][k], At[m][k], acc[ai][bj][m][n], 0, 0, 0); __builtin_amdgcn_s_setprio(0); } while (0)
#define PG8_WAIT_V(n) asm volatile("s_waitcnt vmcnt(" #n ")" ::: "memory")
#define PG8_WAIT_L(n) asm volatile("s_waitcnt lgkmcnt(" #n ")" ::: "memory")
#define PG8_BAR __builtin_amdgcn_s_barrier()
#define PG8_SCHED __builtin_amdgcn_sched_barrier(0)
    Unit cur, nxt; int ui = 0;
    if (!S.next(0, cur)) return;
    f32x4 acc[2][2][4][2];
#pragma unroll
    for (int a = 0; a < 2; ++a)
#pragma unroll
        for (int b = 0; b < 2; ++b)
#pragma unroll
            for (int m = 0; m < 4; ++m)
#pragma unroll
                for (int n = 0; n < 2; ++n) acc[a][b][m][n] = (f32x4){0.f, 0.f, 0.f, 0.f};
    bf16x8 At[4][2], B0[2][2], B1[2][2];
    const char* cA = (const char*)Ab + (size_t)cur.pm * 2 * hsA + (size_t)cur.k0 * 2; const char* cB = (const char*)Bb + (size_t)cur.pn * 2 * hsB + (size_t)cur.k0 * 2;
    PG8_STAGE(PG8_SB(0, 0), cB, voffB); PG8_STAGE(PG8_SB(0, 1), cB + hsB, voffB); PG8_STAGE(PG8_SA(0, 0), cA, voffA); PG8_STAGE(PG8_SA(0, 1), cA + hsA, voffA);
    if (wr == 1) PG8_BAR;
    PG8_WAIT_V(2); PG8_BAR;
    PG8_STAGE(PG8_SB(1, 0), cB + kstep, voffB); PG8_STAGE(PG8_SA(1, 0), cA + kstep, voffA); PG8_STAGE(PG8_SB(1, 1), cB + hsB + kstep, voffB);
    PG8_WAIT_V(6); PG8_BAR;
    for (;;) {
        const bool has_next = S.next(ui + 1, nxt);
        const char* nA = has_next ? (const char*)Ab + (size_t)nxt.pm * 2 * hsA + (size_t)nxt.k0 * 2 : cA;
        const char* nB = has_next ? (const char*)Bb + (size_t)nxt.pn * 2 * hsB + (size_t)nxt.k0 * 2 : cB;
        const int nt = cur.nt;
        for (int t = 0; t < nt; t += 2) {
            const bool last = (t == nt - 2);
            const char* a1 = cA + (size_t)(t + 1) * kstep;
            const char* a2 = last ? nA : cA + (size_t)(t + 2) * kstep; const char* b2 = last ? nB : cB + (size_t)(t + 2) * kstep;
            const char* a3 = a2 + kstep; const char* b3 = b2 + kstep;
            PG8_LDB(B0, 0, 0); PG8_LDB(B1, 0, 1); PG8_SCHED; PG8_LDA(At, 0, 0); PG8_STAGE(PG8_SA(1, 1), a1 + hsA, voffA);
            PG8_WAIT_V(8); PG8_WAIT_L(0); PG8_BAR; PG8_MMA(0, 0, At, B0); PG8_MMA(0, 1, At, B1); PG8_BAR; PG8_SCHED;
            PG8_LDA(At, 0, 1); PG8_STAGE(PG8_SB(0, 0), b2, voffB); PG8_STAGE(PG8_SB(0, 1), b2 + hsB, voffB); PG8_STAGE(PG8_SA(0, 0), a2, voffA);
            PG8_WAIT_V(8); PG8_WAIT_L(0); PG8_BAR; PG8_MMA(1, 0, At, B0); PG8_MMA(1, 1, At, B1); PG8_BAR; PG8_SCHED;
            PG8_LDB(B0, 1, 0); PG8_LDB(B1, 1, 1); PG8_SCHED; PG8_LDA(At, 1, 0); PG8_STAGE(PG8_SA(0, 1), a2 + hsA, voffA);
            PG8_WAIT_V(8); PG8_WAIT_L(0); PG8_BAR; PG8_MMA(0, 0, At, B0); PG8_MMA(0, 1, At, B1); PG8_BAR; PG8_SCHED;
            PG8_LDA(At, 1, 1); PG8_STAGE(PG8_SB(1, 0), b3, voffB); PG8_STAGE(PG8_SB(1, 1), b3 + hsB, voffB); PG8_STAGE(PG8_SA(1, 0), a3, voffA);
            PG8_WAIT_V(8); PG8_WAIT_L(0); PG8_BAR; PG8_MMA(1, 0, At, B0); PG8_MMA(1, 1, At, B1); PG8_BAR; PG8_SCHED;
        }
        if (wr == 0) PG8_BAR;
        if (S.sk && (cur.tag & 2)) {
            for (int j = S.c + 1; j < S.G; ++j) {
                const int sj = (int)((long long)j * S.ttot / S.G); if (sj >= cur.te) break;
                const int ej = (int)((long long)(j + 1) * S.ttot / S.G); if (ej == sj) continue;
                unsigned* fl = S.flags + j * 8 + wid;
                if (lane == 0) { while (__hip_atomic_load(fl, __ATOMIC_RELAXED, __HIP_MEMORY_SCOPE_AGENT) != S.epoch) __builtin_amdgcn_s_sleep(1); }
                asm volatile("" ::: "memory");
                const unsigned long long* sp = (const unsigned long long*)(S.slots + (size_t)j * 65536 + wid * 8192) + lane; asm volatile("" : "+v"(sp));
#pragma unroll
                for (int a = 0; a < 2; ++a)
#pragma unroll
                    for (int b = 0; b < 2; ++b)
#pragma unroll
                        for (int m = 0; m < 4; ++m) {
#pragma unroll
                            for (int n = 0; n < 2; ++n) {
                                const unsigned long long v0 = __hip_atomic_load(sp, __ATOMIC_RELAXED, __HIP_MEMORY_SCOPE_AGENT), v1 = __hip_atomic_load(sp + 64, __ATOMIC_RELAXED, __HIP_MEMORY_SCOPE_AGENT);
                                acc[a][b][m][n][0] += __uint_as_float((unsigned)v0); acc[a][b][m][n][1] += __uint_as_float((unsigned)(v0 >> 32));
                                acc[a][b][m][n][2] += __uint_as_float((unsigned)v1); acc[a][b][m][n][3] += __uint_as_float((unsigned)(v1 >> 32));
                                sp += 128; }
                            if (m & 1) asm volatile("" : "+v"(sp) :: "memory");
                        }
            }
        }
        if (S.sk && (cur.tag & 1)) {
            unsigned long long* sp = (unsigned long long*)(S.slots + (size_t)S.c * 65536 + wid * 8192) + lane; asm volatile("" : "+v"(sp));
#pragma unroll
            for (int a = 0; a < 2; ++a)
#pragma unroll
                for (int b = 0; b < 2; ++b)
#pragma unroll
                    for (int m = 0; m < 4; ++m)
#pragma unroll
                        for (int n = 0; n < 2; ++n) {
                            const f32x4 v = acc[a][b][m][n];
                            __hip_atomic_store(sp, (unsigned long long)__float_as_uint(v[0]) | ((unsigned long long)__float_as_uint(v[1]) << 32), __ATOMIC_RELAXED, __HIP_MEMORY_SCOPE_AGENT);
                            __hip_atomic_store(sp + 64, (unsigned long long)__float_as_uint(v[2]) | ((unsigned long long)__float_as_uint(v[3]) << 32), __ATOMIC_RELAXED, __HIP_MEMORY_SCOPE_AGENT);
                            sp += 128; asm volatile("" : "+v"(sp)); }
            asm volatile("s_waitcnt vmcnt(0)" ::: "memory");
            if (lane == 0) __hip_atomic_store(S.flags + S.c * 8 + wid, S.epoch, __ATOMIC_RELAXED, __HIP_MEMORY_SCOPE_AGENT);
        } else E(acc, cur, wr, wc, fr, fq);
        if (!has_next) break;
#pragma unroll
        for (int a = 0; a < 2; ++a)
#pragma unroll
            for (int b = 0; b < 2; ++b)
#pragma unroll
                for (int m = 0; m < 4; ++m)
#pragma unroll
                    for (int n = 0; n < 2; ++n) acc[a][b][m][n] = (f32x4){0.f, 0.f, 0.f, 0.f};
        cur = nxt; cA = nA; cB = nB; ++ui;
        if (wr == 1) PG8_BAR;
    }
    PG8_WAIT_V(0);
    PG8_BAR;
#undef PG8_SA
#undef PG8_SB
#undef PG8_STAGE
#undef PG8_LDA
#undef PG8_LDB
#undef PG8_MMA
#undef PG8_WAIT_V
#undef PG8_WAIT_L
#undef PG8_BAR
#undef PG8_SCHED
}
}

struct Args {
    const float* in[26];
    float* out; unsigned char* ws;
    int ph_lo, ph_hi;
};
enum { I_X = 0, I_C, I_CTX, I_CCTX, I_WADA, I_BADA, I_NFFN1, I_F1W13, I_F1W2, I_NMIX, I_WIN, I_QN, I_KN, I_POOLW, I_POOLS, I_SGUN, I_SGUW, I_SGUB,
       I_WBRP, I_WBRA, I_WBRS, I_WOUT, I_NFFN2, I_F2W13, I_F2W2, I_FNORM };

__device__ __forceinline__ float wave_sum(float v) {
#pragma unroll
    for (int o = 1; o < 64; o <<= 1) v += __shfl_xor(v, o);
    return v;
}

__device__ __forceinline__ void tr_item(const float* W, int N, bf16_t* WT, int ldt, int coloff, int mode13, float* scr, int item, int lane) {
    const int nblk = N / 32, kb = item / nblk, nb = item - kb * nblk, k0 = 64 * kb, n0 = 32 * nb;
#pragma unroll 8
    for (int i = 0; i < 32; ++i) { const int kk = 2 * i + (lane >> 5); scr[kk * 33 + (lane & 31)] = W[(size_t)(k0 + kk) * N + n0 + (lane & 31)]; }
    LDS_WAIT();
    int r0 = n0;
    if (mode13) { const int s = n0 / DFF, rem = n0 - s * DFF, t = rem >> 7, j = rem & 127; r0 = 256 * t + 128 * s + j; }
    const int c = lane & 7;
#pragma unroll
    for (int j = 0; j < 4; ++j) { const int n = (lane >> 3) + 8 * j; const float* s = scr + (8 * c) * 33 + n;
        u32x4 o; o.x = cvtpk(s[0 * 33], s[1 * 33]); o.y = cvtpk(s[2 * 33], s[3 * 33]); o.z = cvtpk(s[4 * 33], s[5 * 33]); o.w = cvtpk(s[6 * 33], s[7 * 33]);
        *(u32x4*)(WT + (size_t)(r0 + n) * ldt + coloff + k0 + 8 * c) = o; }
    LDS_WAIT();
}

__device__ __forceinline__ void convert_weights(const int tid, const Args& a, int l, unsigned char* lds) {
    const int lane = tid & 63, wave = tid >> 6;
    float* scr = (float*)(lds + wave * 8704);
    const int gw = blockIdx.x * 8 + wave, NGW = gridDim.x * 8;
    unsigned char* ws = a.ws;
    constexpr int I13 = (DM / 64) * (2 * DFF / 32), I2 = (DFF / 64) * (DM / 32), IIN = (DM / 64) * (NIN / 32), IOUT = (DM / 64) * (DM / 32), IBA = (512 / 64) * (DM / 32), IBS = (256 / 64) * (DM / 32);
    constexpr int NITEMS = 2 * I13 + 2 * I2 + IIN + IOUT + IBA + IBS;
    for (int it = gw; it < NITEMS; it += NGW) {
        int r = it; const float* W; int N; bf16_t* WT; int ldt = DM, coloff = 0, m13 = 0;
        if (r < 2 * I13) { const bool second = r >= I13; r -= second ? I13 : 0; W = a.in[second ? I_F2W13 : I_F1W13] + (size_t)l * DM * 2 * DFF; N = 2 * DFF; WT = (bf16_t*)(ws + (second ? WS_W13B : WS_W13A)); m13 = 1; }
        else if (r < 2 * I13 + 2 * I2) { r -= 2 * I13; const bool second = r >= I2; r -= second ? I2 : 0; W = a.in[second ? I_F2W2 : I_F1W2] + (size_t)l * DFF * DM; N = DM; WT = (bf16_t*)(ws + (second ? WS_W2B : WS_W2A)); ldt = DFF; }
        else if (r < 2 * I13 + 2 * I2 + IIN) { r -= 2 * I13 + 2 * I2; W = a.in[I_WIN] + (size_t)l * DM * NIN; N = NIN; WT = (bf16_t*)(ws + WS_WIN); }
        else if (r < 2 * I13 + 2 * I2 + IIN + IOUT) { r -= 2 * I13 + 2 * I2 + IIN; W = a.in[I_WOUT] + (size_t)l * DM * DM; N = DM; WT = (bf16_t*)(ws + WS_WOUT); }
        else if (r < 2 * I13 + 2 * I2 + IIN + IOUT + IBA) { r -= 2 * I13 + 2 * I2 + IIN + IOUT; W = a.in[I_WBRA] + (size_t)l * 512 * DM; N = DM; WT = (bf16_t*)(ws + WS_WCAT); coloff = 256; }
        else { r -= 2 * I13 + 2 * I2 + IIN + IOUT + IBA; W = a.in[I_WBRS] + (size_t)l * 256 * DM; N = DM; WT = (bf16_t*)(ws + WS_WCAT); coloff = 768; }
        tr_item(W, N, WT, ldt, coloff, m13, scr, r, lane);
    }
    {
        const float* pw = a.in[I_POOLW] + (size_t)l * 4 * 64 * 64; const float* ps = a.in[I_POOLS] + (size_t)l * 256; const float* wb = a.in[I_WBRP] + (size_t)l * 256 * DM;
        bf16_t* wcat = (bf16_t*)(ws + WS_WCAT);
        for (int it = blockIdx.x * 512 + tid; it < 1024 * 32; it += gridDim.x * 512) {
            const int n = it & 1023, kg = it >> 10, g = kg >> 3, c0 = (kg & 7) * 8;
            float s[8];
#pragma unroll
            for (int i = 0; i < 8; ++i) s[i] = 0.f;
            for (int d = 0; d < 64; ++d) {
                const float wv = wb[(size_t)(g * 64 + d) * DM + n] * ps[g * 64 + d];
#pragma unroll
                for (int i = 0; i < 8; ++i) s[i] += pw[(g * 64 + c0 + i) * 64 + d] * wv;
            }
            u32x4 o; o.x = cvtpk(s[0], s[1]); o.y = cvtpk(s[2], s[3]); o.z = cvtpk(s[4], s[5]); o.w = cvtpk(s[6], s[7]);
            *(u32x4*)(wcat + (size_t)n * DM + kg * 8) = o;
        }
    }
    {
        const float* sw = a.in[I_SGUW] + (size_t)l * 4 * 128 * 128; unsigned* dst = (unsigned*)(ws + WS_SGUW);
        for (int it = blockIdx.x * 512 + tid; it < 4 * 128 * 64; it += gridDim.x * 512) dst[it] = cvtpk(sw[2 * it], sw[2 * it + 1]);
    }
}

__device__ __forceinline__ void compute_biases(const int tid, const Args& a, int l, unsigned char* lds) {
    const int lane = tid & 63, wave = tid >> 6;
    float* sh = (float*)lds;
    const float* modl = (const float*)(a.ws + WS_MOD) + (size_t)l * 17 * NMOD;
    const int gw = blockIdx.x * 8 + wave, NGW = gridDim.x * 8;
    for (int j = 0; j < 3; ++j) {
        __syncthreads();
        for (int i = tid; i < 17 * DM; i += 512) sh[i] = modl[(size_t)(i >> 10) * NMOD + (3 * j) * DM + (i & 1023)];
        __syncthreads();
        const bf16_t* Wt = (const bf16_t*)(a.ws + (j == 0 ? WS_W13A : (j == 1 ? WS_WIN : WS_W13B)));
        float* bo = (float*)(a.ws + (j == 0 ? WS_B13A : (j == 1 ? WS_BIN : WS_B13B)));
        const int N = (j == 1) ? NIN : 2 * DFF;
        for (int n = gw; n < N; n += NGW) {
            float w[16];
#pragma unroll
            for (int c = 0; c < 4; ++c) { const u32x2 v = *(const u32x2*)(Wt + (size_t)n * DM + c * 256 + lane * 4); w[4 * c] = bflo(v.x); w[4 * c + 1] = bfhi(v.x); w[4 * c + 2] = bflo(v.y); w[4 * c + 3] = bfhi(v.y); }
            float mine = 0.f;
#pragma unroll 1
            for (int mb = 0; mb < 17; ++mb) {
                float p = 0.f;
#pragma unroll
                for (int c = 0; c < 4; ++c) { const f32x4 s = *(const f32x4*)(sh + mb * DM + c * 256 + lane * 4); p += w[4 * c] * s[0] + w[4 * c + 1] * s[1] + w[4 * c + 2] * s[2] + w[4 * c + 3] * s[3]; }
                p = wave_sum(p);
                if (lane == mb) mine = p;
            }
            if (lane < 17) bo[(size_t)lane * N + n] = mine;
        }
    }
}

__device__ __forceinline__ void post_phase(const int tid, const Args& a, int l, unsigned char* lds) {
    const int lane = tid & 63, wave = tid >> 6;
    unsigned char* ws = a.ws;
    const bf16_t* P = (const bf16_t*)(ws + WS_P);
    bf16_t* Bcat = (bf16_t*)(ws + WS_AP); bf16_t* kbuf = (bf16_t*)(ws + WS_KB); bf16_t* Vt = (bf16_t*)(ws + WS_VT);
    const float* rope = (const float*)(ws + WS_ROPE);
    const float* qn = a.in[I_QN] + l * 64; const float* kn = a.in[I_KN] + l * 64;
    const int nchf = (l == 0) ? 288 : 256;
    const int nSGU = nchf * 2, nPOOL = nchf, nV = 288, nQK = TT / 64, total = nSGU + nPOOL + nV + nQK;
    for (int it = blockIdx.x; it < total; it += gridDim.x) {
        if (it < nSGU + nPOOL + nV) {
            const int ch = it < nSGU ? (it >> 1) : (it < nSGU + nPOOL ? it - nSGU : it - nSGU - nPOOL);
            const bool lat = ch < 256;
            const int b = lat ? (ch >> 4) : ((ch - 256) >> 1), t0 = lat ? (ch & 15) * 128 : ((ch - 256) & 1) * 128, L = lat ? SEQ : CTXL;
            const int Rb = lat ? b * SEQ : TL + b * CTXL, R0 = Rb + t0;
            if (it < nSGU) {
                const int gp = it & 1;
                bf16_t* vT = (bf16_t*)lds;
                bf16_t* Ws = (bf16_t*)(lds + 34816);
                const float* sn = a.in[I_SGUN] + l * 256;
                {
                    const bf16_t* wsrc = (const bf16_t*)(ws + WS_SGUW) + gp * 2 * 128 * 128;
#pragma unroll 4
                    for (int i2 = tid; i2 < 2 * 128 * 16; i2 += 512) { const int r = i2 >> 4, c = i2 & 15; *(u32x4*)(Ws + r * 136 + c * 8) = *(const u32x4*)(wsrc + r * 128 + c * 8); }
                }
#pragma unroll 2
                for (int i2 = tid; i2 < 128 * 32; i2 += 512) { const int l32 = i2 & 31, tok = i2 >> 5;
                    const u32x4 raw = *(const u32x4*)(P + (size_t)(R0 + tok) * NPC + 1280 + l32 * 8);
                    float x[8] = {bflo(raw.x), bfhi(raw.x), bflo(raw.y), bfhi(raw.y), bflo(raw.z), bfhi(raw.z), bflo(raw.w), bfhi(raw.w)};
                    float ss = 0.f;
#pragma unroll
                    for (int i = 0; i < 8; ++i) { x[i] = gelu_t(x[i]); ss += x[i] * x[i]; }
                    ss += __shfl_xor(ss, 1); ss += __shfl_xor(ss, 2); ss += __shfl_xor(ss, 4); ss += __shfl_xor(ss, 8); ss += __shfl_xor(ss, 16);
                    const float rinv = __builtin_amdgcn_rsqf(ss * (1.f / 256.f) + EPS);
                    if ((l32 >> 4) == gp) { const int cl = (l32 & 15) * 8;
#pragma unroll
                        for (int i = 0; i < 8; i += 2) { const unsigned pk = cvtpk(x[i] * rinv * sn[l32 * 8 + i], x[i + 1] * rinv * sn[l32 * 8 + i + 1]);
                            vT[(cl + i) * 136 + tok] = (bf16_t)(pk & 0xffffu); vT[(cl + i + 1) * 136 + tok] = (bf16_t)(pk >> 16); } }
                }
                __syncthreads();
                const int q32 = lane & 31, hi = lane >> 5, cblk = wave & 1, tblk = wave >> 1;
                const float* sb = a.in[I_SGUB] + (size_t)l * 4 * 128;
                const int tok = tblk * 32 + q32, R = R0 + tok;
#pragma unroll
                for (int g2 = 0; g2 < 2; ++g2) {
                    const int g = gp * 2 + g2;
                    u32x2 ur[4];
#pragma unroll
                    for (int rg = 0; rg < 4; ++rg) ur[rg] = *(const u32x2*)(P + (size_t)R * NPC + 1024 + g * 64 + cblk * 32 + 8 * rg + 4 * hi);
                    const float bias = sb[g * 128 + tok];
                    f32x16 acc;
#pragma unroll
                    for (int r = 0; r < 16; ++r) acc[r] = 0.f;
#pragma unroll
                    for (int ks = 0; ks < 8; ++ks) {
                        const bf16x8 af = *(const bf16x8*)(vT + (g2 * 64 + cblk * 32 + q32) * 136 + ks * 16 + hi * 8);
                        const bf16x8 bf = *(const bf16x8*)(Ws + (g2 * 128 + tblk * 32 + q32) * 136 + ks * 16 + hi * 8);
                        acc = __builtin_amdgcn_mfma_f32_32x32x16_bf16(af, bf, acc, 0, 0, 0);
                    }
#pragma unroll
                    for (int rg = 0; rg < 4; ++rg) {
                        const int c4 = g * 64 + cblk * 32 + 8 * rg + 4 * hi;
                        const float u0 = gelu_t(bflo(ur[rg].x)), u1 = gelu_t(bfhi(ur[rg].x)), u2 = gelu_t(bflo(ur[rg].y)), u3 = gelu_t(bfhi(ur[rg].y));
                        u32x2 w; w.x = cvtpk(u0 * (acc[4 * rg] + bias), u1 * (acc[4 * rg + 1] + bias)); w.y = cvtpk(u2 * (acc[4 * rg + 2] + bias), u3 * (acc[4 * rg + 3] + bias));
                        *(u32x2*)(Bcat + (size_t)R * DM + 768 + c4) = w;
                    }
                }
            } else if (it < nSGU + nPOOL) {
                unsigned* xs = (unsigned*)lds;
#pragma unroll 3
                for (int i2 = tid; i2 < 144 * 32; i2 += 512) { const int rr = i2 >> 5, c = i2 & 31; const int s = t0 - 8 + rr;
                    u32x4 v = (u32x4){0u, 0u, 0u, 0u};
                    if (s >= 0 && s < L) v = *(const u32x4*)(P + (size_t)(Rb + s) * NPC + 768 + c * 8);
                    *(u32x4*)(xs + rr * 128 + c * 4) = v; }
                __syncthreads();
                const int cp = tid & 127, tg = tid >> 7, hw = 1 << (cp >> 5);
                for (int tt = tg * 32; tt < tg * 32 + 32; ++tt) {
                    const int t = t0 + tt; const int lo = (t - hw) < 0 ? 0 : (t - hw), hi = (t + hw) > L ? L : (t + hw);
                    float s0 = 0.f, s1 = 0.f;
                    for (int s = lo; s < hi; ++s) { const unsigned v = xs[(s - t0 + 8) * 128 + cp]; s0 += bflo(v); s1 += bfhi(v); }
                    const float ic = 1.f / (float)(hi - lo); const unsigned xv = xs[(tt + 8) * 128 + cp];
                    *(unsigned*)(Bcat + (size_t)(R0 + tt) * DM + 2 * cp) = cvtpk(s0 * ic - bflo(xv), s1 * ic - bfhi(xv));
                }
            } else {
                bf16_t* vs = (bf16_t*)lds;
#pragma unroll 4
                for (int i2 = tid; i2 < 128 * 16; i2 += 512) { const int tok = i2 >> 4, c = i2 & 15;
                    *(u32x4*)(vs + tok * 136 + c * 8) = *(const u32x4*)(P + (size_t)(R0 + tok) * NPC + 640 + c * 8); }
                __syncthreads();
                const int posbase = lat ? t0 : SEQ + t0;
                for (int i2 = tid; i2 < 128 * 16; i2 += 512) { const int vr = i2 & 127, pg = i2 >> 7;
                    unsigned short e[8];
#pragma unroll
                    for (int i = 0; i < 8; ++i) { const int p = pg * 8 + i; const int kap = (p & ~12) | ((p & 4) << 1) | ((p & 8) >> 1); e[i] = vs[kap * 136 + vr]; }
                    u32x4 w; w.x = e[0] | ((unsigned)e[1] << 16); w.y = e[2] | ((unsigned)e[3] << 16); w.z = e[4] | ((unsigned)e[5] << 16); w.w = e[6] | ((unsigned)e[7] << 16);
                    *(u32x4*)(Vt + ((size_t)(b * 2 + (vr >> 6)) * 64 + (vr & 63)) * KVPOS + posbase + pg * 8) = w; }
            }
            __syncthreads();
        } else {
            const int R0 = (it - (nSGU + nPOOL + nV)) * 64; const bool lat = R0 < TL;
            const bool full = lat || (l == 0);
            const int nh = full ? 10 : 2, hbase = full ? 0 : 8;
#pragma unroll 2
            for (int i2 = tid; i2 < 64 * nh * 8; i2 += 512) {
                const int l8 = i2 & 7, hr = i2 >> 3, tok = hr / nh, hh = hbase + (hr - tok * nh);
                const int R = R0 + tok; const bool isq = hh < 8;
                const bf16_t* src = P + (size_t)R * NPC + (isq ? hh * 64 : 512 + (hh - 8) * 64) + l8 * 8;
                const u32x4 raw = *(const u32x4*)src;
                float x[8] = {bflo(raw.x), bfhi(raw.x), bflo(raw.y), bfhi(raw.y), bflo(raw.z), bfhi(raw.z), bflo(raw.w), bfhi(raw.w)};
                float ss = 0.f;
#pragma unroll
                for (int i = 0; i < 8; ++i) ss += x[i] * x[i];
                ss += __shfl_xor(ss, 1); ss += __shfl_xor(ss, 2); ss += __shfl_xor(ss, 4);
                const float rinv = __builtin_amdgcn_rsqf(ss * (1.f / 64.f) + EPS);
                const float* gn = (isq ? qn : kn) + l8 * 8;
                const f32x4 g0 = *(const f32x4*)gn, g1 = *(const f32x4*)(gn + 4);
                float y[8], o[8];
#pragma unroll
                for (int i = 0; i < 4; ++i) { y[i] = x[i] * rinv * g0[i]; y[4 + i] = x[4 + i] * rinv * g1[i]; }
                const int t = R & (SEQ - 1);
                const int half = l8 >> 2, second = (l8 >> 1) & 1, fi0 = (l8 & 1) * 8;
                const f32x4* rp = (const f32x4*)(rope + ((size_t)t * 32 + half * 16 + fi0) * 2);
                f32x4 cs[4];
                if (lat) {
#pragma unroll
                    for (int i = 0; i < 4; ++i) cs[i] = rp[i];
                }
#pragma unroll
                for (int i = 0; i < 8; ++i) {
                    const float partner = __shfl_xor(y[i], 2);
                    if (lat) { const float cv = cs[i >> 1][(i & 1) * 2], sv = cs[i >> 1][(i & 1) * 2 + 1];
                        o[i] = second ? (y[i] * cv + partner * sv) : (y[i] * cv - partner * sv); }
                    else o[i] = y[i];
                }
                const float sc = isq ? QSCALE : 1.f;
                u32x4 w; w.x = cvtpk(o[0] * sc, o[1] * sc); w.y = cvtpk(o[2] * sc, o[3] * sc); w.z = cvtpk(o[4] * sc, o[5] * sc); w.w = cvtpk(o[6] * sc, o[7] * sc);
                bf16_t* dst = isq ? Bcat + (size_t)R * DM + 256 + hh * 64 + l8 * 8 : kbuf + (size_t)R * 128 + (hh - 8) * 64 + l8 * 8;
                *(u32x4*)dst = w;
            }
        }
    }
}

__device__ __forceinline__ void attn_phase(const int tid, const Args& a, int l, unsigned char* lds, int dry) {
    const int lane = tid & 63, w = tid >> 6, q32 = lane & 31, hi = lane >> 5;
    bf16_t* Bcat = (bf16_t*)(a.ws + WS_AP); const bf16_t* kbuf = (const bf16_t*)(a.ws + WS_KB); const bf16_t* Vt = (const bf16_t*)(a.ws + WS_VT);
    const int G = gridDim.x, c = blockIdx.x;
    const int per = (512 + G - 1) / G;
    const int nlat = (c * per >= 512) ? 0 : ((c + 1) * per > 512 ? 512 - c * per : per);
    const int nctx = (l == 0 && c < 64) ? (64 - c + G - 1) / G : 0;
    const int kr = tid >> 3, kc = tid & 7;
    for (int ui = 0; ui < nlat + nctx; ++ui) {
        int b, kvh, qrow0, jt0, NT;
        if (ui < nlat) { const int u = c * per + ui; const int bk = u >> 4, qb = u & 15; b = bk >> 1; kvh = bk & 1; qrow0 = b * SEQ + qb * 128; jt0 = 0; NT = 36; }
        else { const int u = c + (ui - nlat) * G; const int bk = u >> 1, qb = u & 1; b = bk >> 1; kvh = bk & 1; qrow0 = TL + b * CTXL + qb * 128; jt0 = 32; NT = 4; }
        const int head = kvh * 4 + (w >> 1); const int myrow = qrow0 + 64 * (w & 1) + q32;
        bf16_t* qp = Bcat + (size_t)myrow * DM + 256 + head * 64;
        bf16x8 qf[2][4];
#pragma unroll
        for (int sb = 0; sb < 2; ++sb)
#pragma unroll
            for (int ds = 0; ds < 4; ++ds) qf[sb][ds] = *(const bf16x8*)(qp + (size_t)sb * 32 * DM + 16 * ds + hi * 8);
        const bf16_t* vsrc = Vt + ((size_t)(b * 2 + kvh) * 64 + kr) * KVPOS + kc * 8;
#define KSRC(jt) (kbuf + (size_t)(((jt) < 32 ? b * SEQ + 64 * (jt) : TL + b * CTXL + 64 * ((jt) - 32)) + kr) * 128 + kvh * 64 + kc * 8)
        u32x4 kreg = *(const u32x4*)KSRC(jt0), vreg = *(const u32x4*)(vsrc + 64 * jt0);
        *(u32x4*)(lds + kr * 144 + kc * 16) = kreg; *(u32x4*)(lds + 18432 + kr * 144 + kc * 16) = vreg;
        __syncthreads();
        f32x16 o0[2], o1[2];
        float mrun[2], lrun[2];
#pragma unroll
        for (int sb = 0; sb < 2; ++sb) { mrun[sb] = -1e30f; lrun[sb] = 0.f;
#pragma unroll
            for (int r = 0; r < 16; ++r) { o0[sb][r] = 0.f; o1[sb][r] = 0.f; } }
        for (int j = 0; j < NT; ++j) {
            if (j + 1 < NT) { kreg = *(const u32x4*)KSRC(jt0 + j + 1); vreg = *(const u32x4*)(vsrc + 64 * (jt0 + j + 1)); }
            const unsigned char* Kb = lds + (j & 1) * 9216; const unsigned char* Vb = lds + 18432 + (j & 1) * 9216;
            f32x16 p0[2], p1[2];
#pragma unroll
            for (int sb = 0; sb < 2; ++sb)
#pragma unroll
                for (int r = 0; r < 16; ++r) { p0[sb][r] = 0.f; p1[sb][r] = 0.f; }
#pragma unroll
            for (int ds = 0; ds < 4; ++ds) {
                const bf16x8 k0 = *(const bf16x8*)(Kb + q32 * 144 + ds * 32 + hi * 16);
                const bf16x8 k1 = *(const bf16x8*)(Kb + (32 + q32) * 144 + ds * 32 + hi * 16);
#pragma unroll
                for (int sb = 0; sb < 2; ++sb) {
                    p0[sb] = __builtin_amdgcn_mfma_f32_32x32x16_bf16(k0, qf[sb][ds], p0[sb], 0, 0, 0);
                    p1[sb] = __builtin_amdgcn_mfma_f32_32x32x16_bf16(k1, qf[sb][ds], p1[sb], 0, 0, 0);
                }
            }
            u32x4 pw[2][4];
#pragma unroll
            for (int sb = 0; sb < 2; ++sb) {
                float mx = fmaxf(p0[sb][0], p1[sb][0]);
#pragma unroll
                for (int r = 1; r < 16; ++r) mx = fmaxf(mx, fmaxf(p0[sb][r], p1[sb][r]));
                mx = fmaxf(mx, __shfl_xor(mx, 32));
                const float mnew = fmaxf(mrun[sb], mx); const float alpha = __builtin_amdgcn_exp2f(mrun[sb] - mnew); mrun[sb] = mnew;
                float ls = 0.f;
#pragma unroll
                for (int r = 0; r < 16; ++r) { p0[sb][r] = __builtin_amdgcn_exp2f(p0[sb][r] - mnew); p1[sb][r] = __builtin_amdgcn_exp2f(p1[sb][r] - mnew); ls += p0[sb][r] + p1[sb][r]; }
                lrun[sb] = lrun[sb] * alpha + ls;
#pragma unroll
                for (int r = 0; r < 16; ++r) { o0[sb][r] *= alpha; o1[sb][r] *= alpha; }
                pw[sb][0] = (u32x4){cvtpk(p0[sb][0], p0[sb][1]), cvtpk(p0[sb][2], p0[sb][3]), cvtpk(p0[sb][4], p0[sb][5]), cvtpk(p0[sb][6], p0[sb][7])};
                pw[sb][1] = (u32x4){cvtpk(p0[sb][8], p0[sb][9]), cvtpk(p0[sb][10], p0[sb][11]), cvtpk(p0[sb][12], p0[sb][13]), cvtpk(p0[sb][14], p0[sb][15])};
                pw[sb][2] = (u32x4){cvtpk(p1[sb][0], p1[sb][1]), cvtpk(p1[sb][2], p1[sb][3]), cvtpk(p1[sb][4], p1[sb][5]), cvtpk(p1[sb][6], p1[sb][7])};
                pw[sb][3] = (u32x4){cvtpk(p1[sb][8], p1[sb][9]), cvtpk(p1[sb][10], p1[sb][11]), cvtpk(p1[sb][12], p1[sb][13]), cvtpk(p1[sb][14], p1[sb][15])};
            }
#pragma unroll
            for (int s = 0; s < 4; ++s) {
                const bf16x8 v0 = *(const bf16x8*)(Vb + q32 * 144 + s * 32 + hi * 16);
                const bf16x8 v1 = *(const bf16x8*)(Vb + (32 + q32) * 144 + s * 32 + hi * 16);
#pragma unroll
                for (int sb = 0; sb < 2; ++sb) {
                    const bf16x8 pa = __builtin_bit_cast(bf16x8, pw[sb][s]);
                    o0[sb] = __builtin_amdgcn_mfma_f32_32x32x16_bf16(v0, pa, o0[sb], 0, 0, 0);
                    o1[sb] = __builtin_amdgcn_mfma_f32_32x32x16_bf16(v1, pa, o1[sb], 0, 0, 0);
                }
            }
            if (j + 1 < NT) { unsigned char* Kn = lds + ((j + 1) & 1) * 9216; *(u32x4*)(Kn + kr * 144 + kc * 16) = kreg; *(u32x4*)(Kn + 18432 + kr * 144 + kc * 16) = vreg; }
            __syncthreads();
        }
#undef KSRC
#pragma unroll
        for (int sb = 0; sb < 2; ++sb) {
            float lt = lrun[sb]; lt += __shfl_xor(lt, 32);
            const float inv = 1.f / lt;
            bf16_t* op = qp + (size_t)sb * 32 * DM;
#pragma unroll
            for (int rg = 0; rg < 4; ++rg) {
                u32x2 w0; w0.x = cvtpk(o0[sb][4 * rg] * inv, o0[sb][4 * rg + 1] * inv); w0.y = cvtpk(o0[sb][4 * rg + 2] * inv, o0[sb][4 * rg + 3] * inv);
                u32x2 w1; w1.x = cvtpk(o1[sb][4 * rg] * inv, o1[sb][4 * rg + 1] * inv); w1.y = cvtpk(o1[sb][4 * rg + 2] * inv, o1[sb][4 * rg + 3] * inv);
                if (!dry) { *(u32x2*)(op + 8 * rg + 4 * hi) = w0; *(u32x2*)(op + 32 + 8 * rg + 4 * hi) = w1; }
            }
        }
    }
}

__global__ void __launch_bounds__(512, 2) fwd_megakernel(Args a) {
    extern __shared__ __attribute__((aligned(16))) unsigned char lds[];
    cg::grid_group grid = cg::this_grid();
    unsigned char* ws = a.ws;
    float* modraw = (float*)(ws + WS_MOD);
    float* ssq = (float*)(ws + WS_SSQ);
    bf16_t* Ap = (bf16_t*)(ws + WS_AP);
    float* hctx = (float*)(ws + WS_HCTX);
    LAS unsigned char* ldsl = (LAS unsigned char*)lds;

    int second = 0; unsigned nbar = 0;
    for (int ph = a.ph_lo; ph < a.ph_hi; ++ph) {
        int tid = threadIdx.x; asm volatile("" : "+v"(tid));
        const int lane = tid & 63, wave = tid >> 6;
        int kind;
        { const int sp_ = ph < 11 ? ph - 2 : ph - 13;
          kind = (ph == 0 || ph == 1 || ph == 11 || ph == 12) ? 0 : (ph == 22 ? 7 : ((sp_ == 0 || sp_ == 7) ? 1 : ((sp_ == 1 || sp_ == 6 || sp_ == 8) ? 2 : (sp_ == 2 ? 3 : (sp_ == 3 ? 4 : (sp_ == 4 ? 5 : 6)))))); }
        const int dry = (REPEAT_MASK != 0) && ((REPEAT_MASK >> kind) & 1) && !second;
        if (ph == 0 || ph == 11) {
          if (ph == 0) {
            for (int i = blockIdx.x * 512 + tid; i < 6 * TT; i += gridDim.x * 512) ssq[TT + i] = 0.f;
            {
                float* rope = (float*)(ws + WS_ROPE);
                for (int i = blockIdx.x * 512 + tid; i < SEQ * 32; i += gridDim.x * 512) {
                    const int t = i >> 5, j = i & 31, fi = j & 15; const float pos = (float)((j < 16) ? (t >> 6) : (t & 63));
                    const float invf = __builtin_amdgcn_exp2f(-(float)fi * (13.287712379549449f / 16.f));
                    const float ang = pos * invf;
                    rope[2 * i] = __cosf(ang); rope[2 * i + 1] = __sinf(ang);
                }
            }
            {
                float* sc = (float*)lds;
                float* red = (float*)(lds + 69632);
                for (int i = tid; i < 17 * DM; i += 512) { const int mb = i >> 10, k = i & 1023; const float cv = mb < 16 ? a.in[I_C][mb * DM + k] : a.in[I_CCTX][k]; sc[i] = cv * sigm(cv); }
                __syncthreads();
                for (int item = blockIdx.x; item < 288; item += gridDim.x) {
                    const int l = item / 144, n0 = (item - l * 144) * 64;
                    const float* wp = a.in[I_WADA] + ((size_t)l * DM + wave * 128) * NMOD + n0 + lane;
                    float acc[17];
#pragma unroll
                    for (int mb = 0; mb < 17; ++mb) acc[mb] = 0.f;
#pragma unroll 16
                    for (int k = 0; k < 128; ++k) { const float wv = wp[(size_t)k * NMOD];
#pragma unroll
                        for (int mb = 0; mb < 17; ++mb) acc[mb] += sc[mb * DM + wave * 128 + k] * wv; }
#pragma unroll
                    for (int mb = 0; mb < 17; ++mb) red[(wave * 17 + mb) * 64 + lane] = acc[mb];
                    __syncthreads();
                    for (int i = tid; i < 17 * 64; i += 512) { const int mb = i >> 6, col = i & 63; float s = a.in[I_BADA][l * NMOD + n0 + col];
#pragma unroll
                        for (int w8 = 0; w8 < 8; ++w8) s += red[(w8 * 17 + mb) * 64 + col];
                        modraw[((size_t)l * 17 + mb) * NMOD + n0 + col] = s; }
                    __syncthreads();
                }
            }
            __syncthreads();
          }
            convert_weights(tid, a, ph == 0 ? 0 : 1, lds);
        } else if (ph == 1 || ph == 12) {
            const int l = ph == 1 ? 0 : 1;
            compute_biases(tid, a, l, lds);
            if (l == 0) {
                const float* nrm = a.in[I_NFFN1]; const int gw = blockIdx.x * 8 + wave, NGW = gridDim.x * 8;
                for (int R = gw; R < TT; R += NGW) {
                    const float* xr = R < TL ? a.in[I_X] + (size_t)R * DM : a.in[I_CTX] + (size_t)(R - TL) * DM;
                    const int mb = R < TL ? (R >> 11) : 16; const float* scl = modraw + (size_t)mb * NMOD + DM;
                    float ss = 0.f;
#pragma unroll
                    for (int c4 = 0; c4 < 4; ++c4) { const int col = c4 * 256 + lane * 4; const f32x4 v = *(const f32x4*)(xr + col);
                        ss += (v[0] * v[0] + v[1] * v[1]) + (v[2] * v[2] + v[3] * v[3]);
                        const f32x4 g = *(const f32x4*)(nrm + col) * (*(const f32x4*)(scl + col) + 1.f), y = v * g;
                        u32x2 w; w.x = cvtpk(y[0], y[1]); w.y = cvtpk(y[2], y[3]); *(u32x2*)(Ap + (size_t)R * DM + col) = w; }
                    ss = wave_sum(ss);
                    if (lane == 0) ssq[R] = ss;
                }
            }
        } else if (ph == 22) {
            const float* fn = a.in[I_FNORM]; const int gw = blockIdx.x * 8 + wave, NGW = gridDim.x * 8;
            for (int R = gw; R < TL; R += NGW) {
                const float r = __builtin_amdgcn_rsqf(ssq[(size_t)6 * TT + R] * (1.f / DM) + EPS);
                float* orow = a.out + (size_t)R * DM;
#pragma unroll
                for (int c4 = 0; c4 < 4; ++c4) { const int col = c4 * 256 + lane * 4; const f32x4 v = *(const f32x4*)(orow + col) * r * *(const f32x4*)(fn + col); *(f32x4*)(orow + col) = v; }
            }
        } else {
            const int l = ph < 11 ? 0 : 1, sp = ph < 11 ? ph - 2 : ph - 13;
            const float* modl = modraw + (size_t)l * 17 * NMOD;
            const int nMall = TT / 256, nMlat = TL / 256;
            const float* hin_l = (l == 0 && sp <= 1) ? a.in[I_X] : a.out; const float* hin_c = (l == 0 && sp <= 1) ? a.in[I_CTX] : hctx;
            if (sp == 0 || sp == 7) {
                const bool f1 = sp == 0; const int nM = (f1 || l == 0) ? nMall : nMlat;
                pg8::TileSched S = pg8::make_sched(nM, 2 * DFF / 256, DM);
                pg8::EpiSwiGLU E{(bf16_t*)(ws + WS_G), (const float*)(ws + (f1 ? WS_B13A : WS_B13B)), ssq + (size_t)(3 * l + (f1 ? 0 : 2)) * TT};
                pg8::gemm_phase(tid, ldsl, Ap, DM, (const bf16_t*)(ws + (f1 ? WS_W13A : WS_W13B)), DM, S, E);
            } else if (sp == 1 || sp == 8 || sp == 6) {
                const int nM = (sp == 1 || l == 0) ? nMall : nMlat;
                const int j = sp == 1 ? 0 : (sp == 6 ? 1 : 2);
                const bool lastg = (l == 1 && sp == 8);
                const int ln = (sp == 8) ? l + 1 : l, jn = (sp == 8) ? 0 : j + 1;
                const float* nrm = lastg ? nullptr : (jn == 0 ? a.in[I_NFFN1] : (jn == 1 ? a.in[I_NMIX] : a.in[I_NFFN2])) + (size_t)ln * DM;
                const float* scl = lastg ? nullptr : modraw + (size_t)ln * 17 * NMOD + (3 * jn + 1) * DM;
                float* ssqn = ssq + (size_t)(3 * l + j + 1) * TT;
                pg8::EpiRes E{(uintptr_t)hin_l, (uintptr_t)hin_c - (uintptr_t)hin_l, (uintptr_t)a.out, (uintptr_t)hctx - (uintptr_t)a.out, modl + (3 * j + 2) * DM, sp == 6 ? 1.0f : 0.5f, nrm, scl, ssqn, lastg ? nullptr : Ap, dry};
                const bool wo = sp == 6; const int Kd = wo ? DM : DFF;
                pg8::TileSched S = wo ? pg8::make_sched(nM, DM / 256, Kd) : pg8::make_streamk(nM, DM / 256, Kd, (float*)(ws + WS_P), (unsigned*)(ws + WS_CTL) + 64, (unsigned)(ph + 1));
                pg8::gemm_phase(tid, ldsl, (const bf16_t*)(ws + (wo ? WS_P : WS_G)), Kd, (const bf16_t*)(ws + (wo ? WS_WOUT : (sp == 1 ? WS_W2A : WS_W2B))), Kd, S, E);
            } else if (sp == 2) {
                pg8::TileSched S = pg8::make_sched(l == 0 ? nMall : nMlat, NIN / 256, DM);
                if (l == 1) { S.n2 = TC / 256; S.pm0_2 = nMlat; S.pn0_2 = 2; }
                pg8::EpiIn E{(bf16_t*)(ws + WS_P), (bf16_t*)(ws + WS_G), (const float*)(ws + WS_BIN), ssq + (size_t)(3 * l + 1) * TT};
                pg8::gemm_phase(tid, ldsl, Ap, DM, (const bf16_t*)(ws + WS_WIN), DM, S, E);
            } else if (sp == 3) {
                post_phase(tid, a, l, lds);
            } else if (sp == 4) {
                attn_phase(tid, a, l, lds, dry);
            } else if (sp == 5) {
                pg8::TileSched S = pg8::make_sched(l == 0 ? nMall : nMlat, DM / 256, DM);
                S.nb = 3;
                pg8::EpiMerge E{(const bf16_t*)(ws + WS_G), (bf16_t*)(ws + WS_P)};
                pg8::gemm_phase(tid, ldsl, Ap, DM, (const bf16_t*)(ws + WS_WCAT), DM, S, E);
            }
        }
        if (REPEAT_MASK != 0) { if (dry) { second = 1; --ph; __syncthreads(); continue; } second = 0; }
        if (ph + 1 < a.ph_hi) {
            asm volatile("s_waitcnt vmcnt(0) lgkmcnt(0)" ::: "memory");
            __syncthreads();
            if (ph == a.ph_lo) { if (threadIdx.x == 0) __builtin_amdgcn_fence(__ATOMIC_RELEASE, "agent"); grid.sync(); if (threadIdx.x == 0) __builtin_amdgcn_fence(__ATOMIC_ACQUIRE, "agent"); }
            else {
              for (int bb = 0; bb <= EXTRA_BAR; ++bb) {
                if (threadIdx.x == 0) {
                    unsigned* ctr = (unsigned*)(ws + WS_CTL);
                    __builtin_amdgcn_fence(__ATOMIC_RELEASE, "agent");
                    __hip_atomic_fetch_add(ctr, 1u, __ATOMIC_RELAXED, __HIP_MEMORY_SCOPE_AGENT);
                    ++nbar;
                    const unsigned target = nbar * gridDim.x;
                    while (__hip_atomic_load(ctr, __ATOMIC_RELAXED, __HIP_MEMORY_SCOPE_AGENT) < target) __builtin_amdgcn_s_sleep(2);
                    __builtin_amdgcn_fence(__ATOMIC_ACQUIRE, "agent");
                }
                if (EXTRA_BAR) { asm volatile("s_waitcnt vmcnt(0)" ::: "memory"); __syncthreads(); }
              }
            }
            asm volatile("s_waitcnt vmcnt(0)" ::: "memory");
            __syncthreads();
        }
    }
}

extern "C" void kernel_launch(void* const* d_in, const int* in_sizes, int n_in, void* d_out, int out_size, void* d_ws, size_t ws_size, hipStream_t stream) {
    static int grid = 0;
    if (grid == 0) {
        if (n_in != 26 || out_size != TL * DM || ws_size < WS_END) { fprintf(stderr, "kernel_launch: unexpected shapes (n_in %d out %d ws %zu need %zu)\n", n_in, out_size, ws_size, (size_t)WS_END); grid = -1; return; }
        int dev = 0, cus = 0, per_cu = 0;
        if (hipGetDevice(&dev) != hipSuccess || hipDeviceGetAttribute(&cus, hipDeviceAttributeMultiprocessorCount, dev) != hipSuccess) { grid = -1; return; }
        if (hipFuncSetAttribute((const void*)fwd_megakernel, hipFuncAttributeMaxDynamicSharedMemorySize, LDS_BYTES) != hipSuccess) { fprintf(stderr, "kernel_launch: hipFuncSetAttribute failed\n"); grid = -1; return; }
        if (hipOccupancyMaxActiveBlocksPerMultiprocessor(&per_cu, (const void*)fwd_megakernel, 512, LDS_BYTES) != hipSuccess || per_cu < 1) per_cu = 1;
        (void)hipGetLastError();
        grid = cus * per_cu;
    }
    if (grid < 0) return;
    Args a{};
    for (int i = 0; i < 26; ++i) a.in[i] = (const float*)d_in[i];
    a.out = (float*)d_out; a.ws = (unsigned char*)d_ws;
#if MK_ONE_LAUNCH
    a.ph_lo = 0; a.ph_hi = NPHASES;
    if (hipMemsetAsync((char*)d_ws + WS_CTL, 0, 16384, stream) != hipSuccess) { fprintf(stderr, "memset failed\n"); return; }
    void* args[] = {&a};
    hipError_t e = hipLaunchCooperativeKernel((const void*)fwd_megakernel, dim3(grid), dim3(512), args, LDS_BYTES, stream);
    if (e != hipSuccess) fprintf(stderr, "cooperative launch failed: %s (grid %d)\n", hipGetErrorString(e), grid);
#else
    for (int ph = 0; ph < NPHASES; ++ph) {
        a.ph_lo = ph; a.ph_hi = ph + 1;
        hipLaunchKernelGGL(fwd_megakernel, dim3(grid), dim3(512), LDS_BYTES, stream, a);
    }
#endif
}
```

```cpp
#include <hip/hip_runtime.h>
#include <hip/hip_cooperative_groups.h>
#include <cstdio>
#include <cstdint>
namespace cg = cooperative_groups;

#ifndef REPEAT_MASK
#define REPEAT_MASK 0
#endif
#ifndef EXTRA_BAR
#define EXTRA_BAR 0
#endif
#ifndef MK_ONE_LAUNCH
#define MK_ONE_LAUNCH 1
#endif

#define LAS __attribute__((address_space(3)))
typedef unsigned short bf16_t;
typedef short bf16x8 __attribute__((ext_vector_type(8)));
typedef float f32x4 __attribute__((ext_vector_type(4)));
typedef float f32x16 __attribute__((ext_vector_type(16)));
typedef unsigned u32x4 __attribute__((ext_vector_type(4)));
typedef unsigned u32x2 __attribute__((ext_vector_type(2)));
typedef float f32x2_t __attribute__((ext_vector_type(2)));
typedef __bf16 bf16x2_t __attribute__((ext_vector_type(2)));

constexpr int DM = 1024, NBATCH = 16, SEQ = 2048, CTXL = 256;
constexpr int TL = NBATCH * SEQ;
constexpr int TC = NBATCH * CTXL;
constexpr int TT = TL + TC;
constexpr int DFF = 2816, NIN = 4608, NPC = 1536, NGC = 3072, NMOD = 9 * DM;
constexpr int KVPOS = SEQ + CTXL;
constexpr float EPS = 1e-6f;
constexpr float QSCALE = 0.125f * 1.4426950408889634f;

constexpr size_t MiB = 1u << 20;
constexpr size_t al256(size_t x) { return (x + 255) & ~(size_t)255; }
constexpr size_t SZ_W13 = (size_t)2 * DFF * DM * 2, SZ_W2 = (size_t)DM * DFF * 2, SZ_WIN = (size_t)NIN * DM * 2, SZ_WSQ = (size_t)DM * DM * 2;
constexpr size_t WS_W13A = 0;
constexpr size_t WS_W2A = WS_W13A + SZ_W13;
constexpr size_t WS_WIN = WS_W2A + SZ_W2;
constexpr size_t WS_WCAT = WS_WIN + SZ_WIN;
constexpr size_t WS_WOUT = WS_WCAT + SZ_WSQ;
constexpr size_t WS_W13B = WS_WOUT + SZ_WSQ;
constexpr size_t WS_W2B = WS_W13B + SZ_W13;
constexpr size_t WS_SGUW = WS_W2B + SZ_W2;
constexpr size_t WS_MOD = al256(WS_SGUW + 4 * 128 * 128 * 2);
constexpr size_t WS_B13A = al256(WS_MOD + (size_t)2 * 17 * NMOD * 4);
constexpr size_t WS_BIN = al256(WS_B13A + (size_t)17 * 2 * DFF * 4);
constexpr size_t WS_B13B = al256(WS_BIN + (size_t)17 * NIN * 4);
constexpr size_t WS_SSQ = al256(WS_B13B + (size_t)17 * 2 * DFF * 4);
constexpr size_t WS_ROPE = al256(WS_SSQ + (size_t)7 * TT * 4);
constexpr size_t WS_HCTX = al256(WS_ROPE + (size_t)SEQ * 32 * 8);
constexpr size_t WS_AP = al256(WS_HCTX + (size_t)TC * DM * 4);
constexpr size_t WS_KB = al256(WS_AP + (size_t)TT * DM * 2);
constexpr size_t WS_VT = al256(WS_KB + (size_t)TT * 128 * 2);
constexpr size_t WS_P = al256(WS_VT + (size_t)NBATCH * 2 * 64 * KVPOS * 2);
constexpr size_t WS_G = al256(WS_P + (size_t)TT * NPC * 2);
constexpr size_t WS_CTL = al256(WS_G + (size_t)TT * NGC * 2);
constexpr size_t WS_END = WS_CTL + 16384;

constexpr int LDS_BYTES = 147456;
constexpr int NPHASES = 23;

__device__ __forceinline__ unsigned cvtpk(float lo, float hi) { f32x2_t v = {lo, hi}; bf16x2_t b = __builtin_convertvector(v, bf16x2_t); return __builtin_bit_cast(unsigned, b); }
__device__ __forceinline__ float bflo(unsigned u) { return __uint_as_float(u << 16); }
__device__ __forceinline__ float bfhi(unsigned u) { return __uint_as_float(u & 0xffff0000u); }
__device__ __forceinline__ float fexp(float x) { return __builtin_amdgcn_exp2f(x * 1.4426950408889634f); }
__device__ __forceinline__ float frcp(float x) { return __builtin_amdgcn_rcpf(x); }
__device__ __forceinline__ float sigm(float x) { return frcp(1.f + fexp(-x)); }
__device__ __forceinline__ float gelu_t(float x) { const float z = 0.7978845608028654f * (x + 0.044715f * x * x * x); return x * frcp(1.f + fexp(-2.f * z)); }
#define LDS_WAIT() asm volatile("s_waitcnt lgkmcnt(0)" ::: "memory")
__device__ __forceinline__ uintptr_t uni64(uintptr_t v) { const unsigned lo = __builtin_amdgcn_readfirstlane((unsigned)v), hi = __builtin_amdgcn_readfirstlane((unsigned)(v >> 32)); return ((uintptr_t)hi << 32) | lo; }

namespace pg8 {
constexpr int BM = 256, BK = 64, HALF = 128, HTB = HALF * BK * 2, STAGE_BYTES = 8 * HTB, NXCD = 8, WGM = 8;
__device__ __forceinline__ int lds_byte(int r, int c) { const int st = (r >> 4) * 2 + (c >> 5), rr = r & 15, cc = c & 31, ob = rr * 64 + cc * 2; return st * 1024 + (ob ^ (((ob >> 9) & 1) << 5)); }
__device__ __forceinline__ void stage_rc(int b, int& R, int& C) { const int st = b / 1024, sb = b % 1024, swz = sb ^ (((sb >> 9) & 1) << 5); R = (st >> 1) * 16 + swz / 64; C = (st & 1) * 32 + (swz % 64) / 2; }
__device__ __forceinline__ int perm32(int rho) { const int n = rho >> 4, i = rho & 15; return 8 * (i >> 2) + 4 * n + (i & 3); }

struct Unit { int pm, pn, k0, nt, tag, te; };

struct TileSched {
    int c, G, nM1, nN1, n1, pn0_1, n2, pm0_2, pn0_2, nb, ntk;
    int sk, P, R, s, e, ttot; float* slots; unsigned* flags; unsigned epoch;
    __device__ __forceinline__ void map_tile(int L, Unit& u) const {
        int wgid; { const int q = n1 / NXCD, r = n1 % NXCD, xcd = L % NXCD, off = L / NXCD; wgid = (xcd < r ? xcd * (q + 1) : r * (q + 1) + (xcd - r) * q) + off; }
        const int nig = WGM * nN1, gid = wgid / nig, fm = gid * WGM, gsz = (nM1 - fm) < WGM ? (nM1 - fm) : WGM;
        u.pm = fm + ((wgid % nig) % gsz); u.pn = pn0_1 + (wgid % nig) / gsz;
    }
    __device__ __forceinline__ bool next(int i, Unit& u) const {
        if (sk) {
            if (i < R) { map_tile(i * G + c, u); u.k0 = 0; u.nt = ntk; u.tag = 0; u.te = 0; return true; }
            const int T = s / P + (i - R), base = T * P;
            const int p0 = (i == R) ? s - base : 0; int p1 = e - base; if (p1 > P) p1 = P;
            if (p1 <= p0) return false;
            map_tile(R * G + T, u);
            u.k0 = p0 * 128; u.nt = 2 * (p1 - p0); u.tag = (p0 > 0) ? 1 : (p1 < P ? 2 : 0); u.te = base + P;
            return true;
        }
        int ti = i, br = 0;
        if (nb == 3) { ti = i / 3; br = i - ti * 3; }
        const int L = ti * G + c;
        if (L < n1) {
            map_tile(L, u);
        } else if (L - n1 < n2) { u.pm = pm0_2 + (L - n1); u.pn = pn0_2; }
        else return false;
        if (nb == 3) { u.k0 = br * 256 + (br >> 1) * 256; u.nt = 4 + 4 * (br & 1); }
        else { u.k0 = 0; u.nt = ntk; }
        u.tag = (nb == 3) ? br : 0; u.te = 0;
        return true;
    }
};
__device__ __forceinline__ TileSched make_sched(int nM1, int nN1, int K) {
    TileSched s; s.c = blockIdx.x; s.G = gridDim.x; s.nM1 = nM1; s.nN1 = nN1; s.n1 = nM1 * nN1; s.pn0_1 = 0; s.n2 = 0; s.pm0_2 = 0; s.pn0_2 = 0; s.nb = 1;
    s.ntk = K / BK; s.sk = 0; s.P = 1; s.R = 0; s.s = 0; s.e = 0; s.ttot = 0; s.slots = nullptr; s.flags = nullptr; s.epoch = 0; return s;
}
__device__ __forceinline__ TileSched make_streamk(int nM1, int nN1, int K, float* slots, unsigned* flags, unsigned epoch) {
    TileSched s = make_sched(nM1, nN1, K);
    s.sk = 1; s.P = K / (2 * BK); s.R = s.n1 / s.G; s.ttot = (s.n1 - s.R * s.G) * s.P;
    s.s = (int)((long long)s.c * s.ttot / s.G); s.e = (int)((long long)(s.c + 1) * s.ttot / s.G);
    s.slots = slots; s.flags = flags; s.epoch = epoch;
    return s;
}

__device__ __forceinline__ int unit_mb(const Unit& u) { return u.pm < 128 ? (u.pm >> 3) : 16; }

struct EpiSwiGLU {
    bf16_t* act; const float* bias; const float* ssq;
    __device__ __forceinline__ void operator()(f32x4 (&acc)[2][2][4][2], const Unit& u, int wr, int wc, int fr, int fq) const {
        const int mb = unit_mb(u);
        const float* bp = bias + (size_t)mb * (2 * DFF) + u.pn * 256 + wc * 32 + 8 * fq;
        f32x4 ba[2], bb[2];
#pragma unroll
        for (int n = 0; n < 2; ++n) { ba[n] = *(const f32x4*)(bp + 4 * n); bb[n] = *(const f32x4*)(bp + 128 + 4 * n); }
        const int row0 = u.pm * 256 + wr * 64 + fr;
        bf16_t* op = act + (size_t)row0 * DFF + u.pn * 128 + wc * 32 + 8 * fq;
#pragma unroll
        for (int ai = 0; ai < 2; ++ai)
#pragma unroll
            for (int m = 0; m < 4; ++m) {
                const int ro = ai * 128 + m * 16;
                const float r = __builtin_amdgcn_rsqf(ssq[row0 + ro] * (1.f / DM) + EPS);
                f32x4 a0 = acc[ai][0][m][0] * r + ba[0], a1 = acc[ai][0][m][1] * r + ba[1], b0 = acc[ai][1][m][0] * r + bb[0], b1 = acc[ai][1][m][1] * r + bb[1];
                f32x4 o0, o1;
#pragma unroll
                for (int i = 0; i < 4; ++i) { o0[i] = a0[i] * b0[i] * sigm(a0[i]); o1[i] = a1[i] * b1[i] * sigm(a1[i]); }
                u32x4 w; w.x = cvtpk(o0[0], o0[1]); w.y = cvtpk(o0[2], o0[3]); w.z = cvtpk(o1[0], o1[1]); w.w = cvtpk(o1[2], o1[3]);
                *(u32x4*)(op + (size_t)ro * DFF) = w;
            }
    }
};
struct EpiIn {
    bf16_t* P; bf16_t* G; const float* bias; const float* ssq;
    __device__ __forceinline__ void operator()(f32x4 (&acc)[2][2][4][2], const Unit& u, int wr, int wc, int fr, int fq) const {
        const int mb = unit_mb(u);
        const int colt = u.pn * 256, cw = wc * 32 + 8 * fq;
        const float* bp = bias + (size_t)mb * NIN + colt + cw;
        f32x4 bv[2][2];
#pragma unroll
        for (int bj = 0; bj < 2; ++bj)
#pragma unroll
            for (int n = 0; n < 2; ++n) bv[bj][n] = *(const f32x4*)(bp + bj * 128 + 4 * n);
        const int row0 = u.pm * 256 + wr * 64 + fr;
        const bool gate = u.pn >= 6;
        bf16_t* base = gate ? G + (size_t)row0 * NGC + (colt - NPC) + cw : P + (size_t)row0 * NPC + colt + cw;
        const size_t ld = gate ? NGC : NPC;
#pragma unroll
        for (int ai = 0; ai < 2; ++ai)
#pragma unroll
            for (int m = 0; m < 4; ++m) {
                const int ro = ai * 128 + m * 16;
                const float r = __builtin_amdgcn_rsqf(ssq[row0 + ro] * (1.f / DM) + EPS);
#pragma unroll
                for (int bj = 0; bj < 2; ++bj) {
                    f32x4 v0 = acc[ai][bj][m][0] * r + bv[bj][0], v1 = acc[ai][bj][m][1] * r + bv[bj][1];
                    if (gate) {
#pragma unroll
                        for (int i = 0; i < 4; ++i) { v0[i] = sigm(v0[i]); v1[i] = sigm(v1[i]); }
                    }
                    u32x4 w; w.x = cvtpk(v0[0], v0[1]); w.y = cvtpk(v0[2], v0[3]); w.z = cvtpk(v1[0], v1[1]); w.w = cvtpk(v1[2], v1[3]);
                    *(u32x4*)(base + (size_t)ro * ld + bj * 128) = w;
                }
            }
    }
};
struct EpiRes {
    uintptr_t hin_l, hin_cd, hout_l, hout_cd; const float* gate; float coef; const float* nrm; const float* scl; float* ssq; bf16_t* Ap; int dry;
    __device__ __forceinline__ void operator()(f32x4 (&acc)[2][2][4][2], const Unit& u, int wr, int wc, int fr, int fq) const {
        const int mb = unit_mb(u);
        const bool lat = u.pm < 128;
        uintptr_t hin_l = this->hin_l, hin_cd = this->hin_cd, hout_l = this->hout_l, hout_cd = this->hout_cd; const float* gate = this->gate; float coef = this->coef;
        const float* nrm = this->nrm; const float* scl = this->scl; float* ssq = this->ssq; bf16_t* Ap = this->Ap;
        hin_l = uni64(hin_l); hin_cd = uni64(hin_cd); hout_l = uni64(hout_l); hout_cd = uni64(hout_cd); gate = (const float*)uni64((uintptr_t)gate); coef = __uint_as_float(__builtin_amdgcn_readfirstlane(__float_as_uint(coef)));
        nrm = (const float*)uni64((uintptr_t)nrm); scl = (const float*)uni64((uintptr_t)scl); ssq = (float*)uni64((uintptr_t)ssq); Ap = (bf16_t*)uni64((uintptr_t)Ap);
        const int col0 = u.pn * 256 + wc * 32 + 8 * fq, row0 = u.pm * 256 + wr * 64 + fr, rowl = lat ? row0 : row0 - TL;
        const float* hi = (const float*)(hin_l + (lat ? (uintptr_t)0 : hin_cd)) + (size_t)rowl * DM + col0;
        float* ho = (float*)(hout_l + (lat ? (uintptr_t)0 : hout_cd)) + (size_t)rowl * DM + col0;
        f32x4 gc[2][2], gs[2][2];
#pragma unroll
        for (int bj = 0; bj < 2; ++bj)
#pragma unroll
            for (int n = 0; n < 2; ++n) {
                gc[bj][n] = *(const f32x4*)(gate + (size_t)mb * NMOD + col0 + 128 * bj + 4 * n) * (dry ? 0.f : coef);
                if (Ap) gs[bj][n] = *(const f32x4*)(nrm + col0 + 128 * bj + 4 * n) * (*(const f32x4*)(scl + (size_t)mb * NMOD + col0 + 128 * bj + 4 * n) + 1.f);
                else gs[bj][n] = (f32x4){0.f, 0.f, 0.f, 0.f};
            }
#pragma unroll
        for (int ai = 0; ai < 2; ++ai)
#pragma unroll
            for (int m = 0; m < 4; ++m) {
                const int ro = ai * 128 + m * 16; const size_t off = (size_t)ro * DM;
                float ss = 0.f;
#pragma unroll
                for (int bj = 0; bj < 2; ++bj) {
                    f32x4 h0 = *(const f32x4*)(hi + off + 128 * bj), h1 = *(const f32x4*)(hi + off + 128 * bj + 4);
                    h0 += gc[bj][0] * acc[ai][bj][m][0]; h1 += gc[bj][1] * acc[ai][bj][m][1];
                    *(f32x4*)(ho + off + 128 * bj) = h0; *(f32x4*)(ho + off + 128 * bj + 4) = h1;
                    ss += (h0[0] * h0[0] + h0[1] * h0[1]) + (h0[2] * h0[2] + h0[3] * h0[3]) + (h1[0] * h1[0] + h1[1] * h1[1]) + (h1[2] * h1[2] + h1[3] * h1[3]);
                    if (Ap) { const f32x4 a0 = h0 * gs[bj][0], a1 = h1 * gs[bj][1];
                        u32x4 w; w.x = cvtpk(a0[0], a0[1]); w.y = cvtpk(a0[2], a0[3]); w.z = cvtpk(a1[0], a1[1]); w.w = cvtpk(a1[2], a1[3]);
                        *(u32x4*)(Ap + (size_t)(row0 + ro) * DM + col0 + 128 * bj) = w; }
                }
                ss += __shfl_xor(ss, 16); ss += __shfl_xor(ss, 32);
                if (fq == 0) atomicAdd(ssq + row0 + ro, dry ? 0.f : ss);
            }
    }
};
struct EpiMerge {
    const bf16_t* G; bf16_t* Mg;
    __device__ __forceinline__ void operator()(f32x4 (&acc)[2][2][4][2], const Unit& u, int wr, int wc, int fr, int fq) const {
        const int br = u.tag, col0 = u.pn * 256 + wc * 32 + 8 * fq, row0 = u.pm * 256 + wr * 64 + fr;
#pragma unroll
        for (int ai = 0; ai < 2; ++ai)
#pragma unroll
            for (int m = 0; m < 4; ++m) {
                const int row = row0 + ai * 128 + m * 16;
#pragma unroll
                for (int bj = 0; bj < 2; ++bj) {
                    const bf16_t* gp = G + (size_t)row * NGC + br * 1024 + col0 + 128 * bj;
                    const u32x4 g = *(const u32x4*)gp;
                    f32x4 s0 = (f32x4){bflo(g.x), bfhi(g.x), bflo(g.y), bfhi(g.y)}, s1 = (f32x4){bflo(g.z), bfhi(g.z), bflo(g.w), bfhi(g.w)};
                    if (br < 2) {
                        const u32x4 h = *(const u32x4*)(gp + 1024);
                        const f32x4 d0 = (f32x4){bflo(h.x), bfhi(h.x), bflo(h.y), bfhi(h.y)}, d1 = (f32x4){bflo(h.z), bfhi(h.z), bflo(h.w), bfhi(h.w)};
#pragma unroll
                        for (int i = 0; i < 4; ++i) { s0[i] *= frcp(fmaxf(d0[i], 1e-20f)); s1[i] *= frcp(fmaxf(d1[i], 1e-20f)); }
                        acc[ai][bj][m][0] *= s0; acc[ai][bj][m][1] *= s1;
                    } else {
                        const f32x4 v0 = acc[ai][bj][m][0] * s0, v1 = acc[ai][bj][m][1] * s1;
                        u32x4 w; w.x = cvtpk(v0[0], v0[1]); w.y = cvtpk(v0[2], v0[3]); w.z = cvtpk(v1[0], v1[1]); w.w = cvtpk(v1[2], v1[3]);
                        *(u32x4*)(Mg + (size_t)row * DM + col0 + 128 * bj) = w;
                    }
                }
            }
    }
};

template <class Epi>
__device__ __forceinline__ void gemm_phase(const int tid, LAS unsigned char* lds, const bf16_t* Ab, int lda, const bf16_t* Bb, int ldb, const TileSched& S, const Epi& E) {
    const int wid = __builtin_amdgcn_readfirstlane(tid >> 6), lane = tid & 63, wr = wid >> 2, wc = wid & 3, fr = lane & 15, fq = lane >> 4;
    unsigned voffA[2], voffB[2];
#pragma unroll
    for (int i = 0; i < 2; ++i) { int R, C; stage_rc(tid * 16 + i * 8192, R, C); const int Rb = (R & ~31) + perm32(R & 31);
        voffA[i] = (unsigned)(R * lda + C) * 2u; voffB[i] = (unsigned)(Rb * ldb + C) * 2u; }
    const size_t kstep = (size_t)(BK * 2);
    const size_t hsA = (size_t)HALF * lda * 2, hsB = (size_t)HALF * ldb * 2;
    const unsigned ldsw = (unsigned)wid * 1024u;
    const int aoff = lds_byte(wr * 64 + fr, fq * 8), boff = lds_byte(wc * 32 + fr, fq * 8);
#define PG8_SA(b, h) (((b) * 2 + (h)) * HTB)
#define PG8_SB(b, h) ((4 + (b) * 2 + (h)) * HTB)
#define PG8_STAGE(bufoff, gbase, voff) do { _Pragma("unroll") for (int _i = 0; _i < 2; ++_i) \
        __builtin_amdgcn_global_load_lds((const unsigned*)((const char*)(gbase) + (voff)[_i]), (LAS unsigned*)(lds + (bufoff) + ldsw + _i * 8192), 16, 0, 0); } while (0)
#define PG8_LDA(dst, b, h) do { _Pragma("unroll") for (int m = 0; m < 4; ++m) _Pragma("unroll") for (int k = 0; k < 2; ++k) dst[m][k] = *(const LAS bf16x8*)(lds + PG8_SA(b, h) + aoff + m * 2048 + k * 1024); } while (0)
#define PG8_LDB(dst, b, h) do { _Pragma("unroll") for (int n = 0; n < 2; ++n) _Pragma("unroll") for (int k = 0; k < 2; ++k) dst[n][k] = *(const LAS bf16x8*)(lds + PG8_SB(b, h) + boff + n * 2048 + k * 1024); } while (0)
#define PG8_MMA(ai, bj, At, Bt) do { __builtin_amdgcn_s_setprio(1); _Pragma("unroll") for (int m = 0; m < 4; ++m) _Pragma("unroll") for (int n = 0; n < 2; ++n) _Pragma("unroll") for (int k = 0; k < 2; ++k) \
        acc[ai][bj][m][n] = __builtin_amdgcn_mfma_f32_16x16x32_bf16(Bt[n][k], At[m][k], acc[ai][bj][m][n], 0, 0, 0); __builtin_amdgcn_s_setprio(0); } while (0)
#define PG8_WAIT_V(n) asm volatile("s_waitcnt vmcnt(" #n ")" ::: "memory")
#define PG8_WAIT_L(n) asm volatile("s_waitcnt lgkmcnt(" #n ")" ::: "memory")
#define PG8_BAR __builtin_amdgcn_s_barrier()
#define PG8_SCHED __builtin_amdgcn_sched_barrier(0)
    Unit cur, nxt; int ui = 0;
    if (!S.next(0, cur)) return;
    f32x4 acc[2][2][4][2];
#pragma unroll
    for (int a = 0; a < 2; ++a)
#pragma unroll
        for (int b = 0; b < 2; ++b)
#pragma unroll
            for (int m = 0; m < 4; ++m)
#pragma unroll
                for (int n = 0; n < 2; ++n) acc[a][b][m][n] = (f32x4){0.f, 0.f, 0.f, 0.f};
    bf16x8 At[4][2], B0[2][2], B1[2][2];
    const char* cA = (const char*)Ab + (size_t)cur.pm * 2 * hsA + (size_t)cur.k0 * 2; const char* cB = (const char*)Bb + (size_t)cur.pn * 2 * hsB + (size_t)cur.k0 * 2;
    PG8_STAGE(PG8_SB(0, 0), cB, voffB); PG8_STAGE(PG8_SB(0, 1), cB + hsB, voffB); PG8_STAGE(PG8_SA(0, 0), cA, voffA); PG8_STAGE(PG8_SA(0, 1), cA + hsA, voffA);
    if (wr == 1) PG8_BAR;
    PG8_WAIT_V(2); PG8_BAR;
    PG8_STAGE(PG8_SB(1, 0), cB + kstep, voffB); PG8_STAGE(PG8_SA(1, 0), cA + kstep, voffA); PG8_STAGE(PG8_SB(1, 1), cB + hsB + kstep, voffB);
    PG8_WAIT_V(6); PG8_BAR;
    for (;;) {
        const bool has_next = S.next(ui + 1, nxt);
        const char* nA = has_next ? (const char*)Ab + (size_t)nxt.pm * 2 * hsA + (size_t)nxt.k0 * 2 : cA;
        const char* nB = has_next ? (const char*)Bb + (size_t)nxt.pn * 2 * hsB + (size_t)nxt.k0 * 2 : cB;
        const int nt = cur.nt;
        for (int t = 0; t < nt; t += 2) {
            const bool last = (t == nt - 2);
            const char* a1 = cA + (size_t)(t + 1) * kstep;
            const char* a2 = last ? nA : cA + (size_t)(t + 2) * kstep; const char* b2 = last ? nB : cB + (size_t)(t + 2) * kstep;
            const char* a3 = a2 + kstep; const char* b3 = b2 + kstep;
            PG8_LDB(B0, 0, 0); PG8_LDB(B1, 0, 1); PG8_SCHED; PG8_LDA(At, 0, 0); PG8_STAGE(PG8_SA(1, 1), a1 + hsA, voffA);
            PG8_WAIT_V(8); PG8_WAIT_L(0); PG8_BAR; PG8_MMA(0, 0, At, B0); PG8_MMA(0, 1, At, B1); PG8_BAR; PG8_SCHED;
            PG8_LDA(At, 0, 1); PG8_STAGE(PG8_SB(0, 0), b2, voffB); PG8_STAGE(PG8_SB(0, 1), b2 + hsB, voffB); PG8_STAGE(PG8_SA(0, 0), a2, voffA);
            PG8_WAIT_V(8); PG8_WAIT_L(0); PG8_BAR; PG8_MMA(1, 0, At, B0); PG8_MMA(1, 1, At, B1); PG8_BAR; PG8_SCHED;
            PG8_LDB(B0, 1, 0); PG8_LDB(B1, 1, 1); PG8_SCHED; PG8_LDA(At, 1, 0); PG8_STAGE(PG8_SA(0, 1), a2 + hsA, voffA);
            PG8_WAIT_V(8); PG8_WAIT_L(0); PG8_BAR; PG8_MMA(0, 0, At, B0); PG8_MMA(0, 1, At, B1); PG8_BAR; PG8_SCHED;
            PG8_LDA(At, 1, 1); PG8_STAGE(PG8_SB(1, 0), b3, voffB); PG8_STAGE(PG8_SB(1, 1), b3 + hsB, voffB); PG8_STAGE(PG8_SA(1, 0), a3, voffA);
            PG8_WAIT_V(8); PG8_WAIT_L(0); PG8_BAR; PG8_MMA(1, 0, At, B0); PG8_MMA(1, 1, At, B1); PG8_BAR; PG8_SCHED;
        }
        if (wr == 0) PG8_BAR;
        if (S.sk && (cur.tag & 2)) {
            for (int j = S.c + 1; j < S.G; ++j) {
                const int sj = (int)((long long)j * S.ttot / S.G); if (sj >= cur.te) break;
                const int ej = (int)((long long)(j + 1) * S.ttot / S.G); if (ej == sj) continue;
                unsigned* fl = S.flags + j * 8 + wid;
                if (lane == 0) { while (__hip_atomic_load(fl, __ATOMIC_RELAXED, __HIP_MEMORY_SCOPE_AGENT) != S.epoch) __builtin_amdgcn_s_sleep(1); }
                asm volatile("" ::: "memory");
                const unsigned long long* sp = (const unsigned long long*)(S.slots + (size_t)j * 65536 + wid * 8192) + lane; asm volatile("" : "+v"(sp));
#pragma unroll
                for (int a = 0; a < 2; ++a)
#pragma unroll
                    for (int b = 0; b < 2; ++b)
#pragma unroll
                        for (int m = 0; m < 4; ++m) {
#pragma unroll
                            for (int n = 0; n < 2; ++n) {
                                const unsigned long long v0 = __hip_atomic_load(sp, __ATOMIC_RELAXED, __HIP_MEMORY_SCOPE_AGENT), v1 = __hip_atomic_load(sp + 64, __ATOMIC_RELAXED, __HIP_MEMORY_SCOPE_AGENT);
                                acc[a][b][m][n][0] += __uint_as_float((unsigned)v0); acc[a][b][m][n][1] += __uint_as_float((unsigned)(v0 >> 32));
                                acc[a][b][m][n][2] += __uint_as_float((unsigned)v1); acc[a][b][m][n][3] += __uint_as_float((unsigned)(v1 >> 32));
                                sp += 128; }
                            if (m & 1) asm volatile("" : "+v"(sp) :: "memory");
                        }
            }
        }
        if (S.sk && (cur.tag & 1)) {
            unsigned long long* sp = (unsigned long long*)(S.slots + (size_t)S.c * 65536 + wid * 8192) + lane; asm volatile("" : "+v"(sp));
#pragma unroll
            for (int a = 0; a < 2; ++a)
#pragma unroll
                for (int b = 0; b < 2; ++b)
#pragma unroll
                    for (int m = 0; m < 4; ++m)
#pragma unroll
                        for (int n = 0; n < 2; ++n) {
                            const f32x4 v = acc[a][b][m][n];
                            __hip_atomic_store(sp, (unsigned long long)__float_as_uint(v[0]) | ((unsigned long long)__float_as_uint(v[1]) << 32), __ATOMIC_RELAXED, __HIP_MEMORY_SCOPE_AGENT);
                            __hip_atomic_store(sp + 64, (unsigned long long)__float_as_uint(v[2]) | ((unsigned long long)__float_as_uint(v[3]) << 32), __ATOMIC_RELAXED, __HIP_MEMORY_SCOPE_AGENT);
                            sp += 128; asm volatile("" : "+v"(sp)); }
            asm volatile("s_waitcnt vmcnt(0)" ::: "memory");
            if (lane == 0) __hip_atomic_store(S.flags + S.c * 8 + wid, S.epoch, __ATOMIC_RELAXED, __HIP_MEMORY_SCOPE_AGENT);
        } else E(acc, cur, wr, wc, fr, fq);
        if (!has_next) break;
        if (!(S.nb == 3 && nxt.tag != 0)) {
#pragma unroll
        for (int a = 0; a < 2; ++a)
#pragma unroll
            for (int b = 0; b < 2; ++b)
#pragma unroll
                for (int m = 0; m < 4; ++m)
#pragma unroll
                    for (int n = 0; n < 2; ++n) acc[a][b][m][n] = (f32x4){0.f, 0.f, 0.f, 0.f};
        }
        cur = nxt; cA = nA; cB = nB; ++ui;
        if (wr == 1) PG8_BAR;
    }
    PG8_WAIT_V(0);
    PG8_BAR;
#undef PG8_SA
#undef PG8_SB
#undef PG8_STAGE
#undef PG8_LDA
#undef PG8_LDB
#undef PG8_MMA
#undef PG8_WAIT_V
#undef PG8_WAIT_L
#undef PG8_BAR
#undef PG8_SCHED
}
}

struct Args {
    const float* in[26];
    float* out; unsigned char* ws;
    int ph_lo, ph_hi;
};
enum { I_X = 0, I_C, I_CTX, I_CCTX, I_WADA, I_BADA, I_NFFN1, I_F1W13, I_F1W2, I_NMIX, I_WIN, I_QN, I_KN, I_POOLW, I_POOLS, I_SGUN, I_SGUW, I_SGUB,
       I_WBRP, I_WBRA, I_WBRS, I_WOUT, I_NFFN2, I_F2W13, I_F2W2, I_FNORM };

__device__ __forceinline__ float wave_sum(float v) {
#pragma unroll
    for (int o = 1; o < 64; o <<= 1) v += __shfl_xor(v, o);
    return v;
}

__device__ __forceinline__ void tr_item(const float* W, int N, bf16_t* WT, int ldt, int coloff, int mode13, float* scr, int item, int lane) {
    const int nblk = N / 32, kb = item / nblk, nb = item - kb * nblk, k0 = 64 * kb, n0 = 32 * nb;
#pragma unroll 8
    for (int i = 0; i < 32; ++i) { const int kk = 2 * i + (lane >> 5); scr[kk * 33 + (lane & 31)] = W[(size_t)(k0 + kk) * N + n0 + (lane & 31)]; }
    LDS_WAIT();
    int r0 = n0;
    if (mode13) { const int s = n0 / DFF, rem = n0 - s * DFF, t = rem >> 7, j = rem & 127; r0 = 256 * t + 128 * s + j; }
    const int c = lane & 7;
#pragma unroll
    for (int j = 0; j < 4; ++j) { const int n = (lane >> 3) + 8 * j; const float* s = scr + (8 * c) * 33 + n;
        u32x4 o; o.x = cvtpk(s[0 * 33], s[1 * 33]); o.y = cvtpk(s[2 * 33], s[3 * 33]); o.z = cvtpk(s[4 * 33], s[5 * 33]); o.w = cvtpk(s[6 * 33], s[7 * 33]);
        *(u32x4*)(WT + (size_t)(r0 + n) * ldt + coloff + k0 + 8 * c) = o; }
    LDS_WAIT();
}

__device__ __forceinline__ void convert_weights(const int tid, const Args& a, int l, unsigned char* lds) {
    const int lane = tid & 63, wave = tid >> 6;
    float* scr = (float*)(lds + wave * 8704);
    const int gw = blockIdx.x * 8 + wave, NGW = gridDim.x * 8;
    unsigned char* ws = a.ws;
    constexpr int I13 = (DM / 64) * (2 * DFF / 32), I2 = (DFF / 64) * (DM / 32), IIN = (DM / 64) * (NIN / 32), IOUT = (DM / 64) * (DM / 32), IBA = (512 / 64) * (DM / 32), IBS = (256 / 64) * (DM / 32);
    constexpr int NITEMS = 2 * I13 + 2 * I2 + IIN + IOUT + IBA + IBS;
    for (int it = gw; it < NITEMS; it += NGW) {
        int r = it; const float* W; int N; bf16_t* WT; int ldt = DM, coloff = 0, m13 = 0;
        if (r < 2 * I13) { const bool second = r >= I13; r -= second ? I13 : 0; W = a.in[second ? I_F2W13 : I_F1W13] + (size_t)l * DM * 2 * DFF; N = 2 * DFF; WT = (bf16_t*)(ws + (second ? WS_W13B : WS_W13A)); m13 = 1; }
        else if (r < 2 * I13 + 2 * I2) { r -= 2 * I13; const bool second = r >= I2; r -= second ? I2 : 0; W = a.in[second ? I_F2W2 : I_F1W2] + (size_t)l * DFF * DM; N = DM; WT = (bf16_t*)(ws + (second ? WS_W2B : WS_W2A)); ldt = DFF; }
        else if (r < 2 * I13 + 2 * I2 + IIN) { r -= 2 * I13 + 2 * I2; W = a.in[I_WIN] + (size_t)l * DM * NIN; N = NIN; WT = (bf16_t*)(ws + WS_WIN); }
        else if (r < 2 * I13 + 2 * I2 + IIN + IOUT) { r -= 2 * I13 + 2 * I2 + IIN; W = a.in[I_WOUT] + (size_t)l * DM * DM; N = DM; WT = (bf16_t*)(ws + WS_WOUT); }
        else if (r < 2 * I13 + 2 * I2 + IIN + IOUT + IBA) { r -= 2 * I13 + 2 * I2 + IIN + IOUT; W = a.in[I_WBRA] + (size_t)l * 512 * DM; N = DM; WT = (bf16_t*)(ws + WS_WCAT); coloff = 256; }
        else { r -= 2 * I13 + 2 * I2 + IIN + IOUT + IBA; W = a.in[I_WBRS] + (size_t)l * 256 * DM; N = DM; WT = (bf16_t*)(ws + WS_WCAT); coloff = 768; }
        tr_item(W, N, WT, ldt, coloff, m13, scr, r, lane);
    }
    {
        const float* pw = a.in[I_POOLW] + (size_t)l * 4 * 64 * 64; const float* ps = a.in[I_POOLS] + (size_t)l * 256; const float* wb = a.in[I_WBRP] + (size_t)l * 256 * DM;
        bf16_t* wcat = (bf16_t*)(ws + WS_WCAT);
        for (int it = blockIdx.x * 512 + tid; it < 1024 * 32; it += gridDim.x * 512) {
            const int n = it & 1023, kg = it >> 10, g = kg >> 3, c0 = (kg & 7) * 8;
            float s[8];
#pragma unroll
            for (int i = 0; i < 8; ++i) s[i] = 0.f;
            for (int d = 0; d < 64; ++d) {
                const float wv = wb[(size_t)(g * 64 + d) * DM + n] * ps[g * 64 + d];
#pragma unroll
                for (int i = 0; i < 8; ++i) s[i] += pw[(g * 64 + c0 + i) * 64 + d] * wv;
            }
            u32x4 o; o.x = cvtpk(s[0], s[1]); o.y = cvtpk(s[2], s[3]); o.z = cvtpk(s[4], s[5]); o.w = cvtpk(s[6], s[7]);
            *(u32x4*)(wcat + (size_t)n * DM + kg * 8) = o;
        }
    }
    {
        const float* sw = a.in[I_SGUW] + (size_t)l * 4 * 128 * 128; unsigned* dst = (unsigned*)(ws + WS_SGUW);
        for (int it = blockIdx.x * 512 + tid; it < 4 * 128 * 64; it += gridDim.x * 512) dst[it] = cvtpk(sw[2 * it], sw[2 * it + 1]);
    }
}

__device__ __forceinline__ void compute_biases(const int tid, const Args& a, int l, unsigned char* lds) {
    const int lane = tid & 63, wave = tid >> 6;
    float* sh = (float*)lds;
    const float* modl = (const float*)(a.ws + WS_MOD) + (size_t)l * 17 * NMOD;
    const int gw = blockIdx.x * 8 + wave, NGW = gridDim.x * 8;
    for (int j = 0; j < 3; ++j) {
        __syncthreads();
        for (int i = tid; i < 17 * DM; i += 512) sh[i] = modl[(size_t)(i >> 10) * NMOD + (3 * j) * DM + (i & 1023)];
        __syncthreads();
        const bf16_t* Wt = (const bf16_t*)(a.ws + (j == 0 ? WS_W13A : (j == 1 ? WS_WIN : WS_W13B)));
        float* bo = (float*)(a.ws + (j == 0 ? WS_B13A : (j == 1 ? WS_BIN : WS_B13B)));
        const int N = (j == 1) ? NIN : 2 * DFF;
        for (int n = gw; n < N; n += NGW) {
            float w[16];
#pragma unroll
            for (int c = 0; c < 4; ++c) { const u32x2 v = *(const u32x2*)(Wt + (size_t)n * DM + c * 256 + lane * 4); w[4 * c] = bflo(v.x); w[4 * c + 1] = bfhi(v.x); w[4 * c + 2] = bflo(v.y); w[4 * c + 3] = bfhi(v.y); }
            float mine = 0.f;
#pragma unroll 1
            for (int mb = 0; mb < 17; ++mb) {
                float p = 0.f;
#pragma unroll
                for (int c = 0; c < 4; ++c) { const f32x4 s = *(const f32x4*)(sh + mb * DM + c * 256 + lane * 4); p += w[4 * c] * s[0] + w[4 * c + 1] * s[1] + w[4 * c + 2] * s[2] + w[4 * c + 3] * s[3]; }
                p = wave_sum(p);
                if (lane == mb) mine = p;
            }
            if (lane < 17) bo[(size_t)lane * N + n] = mine;
        }
    }
}

__device__ __forceinline__ void post_phase(const int tid, const Args& a, int l, unsigned char* lds) {
    const int lane = tid & 63, wave = tid >> 6;
    unsigned char* ws = a.ws;
    const bf16_t* P = (const bf16_t*)(ws + WS_P);
    bf16_t* Bcat = (bf16_t*)(ws + WS_AP); bf16_t* kbuf = (bf16_t*)(ws + WS_KB); bf16_t* Vt = (bf16_t*)(ws + WS_VT);
    const float* rope = (const float*)(ws + WS_ROPE);
    const float* qn = a.in[I_QN] + l * 64; const float* kn = a.in[I_KN] + l * 64;
    const int nchf = (l == 0) ? 288 : 256;
    const int nSGU = nchf * 2, nPOOL = nchf, nV = 288, nQK = TT / 64, total = nSGU + nPOOL + nV + nQK;
    for (int it = blockIdx.x; it < total; it += gridDim.x) {
        if (it < nSGU + nPOOL + nV) {
            const int ch = it < nSGU ? (it >> 1) : (it < nSGU + nPOOL ? it - nSGU : it - nSGU - nPOOL);
            const bool lat = ch < 256;
            const int b = lat ? (ch >> 4) : ((ch - 256) >> 1), t0 = lat ? (ch & 15) * 128 : ((ch - 256) & 1) * 128, L = lat ? SEQ : CTXL;
            const int Rb = lat ? b * SEQ : TL + b * CTXL, R0 = Rb + t0;
            if (it < nSGU) {
                const int gp = it & 1;
                bf16_t* vT = (bf16_t*)lds;
                bf16_t* Ws = (bf16_t*)(lds + 34816);
                const float* sn = a.in[I_SGUN] + l * 256;
                {
                    const bf16_t* wsrc = (const bf16_t*)(ws + WS_SGUW) + gp * 2 * 128 * 128;
#pragma unroll 4
                    for (int i2 = tid; i2 < 2 * 128 * 16; i2 += 512) { const int r = i2 >> 4, c = i2 & 15; *(u32x4*)(Ws + r * 136 + c * 8) = *(const u32x4*)(wsrc + r * 128 + c * 8); }
                }
#pragma unroll 2
                for (int i2 = tid; i2 < 128 * 32; i2 += 512) { const int l32 = i2 & 31, tok = i2 >> 5;
                    const u32x4 raw = *(const u32x4*)(P + (size_t)(R0 + tok) * NPC + 1280 + l32 * 8);
                    float x[8] = {bflo(raw.x), bfhi(raw.x), bflo(raw.y), bfhi(raw.y), bflo(raw.z), bfhi(raw.z), bflo(raw.w), bfhi(raw.w)};
                    float ss = 0.f;
#pragma unroll
                    for (int i = 0; i < 8; ++i) { x[i] = gelu_t(x[i]); ss += x[i] * x[i]; }
                    ss += __shfl_xor(ss, 1); ss += __shfl_xor(ss, 2); ss += __shfl_xor(ss, 4); ss += __shfl_xor(ss, 8); ss += __shfl_xor(ss, 16);
                    const float rinv = __builtin_amdgcn_rsqf(ss * (1.f / 256.f) + EPS);
                    if ((l32 >> 4) == gp) { const int cl = (l32 & 15) * 8;
#pragma unroll
                        for (int i = 0; i < 8; i += 2) { const unsigned pk = cvtpk(x[i] * rinv * sn[l32 * 8 + i], x[i + 1] * rinv * sn[l32 * 8 + i + 1]);
                            vT[(cl + i) * 136 + tok] = (bf16_t)(pk & 0xffffu); vT[(cl + i + 1) * 136 + tok] = (bf16_t)(pk >> 16); } }
                }
                __syncthreads();
                const int q32 = lane & 31, hi = lane >> 5, cblk = wave & 1, tblk = wave >> 1;
                const float* sb = a.in[I_SGUB] + (size_t)l * 4 * 128;
                const int tok = tblk * 32 + q32, R = R0 + tok;
#pragma unroll
                for (int g2 = 0; g2 < 2; ++g2) {
                    const int g = gp * 2 + g2;
                    u32x2 ur[4];
#pragma unroll
                    for (int rg = 0; rg < 4; ++rg) ur[rg] = *(const u32x2*)(P + (size_t)R * NPC + 1024 + g * 64 + cblk * 32 + 8 * rg + 4 * hi);
                    const float bias = sb[g * 128 + tok];
                    f32x16 acc;
#pragma unroll
                    for (int r = 0; r < 16; ++r) acc[r] = 0.f;
#pragma unroll
                    for (int ks = 0; ks < 8; ++ks) {
                        const bf16x8 af = *(const bf16x8*)(vT + (g2 * 64 + cblk * 32 + q32) * 136 + ks * 16 + hi * 8);
                        const bf16x8 bf = *(const bf16x8*)(Ws + (g2 * 128 + tblk * 32 + q32) * 136 + ks * 16 + hi * 8);
                        acc = __builtin_amdgcn_mfma_f32_32x32x16_bf16(af, bf, acc, 0, 0, 0);
                    }
#pragma unroll
                    for (int rg = 0; rg < 4; ++rg) {
                        const int c4 = g * 64 + cblk * 32 + 8 * rg + 4 * hi;
                        const float u0 = gelu_t(bflo(ur[rg].x)), u1 = gelu_t(bfhi(ur[rg].x)), u2 = gelu_t(bflo(ur[rg].y)), u3 = gelu_t(bfhi(ur[rg].y));
                        u32x2 w; w.x = cvtpk(u0 * (acc[4 * rg] + bias), u1 * (acc[4 * rg + 1] + bias)); w.y = cvtpk(u2 * (acc[4 * rg + 2] + bias), u3 * (acc[4 * rg + 3] + bias));
                        *(u32x2*)(Bcat + (size_t)R * DM + 768 + c4) = w;
                    }
                }
            } else if (it < nSGU + nPOOL) {
                unsigned* xs = (unsigned*)lds;
#pragma unroll 3
                for (int i2 = tid; i2 < 144 * 32; i2 += 512) { const int rr = i2 >> 5, c = i2 & 31; const int s = t0 - 8 + rr;
                    u32x4 v = (u32x4){0u, 0u, 0u, 0u};
                    if (s >= 0 && s < L) v = *(const u32x4*)(P + (size_t)(Rb + s) * NPC + 768 + c * 8);
                    *(u32x4*)(xs + rr * 128 + c * 4) = v; }
                __syncthreads();
                const int cp = tid & 127, tg = tid >> 7, hw = 1 << (cp >> 5);
                for (int tt = tg * 32; tt < tg * 32 + 32; ++tt) {
                    const int t = t0 + tt; const int lo = (t - hw) < 0 ? 0 : (t - hw), hi = (t + hw) > L ? L : (t + hw);
                    float s0 = 0.f, s1 = 0.f;
                    for (int s = lo; s < hi; ++s) { const unsigned v = xs[(s - t0 + 8) * 128 + cp]; s0 += bflo(v); s1 += bfhi(v); }
                    const float ic = 1.f / (float)(hi - lo); const unsigned xv = xs[(tt + 8) * 128 + cp];
                    *(unsigned*)(Bcat + (size_t)(R0 + tt) * DM + 2 * cp) = cvtpk(s0 * ic - bflo(xv), s1 * ic - bfhi(xv));
                }
            } else {
                bf16_t* vs = (bf16_t*)lds;
#pragma unroll 4
                for (int i2 = tid; i2 < 128 * 16; i2 += 512) { const int tok = i2 >> 4, c = i2 & 15;
                    *(u32x4*)(vs + tok * 136 + c * 8) = *(const u32x4*)(P + (size_t)(R0 + tok) * NPC + 640 + c * 8); }
                __syncthreads();
                const int posbase = lat ? t0 : SEQ + t0;
                for (int i2 = tid; i2 < 128 * 16; i2 += 512) { const int vr = i2 & 127, pg = i2 >> 7;
                    unsigned short e[8];
#pragma unroll
                    for (int i = 0; i < 8; ++i) { const int p = pg * 8 + i; const int kap = (p & ~12) | ((p & 4) << 1) | ((p & 8) >> 1); e[i] = vs[kap * 136 + vr]; }
                    u32x4 w; w.x = e[0] | ((unsigned)e[1] << 16); w.y = e[2] | ((unsigned)e[3] << 16); w.z = e[4] | ((unsigned)e[5] << 16); w.w = e[6] | ((unsigned)e[7] << 16);
                    *(u32x4*)(Vt + ((size_t)(b * 2 + (vr >> 6)) * 64 + (vr & 63)) * KVPOS + posbase + pg * 8) = w; }
            }
            __syncthreads();
        } else {
            const int R0 = (it - (nSGU + nPOOL + nV)) * 64; const bool lat = R0 < TL;
            const bool full = lat || (l == 0);
            const int nh = full ? 10 : 2, hbase = full ? 0 : 8;
#pragma unroll 2
            for (int i2 = tid; i2 < 64 * nh * 8; i2 += 512) {
                const int l8 = i2 & 7, hr = i2 >> 3, tok = hr / nh, hh = hbase + (hr - tok * nh);
                const int R = R0 + tok; const bool isq = hh < 8;
                const bf16_t* src = P + (size_t)R * NPC + (isq ? hh * 64 : 512 + (hh - 8) * 64) + l8 * 8;
                const u32x4 raw = *(const u32x4*)src;
                float x[8] = {bflo(raw.x), bfhi(raw.x), bflo(raw.y), bfhi(raw.y), bflo(raw.z), bfhi(raw.z), bflo(raw.w), bfhi(raw.w)};
                float ss = 0.f;
#pragma unroll
                for (int i = 0; i < 8; ++i) ss += x[i] * x[i];
                ss += __shfl_xor(ss, 1); ss += __shfl_xor(ss, 2); ss += __shfl_xor(ss, 4);
                const float rinv = __builtin_amdgcn_rsqf(ss * (1.f / 64.f) + EPS);
                const float* gn = (isq ? qn : kn) + l8 * 8;
                const f32x4 g0 = *(const f32x4*)gn, g1 = *(const f32x4*)(gn + 4);
                float y[8], o[8];
#pragma unroll
                for (int i = 0; i < 4; ++i) { y[i] = x[i] * rinv * g0[i]; y[4 + i] = x[4 + i] * rinv * g1[i]; }
                const int t = R & (SEQ - 1);
                const int half = l8 >> 2, second = (l8 >> 1) & 1, fi0 = (l8 & 1) * 8;
                const f32x4* rp = (const f32x4*)(rope + ((size_t)t * 32 + half * 16 + fi0) * 2);
                f32x4 cs[4];
                if (lat) {
#pragma unroll
                    for (int i = 0; i < 4; ++i) cs[i] = rp[i];
                }
#pragma unroll
                for (int i = 0; i < 8; ++i) {
                    const float partner = __shfl_xor(y[i], 2);
                    if (lat) { const float cv = cs[i >> 1][(i & 1) * 2], sv = cs[i >> 1][(i & 1) * 2 + 1];
                        o[i] = second ? (y[i] * cv + partner * sv) : (y[i] * cv - partner * sv); }
                    else o[i] = y[i];
                }
                const float sc = isq ? QSCALE : 1.f;
                u32x4 w; w.x = cvtpk(o[0] * sc, o[1] * sc); w.y = cvtpk(o[2] * sc, o[3] * sc); w.z = cvtpk(o[4] * sc, o[5] * sc); w.w = cvtpk(o[6] * sc, o[7] * sc);
                bf16_t* dst = isq ? Bcat + (size_t)R * DM + 256 + hh * 64 + l8 * 8 : kbuf + (size_t)R * 128 + (hh - 8) * 64 + l8 * 8;
                *(u32x4*)dst = w;
            }
        }
    }
}

__device__ __forceinline__ void attn_phase(const int tid, const Args& a, int l, unsigned char* lds, int dry) {
    const int lane = tid & 63, w = tid >> 6, q32 = lane & 31, hi = lane >> 5;
    bf16_t* Bcat = (bf16_t*)(a.ws + WS_AP); const bf16_t* kbuf = (const bf16_t*)(a.ws + WS_KB); const bf16_t* Vt = (const bf16_t*)(a.ws + WS_VT);
    const int G = gridDim.x, c = blockIdx.x;
    const int per = (512 + G - 1) / G;
    const int nlat = (c * per >= 512) ? 0 : ((c + 1) * per > 512 ? 512 - c * per : per);
    const int nctx = (l == 0 && c < 64) ? (64 - c + G - 1) / G : 0;
    const int kr = tid >> 3, kc = tid & 7;
    for (int ui = 0; ui < nlat + nctx; ++ui) {
        int b, kvh, qrow0, jt0, NT;
        if (ui < nlat) { const int u = c * per + ui; const int bk = u >> 4, qb = u & 15; b = bk >> 1; kvh = bk & 1; qrow0 = b * SEQ + qb * 128; jt0 = 0; NT = 36; }
        else { const int u = c + (ui - nlat) * G; const int bk = u >> 1, qb = u & 1; b = bk >> 1; kvh = bk & 1; qrow0 = TL + b * CTXL + qb * 128; jt0 = 32; NT = 4; }
        const int head = kvh * 4 + (w >> 1); const int myrow = qrow0 + 64 * (w & 1) + q32;
        bf16_t* qp = Bcat + (size_t)myrow * DM + 256 + head * 64;
        bf16x8 qf[2][4];
#pragma unroll
        for (int sb = 0; sb < 2; ++sb)
#pragma unroll
            for (int ds = 0; ds < 4; ++ds) qf[sb][ds] = *(const bf16x8*)(qp + (size_t)sb * 32 * DM + 16 * ds + hi * 8);
        const bf16_t* vsrc = Vt + ((size_t)(b * 2 + kvh) * 64 + kr) * KVPOS + kc * 8;
#define KSRC(jt) (kbuf + (size_t)(((jt) < 32 ? b * SEQ + 64 * (jt) : TL + b * CTXL + 64 * ((jt) - 32)) + kr) * 128 + kvh * 64 + kc * 8)
        u32x4 kreg = *(const u32x4*)KSRC(jt0), vreg = *(const u32x4*)(vsrc + 64 * jt0);
        *(u32x4*)(lds + kr * 144 + kc * 16) = kreg; *(u32x4*)(lds + 18432 + kr * 144 + kc * 16) = vreg;
        __syncthreads();
        f32x16 o0[2], o1[2];
        float mrun[2], lrun[2];
#pragma unroll
        for (int sb = 0; sb < 2; ++sb) { mrun[sb] = -1e30f; lrun[sb] = 0.f;
#pragma unroll
            for (int r = 0; r < 16; ++r) { o0[sb][r] = 0.f; o1[sb][r] = 0.f; } }
        for (int j = 0; j < NT; ++j) {
            if (j + 1 < NT) { kreg = *(const u32x4*)KSRC(jt0 + j + 1); vreg = *(const u32x4*)(vsrc + 64 * (jt0 + j + 1)); }
            const unsigned char* Kb = lds + (j & 1) * 9216; const unsigned char* Vb = lds + 18432 + (j & 1) * 9216;
            f32x16 p0[2], p1[2];
#pragma unroll
            for (int sb = 0; sb < 2; ++sb)
#pragma unroll
                for (int r = 0; r < 16; ++r) { p0[sb][r] = 0.f; p1[sb][r] = 0.f; }
#pragma unroll
            for (int ds = 0; ds < 4; ++ds) {
                const bf16x8 k0 = *(const bf16x8*)(Kb + q32 * 144 + ds * 32 + hi * 16);
                const bf16x8 k1 = *(const bf16x8*)(Kb + (32 + q32) * 144 + ds * 32 + hi * 16);
#pragma unroll
                for (int sb = 0; sb < 2; ++sb) {
                    p0[sb] = __builtin_amdgcn_mfma_f32_32x32x16_bf16(k0, qf[sb][ds], p0[sb], 0, 0, 0);
                    p1[sb] = __builtin_amdgcn_mfma_f32_32x32x16_bf16(k1, qf[sb][ds], p1[sb], 0, 0, 0);
                }
            }
            u32x4 pw[2][4];
#pragma unroll
            for (int sb = 0; sb < 2; ++sb) {
                float mx = fmaxf(p0[sb][0], p1[sb][0]);
#pragma unroll
                for (int r = 1; r < 16; ++r) mx = fmaxf(mx, fmaxf(p0[sb][r], p1[sb][r]));
                mx = fmaxf(mx, __shfl_xor(mx, 32));
                const float mnew = fmaxf(mrun[sb], mx); const float alpha = __builtin_amdgcn_exp2f(mrun[sb] - mnew); mrun[sb] = mnew;
                float ls = 0.f;
#pragma unroll
                for (int r = 0; r < 16; ++r) { p0[sb][r] = __builtin_amdgcn_exp2f(p0[sb][r] - mnew); p1[sb][r] = __builtin_amdgcn_exp2f(p1[sb][r] - mnew); ls += p0[sb][r] + p1[sb][r]; }
                lrun[sb] = lrun[sb] * alpha + ls;
#pragma unroll
                for (int r = 0; r < 16; ++r) { o0[sb][r] *= alpha; o1[sb][r] *= alpha; }
                pw[sb][0] = (u32x4){cvtpk(p0[sb][0], p0[sb][1]), cvtpk(p0[sb][2], p0[sb][3]), cvtpk(p0[sb][4], p0[sb][5]), cvtpk(p0[sb][6], p0[sb][7])};
                pw[sb][1] = (u32x4){cvtpk(p0[sb][8], p0[sb][9]), cvtpk(p0[sb][10], p0[sb][11]), cvtpk(p0[sb][12], p0[sb][13]), cvtpk(p0[sb][14], p0[sb][15])};
                pw[sb][2] = (u32x4){cvtpk(p1[sb][0], p1[sb][1]), cvtpk(p1[sb][2], p1[sb][3]), cvtpk(p1[sb][4], p1[sb][5]), cvtpk(p1[sb][6], p1[sb][7])};
                pw[sb][3] = (u32x4){cvtpk(p1[sb][8], p1[sb][9]), cvtpk(p1[sb][10], p1[sb][11]), cvtpk(p1[sb][12], p1[sb][13]), cvtpk(p1[sb][14], p1[sb][15])};
            }
#pragma unroll
            for (int s = 0; s < 4; ++s) {
                const bf16x8 v0 = *(const bf16x8*)(Vb + q32 * 144 + s * 32 + hi * 16);
                const bf16x8 v1 = *(const bf16x8*)(Vb + (32 + q32) * 144 + s * 32 + hi * 16);
#pragma unroll
                for (int sb = 0; sb < 2; ++sb) {
                    const bf16x8 pa = __builtin_bit_cast(bf16x8, pw[sb][s]);
                    o0[sb] = __builtin_amdgcn_mfma_f32_32x32x16_bf16(v0, pa, o0[sb], 0, 0, 0);
                    o1[sb] = __builtin_amdgcn_mfma_f32_32x32x16_bf16(v1, pa, o1[sb], 0, 0, 0);
                }
            }
            if (j + 1 < NT) { unsigned char* Kn = lds + ((j + 1) & 1) * 9216; *(u32x4*)(Kn + kr * 144 + kc * 16) = kreg; *(u32x4*)(Kn + 18432 + kr * 144 + kc * 16) = vreg; }
            __syncthreads();
        }
#undef KSRC
#pragma unroll
        for (int sb = 0; sb < 2; ++sb) {
            float lt = lrun[sb]; lt += __shfl_xor(lt, 32);
            const float inv = 1.f / lt;
            bf16_t* op = qp + (size_t)sb * 32 * DM;
#pragma unroll
            for (int rg = 0; rg < 4; ++rg) {
                u32x2 w0; w0.x = cvtpk(o0[sb][4 * rg] * inv, o0[sb][4 * rg + 1] * inv); w0.y = cvtpk(o0[sb][4 * rg + 2] * inv, o0[sb][4 * rg + 3] * inv);
                u32x2 w1; w1.x = cvtpk(o1[sb][4 * rg] * inv, o1[sb][4 * rg + 1] * inv); w1.y = cvtpk(o1[sb][4 * rg + 2] * inv, o1[sb][4 * rg + 3] * inv);
                if (!dry) { *(u32x2*)(op + 8 * rg + 4 * hi) = w0; *(u32x2*)(op + 32 + 8 * rg + 4 * hi) = w1; }
            }
        }
    }
}

__global__ void __launch_bounds__(512, 2) fwd_megakernel(Args a) {
    extern __shared__ __attribute__((aligned(16))) unsigned char lds[];
    cg::grid_group grid = cg::this_grid();
    unsigned char* ws = a.ws;
    float* modraw = (float*)(ws + WS_MOD);
    float* ssq = (float*)(ws + WS_SSQ);
    bf16_t* Ap = (bf16_t*)(ws + WS_AP);
    float* hctx = (float*)(ws + WS_HCTX);
    LAS unsigned char* ldsl = (LAS unsigned char*)lds;

    int second = 0; unsigned nbar = 0;
    for (int ph = a.ph_lo; ph < a.ph_hi; ++ph) {
        int tid = threadIdx.x; asm volatile("" : "+v"(tid));
        const int lane = tid & 63, wave = tid >> 6;
        int kind;
        { const int sp_ = ph < 11 ? ph - 2 : ph - 13;
          kind = (ph == 0 || ph == 1 || ph == 11 || ph == 12) ? 0 : (ph == 22 ? 7 : ((sp_ == 0 || sp_ == 7) ? 1 : ((sp_ == 1 || sp_ == 6 || sp_ == 8) ? 2 : (sp_ == 2 ? 3 : (sp_ == 3 ? 4 : (sp_ == 4 ? 5 : 6)))))); }
        const int dry = (REPEAT_MASK != 0) && ((REPEAT_MASK >> kind) & 1) && !second;
        if (ph == 0 || ph == 11) {
          if (ph == 0) {
            for (int i = blockIdx.x * 512 + tid; i < 6 * TT; i += gridDim.x * 512) ssq[TT + i] = 0.f;
            {
                float* rope = (float*)(ws + WS_ROPE);
                for (int i = blockIdx.x * 512 + tid; i < SEQ * 32; i += gridDim.x * 512) {
                    const int t = i >> 5, j = i & 31, fi = j & 15; const float pos = (float)((j < 16) ? (t >> 6) : (t & 63));
                    const float invf = __builtin_amdgcn_exp2f(-(float)fi * (13.287712379549449f / 16.f));
                    const float ang = pos * invf;
                    rope[2 * i] = __cosf(ang); rope[2 * i + 1] = __sinf(ang);
                }
            }
            {
                float* sc = (float*)lds;
                float* red = (float*)(lds + 69632);
                for (int i = tid; i < 17 * DM; i += 512) { const int mb = i >> 10, k = i & 1023; const float cv = mb < 16 ? a.in[I_C][mb * DM + k] : a.in[I_CCTX][k]; sc[i] = cv * sigm(cv); }
                __syncthreads();
                for (int item = blockIdx.x; item < 288; item += gridDim.x) {
                    const int l = item / 144, n0 = (item - l * 144) * 64;
                    const float* wp = a.in[I_WADA] + ((size_t)l * DM + wave * 128) * NMOD + n0 + lane;
                    float acc[17];
#pragma unroll
                    for (int mb = 0; mb < 17; ++mb) acc[mb] = 0.f;
#pragma unroll 16
                    for (int k = 0; k < 128; ++k) { const float wv = wp[(size_t)k * NMOD];
#pragma unroll
                        for (int mb = 0; mb < 17; ++mb) acc[mb] += sc[mb * DM + wave * 128 + k] * wv; }
#pragma unroll
                    for (int mb = 0; mb < 17; ++mb) red[(wave * 17 + mb) * 64 + lane] = acc[mb];
                    __syncthreads();
                    for (int i = tid; i < 17 * 64; i += 512) { const int mb = i >> 6, col = i & 63; float s = a.in[I_BADA][l * NMOD + n0 + col];
#pragma unroll
                        for (int w8 = 0; w8 < 8; ++w8) s += red[(w8 * 17 + mb) * 64 + col];
                        modraw[((size_t)l * 17 + mb) * NMOD + n0 + col] = s; }
                    __syncthreads();
                }
            }
            __syncthreads();
          }
            convert_weights(tid, a, ph == 0 ? 0 : 1, lds);
        } else if (ph == 1 || ph == 12) {
            const int l = ph == 1 ? 0 : 1;
            compute_biases(tid, a, l, lds);
            if (l == 0) {
                const float* nrm = a.in[I_NFFN1]; const int gw = blockIdx.x * 8 + wave, NGW = gridDim.x * 8;
                for (int R = gw; R < TT; R += NGW) {
                    const float* xr = R < TL ? a.in[I_X] + (size_t)R * DM : a.in[I_CTX] + (size_t)(R - TL) * DM;
                    const int mb = R < TL ? (R >> 11) : 16; const float* scl = modraw + (size_t)mb * NMOD + DM;
                    float ss = 0.f;
#pragma unroll
                    for (int c4 = 0; c4 < 4; ++c4) { const int col = c4 * 256 + lane * 4; const f32x4 v = *(const f32x4*)(xr + col);
                        ss += (v[0] * v[0] + v[1] * v[1]) + (v[2] * v[2] + v[3] * v[3]);
                        const f32x4 g = *(const f32x4*)(nrm + col) * (*(const f32x4*)(scl + col) + 1.f), y = v * g;
                        u32x2 w; w.x = cvtpk(y[0], y[1]); w.y = cvtpk(y[2], y[3]); *(u32x2*)(Ap + (size_t)R * DM + col) = w; }
                    ss = wave_sum(ss);
                    if (lane == 0) ssq[R] = ss;
                }
            }
        } else if (ph == 22) {
            const float* fn = a.in[I_FNORM]; const int gw = blockIdx.x * 8 + wave, NGW = gridDim.x * 8;
            for (int R = gw; R < TL; R += NGW) {
                const float r = __builtin_amdgcn_rsqf(ssq[(size_t)6 * TT + R] * (1.f / DM) + EPS);
                float* orow = a.out + (size_t)R * DM;
#pragma unroll
                for (int c4 = 0; c4 < 4; ++c4) { const int col = c4 * 256 + lane * 4; const f32x4 v = *(const f32x4*)(orow + col) * r * *(const f32x4*)(fn + col); *(f32x4*)(orow + col) = v; }
            }
        } else {
            const int l = ph < 11 ? 0 : 1, sp = ph < 11 ? ph - 2 : ph - 13;
            const float* modl = modraw + (size_t)l * 17 * NMOD;
            const int nMall = TT / 256, nMlat = TL / 256;
            const float* hin_l = (l == 0 && sp <= 1) ? a.in[I_X] : a.out; const float* hin_c = (l == 0 && sp <= 1) ? a.in[I_CTX] : hctx;
            if (sp == 0 || sp == 7) {
                const bool f1 = sp == 0; const int nM = (f1 || l == 0) ? nMall : nMlat;
                pg8::TileSched S = pg8::make_sched(nM, 2 * DFF / 256, DM);
                pg8::EpiSwiGLU E{(bf16_t*)(ws + WS_G), (const float*)(ws + (f1 ? WS_B13A : WS_B13B)), ssq + (size_t)(3 * l + (f1 ? 0 : 2)) * TT};
                pg8::gemm_phase(tid, ldsl, Ap, DM, (const bf16_t*)(ws + (f1 ? WS_W13A : WS_W13B)), DM, S, E);
            } else if (sp == 1 || sp == 8 || sp == 6) {
                const int nM = (sp == 1 || l == 0) ? nMall : nMlat;
                const int j = sp == 1 ? 0 : (sp == 6 ? 1 : 2);
                const bool lastg = (l == 1 && sp == 8);
                const int ln = (sp == 8) ? l + 1 : l, jn = (sp == 8) ? 0 : j + 1;
                const float* nrm = lastg ? nullptr : (jn == 0 ? a.in[I_NFFN1] : (jn == 1 ? a.in[I_NMIX] : a.in[I_NFFN2])) + (size_t)ln * DM;
                const float* scl = lastg ? nullptr : modraw + (size_t)ln * 17 * NMOD + (3 * jn + 1) * DM;
                float* ssqn = ssq + (size_t)(3 * l + j + 1) * TT;
                pg8::EpiRes E{(uintptr_t)hin_l, (uintptr_t)hin_c - (uintptr_t)hin_l, (uintptr_t)a.out, (uintptr_t)hctx - (uintptr_t)a.out, modl + (3 * j + 2) * DM, sp == 6 ? 1.0f : 0.5f, nrm, scl, ssqn, lastg ? nullptr : Ap, dry};
                const bool wo = sp == 6; const int Kd = wo ? DM : DFF;
                pg8::TileSched S = wo ? pg8::make_sched(nM, DM / 256, Kd) : pg8::make_streamk(nM, DM / 256, Kd, (float*)(ws + WS_P), (unsigned*)(ws + WS_CTL) + 64, (unsigned)(ph + 1));
                pg8::gemm_phase(tid, ldsl, (const bf16_t*)(ws + (wo ? WS_P : WS_G)), Kd, (const bf16_t*)(ws + (wo ? WS_WOUT : (sp == 1 ? WS_W2A : WS_W2B))), Kd, S, E);
            } else if (sp == 2) {
                pg8::TileSched S = pg8::make_sched(l == 0 ? nMall : nMlat, NIN / 256, DM);
                if (l == 1) { S.n2 = TC / 256; S.pm0_2 = nMlat; S.pn0_2 = 2; }
                pg8::EpiIn E{(bf16_t*)(ws + WS_P), (bf16_t*)(ws + WS_G), (const float*)(ws + WS_BIN), ssq + (size_t)(3 * l + 1) * TT};
                pg8::gemm_phase(tid, ldsl, Ap, DM, (const bf16_t*)(ws + WS_WIN), DM, S, E);
            } else if (sp == 3) {
                post_phase(tid, a, l, lds);
            } else if (sp == 4) {
                attn_phase(tid, a, l, lds, dry);
            } else if (sp == 5) {
                pg8::TileSched S = pg8::make_sched(l == 0 ? nMall : nMlat, DM / 256, DM);
                S.nb = 3;
                pg8::EpiMerge E{(const bf16_t*)(ws + WS_G), (bf16_t*)(ws + WS_P)};
                pg8::gemm_phase(tid, ldsl, Ap, DM, (const bf16_t*)(ws + WS_WCAT), DM, S, E);
            }
        }
        if (REPEAT_MASK != 0) { if (dry) { second = 1; --ph; __syncthreads(); continue; } second = 0; }
        if (ph + 1 < a.ph_hi) {
            asm volatile("s_waitcnt vmcnt(0) lgkmcnt(0)" ::: "memory");
            __syncthreads();
            if (ph == a.ph_lo) { if (threadIdx.x == 0) __builtin_amdgcn_fence(__ATOMIC_RELEASE, "agent"); grid.sync(); if (threadIdx.x == 0) __builtin_amdgcn_fence(__ATOMIC_ACQUIRE, "agent"); }
            else {
              for (int bb = 0; bb <= EXTRA_BAR; ++bb) {
                if (threadIdx.x == 0) {
                    unsigned* ctr = (unsigned*)(ws + WS_CTL);
                    __builtin_amdgcn_fence(__ATOMIC_RELEASE, "agent");
                    __hip_atomic_fetch_add(ctr, 1u, __ATOMIC_RELAXED, __HIP_MEMORY_SCOPE_AGENT);
                    ++nbar;
                    const unsigned target = nbar * gridDim.x;
                    while (__hip_atomic_load(ctr, __ATOMIC_RELAXED, __HIP_MEMORY_SCOPE_AGENT) < target) __builtin_amdgcn_s_sleep(2);
                    __builtin_amdgcn_fence(__ATOMIC_ACQUIRE, "agent");
                }
                if (EXTRA_BAR) { asm volatile("s_waitcnt vmcnt(0)" ::: "memory"); __syncthreads(); }
              }
            }
            asm volatile("s_waitcnt vmcnt(0)" ::: "memory");
            __syncthreads();
        }
    }
}

extern "C" void kernel_launch(void* const* d_in, const int* in_sizes, int n_in, void* d_out, int out_size, void* d_ws, size_t ws_size, hipStream_t stream) {
    static int grid = 0;
    if (grid == 0) {
        if (n_in != 26 || out_size != TL * DM || ws_size < WS_END) { fprintf(stderr, "kernel_launch: unexpected shapes (n_in %d out %d ws %zu need %zu)\n", n_in, out_size, ws_size, (size_t)WS_END); grid = -1; return; }
        int dev = 0, cus = 0, per_cu = 0;
        if (hipGetDevice(&dev) != hipSuccess || hipDeviceGetAttribute(&cus, hipDeviceAttributeMultiprocessorCount, dev) != hipSuccess) { grid = -1; return; }
        if (hipFuncSetAttribute((const void*)fwd_megakernel, hipFuncAttributeMaxDynamicSharedMemorySize, LDS_BYTES) != hipSuccess) { fprintf(stderr, "kernel_launch: hipFuncSetAttribute failed\n"); grid = -1; return; }
        if (hipOccupancyMaxActiveBlocksPerMultiprocessor(&per_cu, (const void*)fwd_megakernel, 512, LDS_BYTES) != hipSuccess || per_cu < 1) per_cu = 1;
        (void)hipGetLastError();
        grid = cus * per_cu;
    }
    if (grid < 0) return;
    Args a{};
    for (int i = 0; i < 26; ++i) a.in[i] = (const float*)d_in[i];
    a.out = (float*)d_out; a.ws = (unsigned char*)d_ws;
#if MK_ONE_LAUNCH
    a.ph_lo = 0; a.ph_hi = NPHASES;
    if (hipMemsetAsync((char*)d_ws + WS_CTL, 0, 16384, stream) != hipSuccess) { fprintf(stderr, "memset failed\n"); return; }
    void* args[] = {&a};
    hipError_t e = hipLaunchCooperativeKernel((const void*)fwd_megakernel, dim3(grid), dim3(512), args, LDS_BYTES, stream);
    if (e != hipSuccess) fprintf(stderr, "cooperative launch failed: %s (grid %d)\n", hipGetErrorString(e), grid);
#else
    for (int ph = 0; ph < NPHASES; ++ph) {
        a.ph_lo = ph; a.ph_hi = ph + 1;
        hipLaunchKernelGGL(fwd_megakernel, dim3(grid), dim3(512), LDS_BYTES, stream, a);
    }
#endif
}
```

```cpp
#include <hip/hip_runtime.h>
#include <hip/hip_cooperative_groups.h>
#include <cstdio>
#include <cstdint>
namespace cg = cooperative_groups;

#ifndef REPEAT_MASK
#define REPEAT_MASK 0
#endif
#ifndef EXTRA_BAR
#define EXTRA_BAR 0
#endif
#ifndef MK_ONE_LAUNCH
#define MK_ONE_LAUNCH 1
#endif

#define LAS __attribute__((address_space(3)))
#define GAS __attribute__((address_space(1)))
typedef unsigned short bf16_t;
typedef short bf16x8 __attribute__((ext_vector_type(8)));
typedef float f32x4 __attribute__((ext_vector_type(4)));
typedef float f32x16 __attribute__((ext_vector_type(16)));
typedef unsigned u32x4 __attribute__((ext_vector_type(4)));
typedef unsigned u32x2 __attribute__((ext_vector_type(2)));
typedef float f32x2_t __attribute__((ext_vector_type(2)));
typedef __bf16 bf16x2_t __attribute__((ext_vector_type(2)));

constexpr int DM = 1024, NBATCH = 16, SEQ = 2048, CTXL = 256;
constexpr int TL = NBATCH * SEQ;
constexpr int TC = NBATCH * CTXL;
constexpr int TT = TL + TC;
constexpr int DFF = 2816, NIN = 4608, NPC = 1536, NGC = 3072, NMOD = 9 * DM;
constexpr int KVPOS = SEQ + CTXL;
constexpr float EPS = 1e-6f;
constexpr float QSCALE = 0.125f * 1.4426950408889634f;

constexpr size_t MiB = 1u << 20;
constexpr size_t al256(size_t x) { return (x + 255) & ~(size_t)255; }
constexpr size_t SZ_W13 = (size_t)2 * DFF * DM * 2, SZ_W2 = (size_t)DM * DFF * 2, SZ_WIN = (size_t)NIN * DM * 2, SZ_WSQ = (size_t)DM * DM * 2;
constexpr size_t WS_W13A = 0;
constexpr size_t WS_W2A = WS_W13A + SZ_W13;
constexpr size_t WS_WIN = WS_W2A + SZ_W2;
constexpr size_t WS_WCAT = WS_WIN + SZ_WIN;
constexpr size_t WS_WOUT = WS_WCAT + SZ_WSQ;
constexpr size_t WS_W13B = WS_WOUT + SZ_WSQ;
constexpr size_t WS_W2B = WS_W13B + SZ_W13;
constexpr size_t WS_SGUW = WS_W2B + SZ_W2;
constexpr size_t WS_MOD = al256(WS_SGUW + 4 * 128 * 128 * 2);
constexpr size_t WS_B13A = al256(WS_MOD + (size_t)2 * 17 * NMOD * 4);
constexpr size_t WS_BIN = al256(WS_B13A + (size_t)17 * 2 * DFF * 4);
constexpr size_t WS_B13B = al256(WS_BIN + (size_t)17 * NIN * 4);
constexpr size_t WS_SSQ = al256(WS_B13B + (size_t)17 * 2 * DFF * 4);
constexpr size_t WS_ROPE = al256(WS_SSQ + (size_t)7 * TT * 4);
constexpr size_t WS_HCTX = al256(WS_ROPE + (size_t)SEQ * 32 * 8);
constexpr size_t WS_AP = al256(WS_HCTX + (size_t)TC * DM * 4);
constexpr size_t WS_KB = al256(WS_AP + (size_t)TT * DM * 2);
constexpr size_t WS_VT = al256(WS_KB + (size_t)TT * 128 * 2);
constexpr size_t WS_P = al256(WS_VT + (size_t)NBATCH * 2 * 64 * KVPOS * 2);
constexpr size_t WS_G = al256(WS_P + (size_t)TT * NPC * 2);
constexpr size_t WS_CTL = al256(WS_G + (size_t)TT * NGC * 2);
constexpr size_t WS_END = WS_CTL + 16384;

constexpr int LDS_BYTES = 147456;
constexpr int NPHASES = 23;

__device__ __forceinline__ unsigned cvtpk(float lo, float hi) { f32x2_t v = {lo, hi}; bf16x2_t b = __builtin_convertvector(v, bf16x2_t); return __builtin_bit_cast(unsigned, b); }
__device__ __forceinline__ float bflo(unsigned u) { return __uint_as_float(u << 16); }
__device__ __forceinline__ float bfhi(unsigned u) { return __uint_as_float(u & 0xffff0000u); }
__device__ __forceinline__ float fexp(float x) { return __builtin_amdgcn_exp2f(x * 1.4426950408889634f); }
__device__ __forceinline__ float frcp(float x) { return __builtin_amdgcn_rcpf(x); }
__device__ __forceinline__ float sigm(float x) { return frcp(1.f + fexp(-x)); }
__device__ __forceinline__ float gelu_t(float x) { const float z = 0.7978845608028654f * (x + 0.044715f * x * x * x); return x * frcp(1.f + fexp(-2.f * z)); }
#define LDS_WAIT() asm volatile("s_waitcnt lgkmcnt(0)" ::: "memory")
__device__ __forceinline__ uintptr_t uni64(uintptr_t v) { const unsigned lo = __builtin_amdgcn_readfirstlane((unsigned)v), hi = __builtin_amdgcn_readfirstlane((unsigned)(v >> 32)); return ((uintptr_t)hi << 32) | lo; }

namespace pg8 {
constexpr int BM = 256, BK = 64, HALF = 128, HTB = HALF * BK * 2, STAGE_BYTES = 8 * HTB, NXCD = 8, WGM = 8;
__device__ __forceinline__ int lds_byte(int r, int c) { const int st = (r >> 4) * 2 + (c >> 5), rr = r & 15, cc = c & 31, ob = rr * 64 + cc * 2; return st * 1024 + (ob ^ (((ob >> 9) & 1) << 5)); }
__device__ __forceinline__ void stage_rc(int b, int& R, int& C) { const int st = b / 1024, sb = b % 1024, swz = sb ^ (((sb >> 9) & 1) << 5); R = (st >> 1) * 16 + swz / 64; C = (st & 1) * 32 + (swz % 64) / 2; }
__device__ __forceinline__ int perm32(int rho) { const int n = rho >> 4, i = rho & 15; return 8 * (i >> 2) + 4 * n + (i & 3); }

struct Unit { int pm, pn, k0, nt, tag, te; };

struct TileSched {
    int c, G, nM1, nN1, n1, pn0_1, n2, pm0_2, pn0_2, nb, ntk;
    int sk, P, R, s, e, ttot; float* slots; unsigned* flags; unsigned epoch;
    __device__ __forceinline__ void map_tile(int L, Unit& u) const {
        int wgid; { const int q = n1 / NXCD, r = n1 % NXCD, xcd = L % NXCD, off = L / NXCD; wgid = (xcd < r ? xcd * (q + 1) : r * (q + 1) + (xcd - r) * q) + off; }
        const int nig = WGM * nN1, gid = wgid / nig, fm = gid * WGM, gsz = (nM1 - fm) < WGM ? (nM1 - fm) : WGM;
        u.pm = fm + ((wgid % nig) % gsz); u.pn = pn0_1 + (wgid % nig) / gsz;
    }
    __device__ __forceinline__ bool next(int i, Unit& u) const {
        if (sk) {
            if (i < R) { map_tile(i * G + c, u); u.k0 = 0; u.nt = ntk; u.tag = 0; u.te = 0; return true; }
            const int T = s / P + (i - R), base = T * P;
            const int p0 = (i == R) ? s - base : 0; int p1 = e - base; if (p1 > P) p1 = P;
            if (p1 <= p0) return false;
            map_tile(R * G + T, u);
            u.k0 = p0 * 128; u.nt = 2 * (p1 - p0); u.tag = (p0 > 0) ? 1 : (p1 < P ? 2 : 0); u.te = base + P;
            return true;
        }
        int ti = i, br = 0;
        if (nb == 3) { ti = i / 3; br = i - ti * 3; }
        const int L = ti * G + c;
        if (L < n1) {
            map_tile(L, u);
        } else if (L - n1 < n2) { u.pm = pm0_2 + (L - n1); u.pn = pn0_2; }
        else return false;
        if (nb == 3) { u.k0 = br * 256 + (br >> 1) * 256; u.nt = 4 + 4 * (br & 1); }
        else { u.k0 = 0; u.nt = ntk; }
        u.tag = (nb == 3) ? br : 0; u.te = 0;
        return true;
    }
};
__device__ __forceinline__ TileSched make_sched(int nM1, int nN1, int K) {
    TileSched s; s.c = blockIdx.x; s.G = gridDim.x; s.nM1 = nM1; s.nN1 = nN1; s.n1 = nM1 * nN1; s.pn0_1 = 0; s.n2 = 0; s.pm0_2 = 0; s.pn0_2 = 0; s.nb = 1;
    s.ntk = K / BK; s.sk = 0; s.P = 1; s.R = 0; s.s = 0; s.e = 0; s.ttot = 0; s.slots = nullptr; s.flags = nullptr; s.epoch = 0; return s;
}
__device__ __forceinline__ TileSched make_streamk(int nM1, int nN1, int K, float* slots, unsigned* flags, unsigned epoch) {
    TileSched s = make_sched(nM1, nN1, K);
    s.sk = 1; s.P = K / (2 * BK); s.R = s.n1 / s.G; s.ttot = (s.n1 - s.R * s.G) * s.P;
    s.s = (int)((long long)s.c * s.ttot / s.G); s.e = (int)((long long)(s.c + 1) * s.ttot / s.G);
    s.slots = slots; s.flags = flags; s.epoch = epoch;
    return s;
}

__device__ __forceinline__ int unit_mb(const Unit& u) { return u.pm < 128 ? (u.pm >> 3) : 16; }

struct EpiSwiGLU {
    bf16_t* act; const float* bias; const float* ssq;
    __device__ __forceinline__ void operator()(f32x4 (&acc)[2][2][4][2], const Unit& u, int wr, int wc, int fr, int fq) const {
        const int mb = unit_mb(u);
        const float* bp = bias + (size_t)mb * (2 * DFF) + u.pn * 256 + wc * 32 + 8 * fq;
        f32x4 ba[2], bb[2];
#pragma unroll
        for (int n = 0; n < 2; ++n) { ba[n] = *(const f32x4*)(bp + 4 * n); bb[n] = *(const f32x4*)(bp + 128 + 4 * n); }
        const int row0 = u.pm * 256 + wr * 64 + fr;
        GAS bf16_t* op = (GAS bf16_t*)act + (size_t)row0 * DFF + u.pn * 128 + wc * 32 + 8 * fq;
        float rs[8];
#pragma unroll
        for (int g = 0; g < 8; ++g) rs[g] = ((const GAS float*)ssq)[row0 + (g >> 2) * 128 + (g & 3) * 16];
#pragma unroll
        for (int ai = 0; ai < 2; ++ai)
#pragma unroll
            for (int m = 0; m < 4; ++m) {
                const int ro = ai * 128 + m * 16;
                const float r = __builtin_amdgcn_rsqf(rs[ai * 4 + m] * (1.f / DM) + EPS);
                f32x4 a0 = acc[ai][0][m][0] * r + ba[0], a1 = acc[ai][0][m][1] * r + ba[1], b0 = acc[ai][1][m][0] * r + bb[0], b1 = acc[ai][1][m][1] * r + bb[1];
                f32x4 o0, o1;
#pragma unroll
                for (int i = 0; i < 4; ++i) { o0[i] = a0[i] * b0[i] * sigm(a0[i]); o1[i] = a1[i] * b1[i] * sigm(a1[i]); }
                u32x4 w; w.x = cvtpk(o0[0], o0[1]); w.y = cvtpk(o0[2], o0[3]); w.z = cvtpk(o1[0], o1[1]); w.w = cvtpk(o1[2], o1[3]);
                *(GAS u32x4*)(op + (size_t)ro * DFF) = w;
            }
    }
};
struct EpiIn {
    bf16_t* P; bf16_t* G; const float* bias; const float* ssq;
    __device__ __forceinline__ void operator()(f32x4 (&acc)[2][2][4][2], const Unit& u, int wr, int wc, int fr, int fq) const {
        const int mb = unit_mb(u);
        const int colt = u.pn * 256, cw = wc * 32 + 8 * fq;
        const float* bp = bias + (size_t)mb * NIN + colt + cw;
        f32x4 bv[2][2];
#pragma unroll
        for (int bj = 0; bj < 2; ++bj)
#pragma unroll
            for (int n = 0; n < 2; ++n) bv[bj][n] = *(const f32x4*)(bp + bj * 128 + 4 * n);
        const int row0 = u.pm * 256 + wr * 64 + fr;
        const bool gate = u.pn >= 6;
        GAS bf16_t* base = gate ? (GAS bf16_t*)G + (size_t)row0 * NGC + (colt - NPC) + cw : (GAS bf16_t*)P + (size_t)row0 * NPC + colt + cw;
        const size_t ld = gate ? NGC : NPC;
        float rs[8];
#pragma unroll
        for (int g = 0; g < 8; ++g) rs[g] = ((const GAS float*)ssq)[row0 + (g >> 2) * 128 + (g & 3) * 16];
#pragma unroll
        for (int ai = 0; ai < 2; ++ai)
#pragma unroll
            for (int m = 0; m < 4; ++m) {
                const int ro = ai * 128 + m * 16;
                const float r = __builtin_amdgcn_rsqf(rs[ai * 4 + m] * (1.f / DM) + EPS);
#pragma unroll
                for (int bj = 0; bj < 2; ++bj) {
                    f32x4 v0 = acc[ai][bj][m][0] * r + bv[bj][0], v1 = acc[ai][bj][m][1] * r + bv[bj][1];
                    if (gate) {
#pragma unroll
                        for (int i = 0; i < 4; ++i) { v0[i] = sigm(v0[i]); v1[i] = sigm(v1[i]); }
                    }
                    u32x4 w; w.x = cvtpk(v0[0], v0[1]); w.y = cvtpk(v0[2], v0[3]); w.z = cvtpk(v1[0], v1[1]); w.w = cvtpk(v1[2], v1[3]);
                    *(GAS u32x4*)(base + (size_t)ro * ld + bj * 128) = w;
                }
            }
    }
};
struct EpiRes {
    uintptr_t hin_l, hin_cd, hout_l, hout_cd; const float* gate; float coef; const float* nrm; const float* scl; float* ssq; bf16_t* Ap; int dry;
    __device__ __forceinline__ void operator()(f32x4 (&acc)[2][2][4][2], const Unit& u, int wr, int wc, int fr, int fq) const {
        const int mb = unit_mb(u);
        const bool lat = u.pm < 128;
        uintptr_t hin_l = this->hin_l, hin_cd = this->hin_cd, hout_l = this->hout_l, hout_cd = this->hout_cd; const float* gate = this->gate; float coef = this->coef;
        const float* nrm = this->nrm; const float* scl = this->scl; float* ssq = this->ssq; bf16_t* Ap = this->Ap;
        hin_l = uni64(hin_l); hin_cd = uni64(hin_cd); hout_l = uni64(hout_l); hout_cd = uni64(hout_cd); gate = (const float*)uni64((uintptr_t)gate); coef = __uint_as_float(__builtin_amdgcn_readfirstlane(__float_as_uint(coef)));
        nrm = (const float*)uni64((uintptr_t)nrm); scl = (const float*)uni64((uintptr_t)scl); ssq = (float*)uni64((uintptr_t)ssq); Ap = (bf16_t*)uni64((uintptr_t)Ap);
        const int col0 = u.pn * 256 + wc * 32 + 8 * fq, row0 = u.pm * 256 + wr * 64 + fr, rowl = lat ? row0 : row0 - TL;
        const GAS float* hi = (const GAS float*)(hin_l + (lat ? (uintptr_t)0 : hin_cd)) + (size_t)rowl * DM + col0;
        GAS float* ho = (GAS float*)(hout_l + (lat ? (uintptr_t)0 : hout_cd)) + (size_t)rowl * DM + col0;
        f32x4 gc[2][2], gs[2][2];
#pragma unroll
        for (int bj = 0; bj < 2; ++bj)
#pragma unroll
            for (int n = 0; n < 2; ++n) {
                gc[bj][n] = *(const GAS f32x4*)(gate + (size_t)mb * NMOD + col0 + 128 * bj + 4 * n) * (dry ? 0.f : coef);
                if (Ap) gs[bj][n] = *(const GAS f32x4*)(nrm + col0 + 128 * bj + 4 * n) * (*(const GAS f32x4*)(scl + (size_t)mb * NMOD + col0 + 128 * bj + 4 * n) + 1.f);
                else gs[bj][n] = (f32x4){0.f, 0.f, 0.f, 0.f};
            }
#pragma unroll
        for (int ai = 0; ai < 2; ++ai)
#pragma unroll
          for (int mh = 0; mh < 2; ++mh) {
            f32x4 hv[2][2][2];
#pragma unroll
            for (int m2 = 0; m2 < 2; ++m2)
#pragma unroll
                for (int bj = 0; bj < 2; ++bj) { const size_t off = (size_t)(ai * 128 + (mh * 2 + m2) * 16) * DM + 128 * bj;
                    hv[m2][bj][0] = *(const GAS f32x4*)(hi + off); hv[m2][bj][1] = *(const GAS f32x4*)(hi + off + 4); }
#pragma unroll
            for (int m2 = 0; m2 < 2; ++m2) {
                const int m = mh * 2 + m2;
                const int ro = ai * 128 + m * 16; const size_t off = (size_t)ro * DM;
                float ss = 0.f;
#pragma unroll
                for (int bj = 0; bj < 2; ++bj) {
                    const f32x4 h0 = hv[m2][bj][0] + gc[bj][0] * acc[ai][bj][m][0], h1 = hv[m2][bj][1] + gc[bj][1] * acc[ai][bj][m][1];
                    *(GAS f32x4*)(ho + off + 128 * bj) = h0; *(GAS f32x4*)(ho + off + 128 * bj + 4) = h1;
                    ss += (h0[0] * h0[0] + h0[1] * h0[1]) + (h0[2] * h0[2] + h0[3] * h0[3]) + (h1[0] * h1[0] + h1[1] * h1[1]) + (h1[2] * h1[2] + h1[3] * h1[3]);
                    if (Ap) { const f32x4 a0 = h0 * gs[bj][0], a1 = h1 * gs[bj][1];
                        u32x4 w; w.x = cvtpk(a0[0], a0[1]); w.y = cvtpk(a0[2], a0[3]); w.z = cvtpk(a1[0], a1[1]); w.w = cvtpk(a1[2], a1[3]);
                        *(GAS u32x4*)((GAS bf16_t*)Ap + (size_t)(row0 + ro) * DM + col0 + 128 * bj) = w; }
                }
                ss += __shfl_xor(ss, 16); ss += __shfl_xor(ss, 32);
                if (fq == 0) atomicAdd(ssq + row0 + ro, dry ? 0.f : ss);
            }
          }
    }
};
struct EpiMerge {
    const bf16_t* G; bf16_t* Mg;
    __device__ __forceinline__ void operator()(f32x4 (&acc)[2][2][4][2], const Unit& u, int wr, int wc, int fr, int fq) const {
        const int br = u.tag, col0 = u.pn * 256 + wc * 32 + 8 * fq, row0 = u.pm * 256 + wr * 64 + fr;
        const GAS bf16_t* g0 = (const GAS bf16_t*)G + (size_t)row0 * NGC + br * 1024 + col0;
#pragma unroll
        for (int ai = 0; ai < 2; ++ai) {
            u32x4 gv[4][2], hv[4][2];
#pragma unroll
            for (int m = 0; m < 4; ++m)
#pragma unroll
                for (int bj = 0; bj < 2; ++bj) { const GAS bf16_t* gp = g0 + (size_t)(ai * 128 + m * 16) * NGC + 128 * bj;
                    gv[m][bj] = *(const GAS u32x4*)gp; hv[m][bj] = (br < 2) ? *(const GAS u32x4*)(gp + 1024) : (u32x4){0u, 0u, 0u, 0u}; }
#pragma unroll
            for (int m = 0; m < 4; ++m) {
                const int row = row0 + ai * 128 + m * 16;
#pragma unroll
                for (int bj = 0; bj < 2; ++bj) {
                    const u32x4 g = gv[m][bj];
                    f32x4 s0 = (f32x4){bflo(g.x), bfhi(g.x), bflo(g.y), bfhi(g.y)}, s1 = (f32x4){bflo(g.z), bfhi(g.z), bflo(g.w), bfhi(g.w)};
                    if (br < 2) {
                        const u32x4 h = hv[m][bj];
                        const f32x4 d0 = (f32x4){bflo(h.x), bfhi(h.x), bflo(h.y), bfhi(h.y)}, d1 = (f32x4){bflo(h.z), bfhi(h.z), bflo(h.w), bfhi(h.w)};
#pragma unroll
                        for (int i = 0; i < 4; ++i) { s0[i] *= frcp(fmaxf(d0[i], 1e-20f)); s1[i] *= frcp(fmaxf(d1[i], 1e-20f)); }
                        acc[ai][bj][m][0] *= s0; acc[ai][bj][m][1] *= s1;
                    } else {
                        const f32x4 v0 = acc[ai][bj][m][0] * s0, v1 = acc[ai][bj][m][1] * s1;
                        u32x4 w; w.x = cvtpk(v0[0], v0[1]); w.y = cvtpk(v0[2], v0[3]); w.z = cvtpk(v1[0], v1[1]); w.w = cvtpk(v1[2], v1[3]);
                        *(GAS u32x4*)((GAS bf16_t*)Mg + (size_t)row * DM + col0 + 128 * bj) = w;
                    }
                }
            }
        }
    }
};

template <class Epi>
__device__ __forceinline__ void gemm_phase(const int tid, LAS unsigned char* lds, const bf16_t* Ab, int lda, const bf16_t* Bb, int ldb, const TileSched& S, const Epi& E) {
    const int wid = __builtin_amdgcn_readfirstlane(tid >> 6), lane = tid & 63, wr = wid >> 2, wc = wid & 3, fr = lane & 15, fq = lane >> 4;
    unsigned voffA[2], voffB[2];
#pragma unroll
    for (int i = 0; i < 2; ++i) { int R, C; stage_rc(tid * 16 + i * 8192, R, C); const int Rb = (R & ~31) + perm32(R & 31);
        voffA[i] = (unsigned)(R * lda + C) * 2u; voffB[i] = (unsigned)(Rb * ldb + C) * 2u; }
    const size_t kstep = (size_t)(BK * 2);
    const size_t hsA = (size_t)HALF * lda * 2, hsB = (size_t)HALF * ldb * 2;
    const unsigned ldsw = (unsigned)wid * 1024u;
    const int aoff = lds_byte(wr * 64 + fr, fq * 8), boff = lds_byte(wc * 32 + fr, fq * 8);
#define PG8_SA(b, h) (((b) * 2 + (h)) * HTB)
#define PG8_SB(b, h) ((4 + (b) * 2 + (h)) * HTB)
#define PG8_STAGE(bufoff, gbase, voff) do { _Pragma("unroll") for (int _i = 0; _i < 2; ++_i) \
        __builtin_amdgcn_global_load_lds((const unsigned*)((const char*)(gbase) + (voff)[_i]), (LAS unsigned*)(lds + (bufoff) + ldsw + _i * 8192), 16, 0, 0); } while (0)
#define PG8_LDA(dst, b, h) do { _Pragma("unroll") for (int m = 0; m < 4; ++m) _Pragma("unroll") for (int k = 0; k < 2; ++k) dst[m][k] = *(const LAS bf16x8*)(lds + PG8_SA(b, h) + aoff + m * 2048 + k * 1024); } while (0)
#define PG8_LDB(dst, b, h) do { _Pragma("unroll") for (int n = 0; n < 2; ++n) _Pragma("unroll") for (int k = 0; k < 2; ++k) dst[n][k] = *(const LAS bf16x8*)(lds + PG8_SB(b, h) + boff + n * 2048 + k * 1024); } while (0)
#define PG8_MMA(ai, bj, At, Bt) do { __builtin_amdgcn_s_setprio(1); _Pragma("unroll") for (int m = 0; m < 4; ++m) _Pragma("unroll") for (int n = 0; n < 2; ++n) _Pragma("unroll") for (int k = 0; k < 2; ++k) \
        acc[ai][bj][m][n] = __builtin_amdgcn_mfma_f32_16x16x32_bf16(Bt[n][k], At[m][k], acc[ai][bj][m][n], 0, 0, 0); __builtin_amdgcn_s_setprio(0); } while (0)
#define PG8_WAIT_V(n) asm volatile("s_waitcnt vmcnt(" #n ")" ::: "memory")
#define PG8_WAIT_L(n) asm volatile("s_waitcnt lgkmcnt(" #n ")" ::: "memory")
#define PG8_BAR __builtin_amdgcn_s_barrier()
#define PG8_SCHED __builtin_amdgcn_sched_barrier(0)
    Unit cur, nxt; int ui = 0;
    if (!S.next(0, cur)) return;
    f32x4 acc[2][2][4][2];
#pragma unroll
    for (int a = 0; a < 2; ++a)
#pragma unroll
        for (int b = 0; b < 2; ++b)
#pragma unroll
            for (int m = 0; m < 4; ++m)
#pragma unroll
                for (int n = 0; n < 2; ++n) acc[a][b][m][n] = (f32x4){0.f, 0.f, 0.f, 0.f};
    bf16x8 At[4][2], B0[2][2], B1[2][2];
    const char* cA = (const char*)Ab + (size_t)cur.pm * 2 * hsA + (size_t)cur.k0 * 2; const char* cB = (const char*)Bb + (size_t)cur.pn * 2 * hsB + (size_t)cur.k0 * 2;
    PG8_STAGE(PG8_SB(0, 0), cB, voffB); PG8_STAGE(PG8_SB(0, 1), cB + hsB, voffB); PG8_STAGE(PG8_SA(0, 0), cA, voffA); PG8_STAGE(PG8_SA(0, 1), cA + hsA, voffA);
    if (wr == 1) PG8_BAR;
    PG8_WAIT_V(2); PG8_BAR;
    PG8_STAGE(PG8_SB(1, 0), cB + kstep, voffB); PG8_STAGE(PG8_SA(1, 0), cA + kstep, voffA); PG8_STAGE(PG8_SB(1, 1), cB + hsB + kstep, voffB);
    PG8_WAIT_V(6); PG8_BAR;
    for (;;) {
        const bool has_next = S.next(ui + 1, nxt);
        const char* nA = has_next ? (const char*)Ab + (size_t)nxt.pm * 2 * hsA + (size_t)nxt.k0 * 2 : cA;
        const char* nB = has_next ? (const char*)Bb + (size_t)nxt.pn * 2 * hsB + (size_t)nxt.k0 * 2 : cB;
        const int nt = cur.nt;
        for (int t = 0; t < nt; t += 2) {
            const bool last = (t == nt - 2);
            const char* a1 = cA + (size_t)(t + 1) * kstep;
            const char* a2 = last ? nA : cA + (size_t)(t + 2) * kstep; const char* b2 = last ? nB : cB + (size_t)(t + 2) * kstep;
            const char* a3 = a2 + kstep; const char* b3 = b2 + kstep;
            PG8_LDB(B0, 0, 0); PG8_LDB(B1, 0, 1); PG8_SCHED; PG8_LDA(At, 0, 0); PG8_STAGE(PG8_SA(1, 1), a1 + hsA, voffA);
            PG8_WAIT_V(8); PG8_WAIT_L(0); PG8_BAR; PG8_MMA(0, 0, At, B0); PG8_MMA(0, 1, At, B1); PG8_BAR; PG8_SCHED;
            PG8_LDA(At, 0, 1); PG8_STAGE(PG8_SB(0, 0), b2, voffB); PG8_STAGE(PG8_SB(0, 1), b2 + hsB, voffB); PG8_STAGE(PG8_SA(0, 0), a2, voffA);
            PG8_WAIT_V(8); PG8_WAIT_L(0); PG8_BAR; PG8_MMA(1, 0, At, B0); PG8_MMA(1, 1, At, B1); PG8_BAR; PG8_SCHED;
            PG8_LDB(B0, 1, 0); PG8_LDB(B1, 1, 1); PG8_SCHED; PG8_LDA(At, 1, 0); PG8_STAGE(PG8_SA(0, 1), a2 + hsA, voffA);
            PG8_WAIT_V(8); PG8_WAIT_L(0); PG8_BAR; PG8_MMA(0, 0, At, B0); PG8_MMA(0, 1, At, B1); PG8_BAR; PG8_SCHED;
            PG8_LDA(At, 1, 1); PG8_STAGE(PG8_SB(1, 0), b3, voffB); PG8_STAGE(PG8_SB(1, 1), b3 + hsB, voffB); PG8_STAGE(PG8_SA(1, 0), a3, voffA);
            PG8_WAIT_V(8); PG8_WAIT_L(0); PG8_BAR; PG8_MMA(1, 0, At, B0); PG8_MMA(1, 1, At, B1); PG8_BAR; PG8_SCHED;
        }
        if (wr == 0) PG8_BAR;
        if (S.sk && (cur.tag & 2)) {
            for (int j = S.c + 1; j < S.G; ++j) {
                const int sj = (int)((long long)j * S.ttot / S.G); if (sj >= cur.te) break;
                const int ej = (int)((long long)(j + 1) * S.ttot / S.G); if (ej == sj) continue;
                unsigned* fl = S.flags + j * 8 + wid;
                if (lane == 0) { while (__hip_atomic_load(fl, __ATOMIC_RELAXED, __HIP_MEMORY_SCOPE_AGENT) != S.epoch) __builtin_amdgcn_s_sleep(1); }
                asm volatile("" ::: "memory");
                const unsigned long long* sp = (const unsigned long long*)(S.slots + (size_t)j * 65536 + wid * 8192) + lane; asm volatile("" : "+v"(sp));
#pragma unroll
                for (int a = 0; a < 2; ++a)
#pragma unroll
                    for (int b = 0; b < 2; ++b)
#pragma unroll
                        for (int m = 0; m < 4; ++m) {
#pragma unroll
                            for (int n = 0; n < 2; ++n) {
                                const unsigned long long v0 = __hip_atomic_load(sp, __ATOMIC_RELAXED, __HIP_MEMORY_SCOPE_AGENT), v1 = __hip_atomic_load(sp + 64, __ATOMIC_RELAXED, __HIP_MEMORY_SCOPE_AGENT);
                                acc[a][b][m][n][0] += __uint_as_float((unsigned)v0); acc[a][b][m][n][1] += __uint_as_float((unsigned)(v0 >> 32));
                                acc[a][b][m][n][2] += __uint_as_float((unsigned)v1); acc[a][b][m][n][3] += __uint_as_float((unsigned)(v1 >> 32));
                                sp += 128; }
                            if (m & 1) asm volatile("" : "+v"(sp) :: "memory");
                        }
            }
        }
        if (S.sk && (cur.tag & 1)) {
            unsigned long long* sp = (unsigned long long*)(S.slots + (size_t)S.c * 65536 + wid * 8192) + lane; asm volatile("" : "+v"(sp));
#pragma unroll
            for (int a = 0; a < 2; ++a)
#pragma unroll
                for (int b = 0; b < 2; ++b)
#pragma unroll
                    for (int m = 0; m < 4; ++m)
#pragma unroll
                        for (int n = 0; n < 2; ++n) {
                            const f32x4 v = acc[a][b][m][n];
                            __hip_atomic_store(sp, (unsigned long long)__float_as_uint(v[0]) | ((unsigned long long)__float_as_uint(v[1]) << 32), __ATOMIC_RELAXED, __HIP_MEMORY_SCOPE_AGENT);
                            __hip_atomic_store(sp + 64, (unsigned long long)__float_as_uint(v[2]) | ((unsigned long long)__float_as_uint(v[3]) << 32), __ATOMIC_RELAXED, __HIP_MEMORY_SCOPE_AGENT);
                            sp += 128; asm volatile("" : "+v"(sp)); }
            asm volatile("s_waitcnt vmcnt(0)" ::: "memory");
            if (lane == 0) __hip_atomic_store(S.flags + S.c * 8 + wid, S.epoch, __ATOMIC_RELAXED, __HIP_MEMORY_SCOPE_AGENT);
        } else E(acc, cur, wr, wc, fr, fq);
        if (!has_next) break;
        if (!(S.nb == 3 && nxt.tag != 0)) {
#pragma unroll
        for (int a = 0; a < 2; ++a)
#pragma unroll
            for (int b = 0; b < 2; ++b)
#pragma unroll
                for (int m = 0; m < 4; ++m)
#pragma unroll
                    for (int n = 0; n < 2; ++n) acc[a][b][m][n] = (f32x4){0.f, 0.f, 0.f, 0.f};
        }
        cur = nxt; cA = nA; cB = nB; ++ui;
        if (wr == 1) PG8_BAR;
    }
    PG8_WAIT_V(0);
    PG8_BAR;
#undef PG8_SA
#undef PG8_SB
#undef PG8_STAGE
#undef PG8_LDA
#undef PG8_LDB
#undef PG8_MMA
#undef PG8_WAIT_V
#undef PG8_WAIT_L
#undef PG8_BAR
#undef PG8_SCHED
}
}

struct Args {
    const float* in[26];
    float* out; unsigned char* ws;
    int ph_lo, ph_hi;
};
enum { I_X = 0, I_C, I_CTX, I_CCTX, I_WADA, I_BADA, I_NFFN1, I_F1W13, I_F1W2, I_NMIX, I_WIN, I_QN, I_KN, I_POOLW, I_POOLS, I_SGUN, I_SGUW, I_SGUB,
       I_WBRP, I_WBRA, I_WBRS, I_WOUT, I_NFFN2, I_F2W13, I_F2W2, I_FNORM };

__device__ __forceinline__ float wave_sum(float v) {
#pragma unroll
    for (int o = 1; o < 64; o <<= 1) v += __shfl_xor(v, o);
    return v;
}

__device__ __forceinline__ void tr_item(const float* W, int N, bf16_t* WT, int ldt, int coloff, int mode13, float* scr, int item, int lane) {
    const int nblk = N / 32, kb = item / nblk, nb = item - kb * nblk, k0 = 64 * kb, n0 = 32 * nb;
#pragma unroll 8
    for (int i = 0; i < 32; ++i) { const int kk = 2 * i + (lane >> 5); scr[kk * 33 + (lane & 31)] = W[(size_t)(k0 + kk) * N + n0 + (lane & 31)]; }
    LDS_WAIT();
    int r0 = n0;
    if (mode13) { const int s = n0 / DFF, rem = n0 - s * DFF, t = rem >> 7, j = rem & 127; r0 = 256 * t + 128 * s + j; }
    const int c = lane & 7;
#pragma unroll
    for (int j = 0; j < 4; ++j) { const int n = (lane >> 3) + 8 * j; const float* s = scr + (8 * c) * 33 + n;
        u32x4 o; o.x = cvtpk(s[0 * 33], s[1 * 33]); o.y = cvtpk(s[2 * 33], s[3 * 33]); o.z = cvtpk(s[4 * 33], s[5 * 33]); o.w = cvtpk(s[6 * 33], s[7 * 33]);
        *(u32x4*)(WT + (size_t)(r0 + n) * ldt + coloff + k0 + 8 * c) = o; }
    LDS_WAIT();
}

__device__ __forceinline__ void convert_weights(const int tid, const Args& a, int l, unsigned char* lds) {
    const int lane = tid & 63, wave = tid >> 6;
    float* scr = (float*)(lds + wave * 8704);
    const int gw = blockIdx.x * 8 + wave, NGW = gridDim.x * 8;
    unsigned char* ws = a.ws;
    constexpr int I13 = (DM / 64) * (2 * DFF / 32), I2 = (DFF / 64) * (DM / 32), IIN = (DM / 64) * (NIN / 32), IOUT = (DM / 64) * (DM / 32), IBA = (512 / 64) * (DM / 32), IBS = (256 / 64) * (DM / 32);
    constexpr int NITEMS = 2 * I13 + 2 * I2 + IIN + IOUT + IBA + IBS;
    for (int it = gw; it < NITEMS; it += NGW) {
        int r = it; const float* W; int N; bf16_t* WT; int ldt = DM, coloff = 0, m13 = 0;
        if (r < 2 * I13) { const bool second = r >= I13; r -= second ? I13 : 0; W = a.in[second ? I_F2W13 : I_F1W13] + (size_t)l * DM * 2 * DFF; N = 2 * DFF; WT = (bf16_t*)(ws + (second ? WS_W13B : WS_W13A)); m13 = 1; }
        else if (r < 2 * I13 + 2 * I2) { r -= 2 * I13; const bool second = r >= I2; r -= second ? I2 : 0; W = a.in[second ? I_F2W2 : I_F1W2] + (size_t)l * DFF * DM; N = DM; WT = (bf16_t*)(ws + (second ? WS_W2B : WS_W2A)); ldt = DFF; }
        else if (r < 2 * I13 + 2 * I2 + IIN) { r -= 2 * I13 + 2 * I2; W = a.in[I_WIN] + (size_t)l * DM * NIN; N = NIN; WT = (bf16_t*)(ws + WS_WIN); }
        else if (r < 2 * I13 + 2 * I2 + IIN + IOUT) { r -= 2 * I13 + 2 * I2 + IIN; W = a.in[I_WOUT] + (size_t)l * DM * DM; N = DM; WT = (bf16_t*)(ws + WS_WOUT); }
        else if (r < 2 * I13 + 2 * I2 + IIN + IOUT + IBA) { r -= 2 * I13 + 2 * I2 + IIN + IOUT; W = a.in[I_WBRA] + (size_t)l * 512 * DM; N = DM; WT = (bf16_t*)(ws + WS_WCAT); coloff = 256; }
        else { r -= 2 * I13 + 2 * I2 + IIN + IOUT + IBA; W = a.in[I_WBRS] + (size_t)l * 256 * DM; N = DM; WT = (bf16_t*)(ws + WS_WCAT); coloff = 768; }
        tr_item(W, N, WT, ldt, coloff, m13, scr, r, lane);
    }
    {
        const float* pw = a.in[I_POOLW] + (size_t)l * 4 * 64 * 64; const float* ps = a.in[I_POOLS] + (size_t)l * 256; const float* wb = a.in[I_WBRP] + (size_t)l * 256 * DM;
        bf16_t* wcat = (bf16_t*)(ws + WS_WCAT);
        for (int it = blockIdx.x * 512 + tid; it < 1024 * 32; it += gridDim.x * 512) {
            const int n = it & 1023, kg = it >> 10, g = kg >> 3, c0 = (kg & 7) * 8;
            float s[8];
#pragma unroll
            for (int i = 0; i < 8; ++i) s[i] = 0.f;
            for (int d = 0; d < 64; ++d) {
                const float wv = wb[(size_t)(g * 64 + d) * DM + n] * ps[g * 64 + d];
#pragma unroll
                for (int i = 0; i < 8; ++i) s[i] += pw[(g * 64 + c0 + i) * 64 + d] * wv;
            }
            u32x4 o; o.x = cvtpk(s[0], s[1]); o.y = cvtpk(s[2], s[3]); o.z = cvtpk(s[4], s[5]); o.w = cvtpk(s[6], s[7]);
            *(u32x4*)(wcat + (size_t)n * DM + kg * 8) = o;
        }
    }
    {
        const float* sw = a.in[I_SGUW] + (size_t)l * 4 * 128 * 128; unsigned* dst = (unsigned*)(ws + WS_SGUW);
        for (int it = blockIdx.x * 512 + tid; it < 4 * 128 * 64; it += gridDim.x * 512) dst[it] = cvtpk(sw[2 * it], sw[2 * it + 1]);
    }
}

__device__ __forceinline__ void compute_biases(const int tid, const Args& a, int l, unsigned char* lds) {
    const int lane = tid & 63, wave = tid >> 6;
    float* sh = (float*)lds;
    const float* modl = (const float*)(a.ws + WS_MOD) + (size_t)l * 17 * NMOD;
    const int gw = blockIdx.x * 8 + wave, NGW = gridDim.x * 8;
    for (int j = 0; j < 3; ++j) {
        __syncthreads();
        for (int i = tid; i < 17 * DM; i += 512) sh[i] = modl[(size_t)(i >> 10) * NMOD + (3 * j) * DM + (i & 1023)];
        __syncthreads();
        const bf16_t* Wt = (const bf16_t*)(a.ws + (j == 0 ? WS_W13A : (j == 1 ? WS_WIN : WS_W13B)));
        float* bo = (float*)(a.ws + (j == 0 ? WS_B13A : (j == 1 ? WS_BIN : WS_B13B)));
        const int N = (j == 1) ? NIN : 2 * DFF;
        for (int n = gw; n < N; n += NGW) {
            float w[16];
#pragma unroll
            for (int c = 0; c < 4; ++c) { const u32x2 v = *(const u32x2*)(Wt + (size_t)n * DM + c * 256 + lane * 4); w[4 * c] = bflo(v.x); w[4 * c + 1] = bfhi(v.x); w[4 * c + 2] = bflo(v.y); w[4 * c + 3] = bfhi(v.y); }
            float mine = 0.f;
#pragma unroll 1
            for (int mb = 0; mb < 17; ++mb) {
                float p = 0.f;
#pragma unroll
                for (int c = 0; c < 4; ++c) { const f32x4 s = *(const f32x4*)(sh + mb * DM + c * 256 + lane * 4); p += w[4 * c] * s[0] + w[4 * c + 1] * s[1] + w[4 * c + 2] * s[2] + w[4 * c + 3] * s[3]; }
                p = wave_sum(p);
                if (lane == mb) mine = p;
            }
            if (lane < 17) bo[(size_t)lane * N + n] = mine;
        }
    }
}

__device__ __forceinline__ void post_phase(const int tid, const Args& a, int l, unsigned char* lds) {
    const int lane = tid & 63, wave = tid >> 6;
    unsigned char* ws = a.ws;
    const bf16_t* P = (const bf16_t*)(ws + WS_P);
    bf16_t* Bcat = (bf16_t*)(ws + WS_AP); bf16_t* kbuf = (bf16_t*)(ws + WS_KB); bf16_t* Vt = (bf16_t*)(ws + WS_VT);
    const float* rope = (const float*)(ws + WS_ROPE);
    const float* qn = a.in[I_QN] + l * 64; const float* kn = a.in[I_KN] + l * 64;
    const int nchf = (l == 0) ? 288 : 256;
    const int nSGU = nchf * 2, nPOOL = nchf, nV = 288, nQK = TT / 64, total = nSGU + nPOOL + nV + nQK;
    for (int it = blockIdx.x; it < total; it += gridDim.x) {
        if (it < nSGU + nPOOL + nV) {
            const int ch = it < nSGU ? (it >> 1) : (it < nSGU + nPOOL ? it - nSGU : it - nSGU - nPOOL);
            const bool lat = ch < 256;
            const int b = lat ? (ch >> 4) : ((ch - 256) >> 1), t0 = lat ? (ch & 15) * 128 : ((ch - 256) & 1) * 128, L = lat ? SEQ : CTXL;
            const int Rb = lat ? b * SEQ : TL + b * CTXL, R0 = Rb + t0;
            if (it < nSGU) {
                const int gp = it & 1;
                bf16_t* vT = (bf16_t*)lds;
                bf16_t* Ws = (bf16_t*)(lds + 34816);
                const float* sn = a.in[I_SGUN] + l * 256;
                {
                    const bf16_t* wsrc = (const bf16_t*)(ws + WS_SGUW) + gp * 2 * 128 * 128;
#pragma unroll 4
                    for (int i2 = tid; i2 < 2 * 128 * 16; i2 += 512) { const int r = i2 >> 4, c = i2 & 15; *(u32x4*)(Ws + r * 136 + c * 8) = *(const u32x4*)(wsrc + r * 128 + c * 8); }
                }
#pragma unroll 2
                for (int i2 = tid; i2 < 128 * 32; i2 += 512) { const int l32 = i2 & 31, tok = i2 >> 5;
                    const u32x4 raw = *(const u32x4*)(P + (size_t)(R0 + tok) * NPC + 1280 + l32 * 8);
                    float x[8] = {bflo(raw.x), bfhi(raw.x), bflo(raw.y), bfhi(raw.y), bflo(raw.z), bfhi(raw.z), bflo(raw.w), bfhi(raw.w)};
                    float ss = 0.f;
#pragma unroll
                    for (int i = 0; i < 8; ++i) { x[i] = gelu_t(x[i]); ss += x[i] * x[i]; }
                    ss += __shfl_xor(ss, 1); ss += __shfl_xor(ss, 2); ss += __shfl_xor(ss, 4); ss += __shfl_xor(ss, 8); ss += __shfl_xor(ss, 16);
                    const float rinv = __builtin_amdgcn_rsqf(ss * (1.f / 256.f) + EPS);
                    if ((l32 >> 4) == gp) { const int cl = (l32 & 15) * 8;
#pragma unroll
                        for (int i = 0; i < 8; i += 2) { const unsigned pk = cvtpk(x[i] * rinv * sn[l32 * 8 + i], x[i + 1] * rinv * sn[l32 * 8 + i + 1]);
                            vT[(cl + i) * 136 + tok] = (bf16_t)(pk & 0xffffu); vT[(cl + i + 1) * 136 + tok] = (bf16_t)(pk >> 16); } }
                }
                __syncthreads();
                const int q32 = lane & 31, hi = lane >> 5, cblk = wave & 1, tblk = wave >> 1;
                const float* sb = a.in[I_SGUB] + (size_t)l * 4 * 128;
                const int tok = tblk * 32 + q32, R = R0 + tok;
#pragma unroll
                for (int g2 = 0; g2 < 2; ++g2) {
                    const int g = gp * 2 + g2;
                    u32x2 ur[4];
#pragma unroll
                    for (int rg = 0; rg < 4; ++rg) ur[rg] = *(const u32x2*)(P + (size_t)R * NPC + 1024 + g * 64 + cblk * 32 + 8 * rg + 4 * hi);
                    const float bias = sb[g * 128 + tok];
                    f32x16 acc;
#pragma unroll
                    for (int r = 0; r < 16; ++r) acc[r] = 0.f;
#pragma unroll
                    for (int ks = 0; ks < 8; ++ks) {
                        const bf16x8 af = *(const bf16x8*)(vT + (g2 * 64 + cblk * 32 + q32) * 136 + ks * 16 + hi * 8);
                        const bf16x8 bf = *(const bf16x8*)(Ws + (g2 * 128 + tblk * 32 + q32) * 136 + ks * 16 + hi * 8);
                        acc = __builtin_amdgcn_mfma_f32_32x32x16_bf16(af, bf, acc, 0, 0, 0);
                    }
#pragma unroll
                    for (int rg = 0; rg < 4; ++rg) {
                        const int c4 = g * 64 + cblk * 32 + 8 * rg + 4 * hi;
                        const float u0 = gelu_t(bflo(ur[rg].x)), u1 = gelu_t(bfhi(ur[rg].x)), u2 = gelu_t(bflo(ur[rg].y)), u3 = gelu_t(bfhi(ur[rg].y));
                        u32x2 w; w.x = cvtpk(u0 * (acc[4 * rg] + bias), u1 * (acc[4 * rg + 1] + bias)); w.y = cvtpk(u2 * (acc[4 * rg + 2] + bias), u3 * (acc[4 * rg + 3] + bias));
                        *(u32x2*)(Bcat + (size_t)R * DM + 768 + c4) = w;
                    }
                }
            } else if (it < nSGU + nPOOL) {
                unsigned* xs = (unsigned*)lds;
#pragma unroll 3
                for (int i2 = tid; i2 < 144 * 32; i2 += 512) { const int rr = i2 >> 5, c = i2 & 31; const int s = t0 - 8 + rr;
                    u32x4 v = (u32x4){0u, 0u, 0u, 0u};
                    if (s >= 0 && s < L) v = *(const u32x4*)(P + (size_t)(Rb + s) * NPC + 768 + c * 8);
                    *(u32x4*)(xs + rr * 128 + c * 4) = v; }
                __syncthreads();
                const int cp = tid & 127, tg = tid >> 7, hw = 1 << (cp >> 5);
                for (int tt = tg * 32; tt < tg * 32 + 32; ++tt) {
                    const int t = t0 + tt; const int lo = (t - hw) < 0 ? 0 : (t - hw), hi = (t + hw) > L ? L : (t + hw);
                    float s0 = 0.f, s1 = 0.f;
                    for (int s = lo; s < hi; ++s) { const unsigned v = xs[(s - t0 + 8) * 128 + cp]; s0 += bflo(v); s1 += bfhi(v); }
                    const float ic = 1.f / (float)(hi - lo); const unsigned xv = xs[(tt + 8) * 128 + cp];
                    *(unsigned*)(Bcat + (size_t)(R0 + tt) * DM + 2 * cp) = cvtpk(s0 * ic - bflo(xv), s1 * ic - bfhi(xv));
                }
            } else {
                bf16_t* vs = (bf16_t*)lds;
#pragma unroll 4
                for (int i2 = tid; i2 < 128 * 16; i2 += 512) { const int tok = i2 >> 4, c = i2 & 15;
                    *(u32x4*)(vs + tok * 136 + c * 8) = *(const u32x4*)(P + (size_t)(R0 + tok) * NPC + 640 + c * 8); }
                __syncthreads();
                const int posbase = lat ? t0 : SEQ + t0;
                for (int i2 = tid; i2 < 128 * 16; i2 += 512) { const int vr = i2 & 127, pg = i2 >> 7;
                    unsigned short e[8];
#pragma unroll
                    for (int i = 0; i < 8; ++i) { const int p = pg * 8 + i; const int kap = (p & ~12) | ((p & 4) << 1) | ((p & 8) >> 1); e[i] = vs[kap * 136 + vr]; }
                    u32x4 w; w.x = e[0] | ((unsigned)e[1] << 16); w.y = e[2] | ((unsigned)e[3] << 16); w.z = e[4] | ((unsigned)e[5] << 16); w.w = e[6] | ((unsigned)e[7] << 16);
                    *(u32x4*)(Vt + ((size_t)(b * 2 + (vr >> 6)) * 64 + (vr & 63)) * KVPOS + posbase + pg * 8) = w; }
            }
            __syncthreads();
        } else {
            const int R0 = (it - (nSGU + nPOOL + nV)) * 64; const bool lat = R0 < TL;
            const bool full = lat || (l == 0);
            const int nh = full ? 10 : 2, hbase = full ? 0 : 8;
#pragma unroll 2
            for (int i2 = tid; i2 < 64 * nh * 8; i2 += 512) {
                const int l8 = i2 & 7, hr = i2 >> 3, tok = hr / nh, hh = hbase + (hr - tok * nh);
                const int R = R0 + tok; const bool isq = hh < 8;
                const bf16_t* src = P + (size_t)R * NPC + (isq ? hh * 64 : 512 + (hh - 8) * 64) + l8 * 8;
                const u32x4 raw = *(const u32x4*)src;
                float x[8] = {bflo(raw.x), bfhi(raw.x), bflo(raw.y), bfhi(raw.y), bflo(raw.z), bfhi(raw.z), bflo(raw.w), bfhi(raw.w)};
                float ss = 0.f;
#pragma unroll
                for (int i = 0; i < 8; ++i) ss += x[i] * x[i];
                ss += __shfl_xor(ss, 1); ss += __shfl_xor(ss, 2); ss += __shfl_xor(ss, 4);
                const float rinv = __builtin_amdgcn_rsqf(ss * (1.f / 64.f) + EPS);
                const float* gn = (isq ? qn : kn) + l8 * 8;
                const f32x4 g0 = *(const f32x4*)gn, g1 = *(const f32x4*)(gn + 4);
                float y[8], o[8];
#pragma unroll
                for (int i = 0; i < 4; ++i) { y[i] = x[i] * rinv * g0[i]; y[4 + i] = x[4 + i] * rinv * g1[i]; }
                const int t = R & (SEQ - 1);
                const int half = l8 >> 2, second = (l8 >> 1) & 1, fi0 = (l8 & 1) * 8;
                const f32x4* rp = (const f32x4*)(rope + ((size_t)t * 32 + half * 16 + fi0) * 2);
                f32x4 cs[4];
                if (lat) {
#pragma unroll
                    for (int i = 0; i < 4; ++i) cs[i] = rp[i];
                }
#pragma unroll
                for (int i = 0; i < 8; ++i) {
                    const float partner = __shfl_xor(y[i], 2);
                    if (lat) { const float cv = cs[i >> 1][(i & 1) * 2], sv = cs[i >> 1][(i & 1) * 2 + 1];
                        o[i] = second ? (y[i] * cv + partner * sv) : (y[i] * cv - partner * sv); }
                    else o[i] = y[i];
                }
                const float sc = isq ? QSCALE : 1.f;
                u32x4 w; w.x = cvtpk(o[0] * sc, o[1] * sc); w.y = cvtpk(o[2] * sc, o[3] * sc); w.z = cvtpk(o[4] * sc, o[5] * sc); w.w = cvtpk(o[6] * sc, o[7] * sc);
                bf16_t* dst = isq ? Bcat + (size_t)R * DM + 256 + hh * 64 + l8 * 8 : kbuf + (size_t)R * 128 + (hh - 8) * 64 + l8 * 8;
                *(u32x4*)dst = w;
            }
        }
    }
}

__device__ __forceinline__ void attn_phase(const int tid, const Args& a, int l, unsigned char* lds, int dry) {
    const int lane = tid & 63, w = tid >> 6, q32 = lane & 31, hi = lane >> 5;
    bf16_t* Bcat = (bf16_t*)(a.ws + WS_AP); const bf16_t* kbuf = (const bf16_t*)(a.ws + WS_KB); const bf16_t* Vt = (const bf16_t*)(a.ws + WS_VT);
    const int G = gridDim.x, c = blockIdx.x;
    const int per = (512 + G - 1) / G;
    const int nlat = (c * per >= 512) ? 0 : ((c + 1) * per > 512 ? 512 - c * per : per);
    const int nctx = (l == 0 && c < 64) ? (64 - c + G - 1) / G : 0;
    const int kr = tid >> 3, kc = tid & 7;
    float sshift;
    { float gq = 0.f, gk = 0.f; const float* qn = a.in[I_QN] + l * 64; const float* kn = a.in[I_KN] + l * 64;
      for (int i = 0; i < 64; ++i) { gq = fmaxf(gq, fabsf(qn[i])); gk = fmaxf(gk, fabsf(kn[i])); }
      const float sbound = QSCALE * 64.f * 1.02f * gq * gk; sshift = sbound > 64.f ? sbound - 64.f : 0.f; }
    const bool use_shift = __builtin_amdgcn_readfirstlane(__float_as_uint(sshift)) != 0u;
    for (int ui = 0; ui < nlat + nctx; ++ui) {
        int b, kvh, qrow0, jt0, NT;
        if (ui < nlat) { const int u = c * per + ui; const int bk = u >> 4, qb = u & 15; b = bk >> 1; kvh = bk & 1; qrow0 = b * SEQ + qb * 128; jt0 = 0; NT = 36; }
        else { const int u = c + (ui - nlat) * G; const int bk = u >> 1, qb = u & 1; b = bk >> 1; kvh = bk & 1; qrow0 = TL + b * CTXL + qb * 128; jt0 = 32; NT = 4; }
        const int head = kvh * 4 + (w >> 1); const int myrow = qrow0 + 64 * (w & 1) + q32;
        bf16_t* qp = Bcat + (size_t)myrow * DM + 256 + head * 64;
        bf16x8 qf[2][4];
#pragma unroll
        for (int sb = 0; sb < 2; ++sb)
#pragma unroll
            for (int ds = 0; ds < 4; ++ds) qf[sb][ds] = *(const bf16x8*)(qp + (size_t)sb * 32 * DM + 16 * ds + hi * 8);
        const bf16_t* vsrc = Vt + ((size_t)(b * 2 + kvh) * 64 + kr) * KVPOS + kc * 8;
#define KSRC(jt) (kbuf + (size_t)(((jt) < 32 ? b * SEQ + 64 * (jt) : TL + b * CTXL + 64 * ((jt) - 32)) + kr) * 128 + kvh * 64 + kc * 8)
        u32x4 kreg = *(const u32x4*)KSRC(jt0), vreg = *(const u32x4*)(vsrc + 64 * jt0);
        *(u32x4*)(lds + kr * 144 + kc * 16) = kreg; *(u32x4*)(lds + 18432 + kr * 144 + kc * 16) = vreg;
        __syncthreads();
        f32x16 o0[2], o1[2];
        float lrun[2];
#pragma unroll
        for (int sb = 0; sb < 2; ++sb) { lrun[sb] = 0.f;
#pragma unroll
            for (int r = 0; r < 16; ++r) { o0[sb][r] = 0.f; o1[sb][r] = 0.f; } }
        for (int j = 0; j < NT; ++j) {
            if (j + 1 < NT) { kreg = *(const u32x4*)KSRC(jt0 + j + 1); vreg = *(const u32x4*)(vsrc + 64 * (jt0 + j + 1)); }
            const unsigned char* Kb = lds + (j & 1) * 9216; const unsigned char* Vb = lds + 18432 + (j & 1) * 9216;
            f32x16 p0[2], p1[2];
#pragma unroll
            for (int sb = 0; sb < 2; ++sb)
#pragma unroll
                for (int r = 0; r < 16; ++r) { p0[sb][r] = 0.f; p1[sb][r] = 0.f; }
#pragma unroll
            for (int ds = 0; ds < 4; ++ds) {
                const bf16x8 k0 = *(const bf16x8*)(Kb + q32 * 144 + ds * 32 + hi * 16);
                const bf16x8 k1 = *(const bf16x8*)(Kb + (32 + q32) * 144 + ds * 32 + hi * 16);
#pragma unroll
                for (int sb = 0; sb < 2; ++sb) {
                    p0[sb] = __builtin_amdgcn_mfma_f32_32x32x16_bf16(k0, qf[sb][ds], p0[sb], 0, 0, 0);
                    p1[sb] = __builtin_amdgcn_mfma_f32_32x32x16_bf16(k1, qf[sb][ds], p1[sb], 0, 0, 0);
                }
            }
            if (use_shift) {
#pragma unroll
                for (int sb = 0; sb < 2; ++sb)
#pragma unroll
                    for (int r = 0; r < 16; ++r) { p0[sb][r] -= sshift; p1[sb][r] -= sshift; }
            }
            u32x4 pw[2][4];
#pragma unroll
            for (int sb = 0; sb < 2; ++sb) {
                float ls = 0.f;
#pragma unroll
                for (int r = 0; r < 16; ++r) { p0[sb][r] = __builtin_amdgcn_exp2f(p0[sb][r]); p1[sb][r] = __builtin_amdgcn_exp2f(p1[sb][r]); ls += p0[sb][r] + p1[sb][r]; }
                lrun[sb] += ls;
                pw[sb][0] = (u32x4){cvtpk(p0[sb][0], p0[sb][1]), cvtpk(p0[sb][2], p0[sb][3]), cvtpk(p0[sb][4], p0[sb][5]), cvtpk(p0[sb][6], p0[sb][7])};
                pw[sb][1] = (u32x4){cvtpk(p0[sb][8], p0[sb][9]), cvtpk(p0[sb][10], p0[sb][11]), cvtpk(p0[sb][12], p0[sb][13]), cvtpk(p0[sb][14], p0[sb][15])};
                pw[sb][2] = (u32x4){cvtpk(p1[sb][0], p1[sb][1]), cvtpk(p1[sb][2], p1[sb][3]), cvtpk(p1[sb][4], p1[sb][5]), cvtpk(p1[sb][6], p1[sb][7])};
                pw[sb][3] = (u32x4){cvtpk(p1[sb][8], p1[sb][9]), cvtpk(p1[sb][10], p1[sb][11]), cvtpk(p1[sb][12], p1[sb][13]), cvtpk(p1[sb][14], p1[sb][15])};
            }
#pragma unroll
            for (int s = 0; s < 4; ++s) {
                const bf16x8 v0 = *(const bf16x8*)(Vb + q32 * 144 + s * 32 + hi * 16);
                const bf16x8 v1 = *(const bf16x8*)(Vb + (32 + q32) * 144 + s * 32 + hi * 16);
#pragma unroll
                for (int sb = 0; sb < 2; ++sb) {
                    const bf16x8 pa = __builtin_bit_cast(bf16x8, pw[sb][s]);
                    o0[sb] = __builtin_amdgcn_mfma_f32_32x32x16_bf16(v0, pa, o0[sb], 0, 0, 0);
                    o1[sb] = __builtin_amdgcn_mfma_f32_32x32x16_bf16(v1, pa, o1[sb], 0, 0, 0);
                }
            }
            if (j + 1 < NT) { unsigned char* Kn = lds + ((j + 1) & 1) * 9216; *(u32x4*)(Kn + kr * 144 + kc * 16) = kreg; *(u32x4*)(Kn + 18432 + kr * 144 + kc * 16) = vreg; }
            __syncthreads();
        }
#undef KSRC
#pragma unroll
        for (int sb = 0; sb < 2; ++sb) {
            float lt = lrun[sb]; lt += __shfl_xor(lt, 32);
            const float inv = 1.f / lt;
            bf16_t* op = qp + (size_t)sb * 32 * DM;
#pragma unroll
            for (int rg = 0; rg < 4; ++rg) {
                u32x2 w0; w0.x = cvtpk(o0[sb][4 * rg] * inv, o0[sb][4 * rg + 1] * inv); w0.y = cvtpk(o0[sb][4 * rg + 2] * inv, o0[sb][4 * rg + 3] * inv);
                u32x2 w1; w1.x = cvtpk(o1[sb][4 * rg] * inv, o1[sb][4 * rg + 1] * inv); w1.y = cvtpk(o1[sb][4 * rg + 2] * inv, o1[sb][4 * rg + 3] * inv);
                if (!dry) { *(u32x2*)(op + 8 * rg + 4 * hi) = w0; *(u32x2*)(op + 32 + 8 * rg + 4 * hi) = w1; }
            }
        }
    }
}

__global__ void __launch_bounds__(512, 2) fwd_megakernel(Args a) {
    extern __shared__ __attribute__((aligned(16))) unsigned char lds[];
    cg::grid_group grid = cg::this_grid();
    unsigned char* ws = a.ws;
    float* modraw = (float*)(ws + WS_MOD);
    float* ssq = (float*)(ws + WS_SSQ);
    bf16_t* Ap = (bf16_t*)(ws + WS_AP);
    float* hctx = (float*)(ws + WS_HCTX);
    LAS unsigned char* ldsl = (LAS unsigned char*)lds;

    int second = 0; unsigned nbar = 0;
    const int wave_s = __builtin_amdgcn_readfirstlane((int)threadIdx.x >> 6);
    for (int ph = a.ph_lo; ph < a.ph_hi; ++ph) {
        int tid = wave_s * 64 + (int)__builtin_amdgcn_mbcnt_hi(~0u, __builtin_amdgcn_mbcnt_lo(~0u, 0u)); asm volatile("" : "+v"(tid));
        const int lane = tid & 63, wave = tid >> 6;
        int kind;
        { const int sp_ = ph < 11 ? ph - 2 : ph - 13;
          kind = (ph == 0 || ph == 1 || ph == 11 || ph == 12) ? 0 : (ph == 22 ? 7 : ((sp_ == 0 || sp_ == 7) ? 1 : ((sp_ == 1 || sp_ == 6 || sp_ == 8) ? 2 : (sp_ == 2 ? 3 : (sp_ == 3 ? 4 : (sp_ == 4 ? 5 : 6)))))); }
        const int dry = (REPEAT_MASK != 0) && ((REPEAT_MASK >> kind) & 1) && !second;
        if (ph == 0 || ph == 11) {
          if (ph == 0) {
            for (int i = blockIdx.x * 512 + tid; i < 6 * TT; i += gridDim.x * 512) ssq[TT + i] = 0.f;
            {
                float* rope = (float*)(ws + WS_ROPE);
                for (int i = blockIdx.x * 512 + tid; i < SEQ * 32; i += gridDim.x * 512) {
                    const int t = i >> 5, j = i & 31, fi = j & 15; const float pos = (float)((j < 16) ? (t >> 6) : (t & 63));
                    const float invf = __builtin_amdgcn_exp2f(-(float)fi * (13.287712379549449f / 16.f));
                    const float ang = pos * invf;
                    rope[2 * i] = __cosf(ang); rope[2 * i + 1] = __sinf(ang);
                }
            }
            {
                float* sc = (float*)lds;
                float* red = (float*)(lds + 69632);
                for (int i = tid; i < 17 * DM; i += 512) { const int mb = i >> 10, k = i & 1023; const float cv = mb < 16 ? a.in[I_C][mb * DM + k] : a.in[I_CCTX][k]; sc[i] = cv * sigm(cv); }
                __syncthreads();
                for (int item = blockIdx.x; item < 288; item += gridDim.x) {
                    const int l = item / 144, n0 = (item - l * 144) * 64;
                    const float* wp = a.in[I_WADA] + ((size_t)l * DM + wave * 128) * NMOD + n0 + lane;
                    float acc[17];
#pragma unroll
                    for (int mb = 0; mb < 17; ++mb) acc[mb] = 0.f;
#pragma unroll 16
                    for (int k = 0; k < 128; ++k) { const float wv = wp[(size_t)k * NMOD];
#pragma unroll
                        for (int mb = 0; mb < 17; ++mb) acc[mb] += sc[mb * DM + wave * 128 + k] * wv; }
#pragma unroll
                    for (int mb = 0; mb < 17; ++mb) red[(wave * 17 + mb) * 64 + lane] = acc[mb];
                    __syncthreads();
                    for (int i = tid; i < 17 * 64; i += 512) { const int mb = i >> 6, col = i & 63; float s = a.in[I_BADA][l * NMOD + n0 + col];
#pragma unroll
                        for (int w8 = 0; w8 < 8; ++w8) s += red[(w8 * 17 + mb) * 64 + col];
                        modraw[((size_t)l * 17 + mb) * NMOD + n0 + col] = s; }
                    __syncthreads();
                }
            }
            __syncthreads();
          }
            convert_weights(tid, a, ph == 0 ? 0 : 1, lds);
        } else if (ph == 1 || ph == 12) {
            const int l = ph == 1 ? 0 : 1;
            compute_biases(tid, a, l, lds);
            if (l == 0) {
                const float* nrm = a.in[I_NFFN1]; const int gw = blockIdx.x * 8 + wave, NGW = gridDim.x * 8;
                for (int R = gw; R < TT; R += NGW) {
                    const float* xr = R < TL ? a.in[I_X] + (size_t)R * DM : a.in[I_CTX] + (size_t)(R - TL) * DM;
                    const int mb = R < TL ? (R >> 11) : 16; const float* scl = modraw + (size_t)mb * NMOD + DM;
                    float ss = 0.f;
#pragma unroll
                    for (int c4 = 0; c4 < 4; ++c4) { const int col = c4 * 256 + lane * 4; const f32x4 v = *(const f32x4*)(xr + col);
                        ss += (v[0] * v[0] + v[1] * v[1]) + (v[2] * v[2] + v[3] * v[3]);
                        const f32x4 g = *(const f32x4*)(nrm + col) * (*(const f32x4*)(scl + col) + 1.f), y = v * g;
                        u32x2 w; w.x = cvtpk(y[0], y[1]); w.y = cvtpk(y[2], y[3]); *(u32x2*)(Ap + (size_t)R * DM + col) = w; }
                    ss = wave_sum(ss);
                    if (lane == 0) ssq[R] = ss;
                }
            }
        } else if (ph == 22) {
            const float* fn = a.in[I_FNORM]; const int gw = blockIdx.x * 8 + wave, NGW = gridDim.x * 8;
            for (int R = gw; R < TL; R += NGW) {
                const float r = __builtin_amdgcn_rsqf(ssq[(size_t)6 * TT + R] * (1.f / DM) + EPS);
                float* orow = a.out + (size_t)R * DM;
#pragma unroll
                for (int c4 = 0; c4 < 4; ++c4) { const int col = c4 * 256 + lane * 4; const f32x4 v = *(const f32x4*)(orow + col) * r * *(const f32x4*)(fn + col); *(f32x4*)(orow + col) = v; }
            }
        } else {
            const int l = ph < 11 ? 0 : 1, sp = ph < 11 ? ph - 2 : ph - 13;
            const float* modl = modraw + (size_t)l * 17 * NMOD;
            const int nMall = TT / 256, nMlat = TL / 256;
            const float* hin_l = (l == 0 && sp <= 1) ? a.in[I_X] : a.out; const float* hin_c = (l == 0 && sp <= 1) ? a.in[I_CTX] : hctx;
            if (sp == 0 || sp == 7) {
                const bool f1 = sp == 0; const int nM = (f1 || l == 0) ? nMall : nMlat;
                pg8::TileSched S = pg8::make_sched(nM, 2 * DFF / 256, DM);
                pg8::EpiSwiGLU E{(bf16_t*)(ws + WS_G), (const float*)(ws + (f1 ? WS_B13A : WS_B13B)), ssq + (size_t)(3 * l + (f1 ? 0 : 2)) * TT};
                pg8::gemm_phase(tid, ldsl, Ap, DM, (const bf16_t*)(ws + (f1 ? WS_W13A : WS_W13B)), DM, S, E);
            } else if (sp == 1 || sp == 8 || sp == 6) {
                const int nM = (sp == 1 || l == 0) ? nMall : nMlat;
                const int j = sp == 1 ? 0 : (sp == 6 ? 1 : 2);
                const bool lastg = (l == 1 && sp == 8);
                const int ln = (sp == 8) ? l + 1 : l, jn = (sp == 8) ? 0 : j + 1;
                const float* nrm = lastg ? nullptr : (jn == 0 ? a.in[I_NFFN1] : (jn == 1 ? a.in[I_NMIX] : a.in[I_NFFN2])) + (size_t)ln * DM;
                const float* scl = lastg ? nullptr : modraw + (size_t)ln * 17 * NMOD + (3 * jn + 1) * DM;
                float* ssqn = ssq + (size_t)(3 * l + j + 1) * TT;
                pg8::EpiRes E{(uintptr_t)hin_l, (uintptr_t)hin_c - (uintptr_t)hin_l, (uintptr_t)a.out, (uintptr_t)hctx - (uintptr_t)a.out, modl + (3 * j + 2) * DM, sp == 6 ? 1.0f : 0.5f, nrm, scl, ssqn, lastg ? nullptr : Ap, dry};
                const bool wo = sp == 6; const int Kd = wo ? DM : DFF;
                pg8::TileSched S = wo ? pg8::make_sched(nM, DM / 256, Kd) : pg8::make_streamk(nM, DM / 256, Kd, (float*)(ws + WS_P), (unsigned*)(ws + WS_CTL) + 64, (unsigned)(ph + 1));
                pg8::gemm_phase(tid, ldsl, (const bf16_t*)(ws + (wo ? WS_P : WS_G)), Kd, (const bf16_t*)(ws + (wo ? WS_WOUT : (sp == 1 ? WS_W2A : WS_W2B))), Kd, S, E);
            } else if (sp == 2) {
                pg8::TileSched S = pg8::make_sched(l == 0 ? nMall : nMlat, NIN / 256, DM);
                if (l == 1) { S.n2 = TC / 256; S.pm0_2 = nMlat; S.pn0_2 = 2; }
                pg8::EpiIn E{(bf16_t*)(ws + WS_P), (bf16_t*)(ws + WS_G), (const float*)(ws + WS_BIN), ssq + (size_t)(3 * l + 1) * TT};
                pg8::gemm_phase(tid, ldsl, Ap, DM, (const bf16_t*)(ws + WS_WIN), DM, S, E);
            } else if (sp == 3) {
                post_phase(tid, a, l, lds);
            } else if (sp == 4) {
                attn_phase(tid, a, l, lds, dry);
            } else if (sp == 5) {
                pg8::TileSched S = pg8::make_sched(l == 0 ? nMall : nMlat, DM / 256, DM);
                S.nb = 3;
                pg8::EpiMerge E{(const bf16_t*)(ws + WS_G), (bf16_t*)(ws + WS_P)};
                pg8::gemm_phase(tid, ldsl, Ap, DM, (const bf16_t*)(ws + WS_WCAT), DM, S, E);
            }
        }
        if (REPEAT_MASK != 0) { if (dry) { second = 1; --ph; __syncthreads(); continue; } second = 0; }
        if (ph + 1 < a.ph_hi) {
            asm volatile("s_waitcnt vmcnt(0) lgkmcnt(0)" ::: "memory");
            __syncthreads();
            if (ph == a.ph_lo) { if (tid == 0) __builtin_amdgcn_fence(__ATOMIC_RELEASE, "agent"); grid.sync(); if (tid == 0) __builtin_amdgcn_fence(__ATOMIC_ACQUIRE, "agent"); }
            else {
              for (int bb = 0; bb <= EXTRA_BAR; ++bb) {
                if (tid == 0) {
                    unsigned* ctr = (unsigned*)(ws + WS_CTL);
                    __builtin_amdgcn_fence(__ATOMIC_RELEASE, "agent");
                    __hip_atomic_fetch_add(ctr, 1u, __ATOMIC_RELAXED, __HIP_MEMORY_SCOPE_AGENT);
                    ++nbar;
                    const unsigned target = nbar * gridDim.x;
                    while (__hip_atomic_load(ctr, __ATOMIC_RELAXED, __HIP_MEMORY_SCOPE_AGENT) < target) __builtin_amdgcn_s_sleep(2);
                    __builtin_amdgcn_fence(__ATOMIC_ACQUIRE, "agent");
                }
                if (EXTRA_BAR) { asm volatile("s_waitcnt vmcnt(0)" ::: "memory"); __syncthreads(); }
              }
            }
            asm volatile("s_waitcnt vmcnt(0)" ::: "memory");
            __syncthreads();
        }
    }
}

extern "C" void kernel_launch(void* const* d_in, const int* in_sizes, int n_in, void* d_out, int out_size, void* d_ws, size_t ws_size, hipStream_t stream) {
    static int grid = 0;
    if (grid == 0) {
        if (n_in != 26 || out_size != TL * DM || ws_size < WS_END) { fprintf(stderr, "kernel_launch: unexpected shapes (n_in %d out %d ws %zu need %zu)\n", n_in, out_size, ws_size, (size_t)WS_END); grid = -1; return; }
        int dev = 0, cus = 0, per_cu = 0;
        if (hipGetDevice(&dev) != hipSuccess || hipDeviceGetAttribute(&cus, hipDeviceAttributeMultiprocessorCount, dev) != hipSuccess) { grid = -1; return; }
        if (hipFuncSetAttribute((const void*)fwd_megakernel, hipFuncAttributeMaxDynamicSharedMemorySize, LDS_BYTES) != hipSuccess) { fprintf(stderr, "kernel_launch: hipFuncSetAttribute failed\n"); grid = -1; return; }
        if (hipOccupancyMaxActiveBlocksPerMultiprocessor(&per_cu, (const void*)fwd_megakernel, 512, LDS_BYTES) != hipSuccess || per_cu < 1) per_cu = 1;
        (void)hipGetLastError();
        grid = cus * per_cu;
    }
    if (grid < 0) return;
    Args a{};
    for (int i = 0; i < 26; ++i) a.in[i] = (const float*)d_in[i];
    a.out = (float*)d_out; a.ws = (unsigned char*)d_ws;
#if MK_ONE_LAUNCH
    a.ph_lo = 0; a.ph_hi = NPHASES;
    if (hipMemsetAsync((char*)d_ws + WS_CTL, 0, 16384, stream) != hipSuccess) { fprintf(stderr, "memset failed\n"); return; }
    void* args[] = {&a};
    hipError_t e = hipLaunchCooperativeKernel((const void*)fwd_megakernel, dim3(grid), dim3(512), args, LDS_BYTES, stream);
    if (e != hipSuccess) fprintf(stderr, "cooperative launch failed: %s (grid %d)\n", hipGetErrorString(e), grid);
#else
    for (int ph = 0; ph < NPHASES; ++ph) {
        a.ph_lo = ph; a.ph_hi = ph + 1;
        hipLaunchKernelGGL(fwd_megakernel, dim3(grid), dim3(512), LDS_BYTES, stream, a);
    }
#endif
}
```

```cpp
#include <hip/hip_runtime.h>
#include <hip/hip_cooperative_groups.h>
#include <cstdio>
#include <cstdint>
namespace cg = cooperative_groups;

#ifndef REPEAT_MASK
#define REPEAT_MASK 0
#endif
#ifndef STAGGER_TICKS
#define STAGGER_TICKS 0
#endif
#ifndef XCD_OFFSET
#define XCD_OFFSET 0
#endif
#ifndef EXTRA_BAR
#define EXTRA_BAR 0
#endif
#ifndef MK_ONE_LAUNCH
#define MK_ONE_LAUNCH 1
#endif

#define LAS __attribute__((address_space(3)))
#define GAS __attribute__((address_space(1)))
typedef unsigned short bf16_t;
typedef short bf16x8 __attribute__((ext_vector_type(8)));
typedef float f32x4 __attribute__((ext_vector_type(4)));
typedef float f32x16 __attribute__((ext_vector_type(16)));
typedef unsigned u32x4 __attribute__((ext_vector_type(4)));
typedef unsigned u32x2 __attribute__((ext_vector_type(2)));
typedef float f32x2_t __attribute__((ext_vector_type(2)));
typedef __bf16 bf16x2_t __attribute__((ext_vector_type(2)));

constexpr int DM = 1024, NBATCH = 16, SEQ = 2048, CTXL = 256;
constexpr int TL = NBATCH * SEQ;
constexpr int TC = NBATCH * CTXL;
constexpr int TT = TL + TC;
constexpr int DFF = 2816, NIN = 4608, NPC = 1536, NGC = 3072, NMOD = 9 * DM;
constexpr int KVPOS = SEQ + CTXL;
constexpr float EPS = 1e-6f;
constexpr float QSCALE = 0.125f * 1.4426950408889634f;

constexpr size_t MiB = 1u << 20;
constexpr size_t al256(size_t x) { return (x + 255) & ~(size_t)255; }
constexpr size_t SZ_W13 = (size_t)2 * DFF * DM * 2, SZ_W2 = (size_t)DM * DFF * 2, SZ_WIN = (size_t)NIN * DM * 2, SZ_WSQ = (size_t)DM * DM * 2;
constexpr size_t WS_W13A = 0;
constexpr size_t WS_W2A = WS_W13A + SZ_W13;
constexpr size_t WS_WIN = WS_W2A + SZ_W2;
constexpr size_t WS_WCAT = WS_WIN + SZ_WIN;
constexpr size_t WS_WOUT = WS_WCAT + SZ_WSQ;
constexpr size_t WS_W13B = WS_WOUT + SZ_WSQ;
constexpr size_t WS_W2B = WS_W13B + SZ_W13;
constexpr size_t WS_SGUW = WS_W2B + SZ_W2;
constexpr size_t WS_MOD = al256(WS_SGUW + 4 * 128 * 128 * 2);
constexpr size_t WS_B13A = al256(WS_MOD + (size_t)2 * 17 * NMOD * 4);
constexpr size_t WS_BIN = al256(WS_B13A + (size_t)17 * 2 * DFF * 4);
constexpr size_t WS_B13B = al256(WS_BIN + (size_t)17 * NIN * 4);
constexpr size_t WS_SSQ = al256(WS_B13B + (size_t)17 * 2 * DFF * 4);
constexpr size_t WS_ROPE = al256(WS_SSQ + (size_t)7 * TT * 4);
constexpr size_t WS_HCTX = al256(WS_ROPE + (size_t)SEQ * 32 * 8);
constexpr size_t WS_AP = al256(WS_HCTX + (size_t)TC * DM * 4);
constexpr size_t WS_KB = al256(WS_AP + (size_t)TT * DM * 2);
constexpr size_t WS_VT = al256(WS_KB + (size_t)TT * 128 * 2);
constexpr size_t WS_P = al256(WS_VT + (size_t)NBATCH * 2 * 64 * KVPOS * 2);
constexpr size_t WS_G = al256(WS_P + (size_t)TT * NPC * 2);
constexpr size_t WS_CTL = al256(WS_G + (size_t)TT * NGC * 2);
constexpr size_t WS_END = WS_CTL + 16384;

constexpr int LDS_BYTES = 147456;
constexpr int NPHASES = 23;

__device__ __forceinline__ unsigned cvtpk(float lo, float hi) { f32x2_t v = {lo, hi}; bf16x2_t b = __builtin_convertvector(v, bf16x2_t); return __builtin_bit_cast(unsigned, b); }
__device__ __forceinline__ float bflo(unsigned u) { return __uint_as_float(u << 16); }
__device__ __forceinline__ float bfhi(unsigned u) { return __uint_as_float(u & 0xffff0000u); }
__device__ __forceinline__ float fexp(float x) { return __builtin_amdgcn_exp2f(x * 1.4426950408889634f); }
__device__ __forceinline__ float frcp(float x) { return __builtin_amdgcn_rcpf(x); }
__device__ __forceinline__ float sigm(float x) { return frcp(1.f + fexp(-x)); }
__device__ __forceinline__ float gelu_t(float x) { const float z = 0.7978845608028654f * (x + 0.044715f * x * x * x); return x * frcp(1.f + fexp(-2.f * z)); }
#define LDS_WAIT() asm volatile("s_waitcnt lgkmcnt(0)" ::: "memory")
__device__ __forceinline__ uintptr_t uni64(uintptr_t v) { const unsigned lo = __builtin_amdgcn_readfirstlane((unsigned)v), hi = __builtin_amdgcn_readfirstlane((unsigned)(v >> 32)); return ((uintptr_t)hi << 32) | lo; }

namespace pg8 {
constexpr int BM = 256, BK = 64, HALF = 128, HTB = HALF * BK * 2, STAGE_BYTES = 8 * HTB, NXCD = 8, WGM = 4;
__device__ __forceinline__ int lds_byte(int r, int c) { const int st = (r >> 4) * 2 + (c >> 5), rr = r & 15, cc = c & 31, ob = rr * 64 + cc * 2; return st * 1024 + (ob ^ (((ob >> 9) & 1) << 5)); }
__device__ __forceinline__ void stage_rc(int b, int& R, int& C) { const int st = b / 1024, sb = b % 1024, swz = sb ^ (((sb >> 9) & 1) << 5); R = (st >> 1) * 16 + swz / 64; C = (st & 1) * 32 + (swz % 64) / 2; }
__device__ __forceinline__ int perm32(int rho) { const int n = rho >> 4, i = rho & 15; return 8 * (i >> 2) + 4 * n + (i & 3); }

struct Unit { int pm, pn, k0, nt, tag, te; };

struct TileSched {
    int c, G, nM1, nN1, n1, pn0_1, n2, pm0_2, pn0_2, nb, ntk;
    int sk, P, R, xo, kx; float* slots; unsigned* flags; unsigned epoch;
    __device__ __forceinline__ void map_tile(int L, int& pm, int& pn) const {
        int wgid; { const int q = n1 / NXCD, r = n1 % NXCD, xcd = L % NXCD, off = L / NXCD; wgid = (xcd < r ? xcd * (q + 1) : r * (q + 1) + (xcd - r) * q) + off; }
        const int nig = WGM * nN1, gid = wgid / nig, fm = gid * WGM, gsz = (nM1 - fm) < WGM ? (nM1 - fm) : WGM;
        pm = fm + ((wgid % nig) % gsz); pn = pn0_1 + (wgid % nig) / gsz;
    }
    __device__ __forceinline__ bool next(int i, Unit& u) const {
        int L = c, k0 = 0, nt = ntk, tag = 0; bool valid, ctxp = false, rect2 = false;
        if (xo) {
            const int nr = sk ? R : (c < n1 ? (n1 - c + G - 1) / G : 0);
            const int extra = (kx > 0 && nr > 0) ? 1 : 0;
            const bool inmain = i < nr + extra, first = (i == 0) && (extra != 0), last = inmain && (i >= nr);
            L = (i == 0 || last) ? c : i * G + c;
            k0 = first ? kx * 128 : 0; nt = first ? ntk - 2 * kx : (last ? 2 * kx : ntk); tag = first ? 4 : (last ? 8 : 0);
            ctxp = (sk != 0) && (i == nr + extra);
            valid = inmain || ctxp;
        } else if (sk) {
            L = i * G + c; ctxp = (i == R); valid = i <= R;
        } else {
            int ti = i, br = 0;
            if (nb == 3) { ti = i / 3; br = i - ti * 3; k0 = br * 256 + (br >> 1) * 256; nt = 4 + 4 * (br & 1); tag = br; }
            L = ti * G + c; rect2 = L >= n1; valid = L < n1 + n2;
        }
        if (!valid) return false;
        int pm, pn;
        map_tile((ctxp || rect2) ? 0 : L, pm, pn);
        if (ctxp) {
            const int x = c & 7, idx = c >> 3, tix = idx >> 2, part = idx & 3, pb = P >> 2, pr = P & 3;
            const int p0 = part * pb + (part < pr ? part : pr), p1 = (part + 1) * pb + (part + 1 < pr ? part + 1 : pr);
            pm = 128 + 2 * x + (tix >> 2); pn = tix & 3; k0 = p0 * 128; nt = 2 * (p1 - p0); tag = part == 0 ? 2 : 1;
        }
        if (rect2) { pm = pm0_2 + (L - n1); pn = pn0_2; }
        u.pm = pm; u.pn = pn; u.k0 = k0; u.nt = nt; u.tag = tag; u.te = 0;
        return true;
    }
};
__device__ __forceinline__ TileSched make_sched(int nM1, int nN1, int K) {
    TileSched s; s.c = blockIdx.x; s.G = gridDim.x; s.nM1 = nM1; s.nN1 = nN1; s.n1 = nM1 * nN1; s.pn0_1 = 0; s.n2 = 0; s.pm0_2 = 0; s.pn0_2 = 0; s.nb = 1;
    s.ntk = K / BK; s.sk = 0; s.P = 1; s.R = 0; s.xo = 0; s.kx = 0; s.slots = nullptr; s.flags = nullptr; s.epoch = 0; return s;
}
__device__ __forceinline__ TileSched make_ctxtail(int K, float* slots, unsigned* flags, unsigned epoch) {
    if (gridDim.x != 256) return make_sched(TT / 256, 4, K);
    TileSched s = make_sched(TL / 256, 4, K);
    s.sk = 1; s.P = K / (2 * BK); s.R = 2; s.slots = slots; s.flags = flags; s.epoch = epoch;
    return s;
}

__device__ __forceinline__ void add_xcd_offset(TileSched& s, int K, float* slots) {
    if (gridDim.x != 256 || s.nb != 1 || s.n2 != 0) return;
    s.xo = 1; s.P = K / (2 * BK); s.kx = ((int)(blockIdx.x & 7) * s.P) >> 3; s.slots = slots;
}
__device__ __forceinline__ int unit_mb(const Unit& u) { return u.pm < 128 ? (u.pm >> 3) : 16; }

struct EpiSwiGLU {
    bf16_t* act; const float* bias; const float* ssq;
    __device__ __forceinline__ void operator()(f32x4 (&acc)[2][2][4][2], const Unit& u, int wr, int wc, int fr, int fq) const {
        const int mb = unit_mb(u);
        const float* bp = bias + (size_t)mb * (2 * DFF) + u.pn * 256 + wc * 32 + 8 * fq;
        f32x4 ba[2], bb[2];
#pragma unroll
        for (int n = 0; n < 2; ++n) { ba[n] = *(const f32x4*)(bp + 4 * n); bb[n] = *(const f32x4*)(bp + 128 + 4 * n); }
        const int row0 = u.pm * 256 + wr * 64 + fr;
        GAS bf16_t* op = (GAS bf16_t*)act + (size_t)row0 * DFF + u.pn * 128 + wc * 32 + 8 * fq;
        float rs[8];
#pragma unroll
        for (int g = 0; g < 8; ++g) rs[g] = ((const GAS float*)ssq)[row0 + (g >> 2) * 128 + (g & 3) * 16];
#pragma unroll
        for (int ai = 0; ai < 2; ++ai)
#pragma unroll
            for (int m = 0; m < 4; ++m) {
                const int ro = ai * 128 + m * 16;
                const float r = __builtin_amdgcn_rsqf(rs[ai * 4 + m] * (1.f / DM) + EPS);
                f32x4 a0 = acc[ai][0][m][0] * r + ba[0], a1 = acc[ai][0][m][1] * r + ba[1], b0 = acc[ai][1][m][0] * r + bb[0], b1 = acc[ai][1][m][1] * r + bb[1];
                f32x4 o0, o1;
#pragma unroll
                for (int i = 0; i < 4; ++i) { o0[i] = a0[i] * b0[i] * sigm(a0[i]); o1[i] = a1[i] * b1[i] * sigm(a1[i]); }
                u32x4 w; w.x = cvtpk(o0[0], o0[1]); w.y = cvtpk(o0[2], o0[3]); w.z = cvtpk(o1[0], o1[1]); w.w = cvtpk(o1[2], o1[3]);
                *(GAS u32x4*)(op + (size_t)ro * DFF) = w;
            }
    }
};
struct EpiIn {
    bf16_t* P; bf16_t* G; const float* bias; const float* ssq;
    __device__ __forceinline__ void operator()(f32x4 (&acc)[2][2][4][2], const Unit& u, int wr, int wc, int fr, int fq) const {
        const int mb = unit_mb(u);
        const int colt = u.pn * 256, cw = wc * 32 + 8 * fq;
        const float* bp = bias + (size_t)mb * NIN + colt + cw;
        f32x4 bv[2][2];
#pragma unroll
        for (int bj = 0; bj < 2; ++bj)
#pragma unroll
            for (int n = 0; n < 2; ++n) bv[bj][n] = *(const f32x4*)(bp + bj * 128 + 4 * n);
        const int row0 = u.pm * 256 + wr * 64 + fr;
        const bool gate = u.pn >= 6;
        GAS bf16_t* base = gate ? (GAS bf16_t*)G + (size_t)row0 * NGC + (colt - NPC) + cw : (GAS bf16_t*)P + (size_t)row0 * NPC + colt + cw;
        const size_t ld = gate ? NGC : NPC;
        float rs[8];
#pragma unroll
        for (int g = 0; g < 8; ++g) rs[g] = ((const GAS float*)ssq)[row0 + (g >> 2) * 128 + (g & 3) * 16];
#pragma unroll
        for (int ai = 0; ai < 2; ++ai)
#pragma unroll
            for (int m = 0; m < 4; ++m) {
                const int ro = ai * 128 + m * 16;
                const float r = __builtin_amdgcn_rsqf(rs[ai * 4 + m] * (1.f / DM) + EPS);
#pragma unroll
                for (int bj = 0; bj < 2; ++bj) {
                    f32x4 v0 = acc[ai][bj][m][0] * r + bv[bj][0], v1 = acc[ai][bj][m][1] * r + bv[bj][1];
                    if (gate) {
#pragma unroll
                        for (int i = 0; i < 4; ++i) { v0[i] = sigm(v0[i]); v1[i] = sigm(v1[i]); }
                    }
                    u32x4 w; w.x = cvtpk(v0[0], v0[1]); w.y = cvtpk(v0[2], v0[3]); w.z = cvtpk(v1[0], v1[1]); w.w = cvtpk(v1[2], v1[3]);
                    *(GAS u32x4*)(base + (size_t)ro * ld + bj * 128) = w;
                }
            }
    }
};
struct EpiRes {
    uintptr_t h_l, h_cd; float* out32; const float* gate; float coef; const float* nrm; const float* scl; float* ssq; bf16_t* Ap; int dry;
    __device__ __forceinline__ void operator()(f32x4 (&acc)[2][2][4][2], const Unit& u, int wr, int wc, int fr, int fq) const {
        const int mb = unit_mb(u);
        const bool lat = u.pm < 128;
        uintptr_t h_l = this->h_l, h_cd = this->h_cd; float* out32 = this->out32; const float* gate = this->gate; float coef = this->coef;
        const float* nrm = this->nrm; const float* scl = this->scl; float* ssq = this->ssq; bf16_t* Ap = this->Ap;
        h_l = uni64(h_l); h_cd = uni64(h_cd); out32 = (float*)uni64((uintptr_t)out32); gate = (const float*)uni64((uintptr_t)gate); coef = __uint_as_float(__builtin_amdgcn_readfirstlane(__float_as_uint(coef)));
        nrm = (const float*)uni64((uintptr_t)nrm); scl = (const float*)uni64((uintptr_t)scl); ssq = (float*)uni64((uintptr_t)ssq); Ap = (bf16_t*)uni64((uintptr_t)Ap);
        const int col0 = u.pn * 256 + wc * 32 + 8 * fq, row0 = u.pm * 256 + wr * 64 + fr, rowl = lat ? row0 : row0 - TL;
        GAS bf16_t* hb = (GAS bf16_t*)(h_l + (lat ? (uintptr_t)0 : h_cd)) + (size_t)rowl * DM + col0;
        GAS float* ho = (GAS float*)out32 + (size_t)rowl * DM + col0;
        f32x4 gc[2][2], gs[2][2];
#pragma unroll
        for (int bj = 0; bj < 2; ++bj)
#pragma unroll
            for (int n = 0; n < 2; ++n) {
                gc[bj][n] = *(const GAS f32x4*)(gate + (size_t)mb * NMOD + col0 + 128 * bj + 4 * n) * (dry ? 0.f : coef);
                if (Ap) gs[bj][n] = *(const GAS f32x4*)(nrm + col0 + 128 * bj + 4 * n) * (*(const GAS f32x4*)(scl + (size_t)mb * NMOD + col0 + 128 * bj + 4 * n) + 1.f);
                else gs[bj][n] = (f32x4){0.f, 0.f, 0.f, 0.f};
            }
        u32x4 hq[3][2];
#pragma unroll
        for (int g0 = 0; g0 < 2; ++g0)
#pragma unroll
            for (int bj = 0; bj < 2; ++bj) hq[g0][bj] = *(const GAS u32x4*)(hb + (size_t)((g0 >> 2) * 128 + (g0 & 3) * 16) * DM + 128 * bj);
#pragma unroll
        for (int g = 0; g < 8; ++g) {
            const int ai = g >> 2, m = g & 3;
            if (g < 6) {
#pragma unroll
                for (int bj = 0; bj < 2; ++bj) hq[(g + 2) % 3][bj] = *(const GAS u32x4*)(hb + (size_t)(((g + 2) >> 2) * 128 + ((g + 2) & 3) * 16) * DM + 128 * bj); }
            const int ro = ai * 128 + m * 16; const size_t off = (size_t)ro * DM;
            float ss = 0.f;
#pragma unroll
            for (int bj = 0; bj < 2; ++bj) {
                const u32x4 q = hq[g % 3][bj];
                const f32x4 h0 = (f32x4){bflo(q.x), bfhi(q.x), bflo(q.y), bfhi(q.y)} + gc[bj][0] * acc[ai][bj][m][0];
                const f32x4 h1 = (f32x4){bflo(q.z), bfhi(q.z), bflo(q.w), bfhi(q.w)} + gc[bj][1] * acc[ai][bj][m][1];
                if (out32) { *(GAS f32x4*)(ho + off + 128 * bj) = h0; *(GAS f32x4*)(ho + off + 128 * bj + 4) = h1; }
                else { u32x4 w; w.x = cvtpk(h0[0], h0[1]); w.y = cvtpk(h0[2], h0[3]); w.z = cvtpk(h1[0], h1[1]); w.w = cvtpk(h1[2], h1[3]); *(GAS u32x4*)(hb + off + 128 * bj) = w; }
                ss += (h0[0] * h0[0] + h0[1] * h0[1]) + (h0[2] * h0[2] + h0[3] * h0[3]) + (h1[0] * h1[0] + h1[1] * h1[1]) + (h1[2] * h1[2] + h1[3] * h1[3]);
                if (Ap) { const f32x4 a0 = h0 * gs[bj][0], a1 = h1 * gs[bj][1];
                    u32x4 w; w.x = cvtpk(a0[0], a0[1]); w.y = cvtpk(a0[2], a0[3]); w.z = cvtpk(a1[0], a1[1]); w.w = cvtpk(a1[2], a1[3]);
                    *(GAS u32x4*)((GAS bf16_t*)Ap + (size_t)(row0 + ro) * DM + col0 + 128 * bj) = w; }
            }
            ss += __shfl_xor(ss, 16); ss += __shfl_xor(ss, 32);
            if (fq == 0) (void)__hip_atomic_fetch_add((GAS float*)ssq + row0 + ro, dry ? 0.f : ss, __ATOMIC_RELAXED, __HIP_MEMORY_SCOPE_AGENT);
        }
    }
};
struct EpiMerge {
    const bf16_t* G; bf16_t* Mg;
    __device__ __forceinline__ void operator()(f32x4 (&acc)[2][2][4][2], const Unit& u, int wr, int wc, int fr, int fq) const {
        const int br = u.tag, col0 = u.pn * 256 + wc * 32 + 8 * fq, row0 = u.pm * 256 + wr * 64 + fr;
        const GAS bf16_t* g0 = (const GAS bf16_t*)G + (size_t)row0 * NGC + br * 1024 + col0;
        u32x4 gq[3][2], hq[3][2];
#pragma unroll
        for (int g_ = 0; g_ < 2; ++g_)
#pragma unroll
            for (int bj = 0; bj < 2; ++bj) { const GAS bf16_t* gp = g0 + (size_t)((g_ >> 2) * 128 + (g_ & 3) * 16) * NGC + 128 * bj;
                gq[g_][bj] = *(const GAS u32x4*)gp; hq[g_][bj] = (br < 2) ? *(const GAS u32x4*)(gp + 1024) : (u32x4){0u, 0u, 0u, 0u}; }
#pragma unroll
        for (int g_ = 0; g_ < 8; ++g_) {
            const int ai = g_ >> 2, m = g_ & 3;
            if (g_ < 6) {
#pragma unroll
                for (int bj = 0; bj < 2; ++bj) { const GAS bf16_t* gp = g0 + (size_t)(((g_ + 2) >> 2) * 128 + ((g_ + 2) & 3) * 16) * NGC + 128 * bj;
                    gq[(g_ + 2) % 3][bj] = *(const GAS u32x4*)gp; hq[(g_ + 2) % 3][bj] = (br < 2) ? *(const GAS u32x4*)(gp + 1024) : (u32x4){0u, 0u, 0u, 0u}; } }
            const int row = row0 + ai * 128 + m * 16;
#pragma unroll
            for (int bj = 0; bj < 2; ++bj) {
                const u32x4 g = gq[g_ % 3][bj];
                f32x4 s0 = (f32x4){bflo(g.x), bfhi(g.x), bflo(g.y), bfhi(g.y)}, s1 = (f32x4){bflo(g.z), bfhi(g.z), bflo(g.w), bfhi(g.w)};
                if (br < 2) {
                    const u32x4 h = hq[g_ % 3][bj];
                    const f32x4 d0 = (f32x4){bflo(h.x), bfhi(h.x), bflo(h.y), bfhi(h.y)}, d1 = (f32x4){bflo(h.z), bfhi(h.z), bflo(h.w), bfhi(h.w)};
#pragma unroll
                    for (int i = 0; i < 4; ++i) { s0[i] *= frcp(fmaxf(d0[i], 1e-20f)); s1[i] *= frcp(fmaxf(d1[i], 1e-20f)); }
                    acc[ai][bj][m][0] *= s0; acc[ai][bj][m][1] *= s1;
                } else {
                    const f32x4 v0 = acc[ai][bj][m][0] * s0, v1 = acc[ai][bj][m][1] * s1;
                    u32x4 w; w.x = cvtpk(v0[0], v0[1]); w.y = cvtpk(v0[2], v0[3]); w.z = cvtpk(v1[0], v1[1]); w.w = cvtpk(v1[2], v1[3]);
                    *(GAS u32x4*)((GAS bf16_t*)Mg + (size_t)row * DM + col0 + 128 * bj) = w;
                }
            }
        }
    }
};

template <class Epi>
__device__ __forceinline__ void gemm_phase(const int tid, LAS unsigned char* lds, const bf16_t* Ab, int lda, const bf16_t* Bb, int ldb, const TileSched& S, const Epi& E) {
    const int wid = __builtin_amdgcn_readfirstlane(tid >> 6), lane = tid & 63, wr = wid >> 2, wc = wid & 3, fr = lane & 15, fq = lane >> 4;
    unsigned voffA[2], voffB[2];
#pragma unroll
    for (int i = 0; i < 2; ++i) { int R, C; stage_rc(tid * 16 + i * 8192, R, C); const int Rb = (R & ~31) + perm32(R & 31);
        voffA[i] = (unsigned)(R * lda + C) * 2u; voffB[i] = (unsigned)(Rb * ldb + C) * 2u; }
    const size_t kstep = (size_t)(BK * 2);
    const size_t hsA = (size_t)HALF * lda * 2, hsB = (size_t)HALF * ldb * 2;
    const unsigned ldsw = (unsigned)wid * 1024u;
    const int aoff = lds_byte(wr * 64 + fr, fq * 8), boff = lds_byte(wc * 32 + fr, fq * 8);
#define PG8_SA(b, h) (((b) * 2 + (h)) * HTB)
#define PG8_SB(b, h) ((4 + (b) * 2 + (h)) * HTB)
#define PG8_STAGE(bufoff, gbase, voff) do { _Pragma("unroll") for (int _i = 0; _i < 2; ++_i) \
        __builtin_amdgcn_global_load_lds((const unsigned*)((const char*)(gbase) + (voff)[_i]), (LAS unsigned*)(lds + (bufoff) + ldsw + _i * 8192), 16, 0, 0); } while (0)
#define PG8_LDA(dst, b, h) do { _Pragma("unroll") for (int m = 0; m < 4; ++m) _Pragma("unroll") for (int k = 0; k < 2; ++k) dst[m][k] = *(const LAS bf16x8*)(lds + PG8_SA(b, h) + aoff + m * 2048 + k * 1024); } while (0)
#define PG8_LDB(dst, b, h) do { _Pragma("unroll") for (int n = 0; n < 2; ++n) _Pragma("unroll") for (int k = 0; k < 2; ++k) dst[n][k] = *(const LAS bf16x8*)(lds + PG8_SB(b, h) + boff + n * 2048 + k * 1024); } while (0)
#define PG8_MMA(ai, bj, At, Bt) do { __builtin_amdgcn_s_setprio(1); _Pragma("unroll") for (int m = 0; m < 4; ++m) _Pragma("unroll") for (int n = 0; n < 2; ++n) _Pragma("unroll") for (int k = 0; k < 2; ++k) \
        acc[ai][bj][m][n] = __builtin_amdgcn_mfma_f32_16x16x32_bf16(Bt[n][k], At[m][k], acc[ai][bj][m][n], 0, 0, 0); __builtin_amdgcn_s_setprio(0); } while (0)
#define PG8_WAIT_V(n) asm volatile("s_waitcnt vmcnt(" #n ")" ::: "memory")
#define PG8_WAIT_L(n) asm volatile("s_waitcnt lgkmcnt(" #n ")" ::: "memory")
#define PG8_BAR __builtin_amdgcn_s_barrier()
#define PG8_SCHED __builtin_amdgcn_sched_barrier(0)
    Unit cur, nxt; int ui = 0;
    if (!S.next(0, cur)) return;
    f32x4 acc[2][2][4][2];
#pragma unroll
    for (int a = 0; a < 2; ++a)
#pragma unroll
        for (int b = 0; b < 2; ++b)
#pragma unroll
            for (int m = 0; m < 4; ++m)
#pragma unroll
                for (int n = 0; n < 2; ++n) acc[a][b][m][n] = (f32x4){0.f, 0.f, 0.f, 0.f};
    bf16x8 At[4][2], B0[2][2], B1[2][2];
    const char* cA = (const char*)Ab + (size_t)cur.pm * 2 * hsA + (size_t)cur.k0 * 2; const char* cB = (const char*)Bb + (size_t)cur.pn * 2 * hsB + (size_t)cur.k0 * 2;
    PG8_STAGE(PG8_SB(0, 0), cB, voffB); PG8_STAGE(PG8_SB(0, 1), cB + hsB, voffB); PG8_STAGE(PG8_SA(0, 0), cA, voffA); PG8_STAGE(PG8_SA(0, 1), cA + hsA, voffA);
    if (wr == 1) PG8_BAR;
    PG8_WAIT_V(2); PG8_BAR;
    PG8_STAGE(PG8_SB(1, 0), cB + kstep, voffB); PG8_STAGE(PG8_SA(1, 0), cA + kstep, voffA); PG8_STAGE(PG8_SB(1, 1), cB + hsB + kstep, voffB);
    PG8_WAIT_V(6); PG8_BAR;
    for (;;) {
        const bool has_next = S.next(ui + 1, nxt);
        const char* nA = has_next ? (const char*)Ab + (size_t)nxt.pm * 2 * hsA + (size_t)nxt.k0 * 2 : cA;
        const char* nB = has_next ? (const char*)Bb + (size_t)nxt.pn * 2 * hsB + (size_t)nxt.k0 * 2 : cB;
        const int nt = cur.nt;
        for (int t = 0; t < nt; t += 2) {
            const bool last = (t == nt - 2);
            const char* a1 = cA + (size_t)(t + 1) * kstep;
            const char* a2 = last ? nA : cA + (size_t)(t + 2) * kstep; const char* b2 = last ? nB : cB + (size_t)(t + 2) * kstep;
            const char* a3 = a2 + kstep; const char* b3 = b2 + kstep;
            PG8_LDB(B0, 0, 0); PG8_LDB(B1, 0, 1); PG8_SCHED; PG8_LDA(At, 0, 0); PG8_STAGE(PG8_SA(1, 1), a1 + hsA, voffA);
            PG8_WAIT_V(8); PG8_WAIT_L(0); PG8_BAR; PG8_MMA(0, 0, At, B0); PG8_MMA(0, 1, At, B1); PG8_BAR; PG8_SCHED;
            PG8_LDA(At, 0, 1); PG8_STAGE(PG8_SB(0, 0), b2, voffB); PG8_STAGE(PG8_SB(0, 1), b2 + hsB, voffB); PG8_STAGE(PG8_SA(0, 0), a2, voffA);
            PG8_WAIT_V(8); PG8_WAIT_L(0); PG8_BAR; PG8_MMA(1, 0, At, B0); PG8_MMA(1, 1, At, B1); PG8_BAR; PG8_SCHED;
            PG8_LDB(B0, 1, 0); PG8_LDB(B1, 1, 1); PG8_SCHED; PG8_LDA(At, 1, 0); PG8_STAGE(PG8_SA(0, 1), a2 + hsA, voffA);
            PG8_WAIT_V(8); PG8_WAIT_L(0); PG8_BAR; PG8_MMA(0, 0, At, B0); PG8_MMA(0, 1, At, B1); PG8_BAR; PG8_SCHED;
            PG8_LDA(At, 1, 1); PG8_STAGE(PG8_SB(1, 0), b3, voffB); PG8_STAGE(PG8_SB(1, 1), b3 + hsB, voffB); PG8_STAGE(PG8_SA(1, 0), a3, voffA);
            PG8_WAIT_V(8); PG8_WAIT_L(0); PG8_BAR; PG8_MMA(1, 0, At, B0); PG8_MMA(1, 1, At, B1); PG8_BAR; PG8_SCHED;
        }
        if (wr == 0) PG8_BAR;
        const bool xch = S.sk || S.xo;
        if (xch && (cur.tag & 10)) {
            const int np = (cur.tag & 2) ? 3 : 1;
#pragma unroll 1
            for (int pp = 1; pp <= np; ++pp) {
                const int j = (cur.tag & 2) ? S.c + 8 * pp : S.c;
                if (cur.tag & 2) {
                    unsigned* fl = S.flags + j * 8 + wid;
                    if (lane == 0) { while (__hip_atomic_load(fl, __ATOMIC_RELAXED, __HIP_MEMORY_SCOPE_AGENT) != S.epoch) __builtin_amdgcn_s_sleep(1); }
                }
                asm volatile("" ::: "memory");
                const unsigned long long* sp = (const unsigned long long*)(S.slots + (size_t)j * 65536 + wid * 8192) + lane; asm volatile("" : "+v"(sp));
#pragma unroll
                for (int a = 0; a < 2; ++a)
#pragma unroll
                    for (int b = 0; b < 2; ++b)
#pragma unroll
                        for (int m = 0; m < 4; ++m) {
#pragma unroll
                            for (int n = 0; n < 2; ++n) {
                                const unsigned long long v0 = __hip_atomic_load(sp, __ATOMIC_RELAXED, __HIP_MEMORY_SCOPE_AGENT), v1 = __hip_atomic_load(sp + 64, __ATOMIC_RELAXED, __HIP_MEMORY_SCOPE_AGENT);
                                acc[a][b][m][n][0] += __uint_as_float((unsigned)v0); acc[a][b][m][n][1] += __uint_as_float((unsigned)(v0 >> 32));
                                acc[a][b][m][n][2] += __uint_as_float((unsigned)v1); acc[a][b][m][n][3] += __uint_as_float((unsigned)(v1 >> 32));
                                sp += 128; }
                            if (m & 1) asm volatile("" : "+v"(sp) :: "memory");
                        }
            }
        }
        if (xch && (cur.tag & 5)) {
            unsigned long long* sp = (unsigned long long*)(S.slots + (size_t)S.c * 65536 + wid * 8192) + lane; asm volatile("" : "+v"(sp));
#pragma unroll
            for (int a = 0; a < 2; ++a)
#pragma unroll
                for (int b = 0; b < 2; ++b)
#pragma unroll
                    for (int m = 0; m < 4; ++m)
#pragma unroll
                        for (int n = 0; n < 2; ++n) {
                            const f32x4 v = acc[a][b][m][n];
                            __hip_atomic_store(sp, (unsigned long long)__float_as_uint(v[0]) | ((unsigned long long)__float_as_uint(v[1]) << 32), __ATOMIC_RELAXED, __HIP_MEMORY_SCOPE_AGENT);
                            __hip_atomic_store(sp + 64, (unsigned long long)__float_as_uint(v[2]) | ((unsigned long long)__float_as_uint(v[3]) << 32), __ATOMIC_RELAXED, __HIP_MEMORY_SCOPE_AGENT);
                            sp += 128; asm volatile("" : "+v"(sp)); }
            if (cur.tag & 1) { asm volatile("s_waitcnt vmcnt(0)" ::: "memory");
                if (lane == 0) __hip_atomic_store(S.flags + S.c * 8 + wid, S.epoch, __ATOMIC_RELAXED, __HIP_MEMORY_SCOPE_AGENT); }
        } else E(acc, cur, wr, wc, fr, fq);
        if (!has_next) break;
        if (!(S.nb == 3 && nxt.tag != 0)) {
#pragma unroll
        for (int a = 0; a < 2; ++a)
#pragma unroll
            for (int b = 0; b < 2; ++b)
#pragma unroll
                for (int m = 0; m < 4; ++m)
#pragma unroll
                    for (int n = 0; n < 2; ++n) acc[a][b][m][n] = (f32x4){0.f, 0.f, 0.f, 0.f};
        }
        cur = nxt; cA = nA; cB = nB; ++ui;
        if (wr == 1) PG8_BAR;
    }
    PG8_WAIT_V(0);
    PG8_BAR;
#undef PG8_SA
#undef PG8_SB
#undef PG8_STAGE
#undef PG8_LDA
#undef PG8_LDB
#undef PG8_MMA
#undef PG8_WAIT_V
#undef PG8_WAIT_L
#undef PG8_BAR
#undef PG8_SCHED
}
}

struct Args {
    const float* in[26];
    float* out; unsigned char* ws;
    int ph_lo, ph_hi;
};
enum { I_X = 0, I_C, I_CTX, I_CCTX, I_WADA, I_BADA, I_NFFN1, I_F1W13, I_F1W2, I_NMIX, I_WIN, I_QN, I_KN, I_POOLW, I_POOLS, I_SGUN, I_SGUW, I_SGUB,
       I_WBRP, I_WBRA, I_WBRS, I_WOUT, I_NFFN2, I_F2W13, I_F2W2, I_FNORM };

__device__ __forceinline__ float wave_sum(float v) {
#pragma unroll
    for (int o = 1; o < 64; o <<= 1) v += __shfl_xor(v, o);
    return v;
}

__device__ __forceinline__ void tr_item(const float* W, int N, bf16_t* WT, int ldt, int coloff, int mode13, float* scr, int item, int lane) {
    const int nblk = N / 32, kb = item / nblk, nb = item - kb * nblk, k0 = 64 * kb, n0 = 32 * nb;
#pragma unroll 8
    for (int i = 0; i < 32; ++i) { const int kk = 2 * i + (lane >> 5); scr[kk * 33 + (lane & 31)] = W[(size_t)(k0 + kk) * N + n0 + (lane & 31)]; }
    LDS_WAIT();
    int r0 = n0;
    if (mode13) { const int s = n0 / DFF, rem = n0 - s * DFF, t = rem >> 7, j = rem & 127; r0 = 256 * t + 128 * s + j; }
    const int c = lane & 7;
#pragma unroll
    for (int j = 0; j < 4; ++j) { const int n = (lane >> 3) + 8 * j; const float* s = scr + (8 * c) * 33 + n;
        u32x4 o; o.x = cvtpk(s[0 * 33], s[1 * 33]); o.y = cvtpk(s[2 * 33], s[3 * 33]); o.z = cvtpk(s[4 * 33], s[5 * 33]); o.w = cvtpk(s[6 * 33], s[7 * 33]);
        *(u32x4*)(WT + (size_t)(r0 + n) * ldt + coloff + k0 + 8 * c) = o; }
    LDS_WAIT();
}

__device__ __forceinline__ void convert_weights(const int tid, const Args& a, int l, unsigned char* lds) {
    const int lane = tid & 63, wave = tid >> 6;
    float* scr = (float*)(lds + wave * 8704);
    const int gw = (gridDim.x - 1 - blockIdx.x) * 8 + wave, NGW = gridDim.x * 8;
    unsigned char* ws = a.ws;
    constexpr int I13 = (DM / 64) * (2 * DFF / 32), I2 = (DFF / 64) * (DM / 32), IIN = (DM / 64) * (NIN / 32), IOUT = (DM / 64) * (DM / 32), IBA = (512 / 64) * (DM / 32), IBS = (256 / 64) * (DM / 32);
    constexpr int NITEMS = 2 * I13 + 2 * I2 + IIN + IOUT + IBA + IBS;
    for (int it = gw; it < NITEMS; it += NGW) {
        int r = it; const float* W; int N; bf16_t* WT; int ldt = DM, coloff = 0, m13 = 0;
        if (r < 2 * I13) { const bool second = r >= I13; r -= second ? I13 : 0; W = a.in[second ? I_F2W13 : I_F1W13] + (size_t)l * DM * 2 * DFF; N = 2 * DFF; WT = (bf16_t*)(ws + (second ? WS_W13B : WS_W13A)); m13 = 1; }
        else if (r < 2 * I13 + 2 * I2) { r -= 2 * I13; const bool second = r >= I2; r -= second ? I2 : 0; W = a.in[second ? I_F2W2 : I_F1W2] + (size_t)l * DFF * DM; N = DM; WT = (bf16_t*)(ws + (second ? WS_W2B : WS_W2A)); ldt = DFF; }
        else if (r < 2 * I13 + 2 * I2 + IIN) { r -= 2 * I13 + 2 * I2; W = a.in[I_WIN] + (size_t)l * DM * NIN; N = NIN; WT = (bf16_t*)(ws + WS_WIN); }
        else if (r < 2 * I13 + 2 * I2 + IIN + IOUT) { r -= 2 * I13 + 2 * I2 + IIN; W = a.in[I_WOUT] + (size_t)l * DM * DM; N = DM; WT = (bf16_t*)(ws + WS_WOUT); }
        else if (r < 2 * I13 + 2 * I2 + IIN + IOUT + IBA) { r -= 2 * I13 + 2 * I2 + IIN + IOUT; W = a.in[I_WBRA] + (size_t)l * 512 * DM; N = DM; WT = (bf16_t*)(ws + WS_WCAT); coloff = 256; }
        else { r -= 2 * I13 + 2 * I2 + IIN + IOUT + IBA; W = a.in[I_WBRS] + (size_t)l * 256 * DM; N = DM; WT = (bf16_t*)(ws + WS_WCAT); coloff = 768; }
        tr_item(W, N, WT, ldt, coloff, m13, scr, r, lane);
    }
    {
        const float* pw = a.in[I_POOLW] + (size_t)l * 4 * 64 * 64; const float* ps = a.in[I_POOLS] + (size_t)l * 256; const float* wb = a.in[I_WBRP] + (size_t)l * 256 * DM;
        bf16_t* wcat = (bf16_t*)(ws + WS_WCAT);
        for (int it = blockIdx.x * 512 + tid; it < 1024 * 32; it += gridDim.x * 512) {
            const int n = it & 1023, kg = it >> 10, g = kg >> 3, c0 = (kg & 7) * 8;
            float s[8];
#pragma unroll
            for (int i = 0; i < 8; ++i) s[i] = 0.f;
            for (int d = 0; d < 64; ++d) {
                const float wv = wb[(size_t)(g * 64 + d) * DM + n] * ps[g * 64 + d];
#pragma unroll
                for (int i = 0; i < 8; ++i) s[i] += pw[(g * 64 + c0 + i) * 64 + d] * wv;
            }
            u32x4 o; o.x = cvtpk(s[0], s[1]); o.y = cvtpk(s[2], s[3]); o.z = cvtpk(s[4], s[5]); o.w = cvtpk(s[6], s[7]);
            *(u32x4*)(wcat + (size_t)n * DM + kg * 8) = o;
        }
    }
    {
        const float* sw = a.in[I_SGUW] + (size_t)l * 4 * 128 * 128; unsigned* dst = (unsigned*)(ws + WS_SGUW);
        for (int it = blockIdx.x * 512 + tid; it < 4 * 128 * 64; it += gridDim.x * 512) dst[it] = cvtpk(sw[2 * it], sw[2 * it + 1]);
    }
}

__device__ __forceinline__ void compute_biases(const int tid, const Args& a, int l, unsigned char* lds) {
    const int lane = tid & 63, wave = tid >> 6;
    float* sh = (float*)lds;
    const float* modl = (const float*)(a.ws + WS_MOD) + (size_t)l * 17 * NMOD;
    const int gw = blockIdx.x * 8 + wave, NGW = gridDim.x * 8;
    for (int j = 0; j < 3; ++j) {
        __syncthreads();
        for (int i = tid; i < 17 * DM; i += 512) sh[i] = modl[(size_t)(i >> 10) * NMOD + (3 * j) * DM + (i & 1023)];
        __syncthreads();
        const bf16_t* Wt = (const bf16_t*)(a.ws + (j == 0 ? WS_W13A : (j == 1 ? WS_WIN : WS_W13B)));
        float* bo = (float*)(a.ws + (j == 0 ? WS_B13A : (j == 1 ? WS_BIN : WS_B13B)));
        const int N = (j == 1) ? NIN : 2 * DFF;
        for (int n = gw; n < N; n += NGW) {
            float w[16];
#pragma unroll
            for (int c = 0; c < 4; ++c) { const u32x2 v = *(const u32x2*)(Wt + (size_t)n * DM + c * 256 + lane * 4); w[4 * c] = bflo(v.x); w[4 * c + 1] = bfhi(v.x); w[4 * c + 2] = bflo(v.y); w[4 * c + 3] = bfhi(v.y); }
            float mine = 0.f;
#pragma unroll 1
            for (int mb = 0; mb < 17; ++mb) {
                float p = 0.f;
#pragma unroll
                for (int c = 0; c < 4; ++c) { const f32x4 s = *(const f32x4*)(sh + mb * DM + c * 256 + lane * 4); p += w[4 * c] * s[0] + w[4 * c + 1] * s[1] + w[4 * c + 2] * s[2] + w[4 * c + 3] * s[3]; }
                p = wave_sum(p);
                if (lane == mb) mine = p;
            }
            if (lane < 17) bo[(size_t)lane * N + n] = mine;
        }
    }
}

__device__ __forceinline__ void post_phase(const int tid, const Args& a, int l, unsigned char* lds) {
    const int lane = tid & 63, wave = tid >> 6;
    unsigned char* ws = a.ws;
    const bf16_t* P = (const bf16_t*)(ws + WS_P);
    bf16_t* Bcat = (bf16_t*)(ws + WS_AP); bf16_t* kbuf = (bf16_t*)(ws + WS_KB); bf16_t* Vt = (bf16_t*)(ws + WS_VT);
    const float* rope = (const float*)(ws + WS_ROPE);
    const float* qn = a.in[I_QN] + l * 64; const float* kn = a.in[I_KN] + l * 64;
    const int nchf = (l == 0) ? 288 : 256;
    const int nSGU = nchf * 2, nPOOL = nchf, nV = 288, nQK = TT / 64, total = nSGU + nPOOL + nV + nQK;
    const int G_ = gridDim.x, c_ = blockIdx.x, nS_ = c_ < nSGU ? (nSGU - c_ + G_ - 1) / G_ : 0;
    for (int k_ = 0;; ++k_) {
        const int it = k_ < nS_ ? c_ + k_ * G_ : nSGU + (G_ - 1 - c_) + (k_ - nS_) * G_;
        if (it >= total) break;
        if (it < nSGU + nPOOL + nV) {
            const int ch = it < nSGU ? (it >> 1) : (it < nSGU + nPOOL ? it - nSGU : it - nSGU - nPOOL);
            const bool lat = ch < 256;
            const int b = lat ? (ch >> 4) : ((ch - 256) >> 1), t0 = lat ? (ch & 15) * 128 : ((ch - 256) & 1) * 128, L = lat ? SEQ : CTXL;
            const int Rb = lat ? b * SEQ : TL + b * CTXL, R0 = Rb + t0;
            if (it < nSGU) {
                const int gp = it & 1;
                bf16_t* vT = (bf16_t*)lds;
                bf16_t* Ws = (bf16_t*)(lds + 34816);
                const float* sn = a.in[I_SGUN] + l * 256;
                {
                    const bf16_t* wsrc = (const bf16_t*)(ws + WS_SGUW) + gp * 2 * 128 * 128;
#pragma unroll 4
                    for (int i2 = tid; i2 < 2 * 128 * 16; i2 += 512) { const int r = i2 >> 4, c = i2 & 15; *(u32x4*)(Ws + r * 136 + c * 8) = *(const u32x4*)(wsrc + r * 128 + c * 8); }
                }
#pragma unroll 2
                for (int i2 = tid; i2 < 128 * 32; i2 += 512) { const int l32 = i2 & 31, tok = i2 >> 5;
                    const u32x4 raw = *(const u32x4*)(P + (size_t)(R0 + tok) * NPC + 1280 + l32 * 8);
                    float x[8] = {bflo(raw.x), bfhi(raw.x), bflo(raw.y), bfhi(raw.y), bflo(raw.z), bfhi(raw.z), bflo(raw.w), bfhi(raw.w)};
                    float ss = 0.f;
#pragma unroll
                    for (int i = 0; i < 8; ++i) { x[i] = gelu_t(x[i]); ss += x[i] * x[i]; }
                    ss += __shfl_xor(ss, 1); ss += __shfl_xor(ss, 2); ss += __shfl_xor(ss, 4); ss += __shfl_xor(ss, 8); ss += __shfl_xor(ss, 16);
                    const float rinv = __builtin_amdgcn_rsqf(ss * (1.f / 256.f) + EPS);
                    if ((l32 >> 4) == gp) { const int cl = (l32 & 15) * 8;
#pragma unroll
                        for (int i = 0; i < 8; i += 2) { const unsigned pk = cvtpk(x[i] * rinv * sn[l32 * 8 + i], x[i + 1] * rinv * sn[l32 * 8 + i + 1]);
                            vT[(cl + i) * 136 + tok] = (bf16_t)(pk & 0xffffu); vT[(cl + i + 1) * 136 + tok] = (bf16_t)(pk >> 16); } }
                }
                __syncthreads();
                const int q32 = lane & 31, hi = lane >> 5, cblk = wave & 1, tblk = wave >> 1;
                const float* sb = a.in[I_SGUB] + (size_t)l * 4 * 128;
                const int tok = tblk * 32 + q32, R = R0 + tok;
#pragma unroll
                for (int g2 = 0; g2 < 2; ++g2) {
                    const int g = gp * 2 + g2;
                    u32x2 ur[4];
#pragma unroll
                    for (int rg = 0; rg < 4; ++rg) ur[rg] = *(const u32x2*)(P + (size_t)R * NPC + 1024 + g * 64 + cblk * 32 + 8 * rg + 4 * hi);
                    const float bias = sb[g * 128 + tok];
                    f32x16 acc;
#pragma unroll
                    for (int r = 0; r < 16; ++r) acc[r] = 0.f;
#pragma unroll
                    for (int ks = 0; ks < 8; ++ks) {
                        const bf16x8 af = *(const bf16x8*)(vT + (g2 * 64 + cblk * 32 + q32) * 136 + ks * 16 + hi * 8);
                        const bf16x8 bf = *(const bf16x8*)(Ws + (g2 * 128 + tblk * 32 + q32) * 136 + ks * 16 + hi * 8);
                        acc = __builtin_amdgcn_mfma_f32_32x32x16_bf16(af, bf, acc, 0, 0, 0);
                    }
#pragma unroll
                    for (int rg = 0; rg < 4; ++rg) {
                        const int c4 = g * 64 + cblk * 32 + 8 * rg + 4 * hi;
                        const float u0 = gelu_t(bflo(ur[rg].x)), u1 = gelu_t(bfhi(ur[rg].x)), u2 = gelu_t(bflo(ur[rg].y)), u3 = gelu_t(bfhi(ur[rg].y));
                        u32x2 w; w.x = cvtpk(u0 * (acc[4 * rg] + bias), u1 * (acc[4 * rg + 1] + bias)); w.y = cvtpk(u2 * (acc[4 * rg + 2] + bias), u3 * (acc[4 * rg + 3] + bias));
                        *(u32x2*)(Bcat + (size_t)R * DM + 768 + c4) = w;
                    }
                }
            } else if (it < nSGU + nPOOL) {
                unsigned* xs = (unsigned*)lds;
#pragma unroll 3
                for (int i2 = tid; i2 < 144 * 32; i2 += 512) { const int rr = i2 >> 5, c = i2 & 31; const int s = t0 - 8 + rr;
                    u32x4 v = (u32x4){0u, 0u, 0u, 0u};
                    if (s >= 0 && s < L) v = *(const u32x4*)(P + (size_t)(Rb + s) * NPC + 768 + c * 8);
                    *(u32x4*)(xs + rr * 128 + c * 4) = v; }
                __syncthreads();
                const int cp = tid & 127, tg = tid >> 7, hw = 1 << (cp >> 5);
                for (int tt = tg * 32; tt < tg * 32 + 32; ++tt) {
                    const int t = t0 + tt; const int lo = (t - hw) < 0 ? 0 : (t - hw), hi = (t + hw) > L ? L : (t + hw);
                    float s0 = 0.f, s1 = 0.f;
                    for (int s = lo; s < hi; ++s) { const unsigned v = xs[(s - t0 + 8) * 128 + cp]; s0 += bflo(v); s1 += bfhi(v); }
                    const float ic = 1.f / (float)(hi - lo); const unsigned xv = xs[(tt + 8) * 128 + cp];
                    *(unsigned*)(Bcat + (size_t)(R0 + tt) * DM + 2 * cp) = cvtpk(s0 * ic - bflo(xv), s1 * ic - bfhi(xv));
                }
            } else {
                bf16_t* vs = (bf16_t*)lds;
#pragma unroll 4
                for (int i2 = tid; i2 < 128 * 16; i2 += 512) { const int tok = i2 >> 4, c = i2 & 15;
                    *(u32x4*)(vs + tok * 136 + c * 8) = *(const u32x4*)(P + (size_t)(R0 + tok) * NPC + 640 + c * 8); }
                __syncthreads();
                const int posbase = lat ? t0 : SEQ + t0;
                for (int i2 = tid; i2 < 128 * 16; i2 += 512) { const int vr = i2 & 127, pg = i2 >> 7;
                    unsigned short e[8];
#pragma unroll
                    for (int i = 0; i < 8; ++i) { const int p = pg * 8 + i; const int kap = (p & ~12) | ((p & 4) << 1) | ((p & 8) >> 1); e[i] = vs[kap * 136 + vr]; }
                    u32x4 w; w.x = e[0] | ((unsigned)e[1] << 16); w.y = e[2] | ((unsigned)e[3] << 16); w.z = e[4] | ((unsigned)e[5] << 16); w.w = e[6] | ((unsigned)e[7] << 16);
                    *(u32x4*)(Vt + ((size_t)(b * 2 + (vr >> 6)) * 64 + (vr & 63)) * KVPOS + posbase + pg * 8) = w; }
            }
            __syncthreads();
        } else {
            const int R0 = (it - (nSGU + nPOOL + nV)) * 64; const bool lat = R0 < TL;
            const bool full = lat || (l == 0);
            const int nh = full ? 10 : 2, hbase = full ? 0 : 8;
#pragma unroll 2
            for (int i2 = tid; i2 < 64 * nh * 8; i2 += 512) {
                const int l8 = i2 & 7, hr = i2 >> 3, tok = hr / nh, hh = hbase + (hr - tok * nh);
                const int R = R0 + tok; const bool isq = hh < 8;
                const bf16_t* src = P + (size_t)R * NPC + (isq ? hh * 64 : 512 + (hh - 8) * 64) + l8 * 8;
                const u32x4 raw = *(const u32x4*)src;
                float x[8] = {bflo(raw.x), bfhi(raw.x), bflo(raw.y), bfhi(raw.y), bflo(raw.z), bfhi(raw.z), bflo(raw.w), bfhi(raw.w)};
                float ss = 0.f;
#pragma unroll
                for (int i = 0; i < 8; ++i) ss += x[i] * x[i];
                ss += __shfl_xor(ss, 1); ss += __shfl_xor(ss, 2); ss += __shfl_xor(ss, 4);
                const float rinv = __builtin_amdgcn_rsqf(ss * (1.f / 64.f) + EPS);
                const float* gn = (isq ? qn : kn) + l8 * 8;
                const f32x4 g0 = *(const f32x4*)gn, g1 = *(const f32x4*)(gn + 4);
                float y[8], o[8];
#pragma unroll
                for (int i = 0; i < 4; ++i) { y[i] = x[i] * rinv * g0[i]; y[4 + i] = x[4 + i] * rinv * g1[i]; }
                const int t = R & (SEQ - 1);
                const int half = l8 >> 2, second = (l8 >> 1) & 1, fi0 = (l8 & 1) * 8;
                const f32x4* rp = (const f32x4*)(rope + ((size_t)t * 32 + half * 16 + fi0) * 2);
                f32x4 cs[4];
                if (lat) {
#pragma unroll
                    for (int i = 0; i < 4; ++i) cs[i] = rp[i];
                }
#pragma unroll
                for (int i = 0; i < 8; ++i) {
                    const float partner = __shfl_xor(y[i], 2);
                    if (lat) { const float cv = cs[i >> 1][(i & 1) * 2], sv = cs[i >> 1][(i & 1) * 2 + 1];
                        o[i] = second ? (y[i] * cv + partner * sv) : (y[i] * cv - partner * sv); }
                    else o[i] = y[i];
                }
                const float sc = isq ? QSCALE : 1.f;
                u32x4 w; w.x = cvtpk(o[0] * sc, o[1] * sc); w.y = cvtpk(o[2] * sc, o[3] * sc); w.z = cvtpk(o[4] * sc, o[5] * sc); w.w = cvtpk(o[6] * sc, o[7] * sc);
                bf16_t* dst = isq ? Bcat + (size_t)R * DM + 256 + hh * 64 + l8 * 8 : kbuf + (size_t)R * 128 + (hh - 8) * 64 + l8 * 8;
                *(u32x4*)dst = w;
            }
        }
    }
}

__device__ __forceinline__ void attn_phase(const int tid, const Args& a, int l, unsigned char* lds, int dry) {
    const int lane = tid & 63, w = tid >> 6, q32 = lane & 31, hi = lane >> 5;
    bf16_t* Bcat = (bf16_t*)(a.ws + WS_AP); const bf16_t* kbuf = (const bf16_t*)(a.ws + WS_KB); const bf16_t* Vt = (const bf16_t*)(a.ws + WS_VT);
    const int G = gridDim.x, c = blockIdx.x;
    const int per = (512 + G - 1) / G;
    const int nlat = (c * per >= 512) ? 0 : ((c + 1) * per > 512 ? 512 - c * per : per);
    const int nctx = (l == 0 && c < 64) ? (64 - c + G - 1) / G : 0;
    const int kr = tid >> 3, kc = tid & 7;
    float sshift;
    { float gq = 0.f, gk = 0.f; const float* qn = a.in[I_QN] + l * 64; const float* kn = a.in[I_KN] + l * 64;
      for (int i = 0; i < 64; ++i) { gq = fmaxf(gq, fabsf(qn[i])); gk = fmaxf(gk, fabsf(kn[i])); }
      const float sbound = QSCALE * 64.f * 1.02f * gq * gk; sshift = sbound > 64.f ? sbound - 64.f : 0.f; }
    const bool use_shift = __builtin_amdgcn_readfirstlane(__float_as_uint(sshift)) != 0u;
    for (int ui = 0; ui < nlat + nctx; ++ui) {
        int b, kvh, qrow0, jt0, NT;
        if (ui < nlat) { const int u = c * per + ui; const int bk = u >> 4, qb = u & 15; b = bk >> 1; kvh = bk & 1; qrow0 = b * SEQ + qb * 128; jt0 = 0; NT = 18; }
        else { const int u = c + (ui - nlat) * G; const int bk = u >> 1, qb = u & 1; b = bk >> 1; kvh = bk & 1; qrow0 = TL + b * CTXL + qb * 128; jt0 = 16; NT = 2; }
        const int head = kvh * 4 + (w >> 1); const int myrow = qrow0 + 64 * (w & 1) + q32;
        bf16_t* qp = Bcat + (size_t)myrow * DM + 256 + head * 64;
        bf16x8 qf[2][4];
#pragma unroll
        for (int sb = 0; sb < 2; ++sb)
#pragma unroll
            for (int ds = 0; ds < 4; ++ds) qf[sb][ds] = *(const bf16x8*)(qp + (size_t)sb * 32 * DM + 16 * ds + hi * 8);
        const int vr = tid >> 4, vc = tid & 15;
        const bf16_t* vsrc = Vt + ((size_t)(b * 2 + kvh) * 64 + vr) * KVPOS + vc * 8;
#define KSRC(jt) (kbuf + (size_t)(((jt) < 16 ? b * SEQ + 128 * (jt) : TL + b * CTXL + 128 * ((jt) - 16)) + kr) * 128 + kvh * 64 + kc * 8)
#define LDS_K(buf) (lds + (buf) * 18432)
#define LDS_V(buf) (lds + 36864 + (buf) * 17408)
        u32x4 kreg0 = *(const u32x4*)KSRC(jt0), kreg1 = *(const u32x4*)(KSRC(jt0) + 64 * 128);
        u32x4 vreg0 = *(const u32x4*)(vsrc + 128 * jt0), vreg1 = *(const u32x4*)(vsrc + 128 * jt0 + (size_t)32 * KVPOS);
        *(u32x4*)(LDS_K(0) + kr * 144 + kc * 16) = kreg0; *(u32x4*)(LDS_K(0) + (kr + 64) * 144 + kc * 16) = kreg1;
        *(u32x4*)(LDS_V(0) + vr * 272 + vc * 16) = vreg0; *(u32x4*)(LDS_V(0) + (vr + 32) * 272 + vc * 16) = vreg1;
        __syncthreads();
        f32x16 o0[2], o1[2];
        float lrun[2];
#pragma unroll
        for (int sb = 0; sb < 2; ++sb) { lrun[sb] = 0.f;
#pragma unroll
            for (int r = 0; r < 16; ++r) { o0[sb][r] = 0.f; o1[sb][r] = 0.f; } }
        for (int j = 0; j < NT; ++j) {
            if (j + 1 < NT) { kreg0 = *(const u32x4*)KSRC(jt0 + j + 1); kreg1 = *(const u32x4*)(KSRC(jt0 + j + 1) + 64 * 128);
                vreg0 = *(const u32x4*)(vsrc + 128 * (jt0 + j + 1)); vreg1 = *(const u32x4*)(vsrc + 128 * (jt0 + j + 1) + (size_t)32 * KVPOS); }
#pragma unroll 1
            for (int h = 0; h < 2; ++h) {
            const unsigned char* Kb = LDS_K(j & 1) + h * 64 * 144; const unsigned char* Vb = LDS_V(j & 1) + h * 128;
            f32x16 p0[2], p1[2];
            const f32x16 czero = {0.f, 0.f, 0.f, 0.f, 0.f, 0.f, 0.f, 0.f, 0.f, 0.f, 0.f, 0.f, 0.f, 0.f, 0.f, 0.f};
#pragma unroll
            for (int ds = 0; ds < 4; ++ds) {
                const bf16x8 k0 = *(const bf16x8*)(Kb + q32 * 144 + ds * 32 + hi * 16);
                const bf16x8 k1 = *(const bf16x8*)(Kb + (32 + q32) * 144 + ds * 32 + hi * 16);
#pragma unroll
                for (int sb = 0; sb < 2; ++sb) {
                    p0[sb] = __builtin_amdgcn_mfma_f32_32x32x16_bf16(k0, qf[sb][ds], ds == 0 ? czero : p0[sb], 0, 0, 0);
                    p1[sb] = __builtin_amdgcn_mfma_f32_32x32x16_bf16(k1, qf[sb][ds], ds == 0 ? czero : p1[sb], 0, 0, 0);
                }
            }
            if (use_shift) {
#pragma unroll
                for (int sb = 0; sb < 2; ++sb)
#pragma unroll
                    for (int r = 0; r < 16; ++r) { p0[sb][r] -= sshift; p1[sb][r] -= sshift; }
            }
            u32x4 pw[2][4];
#pragma unroll
            for (int sb = 0; sb < 2; ++sb) {
                float ls = 0.f;
#pragma unroll
                for (int r = 0; r < 16; ++r) { p0[sb][r] = __builtin_amdgcn_exp2f(p0[sb][r]); p1[sb][r] = __builtin_amdgcn_exp2f(p1[sb][r]); ls += p0[sb][r] + p1[sb][r]; }
                lrun[sb] += ls;
                pw[sb][0] = (u32x4){cvtpk(p0[sb][0], p0[sb][1]), cvtpk(p0[sb][2], p0[sb][3]), cvtpk(p0[sb][4], p0[sb][5]), cvtpk(p0[sb][6], p0[sb][7])};
                pw[sb][1] = (u32x4){cvtpk(p0[sb][8], p0[sb][9]), cvtpk(p0[sb][10], p0[sb][11]), cvtpk(p0[sb][12], p0[sb][13]), cvtpk(p0[sb][14], p0[sb][15])};
                pw[sb][2] = (u32x4){cvtpk(p1[sb][0], p1[sb][1]), cvtpk(p1[sb][2], p1[sb][3]), cvtpk(p1[sb][4], p1[sb][5]), cvtpk(p1[sb][6], p1[sb][7])};
                pw[sb][3] = (u32x4){cvtpk(p1[sb][8], p1[sb][9]), cvtpk(p1[sb][10], p1[sb][11]), cvtpk(p1[sb][12], p1[sb][13]), cvtpk(p1[sb][14], p1[sb][15])};
            }
#pragma unroll
            for (int s = 0; s < 4; ++s) {
                const bf16x8 v0 = *(const bf16x8*)(Vb + q32 * 272 + s * 32 + hi * 16);
                const bf16x8 v1 = *(const bf16x8*)(Vb + (32 + q32) * 272 + s * 32 + hi * 16);
#pragma unroll
                for (int sb = 0; sb < 2; ++sb) {
                    const bf16x8 pa = __builtin_bit_cast(bf16x8, pw[sb][s]);
                    o0[sb] = __builtin_amdgcn_mfma_f32_32x32x16_bf16(v0, pa, o0[sb], 0, 0, 0);
                    o1[sb] = __builtin_amdgcn_mfma_f32_32x32x16_bf16(v1, pa, o1[sb], 0, 0, 0);
                }
            }
            }
            if (j + 1 < NT) { const int nb_ = (j + 1) & 1;
                *(u32x4*)(LDS_K(nb_) + kr * 144 + kc * 16) = kreg0; *(u32x4*)(LDS_K(nb_) + (kr + 64) * 144 + kc * 16) = kreg1;
                *(u32x4*)(LDS_V(nb_) + vr * 272 + vc * 16) = vreg0; *(u32x4*)(LDS_V(nb_) + (vr + 32) * 272 + vc * 16) = vreg1; }
            __syncthreads();
        }
#undef LDS_K
#undef LDS_V
#undef KSRC
#pragma unroll
        for (int sb = 0; sb < 2; ++sb) {
            float lt = lrun[sb]; lt += __shfl_xor(lt, 32);
            const float inv = 1.f / lt;
            bf16_t* op = qp + (size_t)sb * 32 * DM;
#pragma unroll
            for (int rg = 0; rg < 4; ++rg) {
                u32x2 w0; w0.x = cvtpk(o0[sb][4 * rg] * inv, o0[sb][4 * rg + 1] * inv); w0.y = cvtpk(o0[sb][4 * rg + 2] * inv, o0[sb][4 * rg + 3] * inv);
                u32x2 w1; w1.x = cvtpk(o1[sb][4 * rg] * inv, o1[sb][4 * rg + 1] * inv); w1.y = cvtpk(o1[sb][4 * rg + 2] * inv, o1[sb][4 * rg + 3] * inv);
                if (!dry) { *(u32x2*)(op + 8 * rg + 4 * hi) = w0; *(u32x2*)(op + 32 + 8 * rg + 4 * hi) = w1; }
            }
        }
    }
}

__global__ void __launch_bounds__(512, 2) fwd_megakernel(Args a) {
    extern __shared__ __attribute__((aligned(16))) unsigned char lds[];
    cg::grid_group grid = cg::this_grid();
    unsigned char* ws = a.ws;
    float* modraw = (float*)(ws + WS_MOD);
    float* ssq = (float*)(ws + WS_SSQ);
    bf16_t* Ap = (bf16_t*)(ws + WS_AP);
    float* hctx = (float*)(ws + WS_HCTX);
    LAS unsigned char* ldsl = (LAS unsigned char*)lds;

    int second = 0; unsigned nbar = 0;
    const int wave_s = __builtin_amdgcn_readfirstlane((int)threadIdx.x >> 6);
    for (int ph = a.ph_lo; ph < a.ph_hi; ++ph) {
        int lid_; asm volatile("v_mbcnt_lo_u32_b32 %0, -1, 0\n\tv_mbcnt_hi_u32_b32 %0, -1, %0" : "=v"(lid_));
        int tid = wave_s * 64 + lid_; asm volatile("" : "+v"(tid));
        const int lane = tid & 63, wave = tid >> 6;
        int kind;
        { const int sp_ = ph < 11 ? ph - 2 : ph - 13;
          kind = (ph == 0 || ph == 1 || ph == 11 || ph == 12) ? 0 : (ph == 22 ? 7 : ((sp_ == 0 || sp_ == 7) ? 1 : ((sp_ == 1 || sp_ == 6 || sp_ == 8) ? 2 : (sp_ == 2 ? 3 : (sp_ == 3 ? 4 : (sp_ == 4 ? 5 : 6)))))); }
        const int dry = (REPEAT_MASK != 0) && ((REPEAT_MASK >> kind) & 1) && !second;
        if (ph == 0 || ph == 11) {
          if (ph == 0) {
            for (int i = blockIdx.x * 512 + tid; i < 6 * TT; i += gridDim.x * 512) ssq[TT + i] = 0.f;
            {
                float* rope = (float*)(ws + WS_ROPE);
                for (int i = blockIdx.x * 512 + tid; i < SEQ * 32; i += gridDim.x * 512) {
                    const int t = i >> 5, j = i & 31, fi = j & 15; const float pos = (float)((j < 16) ? (t >> 6) : (t & 63));
                    const float invf = __builtin_amdgcn_exp2f(-(float)fi * (13.287712379549449f / 16.f));
                    const float ang = pos * invf;
                    rope[2 * i] = __cosf(ang); rope[2 * i + 1] = __sinf(ang);
                }
            }
            {
                float* sc = (float*)lds;
                float* red = (float*)(lds + 69632);
                for (int i = tid; i < 17 * DM; i += 512) { const int mb = i >> 10, k = i & 1023; const float cv = mb < 16 ? a.in[I_C][mb * DM + k] : a.in[I_CCTX][k]; sc[i] = cv * sigm(cv); }
                __syncthreads();
                for (int item = blockIdx.x; item < 288; item += gridDim.x) {
                    const int l = item / 144, n0 = (item - l * 144) * 64;
                    const float* wp = a.in[I_WADA] + ((size_t)l * DM + wave * 128) * NMOD + n0 + lane;
                    float acc[17];
#pragma unroll
                    for (int mb = 0; mb < 17; ++mb) acc[mb] = 0.f;
#pragma unroll 16
                    for (int k = 0; k < 128; ++k) { const float wv = wp[(size_t)k * NMOD];
#pragma unroll
                        for (int mb = 0; mb < 17; ++mb) acc[mb] += sc[mb * DM + wave * 128 + k] * wv; }
#pragma unroll
                    for (int mb = 0; mb < 17; ++mb) red[(wave * 17 + mb) * 64 + lane] = acc[mb];
                    __syncthreads();
                    for (int i = tid; i < 17 * 64; i += 512) { const int mb = i >> 6, col = i & 63; float s = a.in[I_BADA][l * NMOD + n0 + col];
#pragma unroll
                        for (int w8 = 0; w8 < 8; ++w8) s += red[(w8 * 17 + mb) * 64 + col];
                        modraw[((size_t)l * 17 + mb) * NMOD + n0 + col] = s; }
                    __syncthreads();
                }
            }
            __syncthreads();
          }
            convert_weights(tid, a, ph == 0 ? 0 : 1, lds);
        } else if (ph == 1 || ph == 12) {
            const int l = ph == 1 ? 0 : 1;
            compute_biases(tid, a, l, lds);
            if (l == 0) {
                const float* nrm = a.in[I_NFFN1]; const int gw = blockIdx.x * 8 + wave, NGW = gridDim.x * 8;
                for (int R = gw; R < TT; R += NGW) {
                    const float* xr = R < TL ? a.in[I_X] + (size_t)R * DM : a.in[I_CTX] + (size_t)(R - TL) * DM;
                    const int mb = R < TL ? (R >> 11) : 16; const float* scl = modraw + (size_t)mb * NMOD + DM;
                    float ss = 0.f;
#pragma unroll
                    for (int c4 = 0; c4 < 4; ++c4) { const int col = c4 * 256 + lane * 4; const f32x4 v = *(const f32x4*)(xr + col);
                        ss += (v[0] * v[0] + v[1] * v[1]) + (v[2] * v[2] + v[3] * v[3]);
                        const f32x4 g = *(const f32x4*)(nrm + col) * (*(const f32x4*)(scl + col) + 1.f), y = v * g;
                        u32x2 w; w.x = cvtpk(y[0], y[1]); w.y = cvtpk(y[2], y[3]); *(u32x2*)(Ap + (size_t)R * DM + col) = w;
                        u32x2 hw; hw.x = cvtpk(v[0], v[1]); hw.y = cvtpk(v[2], v[3]);
                        *(u32x2*)((R < TL ? (bf16_t*)a.out + (size_t)R * DM : (bf16_t*)hctx + (size_t)(R - TL) * DM) + col) = hw; }
                    ss = wave_sum(ss);
                    if (lane == 0) ssq[R] = ss;
                }
            }
        } else if (ph == 22) {
            const float* fn = a.in[I_FNORM]; const int gw = blockIdx.x * 8 + wave, NGW = gridDim.x * 8;
            for (int R = gw; R < TL; R += NGW) {
                const float r = __builtin_amdgcn_rsqf(ssq[(size_t)6 * TT + R] * (1.f / DM) + EPS);
                const float* hrow = (const float*)(ws + WS_AP) + (size_t)R * DM; float* orow = a.out + (size_t)R * DM;
#pragma unroll
                for (int c4 = 0; c4 < 4; ++c4) { const int col = c4 * 256 + lane * 4; const f32x4 v = *(const f32x4*)(hrow + col) * r * *(const f32x4*)(fn + col); *(f32x4*)(orow + col) = v; }
            }
        } else {
            const int l = ph < 11 ? 0 : 1, sp = ph < 11 ? ph - 2 : ph - 13;
            const float* modl = modraw + (size_t)l * 17 * NMOD;
            const int nMall = TT / 256, nMlat = TL / 256;
            if (sp == 0 || sp == 7) {
                const bool f1 = sp == 0; const int nM = (f1 || l == 0) ? nMall : nMlat;
                pg8::TileSched S = pg8::make_sched(nM, 2 * DFF / 256, DM);
                pg8::EpiSwiGLU E{(bf16_t*)(ws + WS_G), (const float*)(ws + (f1 ? WS_B13A : WS_B13B)), ssq + (size_t)(3 * l + (f1 ? 0 : 2)) * TT};
                pg8::gemm_phase(tid, ldsl, Ap, DM, (const bf16_t*)(ws + (f1 ? WS_W13A : WS_W13B)), DM, S, E);
            } else if (sp == 1 || sp == 8 || sp == 6) {
                if (STAGGER_TICKS > 0) {
                    if (tid == 0) { const unsigned long long t0 = __builtin_amdgcn_s_memrealtime(); const unsigned long long d = (unsigned long long)((blockIdx.x & 7) * STAGGER_TICKS);
                        while (__builtin_amdgcn_s_memrealtime() - t0 < d) __builtin_amdgcn_s_sleep(4); }
                    __syncthreads();
                }
                const int nM = (sp == 1 || l == 0) ? nMall : nMlat;
                const int j = sp == 1 ? 0 : (sp == 6 ? 1 : 2);
                const bool lastg = (l == 1 && sp == 8);
                const int ln = (sp == 8) ? l + 1 : l, jn = (sp == 8) ? 0 : j + 1;
                const float* nrm = lastg ? nullptr : (jn == 0 ? a.in[I_NFFN1] : (jn == 1 ? a.in[I_NMIX] : a.in[I_NFFN2])) + (size_t)ln * DM;
                const float* scl = lastg ? nullptr : modraw + (size_t)ln * 17 * NMOD + (3 * jn + 1) * DM;
                float* ssqn = ssq + (size_t)(3 * l + j + 1) * TT;
                pg8::EpiRes E{(uintptr_t)a.out, (uintptr_t)hctx - (uintptr_t)a.out, lastg ? (float*)(ws + WS_AP) : nullptr, modl + (3 * j + 2) * DM, sp == 6 ? 1.0f : 0.5f, nrm, scl, ssqn, lastg ? nullptr : Ap, dry};
                const bool wo = sp == 6; const int Kd = wo ? DM : DFF;
                pg8::TileSched S = (wo || nM != nMall) ? pg8::make_sched(nM, DM / 256, Kd) : pg8::make_ctxtail(Kd, (float*)(ws + WS_P), (unsigned*)(ws + WS_CTL) + 64, (unsigned)(ph + 1));
                if (XCD_OFFSET) pg8::add_xcd_offset(S, Kd, (float*)(ws + (wo ? WS_G : WS_P)));
                pg8::gemm_phase(tid, ldsl, (const bf16_t*)(ws + (wo ? WS_P : WS_G)), Kd, (const bf16_t*)(ws + (wo ? WS_WOUT : (sp == 1 ? WS_W2A : WS_W2B))), Kd, S, E);
            } else if (sp == 2) {
                pg8::TileSched S = pg8::make_sched(l == 0 ? nMall : nMlat, NIN / 256, DM);
                if (l == 1) { S.n2 = TC / 256; S.pm0_2 = nMlat; S.pn0_2 = 2; }
                pg8::EpiIn E{(bf16_t*)(ws + WS_P), (bf16_t*)(ws + WS_G), (const float*)(ws + WS_BIN), ssq + (size_t)(3 * l + 1) * TT};
                pg8::gemm_phase(tid, ldsl, Ap, DM, (const bf16_t*)(ws + WS_WIN), DM, S, E);
            } else if (sp == 3) {
                post_phase(tid, a, l, lds);
            } else if (sp == 4) {
                attn_phase(tid, a, l, lds, dry);
            } else if (sp == 5) {
                pg8::TileSched S = pg8::make_sched(l == 0 ? nMall : nMlat, DM / 256, DM);
                S.nb = 3;
                pg8::EpiMerge E{(const bf16_t*)(ws + WS_G), (bf16_t*)(ws + WS_P)};
                pg8::gemm_phase(tid, ldsl, Ap, DM, (const bf16_t*)(ws + WS_WCAT), DM, S, E);
            }
        }
        if (REPEAT_MASK != 0) { if (dry) { second = 1; --ph; __syncthreads(); continue; } second = 0; }
        if (ph + 1 < a.ph_hi) {
            asm volatile("s_waitcnt vmcnt(0) lgkmcnt(0)" ::: "memory");
            __syncthreads();
            if (ph == a.ph_lo) { if (tid == 0) __builtin_amdgcn_fence(__ATOMIC_RELEASE, "agent"); grid.sync(); if (tid == 0) __builtin_amdgcn_fence(__ATOMIC_ACQUIRE, "agent"); }
            else {
              for (int bb = 0; bb <= EXTRA_BAR; ++bb) {
                if (tid == 0) {
                    unsigned* ctl = (unsigned*)(ws + WS_CTL);
                    const unsigned G_ = gridDim.x, g_ = blockIdx.x & 7u, ngrp = G_ < 8u ? G_ : 8u, memb = (G_ - g_ + 7u) >> 3;
                    unsigned* gcnt = ctl + 2304 + 64 * g_; unsigned* ggen = ctl + 2816 + 64 * g_; unsigned* top = ctl + 3328;
                    __builtin_amdgcn_fence(__ATOMIC_RELEASE, "agent");
                    ++nbar;
                    const unsigned old = __hip_atomic_fetch_add(gcnt, 1u, __ATOMIC_RELAXED, __HIP_MEMORY_SCOPE_AGENT);
                    if (old + 1u == nbar * memb) {
                        __hip_atomic_fetch_add(top, 1u, __ATOMIC_RELAXED, __HIP_MEMORY_SCOPE_AGENT);
                        while (__hip_atomic_load(top, __ATOMIC_RELAXED, __HIP_MEMORY_SCOPE_AGENT) < nbar * ngrp) __builtin_amdgcn_s_sleep(1);
                        __hip_atomic_store(ggen, nbar, __ATOMIC_RELAXED, __HIP_MEMORY_SCOPE_AGENT);
                    } else {
                        while (__hip_atomic_load(ggen, __ATOMIC_RELAXED, __HIP_MEMORY_SCOPE_AGENT) < nbar) __builtin_amdgcn_s_sleep(1);
                    }
                    __builtin_amdgcn_fence(__ATOMIC_ACQUIRE, "agent");
                }
                if (EXTRA_BAR) { asm volatile("s_waitcnt vmcnt(0)" ::: "memory"); __syncthreads(); }
              }
            }
            asm volatile("s_waitcnt vmcnt(0)" ::: "memory");
            __syncthreads();
        }
    }
}

extern "C" void kernel_launch(void* const* d_in, const int* in_sizes, int n_in, void* d_out, int out_size, void* d_ws, size_t ws_size, hipStream_t stream) {
    static int grid = 0;
    if (grid == 0) {
        if (n_in != 26 || out_size != TL * DM || ws_size < WS_END) { fprintf(stderr, "kernel_launch: unexpected shapes (n_in %d out %d ws %zu need %zu)\n", n_in, out_size, ws_size, (size_t)WS_END); grid = -1; return; }
        int dev = 0, cus = 0, per_cu = 0;
        if (hipGetDevice(&dev) != hipSuccess || hipDeviceGetAttribute(&cus, hipDeviceAttributeMultiprocessorCount, dev) != hipSuccess) { grid = -1; return; }
        if (hipFuncSetAttribute((const void*)fwd_megakernel, hipFuncAttributeMaxDynamicSharedMemorySize, LDS_BYTES) != hipSuccess) { fprintf(stderr, "kernel_launch: hipFuncSetAttribute failed\n"); grid = -1; return; }
        if (hipOccupancyMaxActiveBlocksPerMultiprocessor(&per_cu, (const void*)fwd_megakernel, 512, LDS_BYTES) != hipSuccess || per_cu < 1) per_cu = 1;
        (void)hipGetLastError();
        grid = cus * per_cu;
    }
    if (grid < 0) return;
    Args a{};
    for (int i = 0; i < 26; ++i) a.in[i] = (const float*)d_in[i];
    a.out = (float*)d_out; a.ws = (unsigned char*)d_ws;
#if MK_ONE_LAUNCH
    a.ph_lo = 0; a.ph_hi = NPHASES;
    if (hipMemsetAsync((char*)d_ws + WS_CTL, 0, 16384, stream) != hipSuccess) { fprintf(stderr, "memset failed\n"); return; }
    void* args[] = {&a};
    hipError_t e = hipLaunchCooperativeKernel((const void*)fwd_megakernel, dim3(grid), dim3(512), args, LDS_BYTES, stream);
    if (e != hipSuccess) fprintf(stderr, "cooperative launch failed: %s (grid %d)\n", hipGetErrorString(e), grid);
#else
    for (int ph = 0; ph < NPHASES; ++ph) {
        a.ph_lo = ph; a.ph_hi = ph + 1;
        hipLaunchKernelGGL(fwd_megakernel, dim3(grid), dim3(512), LDS_BYTES, stream, a);
    }
#endif
}
```

```cpp
#include <hip/hip_runtime.h>
#include <hip/hip_cooperative_groups.h>
#include <cstdio>
#include <cstdint>
namespace cg = cooperative_groups;

#ifndef REPEAT_MASK
#define REPEAT_MASK 0
#endif
#ifndef STAGGER_TICKS
#define STAGGER_TICKS 0
#endif
#ifndef XCD_OFFSET
#define XCD_OFFSET 0
#endif
#ifndef EXTRA_BAR
#define EXTRA_BAR 0
#endif
#ifndef MK_ONE_LAUNCH
#define MK_ONE_LAUNCH 1
#endif

#define LAS __attribute__((address_space(3)))
#define GAS __attribute__((address_space(1)))
typedef unsigned short bf16_t;
typedef short bf16x8 __attribute__((ext_vector_type(8)));
typedef float f32x4 __attribute__((ext_vector_type(4)));
typedef float f32x16 __attribute__((ext_vector_type(16)));
typedef unsigned u32x4 __attribute__((ext_vector_type(4)));
typedef unsigned u32x2 __attribute__((ext_vector_type(2)));
typedef float f32x2_t __attribute__((ext_vector_type(2)));
typedef __bf16 bf16x2_t __attribute__((ext_vector_type(2)));

constexpr int DM = 1024, NBATCH = 16, SEQ = 2048, CTXL = 256;
constexpr int TL = NBATCH * SEQ;
constexpr int TC = NBATCH * CTXL;
constexpr int TT = TL + TC;
constexpr int DFF = 2816, NIN = 4608, NPC = 1536, NGC = 3072, NMOD = 9 * DM;
constexpr int KVPOS = SEQ + CTXL;
constexpr float EPS = 1e-6f;
constexpr float QSCALE = 0.125f * 1.4426950408889634f;

constexpr size_t MiB = 1u << 20;
constexpr size_t al256(size_t x) { return (x + 255) & ~(size_t)255; }
constexpr size_t SZ_W13 = (size_t)2 * DFF * DM * 2, SZ_W2 = (size_t)DM * DFF * 2, SZ_WIN = (size_t)NIN * DM * 2, SZ_WSQ = (size_t)DM * DM * 2;
constexpr size_t WS_W13A = 0;
constexpr size_t WS_W2A = WS_W13A + SZ_W13;
constexpr size_t WS_WIN = WS_W2A + SZ_W2;
constexpr size_t WS_WCAT = WS_WIN + SZ_WIN;
constexpr size_t WS_WOUT = WS_WCAT + SZ_WSQ;
constexpr size_t WS_W13B = WS_WOUT + SZ_WSQ;
constexpr size_t WS_W2B = WS_W13B + SZ_W13;
constexpr size_t WS_SGUW = WS_W2B + SZ_W2;
constexpr size_t WS_MOD = al256(WS_SGUW + 4 * 128 * 128 * 2);
constexpr size_t WS_B13A = al256(WS_MOD + (size_t)2 * 17 * NMOD * 4);
constexpr size_t WS_BIN = al256(WS_B13A + (size_t)17 * 2 * DFF * 4);
constexpr size_t WS_B13B = al256(WS_BIN + (size_t)17 * NIN * 4);
constexpr size_t WS_SSQ = al256(WS_B13B + (size_t)17 * 2 * DFF * 4);
constexpr size_t WS_ROPE = al256(WS_SSQ + (size_t)7 * TT * 4);
constexpr size_t WS_HCTX = al256(WS_ROPE + (size_t)SEQ * 32 * 8);
constexpr size_t WS_AP = al256(WS_HCTX + (size_t)TC * DM * 4);
constexpr size_t WS_KB = al256(WS_AP + (size_t)TT * DM * 2);
constexpr size_t WS_VT = al256(WS_KB + (size_t)TT * 128 * 2);
constexpr size_t WS_P = al256(WS_VT + (size_t)NBATCH * 2 * 64 * KVPOS * 2);
constexpr size_t WS_G = al256(WS_P + (size_t)TT * NPC * 2);
constexpr size_t WS_CTL = al256(WS_G + (size_t)TT * NGC * 2);
constexpr size_t WS_END = WS_CTL + 16384;

constexpr int LDS_BYTES = 147456;
constexpr int NPHASES = 23;

__device__ __forceinline__ unsigned cvtpk(float lo, float hi) { f32x2_t v = {lo, hi}; bf16x2_t b = __builtin_convertvector(v, bf16x2_t); return __builtin_bit_cast(unsigned, b); }
__device__ __forceinline__ float bflo(unsigned u) { return __uint_as_float(u << 16); }
__device__ __forceinline__ float bfhi(unsigned u) { return __uint_as_float(u & 0xffff0000u); }
__device__ __forceinline__ float fexp(float x) { return __builtin_amdgcn_exp2f(x * 1.4426950408889634f); }
__device__ __forceinline__ float frcp(float x) { return __builtin_amdgcn_rcpf(x); }
__device__ __forceinline__ float sigm(float x) { return frcp(1.f + fexp(-x)); }
__device__ __forceinline__ float gelu_t(float x) { const float z = 0.7978845608028654f * (x + 0.044715f * x * x * x); return x * frcp(1.f + fexp(-2.f * z)); }
#define LDS_WAIT() asm volatile("s_waitcnt lgkmcnt(0)" ::: "memory")
__device__ __forceinline__ uintptr_t uni64(uintptr_t v) { const unsigned lo = __builtin_amdgcn_readfirstlane((unsigned)v), hi = __builtin_amdgcn_readfirstlane((unsigned)(v >> 32)); return ((uintptr_t)hi << 32) | lo; }

namespace pg8 {
constexpr int BM = 256, BK = 64, HALF = 128, HTB = HALF * BK * 2, STAGE_BYTES = 8 * HTB, NXCD = 8, WGM = 4;
__device__ __forceinline__ int lds_byte(int r, int c) { const int st = (r >> 4) * 2 + (c >> 5), rr = r & 15, cc = c & 31, ob = rr * 64 + cc * 2; return st * 1024 + (ob ^ (((ob >> 9) & 1) << 5)); }
__device__ __forceinline__ void stage_rc(int b, int& R, int& C) { const int st = b / 1024, sb = b % 1024, swz = sb ^ (((sb >> 9) & 1) << 5); R = (st >> 1) * 16 + swz / 64; C = (st & 1) * 32 + (swz % 64) / 2; }
__device__ __forceinline__ int perm32(int rho) { const int n = rho >> 4, i = rho & 15; return 8 * (i >> 2) + 4 * n + (i & 3); }

struct Unit { int pm, pn, k0, nt, tag, te; };

struct TileSched {
    int c, G, nM1, nN1, n1, pn0_1, n2, pm0_2, pn0_2, nb, ntk;
    int sk, P, R, xo, kx; float* slots; unsigned* flags; unsigned epoch;
    __device__ __forceinline__ void map_tile(int L, int& pm, int& pn) const {
        int wgid; { const int q = n1 / NXCD, r = n1 % NXCD, xcd = L % NXCD, off = L / NXCD; wgid = (xcd < r ? xcd * (q + 1) : r * (q + 1) + (xcd - r) * q) + off; }
        const int nig = WGM * nN1, gid = wgid / nig, fm = gid * WGM, gsz = (nM1 - fm) < WGM ? (nM1 - fm) : WGM;
        pm = fm + ((wgid % nig) % gsz); pn = pn0_1 + (wgid % nig) / gsz;
    }
    __device__ __forceinline__ bool next(int i, Unit& u) const {
        int L = c, k0 = 0, nt = ntk, tag = 0; bool valid, ctxp = false, rect2 = false;
        if (xo) {
            const int nr = sk ? R : (c < n1 ? (n1 - c + G - 1) / G : 0);
            const int extra = (kx > 0 && nr > 0) ? 1 : 0;
            const bool inmain = i < nr + extra, first = (i == 0) && (extra != 0), last = inmain && (i >= nr);
            L = (i == 0 || last) ? c : i * G + c;
            k0 = first ? kx * 128 : 0; nt = first ? ntk - 2 * kx : (last ? 2 * kx : ntk); tag = first ? 4 : (last ? 8 : 0);
            ctxp = (sk != 0) && (i == nr + extra);
            valid = inmain || ctxp;
        } else if (sk) {
            L = i * G + c; ctxp = (i == R); valid = i <= R;
        } else {
            int ti = i, br = 0;
            if (nb == 3) { ti = i / 3; br = i - ti * 3; k0 = br * 256 + (br >> 1) * 256; nt = 4 + 4 * (br & 1); tag = br; }
            L = ti * G + c; rect2 = L >= n1; valid = L < n1 + n2;
        }
        if (!valid) return false;
        int pm, pn;
        map_tile((ctxp || rect2) ? 0 : L, pm, pn);
        if (ctxp) {
            const int x = c & 7, idx = c >> 3, tix = idx >> 2, part = idx & 3, pb = P >> 2, pr = P & 3;
            const int p0 = part * pb + (part < pr ? part : pr), p1 = (part + 1) * pb + (part + 1 < pr ? part + 1 : pr);
            pm = 128 + 2 * x + (tix >> 2); pn = tix & 3; k0 = p0 * 128; nt = 2 * (p1 - p0); tag = part == 0 ? 2 : 1;
        }
        if (rect2) { pm = pm0_2 + (L - n1); pn = pn0_2; }
        u.pm = pm; u.pn = pn; u.k0 = k0; u.nt = nt; u.tag = tag; u.te = 0;
        return true;
    }
};
__device__ __forceinline__ TileSched make_sched(int nM1, int nN1, int K) {
    TileSched s; s.c = blockIdx.x; s.G = gridDim.x; s.nM1 = nM1; s.nN1 = nN1; s.n1 = nM1 * nN1; s.pn0_1 = 0; s.n2 = 0; s.pm0_2 = 0; s.pn0_2 = 0; s.nb = 1;
    s.ntk = K / BK; s.sk = 0; s.P = 1; s.R = 0; s.xo = 0; s.kx = 0; s.slots = nullptr; s.flags = nullptr; s.epoch = 0; return s;
}
__device__ __forceinline__ TileSched make_ctxtail(int K, float* slots, unsigned* flags, unsigned epoch) {
    if (gridDim.x != 256) return make_sched(TT / 256, 4, K);
    TileSched s = make_sched(TL / 256, 4, K);
    s.sk = 1; s.P = K / (2 * BK); s.R = 2; s.slots = slots; s.flags = flags; s.epoch = epoch;
    return s;
}

__device__ __forceinline__ void add_xcd_offset(TileSched& s, int K, float* slots) {
    if (gridDim.x != 256 || s.nb != 1 || s.n2 != 0) return;
    s.xo = 1; s.P = K / (2 * BK); s.kx = ((int)(blockIdx.x & 7) * s.P) >> 3; s.slots = slots;
}
__device__ __forceinline__ int unit_mb(const Unit& u) { return u.pm < 128 ? (u.pm >> 3) : 16; }

struct EpiSwiGLU {
    bf16_t* act; const float* bias; const float* ssq;
    __device__ __forceinline__ void operator()(f32x4 (&acc)[2][2][4][2], const Unit& u, int wr, int wc, int fr, int fq) const {
        const int mb = unit_mb(u);
        const float* bp = bias + (size_t)mb * (2 * DFF) + u.pn * 256 + wc * 32 + 8 * fq;
        f32x4 ba[2], bb[2];
#pragma unroll
        for (int n = 0; n < 2; ++n) { ba[n] = *(const f32x4*)(bp + 4 * n); bb[n] = *(const f32x4*)(bp + 128 + 4 * n); }
        const int row0 = u.pm * 256 + wr * 64 + fr;
        GAS bf16_t* op = (GAS bf16_t*)act + (size_t)row0 * DFF + u.pn * 128 + wc * 32 + 8 * fq;
        float rs[8];
#pragma unroll
        for (int g = 0; g < 8; ++g) rs[g] = ((const GAS float*)ssq)[row0 + (g >> 2) * 128 + (g & 3) * 16];
#pragma unroll
        for (int ai = 0; ai < 2; ++ai)
#pragma unroll
            for (int m = 0; m < 4; ++m) {
                const int ro = ai * 128 + m * 16;
                const float r = __builtin_amdgcn_rsqf(rs[ai * 4 + m] * (1.f / DM) + EPS);
                f32x4 a0 = acc[ai][0][m][0] * r + ba[0], a1 = acc[ai][0][m][1] * r + ba[1], b0 = acc[ai][1][m][0] * r + bb[0], b1 = acc[ai][1][m][1] * r + bb[1];
                f32x4 o0, o1;
#pragma unroll
                for (int i = 0; i < 4; ++i) { o0[i] = a0[i] * b0[i] * sigm(a0[i]); o1[i] = a1[i] * b1[i] * sigm(a1[i]); }
                u32x4 w; w.x = cvtpk(o0[0], o0[1]); w.y = cvtpk(o0[2], o0[3]); w.z = cvtpk(o1[0], o1[1]); w.w = cvtpk(o1[2], o1[3]);
                *(GAS u32x4*)(op + (size_t)ro * DFF) = w;
            }
    }
};
struct EpiIn {
    bf16_t* P; bf16_t* G; const float* bias; const float* ssq;
    __device__ __forceinline__ void operator()(f32x4 (&acc)[2][2][4][2], const Unit& u, int wr, int wc, int fr, int fq) const {
        const int mb = unit_mb(u);
        const int colt = u.pn * 256, cw = wc * 32 + 8 * fq;
        const float* bp = bias + (size_t)mb * NIN + colt + cw;
        f32x4 bv[2][2];
#pragma unroll
        for (int bj = 0; bj < 2; ++bj)
#pragma unroll
            for (int n = 0; n < 2; ++n) bv[bj][n] = *(const f32x4*)(bp + bj * 128 + 4 * n);
        const int row0 = u.pm * 256 + wr * 64 + fr;
        const bool gate = u.pn >= 6;
        GAS bf16_t* base = gate ? (GAS bf16_t*)G + (size_t)row0 * NGC + (colt - NPC) + cw : (GAS bf16_t*)P + (size_t)row0 * NPC + colt + cw;
        const size_t ld = gate ? NGC : NPC;
        float rs[8];
#pragma unroll
        for (int g = 0; g < 8; ++g) rs[g] = ((const GAS float*)ssq)[row0 + (g >> 2) * 128 + (g & 3) * 16];
#pragma unroll
        for (int ai = 0; ai < 2; ++ai)
#pragma unroll
            for (int m = 0; m < 4; ++m) {
                const int ro = ai * 128 + m * 16;
                const float r = __builtin_amdgcn_rsqf(rs[ai * 4 + m] * (1.f / DM) + EPS);
#pragma unroll
                for (int bj = 0; bj < 2; ++bj) {
                    f32x4 v0 = acc[ai][bj][m][0] * r + bv[bj][0], v1 = acc[ai][bj][m][1] * r + bv[bj][1];
                    if (gate) {
#pragma unroll
                        for (int i = 0; i < 4; ++i) { v0[i] = sigm(v0[i]); v1[i] = sigm(v1[i]); }
                    }
                    u32x4 w; w.x = cvtpk(v0[0], v0[1]); w.y = cvtpk(v0[2], v0[3]); w.z = cvtpk(v1[0], v1[1]); w.w = cvtpk(v1[2], v1[3]);
                    *(GAS u32x4*)(base + (size_t)ro * ld + bj * 128) = w;
                }
            }
    }
};
struct EpiRes {
    uintptr_t h_l, h_cd; float* out32; const float* gate; float coef; const float* nrm; const float* scl; float* ssq; bf16_t* Ap; int dry;
    __device__ __forceinline__ void operator()(f32x4 (&acc)[2][2][4][2], const Unit& u, int wr, int wc, int fr, int fq) const {
        const int mb = unit_mb(u);
        const bool lat = u.pm < 128;
        uintptr_t h_l = this->h_l, h_cd = this->h_cd; float* out32 = this->out32; const float* gate = this->gate; float coef = this->coef;
        const float* nrm = this->nrm; const float* scl = this->scl; float* ssq = this->ssq; bf16_t* Ap = this->Ap;
        h_l = uni64(h_l); h_cd = uni64(h_cd); out32 = (float*)uni64((uintptr_t)out32); gate = (const float*)uni64((uintptr_t)gate); coef = __uint_as_float(__builtin_amdgcn_readfirstlane(__float_as_uint(coef)));
        nrm = (const float*)uni64((uintptr_t)nrm); scl = (const float*)uni64((uintptr_t)scl); ssq = (float*)uni64((uintptr_t)ssq); Ap = (bf16_t*)uni64((uintptr_t)Ap);
        const int col0 = u.pn * 256 + wc * 32 + 8 * fq, row0 = u.pm * 256 + wr * 64 + fr, rowl = lat ? row0 : row0 - TL;
        GAS bf16_t* hb = (GAS bf16_t*)(h_l + (lat ? (uintptr_t)0 : h_cd)) + (size_t)rowl * DM + col0;
        GAS float* ho = (GAS float*)out32 + (size_t)rowl * DM + col0;
        f32x4 gc[2][2], gs[2][2];
#pragma unroll
        for (int bj = 0; bj < 2; ++bj)
#pragma unroll
            for (int n = 0; n < 2; ++n) {
                gc[bj][n] = *(const GAS f32x4*)(gate + (size_t)mb * NMOD + col0 + 128 * bj + 4 * n) * (dry ? 0.f : coef);
                if (Ap) gs[bj][n] = *(const GAS f32x4*)(nrm + col0 + 128 * bj + 4 * n) * (*(const GAS f32x4*)(scl + (size_t)mb * NMOD + col0 + 128 * bj + 4 * n) + 1.f);
                else gs[bj][n] = (f32x4){0.f, 0.f, 0.f, 0.f};
            }
        u32x4 hq[3][2];
#pragma unroll
        for (int g0 = 0; g0 < 2; ++g0)
#pragma unroll
            for (int bj = 0; bj < 2; ++bj) hq[g0][bj] = *(const GAS u32x4*)(hb + (size_t)((g0 >> 2) * 128 + (g0 & 3) * 16) * DM + 128 * bj);
#pragma unroll
        for (int g = 0; g < 8; ++g) {
            const int ai = g >> 2, m = g & 3;
            if (g < 6) {
#pragma unroll
                for (int bj = 0; bj < 2; ++bj) hq[(g + 2) % 3][bj] = *(const GAS u32x4*)(hb + (size_t)(((g + 2) >> 2) * 128 + ((g + 2) & 3) * 16) * DM + 128 * bj); }
            const int ro = ai * 128 + m * 16; const size_t off = (size_t)ro * DM;
            float ss = 0.f;
#pragma unroll
            for (int bj = 0; bj < 2; ++bj) {
                const u32x4 q = hq[g % 3][bj];
                const f32x4 h0 = (f32x4){bflo(q.x), bfhi(q.x), bflo(q.y), bfhi(q.y)} + gc[bj][0] * acc[ai][bj][m][0];
                const f32x4 h1 = (f32x4){bflo(q.z), bfhi(q.z), bflo(q.w), bfhi(q.w)} + gc[bj][1] * acc[ai][bj][m][1];
                if (out32) { *(GAS f32x4*)(ho + off + 128 * bj) = h0; *(GAS f32x4*)(ho + off + 128 * bj + 4) = h1; }
                else { u32x4 w; w.x = cvtpk(h0[0], h0[1]); w.y = cvtpk(h0[2], h0[3]); w.z = cvtpk(h1[0], h1[1]); w.w = cvtpk(h1[2], h1[3]); *(GAS u32x4*)(hb + off + 128 * bj) = w; }
                ss += (h0[0] * h0[0] + h0[1] * h0[1]) + (h0[2] * h0[2] + h0[3] * h0[3]) + (h1[0] * h1[0] + h1[1] * h1[1]) + (h1[2] * h1[2] + h1[3] * h1[3]);
                if (Ap) { const f32x4 a0 = h0 * gs[bj][0], a1 = h1 * gs[bj][1];
                    u32x4 w; w.x = cvtpk(a0[0], a0[1]); w.y = cvtpk(a0[2], a0[3]); w.z = cvtpk(a1[0], a1[1]); w.w = cvtpk(a1[2], a1[3]);
                    *(GAS u32x4*)((GAS bf16_t*)Ap + (size_t)(row0 + ro) * DM + col0 + 128 * bj) = w; }
            }
            ss += __shfl_xor(ss, 16); ss += __shfl_xor(ss, 32);
            if (fq == 0) (void)__hip_atomic_fetch_add((GAS float*)ssq + row0 + ro, dry ? 0.f : ss, __ATOMIC_RELAXED, __HIP_MEMORY_SCOPE_AGENT);
        }
    }
};
struct EpiMerge {
    const bf16_t* G; bf16_t* Mg;
    __device__ __forceinline__ void operator()(f32x4 (&acc)[2][2][4][2], const Unit& u, int wr, int wc, int fr, int fq) const {
        const int br = u.tag, col0 = u.pn * 256 + wc * 32 + 8 * fq, row0 = u.pm * 256 + wr * 64 + fr;
        const GAS bf16_t* g0 = (const GAS bf16_t*)G + (size_t)row0 * NGC + br * 1024 + col0;
        u32x4 gq[3][2], hq[3][2];
#pragma unroll
        for (int g_ = 0; g_ < 2; ++g_)
#pragma unroll
            for (int bj = 0; bj < 2; ++bj) { const GAS bf16_t* gp = g0 + (size_t)((g_ >> 2) * 128 + (g_ & 3) * 16) * NGC + 128 * bj;
                gq[g_][bj] = *(const GAS u32x4*)gp; hq[g_][bj] = (br < 2) ? *(const GAS u32x4*)(gp + 1024) : (u32x4){0u, 0u, 0u, 0u}; }
#pragma unroll
        for (int g_ = 0; g_ < 8; ++g_) {
            const int ai = g_ >> 2, m = g_ & 3;
            if (g_ < 6) {
#pragma unroll
                for (int bj = 0; bj < 2; ++bj) { const GAS bf16_t* gp = g0 + (size_t)(((g_ + 2) >> 2) * 128 + ((g_ + 2) & 3) * 16) * NGC + 128 * bj;
                    gq[(g_ + 2) % 3][bj] = *(const GAS u32x4*)gp; hq[(g_ + 2) % 3][bj] = (br < 2) ? *(const GAS u32x4*)(gp + 1024) : (u32x4){0u, 0u, 0u, 0u}; } }
            const int row = row0 + ai * 128 + m * 16;
#pragma unroll
            for (int bj = 0; bj < 2; ++bj) {
                const u32x4 g = gq[g_ % 3][bj];
                f32x4 s0 = (f32x4){bflo(g.x), bfhi(g.x), bflo(g.y), bfhi(g.y)}, s1 = (f32x4){bflo(g.z), bfhi(g.z), bflo(g.w), bfhi(g.w)};
                if (br < 2) {
                    const u32x4 h = hq[g_ % 3][bj];
                    const f32x4 d0 = (f32x4){bflo(h.x), bfhi(h.x), bflo(h.y), bfhi(h.y)}, d1 = (f32x4){bflo(h.z), bfhi(h.z), bflo(h.w), bfhi(h.w)};
#pragma unroll
                    for (int i = 0; i < 4; ++i) { s0[i] *= frcp(fmaxf(d0[i], 1e-20f)); s1[i] *= frcp(fmaxf(d1[i], 1e-20f)); }
                    acc[ai][bj][m][0] *= s0; acc[ai][bj][m][1] *= s1;
                } else {
                    const f32x4 v0 = acc[ai][bj][m][0] * s0, v1 = acc[ai][bj][m][1] * s1;
                    u32x4 w; w.x = cvtpk(v0[0], v0[1]); w.y = cvtpk(v0[2], v0[3]); w.z = cvtpk(v1[0], v1[1]); w.w = cvtpk(v1[2], v1[3]);
                    *(GAS u32x4*)((GAS bf16_t*)Mg + (size_t)row * DM + col0 + 128 * bj) = w;
                }
            }
        }
    }
};

template <class Epi>
__device__ __forceinline__ void gemm_phase(const int tid, LAS unsigned char* lds, const bf16_t* Ab, int lda, const bf16_t* Bb, int ldb, const TileSched& S, const Epi& E) {
    const int wid = __builtin_amdgcn_readfirstlane(tid >> 6), lane = tid & 63, wr = wid >> 2, wc = wid & 3, fr = lane & 15, fq = lane >> 4;
    unsigned voffA[2], voffB[2];
#pragma unroll
    for (int i = 0; i < 2; ++i) { int R, C; stage_rc(tid * 16 + i * 8192, R, C); const int Rb = (R & ~31) + perm32(R & 31);
        voffA[i] = (unsigned)(R * lda + C) * 2u; voffB[i] = (unsigned)(Rb * ldb + C) * 2u; }
    const size_t kstep = (size_t)(BK * 2);
    const size_t hsA = (size_t)HALF * lda * 2, hsB = (size_t)HALF * ldb * 2;
    const unsigned ldsw = (unsigned)wid * 1024u;
    const int aoff = lds_byte(wr * 64 + fr, fq * 8), boff = lds_byte(wc * 32 + fr, fq * 8);
#define PG8_SA(b, h) (((b) * 2 + (h)) * HTB)
#define PG8_SB(b, h) ((4 + (b) * 2 + (h)) * HTB)
#define PG8_STAGE(bufoff, gbase, voff) do { _Pragma("unroll") for (int _i = 0; _i < 2; ++_i) \
        __builtin_amdgcn_global_load_lds((const unsigned*)((const char*)(gbase) + (voff)[_i]), (LAS unsigned*)(lds + (bufoff) + ldsw + _i * 8192), 16, 0, 0); } while (0)
#define PG8_LDA(dst, b, h) do { _Pragma("unroll") for (int m = 0; m < 4; ++m) _Pragma("unroll") for (int k = 0; k < 2; ++k) dst[m][k] = *(const LAS bf16x8*)(lds + PG8_SA(b, h) + aoff + m * 2048 + k * 1024); } while (0)
#define PG8_LDB(dst, b, h) do { _Pragma("unroll") for (int n = 0; n < 2; ++n) _Pragma("unroll") for (int k = 0; k < 2; ++k) dst[n][k] = *(const LAS bf16x8*)(lds + PG8_SB(b, h) + boff + n * 2048 + k * 1024); } while (0)
#define PG8_MMA(ai, bj, At, Bt) do { __builtin_amdgcn_s_setprio(1); _Pragma("unroll") for (int m = 0; m < 4; ++m) _Pragma("unroll") for (int n = 0; n < 2; ++n) _Pragma("unroll") for (int k = 0; k < 2; ++k) \
        acc[ai][bj][m][n] = __builtin_amdgcn_mfma_f32_16x16x32_bf16(Bt[n][k], At[m][k], acc[ai][bj][m][n], 0, 0, 0); __builtin_amdgcn_s_setprio(0); } while (0)
#define PG8_WAIT_V(n) asm volatile("s_waitcnt vmcnt(" #n ")" ::: "memory")
#define PG8_WAIT_L(n) asm volatile("s_waitcnt lgkmcnt(" #n ")" ::: "memory")
#define PG8_BAR __builtin_amdgcn_s_barrier()
#define PG8_SCHED __builtin_amdgcn_sched_barrier(0)
    Unit cur, nxt; int ui = 0;
    if (!S.next(0, cur)) return;
    f32x4 acc[2][2][4][2];
#pragma unroll
    for (int a = 0; a < 2; ++a)
#pragma unroll
        for (int b = 0; b < 2; ++b)
#pragma unroll
            for (int m = 0; m < 4; ++m)
#pragma unroll
                for (int n = 0; n < 2; ++n) acc[a][b][m][n] = (f32x4){0.f, 0.f, 0.f, 0.f};
    bf16x8 At[4][2], B0[2][2], B1[2][2];
    const char* cA = (const char*)Ab + (size_t)cur.pm * 2 * hsA + (size_t)cur.k0 * 2; const char* cB = (const char*)Bb + (size_t)cur.pn * 2 * hsB + (size_t)cur.k0 * 2;
    PG8_STAGE(PG8_SB(0, 0), cB, voffB); PG8_STAGE(PG8_SB(0, 1), cB + hsB, voffB); PG8_STAGE(PG8_SA(0, 0), cA, voffA); PG8_STAGE(PG8_SA(0, 1), cA + hsA, voffA);
    if (wr == 1) PG8_BAR;
    PG8_WAIT_V(2); PG8_BAR;
    PG8_STAGE(PG8_SB(1, 0), cB + kstep, voffB); PG8_STAGE(PG8_SA(1, 0), cA + kstep, voffA); PG8_STAGE(PG8_SB(1, 1), cB + hsB + kstep, voffB);
    PG8_WAIT_V(6); PG8_BAR;
    for (;;) {
        const bool has_next = S.next(ui + 1, nxt);
        const char* nA = has_next ? (const char*)Ab + (size_t)nxt.pm * 2 * hsA + (size_t)nxt.k0 * 2 : cA;
        const char* nB = has_next ? (const char*)Bb + (size_t)nxt.pn * 2 * hsB + (size_t)nxt.k0 * 2 : cB;
        const int nt = cur.nt;
        for (int t = 0; t < nt; t += 2) {
            const bool last = (t == nt - 2);
            const char* a1 = cA + (size_t)(t + 1) * kstep;
            const char* a2 = last ? nA : cA + (size_t)(t + 2) * kstep; const char* b2 = last ? nB : cB + (size_t)(t + 2) * kstep;
            const char* a3 = a2 + kstep; const char* b3 = b2 + kstep;
            PG8_LDB(B0, 0, 0); PG8_LDB(B1, 0, 1); PG8_SCHED; PG8_LDA(At, 0, 0); PG8_STAGE(PG8_SA(1, 1), a1 + hsA, voffA);
            PG8_WAIT_V(8); PG8_WAIT_L(0); PG8_BAR; PG8_MMA(0, 0, At, B0); PG8_MMA(0, 1, At, B1); PG8_BAR; PG8_SCHED;
            PG8_LDA(At, 0, 1); PG8_STAGE(PG8_SB(0, 0), b2, voffB); PG8_STAGE(PG8_SB(0, 1), b2 + hsB, voffB); PG8_STAGE(PG8_SA(0, 0), a2, voffA);
            PG8_WAIT_V(8); PG8_WAIT_L(0); PG8_BAR; PG8_MMA(1, 0, At, B0); PG8_MMA(1, 1, At, B1); PG8_BAR; PG8_SCHED;
            PG8_LDB(B0, 1, 0); PG8_LDB(B1, 1, 1); PG8_SCHED; PG8_LDA(At, 1, 0); PG8_STAGE(PG8_SA(0, 1), a2 + hsA, voffA);
            PG8_WAIT_V(8); PG8_WAIT_L(0); PG8_BAR; PG8_MMA(0, 0, At, B0); PG8_MMA(0, 1, At, B1); PG8_BAR; PG8_SCHED;
            PG8_LDA(At, 1, 1); PG8_STAGE(PG8_SB(1, 0), b3, voffB); PG8_STAGE(PG8_SB(1, 1), b3 + hsB, voffB); PG8_STAGE(PG8_SA(1, 0), a3, voffA);
            PG8_WAIT_V(8); PG8_WAIT_L(0); PG8_BAR; PG8_MMA(1, 0, At, B0); PG8_MMA(1, 1, At, B1); PG8_BAR; PG8_SCHED;
        }
        if (wr == 0) PG8_BAR;
        const bool xch = S.sk || S.xo;
        if (xch && (cur.tag & 10)) {
            const int np = (cur.tag & 2) ? 3 : 1;
#pragma unroll 1
            for (int pp = 1; pp <= np; ++pp) {
                const int j = (cur.tag & 2) ? S.c + 8 * pp : S.c;
                if (cur.tag & 2) {
                    unsigned* fl = S.flags + j * 8 + wid;
                    if (lane == 0) { while (__hip_atomic_load(fl, __ATOMIC_RELAXED, __HIP_MEMORY_SCOPE_AGENT) != S.epoch) __builtin_amdgcn_s_sleep(1); }
                }
                asm volatile("" ::: "memory");
                const unsigned long long* sp = (const unsigned long long*)(S.slots + (size_t)j * 65536 + wid * 8192) + lane; asm volatile("" : "+v"(sp));
#pragma unroll
                for (int a = 0; a < 2; ++a)
#pragma unroll
                    for (int b = 0; b < 2; ++b)
#pragma unroll
                        for (int m = 0; m < 4; ++m) {
#pragma unroll
                            for (int n = 0; n < 2; ++n) {
                                const unsigned long long v0 = __hip_atomic_load(sp, __ATOMIC_RELAXED, __HIP_MEMORY_SCOPE_AGENT), v1 = __hip_atomic_load(sp + 64, __ATOMIC_RELAXED, __HIP_MEMORY_SCOPE_AGENT);
                                acc[a][b][m][n][0] += __uint_as_float((unsigned)v0); acc[a][b][m][n][1] += __uint_as_float((unsigned)(v0 >> 32));
                                acc[a][b][m][n][2] += __uint_as_float((unsigned)v1); acc[a][b][m][n][3] += __uint_as_float((unsigned)(v1 >> 32));
                                sp += 128; }
                            if (m & 1) asm volatile("" : "+v"(sp) :: "memory");
                        }
            }
        }
        if (xch && (cur.tag & 5)) {
            unsigned long long* sp = (unsigned long long*)(S.slots + (size_t)S.c * 65536 + wid * 8192) + lane; asm volatile("" : "+v"(sp));
#pragma unroll
            for (int a = 0; a < 2; ++a)
#pragma unroll
                for (int b = 0; b < 2; ++b)
#pragma unroll
                    for (int m = 0; m < 4; ++m)
#pragma unroll
                        for (int n = 0; n < 2; ++n) {
                            const f32x4 v = acc[a][b][m][n];
                            __hip_atomic_store(sp, (unsigned long long)__float_as_uint(v[0]) | ((unsigned long long)__float_as_uint(v[1]) << 32), __ATOMIC_RELAXED, __HIP_MEMORY_SCOPE_AGENT);
                            __hip_atomic_store(sp + 64, (unsigned long long)__float_as_uint(v[2]) | ((unsigned long long)__float_as_uint(v[3]) << 32), __ATOMIC_RELAXED, __HIP_MEMORY_SCOPE_AGENT);
                            sp += 128; asm volatile("" : "+v"(sp)); }
            if (cur.tag & 1) { asm volatile("s_waitcnt vmcnt(0)" ::: "memory");
                if (lane == 0) __hip_atomic_store(S.flags + S.c * 8 + wid, S.epoch, __ATOMIC_RELAXED, __HIP_MEMORY_SCOPE_AGENT); }
        } else E(acc, cur, wr, wc, fr, fq);
        if (!has_next) break;
        if (!(S.nb == 3 && nxt.tag != 0)) {
#pragma unroll
        for (int a = 0; a < 2; ++a)
#pragma unroll
            for (int b = 0; b < 2; ++b)
#pragma unroll
                for (int m = 0; m < 4; ++m)
#pragma unroll
                    for (int n = 0; n < 2; ++n) acc[a][b][m][n] = (f32x4){0.f, 0.f, 0.f, 0.f};
        }
        cur = nxt; cA = nA; cB = nB; ++ui;
        if (wr == 1) PG8_BAR;
    }
    PG8_WAIT_V(0);
    PG8_BAR;
#undef PG8_SA
#undef PG8_SB
#undef PG8_STAGE
#undef PG8_LDA
#undef PG8_LDB
#undef PG8_MMA
#undef PG8_WAIT_V
#undef PG8_WAIT_L
#undef PG8_BAR
#undef PG8_SCHED
}
}

struct Args {
    const float* in[26];
    float* out; unsigned char* ws;
    int ph_lo, ph_hi;
};
enum { I_X = 0, I_C, I_CTX, I_CCTX, I_WADA, I_BADA, I_NFFN1, I_F1W13, I_F1W2, I_NMIX, I_WIN, I_QN, I_KN, I_POOLW, I_POOLS, I_SGUN, I_SGUW, I_SGUB,
       I_WBRP, I_WBRA, I_WBRS, I_WOUT, I_NFFN2, I_F2W13, I_F2W2, I_FNORM };

__device__ __forceinline__ float wave_sum(float v) {
#pragma unroll
    for (int o = 1; o < 64; o <<= 1) v += __shfl_xor(v, o);
    return v;
}

__device__ __forceinline__ void tr_item(const float* W, int N, bf16_t* WT, int ldt, int coloff, int mode13, float* scr, int item, int lane) {
    const int nblk = N / 32, kb = item / nblk, nb = item - kb * nblk, k0 = 64 * kb, n0 = 32 * nb;
    f32x4 wv[8];
#pragma unroll
    for (int i = 0; i < 8; ++i) wv[i] = *(const f32x4*)(W + (size_t)(k0 + 8 * i + (lane >> 3)) * N + n0 + (lane & 7) * 4);
#pragma unroll
    for (int i = 0; i < 8; ++i) { float* sp = scr + (8 * i + (lane >> 3)) * 33 + (lane & 7) * 4; sp[0] = wv[i][0]; sp[1] = wv[i][1]; sp[2] = wv[i][2]; sp[3] = wv[i][3]; }
    LDS_WAIT();
    int r0 = n0;
    if (mode13) { const int s = n0 / DFF, rem = n0 - s * DFF, t = rem >> 7, j = rem & 127; r0 = 256 * t + 128 * s + j; }
    const int c = lane & 7;
#pragma unroll
    for (int j = 0; j < 4; ++j) { const int n = (lane >> 3) + 8 * j; const float* s = scr + (8 * c) * 33 + n;
        u32x4 o; o.x = cvtpk(s[0 * 33], s[1 * 33]); o.y = cvtpk(s[2 * 33], s[3 * 33]); o.z = cvtpk(s[4 * 33], s[5 * 33]); o.w = cvtpk(s[6 * 33], s[7 * 33]);
        *(u32x4*)(WT + (size_t)(r0 + n) * ldt + coloff + k0 + 8 * c) = o; }
    LDS_WAIT();
}

__device__ __forceinline__ void convert_weights(const int tid, const Args& a, int l, unsigned char* lds) {
    const int lane = tid & 63, wave = tid >> 6;
    float* scr = (float*)(lds + wave * 8704);
    const int gw = blockIdx.x * 8 + wave, NGW = gridDim.x * 8;
    unsigned char* ws = a.ws;
    constexpr int I13 = (DM / 64) * (2 * DFF / 32), I2 = (DFF / 64) * (DM / 32), IIN = (DM / 64) * (NIN / 32), IOUT = (DM / 64) * (DM / 32), IBA = (512 / 64) * (DM / 32), IBS = (256 / 64) * (DM / 32);
    constexpr int NITEMS = 2 * I13 + 2 * I2 + IIN + IOUT + IBA + IBS;
    for (int it = gw; it < NITEMS; it += NGW) {
        int r = it; const float* W; int N; bf16_t* WT; int ldt = DM, coloff = 0, m13 = 0;
        if (r < 2 * I13) { const bool second = r >= I13; r -= second ? I13 : 0; W = a.in[second ? I_F2W13 : I_F1W13] + (size_t)l * DM * 2 * DFF; N = 2 * DFF; WT = (bf16_t*)(ws + (second ? WS_W13B : WS_W13A)); m13 = 1; }
        else if (r < 2 * I13 + 2 * I2) { r -= 2 * I13; const bool second = r >= I2; r -= second ? I2 : 0; W = a.in[second ? I_F2W2 : I_F1W2] + (size_t)l * DFF * DM; N = DM; WT = (bf16_t*)(ws + (second ? WS_W2B : WS_W2A)); ldt = DFF; }
        else if (r < 2 * I13 + 2 * I2 + IIN) { r -= 2 * I13 + 2 * I2; W = a.in[I_WIN] + (size_t)l * DM * NIN; N = NIN; WT = (bf16_t*)(ws + WS_WIN); }
        else if (r < 2 * I13 + 2 * I2 + IIN + IOUT) { r -= 2 * I13 + 2 * I2 + IIN; W = a.in[I_WOUT] + (size_t)l * DM * DM; N = DM; WT = (bf16_t*)(ws + WS_WOUT); }
        else if (r < 2 * I13 + 2 * I2 + IIN + IOUT + IBA) { r -= 2 * I13 + 2 * I2 + IIN + IOUT; W = a.in[I_WBRA] + (size_t)l * 512 * DM; N = DM; WT = (bf16_t*)(ws + WS_WCAT); coloff = 256; }
        else { r -= 2 * I13 + 2 * I2 + IIN + IOUT + IBA; W = a.in[I_WBRS] + (size_t)l * 256 * DM; N = DM; WT = (bf16_t*)(ws + WS_WCAT); coloff = 768; }
        tr_item(W, N, WT, ldt, coloff, m13, scr, r, lane);
    }
    {
        const float* pw = a.in[I_POOLW] + (size_t)l * 4 * 64 * 64; const float* ps = a.in[I_POOLS] + (size_t)l * 256; const float* wb = a.in[I_WBRP] + (size_t)l * 256 * DM;
        bf16_t* wcat = (bf16_t*)(ws + WS_WCAT);
        for (int it = blockIdx.x * 512 + tid; it < 1024 * 32; it += gridDim.x * 512) {
            const int n = it & 1023, kg = it >> 10, g = kg >> 3, c0 = (kg & 7) * 8;
            float s[8];
#pragma unroll
            for (int i = 0; i < 8; ++i) s[i] = 0.f;
            for (int d = 0; d < 64; ++d) {
                const float wv = wb[(size_t)(g * 64 + d) * DM + n] * ps[g * 64 + d];
#pragma unroll
                for (int i = 0; i < 8; ++i) s[i] += pw[(g * 64 + c0 + i) * 64 + d] * wv;
            }
            u32x4 o; o.x = cvtpk(s[0], s[1]); o.y = cvtpk(s[2], s[3]); o.z = cvtpk(s[4], s[5]); o.w = cvtpk(s[6], s[7]);
            *(u32x4*)(wcat + (size_t)n * DM + kg * 8) = o;
        }
    }
    {
        const float* sw = a.in[I_SGUW] + (size_t)l * 4 * 128 * 128; unsigned* dst = (unsigned*)(ws + WS_SGUW);
        for (int it = blockIdx.x * 512 + tid; it < 4 * 128 * 64; it += gridDim.x * 512) dst[it] = cvtpk(sw[2 * it], sw[2 * it + 1]);
    }
}

__device__ __forceinline__ void compute_biases(const int tid, const Args& a, int l, unsigned char* lds) {
    const int lane = tid & 63, wave = tid >> 6;
    float* sh = (float*)lds;
    const float* modl = (const float*)(a.ws + WS_MOD) + (size_t)l * 17 * NMOD;
    const int gw = blockIdx.x * 8 + wave, NGW = gridDim.x * 8;
    for (int j = 0; j < 3; ++j) {
        __syncthreads();
        for (int i = tid; i < 17 * DM; i += 512) sh[i] = modl[(size_t)(i >> 10) * NMOD + (3 * j) * DM + (i & 1023)];
        __syncthreads();
        const bf16_t* Wt = (const bf16_t*)(a.ws + (j == 0 ? WS_W13A : (j == 1 ? WS_WIN : WS_W13B)));
        float* bo = (float*)(a.ws + (j == 0 ? WS_B13A : (j == 1 ? WS_BIN : WS_B13B)));
        const int N = (j == 1) ? NIN : 2 * DFF;
        for (int n = gw; n < N; n += NGW) {
            float w[16];
#pragma unroll
            for (int c = 0; c < 4; ++c) { const u32x2 v = *(const u32x2*)(Wt + (size_t)n * DM + c * 256 + lane * 4); w[4 * c] = bflo(v.x); w[4 * c + 1] = bfhi(v.x); w[4 * c + 2] = bflo(v.y); w[4 * c + 3] = bfhi(v.y); }
            float mine = 0.f;
#pragma unroll 1
            for (int mb = 0; mb < 17; ++mb) {
                float p = 0.f;
#pragma unroll
                for (int c = 0; c < 4; ++c) { const f32x4 s = *(const f32x4*)(sh + mb * DM + c * 256 + lane * 4); p += w[4 * c] * s[0] + w[4 * c + 1] * s[1] + w[4 * c + 2] * s[2] + w[4 * c + 3] * s[3]; }
                p = wave_sum(p);
                if (lane == mb) mine = p;
            }
            if (lane < 17) bo[(size_t)lane * N + n] = mine;
        }
    }
}

__device__ __forceinline__ void post_phase(const int tid, const Args& a, int l, unsigned char* lds) {
    const int lane = tid & 63, wave = tid >> 6;
    unsigned char* ws = a.ws;
    const bf16_t* P = (const bf16_t*)(ws + WS_P);
    bf16_t* Bcat = (bf16_t*)(ws + WS_AP); bf16_t* kbuf = (bf16_t*)(ws + WS_KB); bf16_t* Vt = (bf16_t*)(ws + WS_VT);
    const float* rope = (const float*)(ws + WS_ROPE);
    const float* qn = a.in[I_QN] + l * 64; const float* kn = a.in[I_KN] + l * 64;
    const int nchf = (l == 0) ? 288 : 256;
    const int nSGU = nchf * 2, nPOOL = nchf, nV = 288, nQK = TT / 64, total = nSGU + nPOOL + nV + nQK;
    const int G_ = gridDim.x, c_ = blockIdx.x, nS_ = c_ < nSGU ? (nSGU - c_ + G_ - 1) / G_ : 0;
    for (int k_ = 0;; ++k_) {
        const int it = k_ < nS_ ? c_ + k_ * G_ : nSGU + (G_ - 1 - c_) + (k_ - nS_) * G_;
        if (it >= total) break;
        if (it < nSGU + nPOOL + nV) {
            const int ch = it < nSGU ? (it >> 1) : (it < nSGU + nPOOL ? it - nSGU : it - nSGU - nPOOL);
            const bool lat = ch < 256;
            const int b = lat ? (ch >> 4) : ((ch - 256) >> 1), t0 = lat ? (ch & 15) * 128 : ((ch - 256) & 1) * 128, L = lat ? SEQ : CTXL;
            const int Rb = lat ? b * SEQ : TL + b * CTXL, R0 = Rb + t0;
            if (it < nSGU) {
                const int gp = it & 1;
                bf16_t* vT = (bf16_t*)lds;
                bf16_t* Ws = (bf16_t*)(lds + 34816);
                const float* sn = a.in[I_SGUN] + l * 256;
                {
                    const bf16_t* wsrc = (const bf16_t*)(ws + WS_SGUW) + gp * 2 * 128 * 128;
#pragma unroll 4
                    for (int i2 = tid; i2 < 2 * 128 * 16; i2 += 512) { const int r = i2 >> 4, c = i2 & 15; *(u32x4*)(Ws + r * 136 + c * 8) = *(const u32x4*)(wsrc + r * 128 + c * 8); }
                }
#pragma unroll 2
                for (int i2 = tid; i2 < 128 * 32; i2 += 512) { const int l32 = i2 & 31, tok = i2 >> 5;
                    const u32x4 raw = *(const u32x4*)(P + (size_t)(R0 + tok) * NPC + 1280 + l32 * 8);
                    float x[8] = {bflo(raw.x), bfhi(raw.x), bflo(raw.y), bfhi(raw.y), bflo(raw.z), bfhi(raw.z), bflo(raw.w), bfhi(raw.w)};
                    float ss = 0.f;
#pragma unroll
                    for (int i = 0; i < 8; ++i) { x[i] = gelu_t(x[i]); ss += x[i] * x[i]; }
                    ss += __shfl_xor(ss, 1); ss += __shfl_xor(ss, 2); ss += __shfl_xor(ss, 4); ss += __shfl_xor(ss, 8); ss += __shfl_xor(ss, 16);
                    const float rinv = __builtin_amdgcn_rsqf(ss * (1.f / 256.f) + EPS);
                    if ((l32 >> 4) == gp) { const int cl = (l32 & 15) * 8;
#pragma unroll
                        for (int i = 0; i < 8; i += 2) { const unsigned pk = cvtpk(x[i] * rinv * sn[l32 * 8 + i], x[i + 1] * rinv * sn[l32 * 8 + i + 1]);
                            vT[(cl + i) * 136 + tok] = (bf16_t)(pk & 0xffffu); vT[(cl + i + 1) * 136 + tok] = (bf16_t)(pk >> 16); } }
                }
                __syncthreads();
                const int q32 = lane & 31, hi = lane >> 5, cblk = wave & 1, tblk = wave >> 1;
                const float* sb = a.in[I_SGUB] + (size_t)l * 4 * 128;
                const int tok = tblk * 32 + q32, R = R0 + tok;
#pragma unroll
                for (int g2 = 0; g2 < 2; ++g2) {
                    const int g = gp * 2 + g2;
                    u32x2 ur[4];
#pragma unroll
                    for (int rg = 0; rg < 4; ++rg) ur[rg] = *(const u32x2*)(P + (size_t)R * NPC + 1024 + g * 64 + cblk * 32 + 8 * rg + 4 * hi);
                    const float bias = sb[g * 128 + tok];
                    f32x16 acc;
#pragma unroll
                    for (int r = 0; r < 16; ++r) acc[r] = 0.f;
#pragma unroll
                    for (int ks = 0; ks < 8; ++ks) {
                        const bf16x8 af = *(const bf16x8*)(vT + (g2 * 64 + cblk * 32 + q32) * 136 + ks * 16 + hi * 8);
                        const bf16x8 bf = *(const bf16x8*)(Ws + (g2 * 128 + tblk * 32 + q32) * 136 + ks * 16 + hi * 8);
                        acc = __builtin_amdgcn_mfma_f32_32x32x16_bf16(af, bf, acc, 0, 0, 0);
                    }
#pragma unroll
                    for (int rg = 0; rg < 4; ++rg) {
                        const int c4 = g * 64 + cblk * 32 + 8 * rg + 4 * hi;
                        const float u0 = gelu_t(bflo(ur[rg].x)), u1 = gelu_t(bfhi(ur[rg].x)), u2 = gelu_t(bflo(ur[rg].y)), u3 = gelu_t(bfhi(ur[rg].y));
                        u32x2 w; w.x = cvtpk(u0 * (acc[4 * rg] + bias), u1 * (acc[4 * rg + 1] + bias)); w.y = cvtpk(u2 * (acc[4 * rg + 2] + bias), u3 * (acc[4 * rg + 3] + bias));
                        *(u32x2*)(Bcat + (size_t)R * DM + 768 + c4) = w;
                    }
                }
            } else if (it < nSGU + nPOOL) {
                unsigned* xs = (unsigned*)lds;
#pragma unroll 3
                for (int i2 = tid; i2 < 144 * 32; i2 += 512) { const int rr = i2 >> 5, c = i2 & 31; const int s = t0 - 8 + rr;
                    u32x4 v = (u32x4){0u, 0u, 0u, 0u};
                    if (s >= 0 && s < L) v = *(const u32x4*)(P + (size_t)(Rb + s) * NPC + 768 + c * 8);
                    *(u32x4*)(xs + rr * 128 + c * 4) = v; }
                __syncthreads();
                const int cp = tid & 127, tg = tid >> 7, hw = 1 << (cp >> 5);
                for (int tt = tg * 32; tt < tg * 32 + 32; ++tt) {
                    const int t = t0 + tt; const int lo = (t - hw) < 0 ? 0 : (t - hw), hi = (t + hw) > L ? L : (t + hw);
                    float s0 = 0.f, s1 = 0.f;
                    for (int s = lo; s < hi; ++s) { const unsigned v = xs[(s - t0 + 8) * 128 + cp]; s0 += bflo(v); s1 += bfhi(v); }
                    const float ic = 1.f / (float)(hi - lo); const unsigned xv = xs[(tt + 8) * 128 + cp];
                    *(unsigned*)(Bcat + (size_t)(R0 + tt) * DM + 2 * cp) = cvtpk(s0 * ic - bflo(xv), s1 * ic - bfhi(xv));
                }
            } else {
                bf16_t* vs = (bf16_t*)lds;
#pragma unroll 4
                for (int i2 = tid; i2 < 128 * 16; i2 += 512) { const int tok = i2 >> 4, c = i2 & 15;
                    *(u32x4*)(vs + tok * 136 + c * 8) = *(const u32x4*)(P + (size_t)(R0 + tok) * NPC + 640 + c * 8); }
                __syncthreads();
                const int posbase = lat ? t0 : SEQ + t0;
                for (int i2 = tid; i2 < 128 * 16; i2 += 512) { const int vr = i2 & 127, pg = i2 >> 7;
                    unsigned short e[8];
#pragma unroll
                    for (int i = 0; i < 8; ++i) { const int p = pg * 8 + i; const int kap = (p & ~12) | ((p & 4) << 1) | ((p & 8) >> 1); e[i] = vs[kap * 136 + vr]; }
                    u32x4 w; w.x = e[0] | ((unsigned)e[1] << 16); w.y = e[2] | ((unsigned)e[3] << 16); w.z = e[4] | ((unsigned)e[5] << 16); w.w = e[6] | ((unsigned)e[7] << 16);
                    *(u32x4*)(Vt + ((size_t)(b * 2 + (vr >> 6)) * 64 + (vr & 63)) * KVPOS + posbase + pg * 8) = w; }
            }
            __syncthreads();
        } else {
            const int R0 = (it - (nSGU + nPOOL + nV)) * 64; const bool lat = R0 < TL;
            const bool full = lat || (l == 0);
            const int nh = full ? 10 : 2, hbase = full ? 0 : 8;
#pragma unroll 2
            for (int i2 = tid; i2 < 64 * nh * 8; i2 += 512) {
                const int l8 = i2 & 7, hr = i2 >> 3, tok = hr / nh, hh = hbase + (hr - tok * nh);
                const int R = R0 + tok; const bool isq = hh < 8;
                const bf16_t* src = P + (size_t)R * NPC + (isq ? hh * 64 : 512 + (hh - 8) * 64) + l8 * 8;
                const u32x4 raw = *(const u32x4*)src;
                float x[8] = {bflo(raw.x), bfhi(raw.x), bflo(raw.y), bfhi(raw.y), bflo(raw.z), bfhi(raw.z), bflo(raw.w), bfhi(raw.w)};
                float ss = 0.f;
#pragma unroll
                for (int i = 0; i < 8; ++i) ss += x[i] * x[i];
                ss += __shfl_xor(ss, 1); ss += __shfl_xor(ss, 2); ss += __shfl_xor(ss, 4);
                const float rinv = __builtin_amdgcn_rsqf(ss * (1.f / 64.f) + EPS);
                const float* gn = (isq ? qn : kn) + l8 * 8;
                const f32x4 g0 = *(const f32x4*)gn, g1 = *(const f32x4*)(gn + 4);
                float y[8], o[8];
#pragma unroll
                for (int i = 0; i < 4; ++i) { y[i] = x[i] * rinv * g0[i]; y[4 + i] = x[4 + i] * rinv * g1[i]; }
                const int t = R & (SEQ - 1);
                const int half = l8 >> 2, second = (l8 >> 1) & 1, fi0 = (l8 & 1) * 8;
                const f32x4* rp = (const f32x4*)(rope + ((size_t)t * 32 + half * 16 + fi0) * 2);
                f32x4 cs[4];
                if (lat) {
#pragma unroll
                    for (int i = 0; i < 4; ++i) cs[i] = rp[i];
                }
#pragma unroll
                for (int i = 0; i < 8; ++i) {
                    const float partner = __shfl_xor(y[i], 2);
                    if (lat) { const float cv = cs[i >> 1][(i & 1) * 2], sv = cs[i >> 1][(i & 1) * 2 + 1];
                        o[i] = second ? (y[i] * cv + partner * sv) : (y[i] * cv - partner * sv); }
                    else o[i] = y[i];
                }
                const float sc = isq ? QSCALE : 1.f;
                u32x4 w; w.x = cvtpk(o[0] * sc, o[1] * sc); w.y = cvtpk(o[2] * sc, o[3] * sc); w.z = cvtpk(o[4] * sc, o[5] * sc); w.w = cvtpk(o[6] * sc, o[7] * sc);
                bf16_t* dst = isq ? Bcat + (size_t)R * DM + 256 + hh * 64 + l8 * 8 : kbuf + (size_t)R * 128 + (hh - 8) * 64 + l8 * 8;
                *(u32x4*)dst = w;
            }
        }
    }
}

__device__ __forceinline__ void attn_phase(const int tid, const Args& a, int l, unsigned char* lds, int dry) {
    const int lane = tid & 63, w = tid >> 6, q32 = lane & 31, hi = lane >> 5;
    bf16_t* Bcat = (bf16_t*)(a.ws + WS_AP); const bf16_t* kbuf = (const bf16_t*)(a.ws + WS_KB); const bf16_t* Vt = (const bf16_t*)(a.ws + WS_VT);
    const int G = gridDim.x, c = blockIdx.x;
    const int per = (512 + G - 1) / G;
    const int nlat = (c * per >= 512) ? 0 : ((c + 1) * per > 512 ? 512 - c * per : per);
    const int nctx = (l == 0 && c < 64) ? (64 - c + G - 1) / G : 0;
    const int kr = tid >> 3, kc = tid & 7;
    float sshift;
    { float gq = 0.f, gk = 0.f; const float* qn = a.in[I_QN] + l * 64; const float* kn = a.in[I_KN] + l * 64;
      for (int i = 0; i < 64; ++i) { gq = fmaxf(gq, fabsf(qn[i])); gk = fmaxf(gk, fabsf(kn[i])); }
      const float sbound = QSCALE * 64.f * 1.02f * gq * gk; sshift = sbound > 64.f ? sbound - 64.f : 0.f; }
    const bool use_shift = __builtin_amdgcn_readfirstlane(__float_as_uint(sshift)) != 0u;
    for (int ui = 0; ui < nlat + nctx; ++ui) {
        int b, kvh, qrow0, jt0, NT;
        if (ui < nlat) { const int u = c * per + ui; const int bk = u >> 4, qb = u & 15; b = bk >> 1; kvh = bk & 1; qrow0 = b * SEQ + qb * 128; jt0 = 0; NT = 18; }
        else { const int u = c + (ui - nlat) * G; const int bk = u >> 1, qb = u & 1; b = bk >> 1; kvh = bk & 1; qrow0 = TL + b * CTXL + qb * 128; jt0 = 16; NT = 2; }
        const int head = kvh * 4 + (w >> 1); const int myrow = qrow0 + 64 * (w & 1) + q32;
        bf16_t* qp = Bcat + (size_t)myrow * DM + 256 + head * 64;
        bf16x8 qf[2][4];
#pragma unroll
        for (int sb = 0; sb < 2; ++sb)
#pragma unroll
            for (int ds = 0; ds < 4; ++ds) qf[sb][ds] = *(const bf16x8*)(qp + (size_t)sb * 32 * DM + 16 * ds + hi * 8);
        const int vr = tid >> 4, vc = tid & 15;
        const bf16_t* vsrc = Vt + ((size_t)(b * 2 + kvh) * 64 + vr) * KVPOS + vc * 8;
#define KSRC(jt) (kbuf + (size_t)(((jt) < 16 ? b * SEQ + 128 * (jt) : TL + b * CTXL + 128 * ((jt) - 16)) + kr) * 128 + kvh * 64 + kc * 8)
#define LDS_K(buf) (lds + (buf) * 18432)
#define LDS_V(buf) (lds + 36864 + (buf) * 17408)
        u32x4 kreg0 = *(const u32x4*)KSRC(jt0), kreg1 = *(const u32x4*)(KSRC(jt0) + 64 * 128);
        u32x4 vreg0 = *(const u32x4*)(vsrc + 128 * jt0), vreg1 = *(const u32x4*)(vsrc + 128 * jt0 + (size_t)32 * KVPOS);
        *(u32x4*)(LDS_K(0) + kr * 144 + kc * 16) = kreg0; *(u32x4*)(LDS_K(0) + (kr + 64) * 144 + kc * 16) = kreg1;
        *(u32x4*)(LDS_V(0) + vr * 272 + vc * 16) = vreg0; *(u32x4*)(LDS_V(0) + (vr + 32) * 272 + vc * 16) = vreg1;
        __syncthreads();
        f32x16 o0[2], o1[2];
        float lrun[2];
#pragma unroll
        for (int sb = 0; sb < 2; ++sb) { lrun[sb] = 0.f;
#pragma unroll
            for (int r = 0; r < 16; ++r) { o0[sb][r] = 0.f; o1[sb][r] = 0.f; } }
        for (int j = 0; j < NT; ++j) {
            if (j + 1 < NT) { kreg0 = *(const u32x4*)KSRC(jt0 + j + 1); kreg1 = *(const u32x4*)(KSRC(jt0 + j + 1) + 64 * 128);
                vreg0 = *(const u32x4*)(vsrc + 128 * (jt0 + j + 1)); vreg1 = *(const u32x4*)(vsrc + 128 * (jt0 + j + 1) + (size_t)32 * KVPOS); }
#pragma unroll 1
            for (int h = 0; h < 2; ++h) {
            const unsigned char* Kb = LDS_K(j & 1) + h * 64 * 144; const unsigned char* Vb = LDS_V(j & 1) + h * 128;
            f32x16 p0[2], p1[2];
            const f32x16 czero = {0.f, 0.f, 0.f, 0.f, 0.f, 0.f, 0.f, 0.f, 0.f, 0.f, 0.f, 0.f, 0.f, 0.f, 0.f, 0.f};
#pragma unroll
            for (int ds = 0; ds < 4; ++ds) {
                const bf16x8 k0 = *(const bf16x8*)(Kb + q32 * 144 + ds * 32 + hi * 16);
                const bf16x8 k1 = *(const bf16x8*)(Kb + (32 + q32) * 144 + ds * 32 + hi * 16);
#pragma unroll
                for (int sb = 0; sb < 2; ++sb) {
                    p0[sb] = __builtin_amdgcn_mfma_f32_32x32x16_bf16(k0, qf[sb][ds], ds == 0 ? czero : p0[sb], 0, 0, 0);
                    p1[sb] = __builtin_amdgcn_mfma_f32_32x32x16_bf16(k1, qf[sb][ds], ds == 0 ? czero : p1[sb], 0, 0, 0);
                }
            }
            if (use_shift) {
#pragma unroll
                for (int sb = 0; sb < 2; ++sb)
#pragma unroll
                    for (int r = 0; r < 16; ++r) { p0[sb][r] -= sshift; p1[sb][r] -= sshift; }
            }
            u32x4 pw[2][4];
#pragma unroll
            for (int sb = 0; sb < 2; ++sb) {
                float ls = 0.f;
#pragma unroll
                for (int r = 0; r < 16; ++r) { p0[sb][r] = __builtin_amdgcn_exp2f(p0[sb][r]); p1[sb][r] = __builtin_amdgcn_exp2f(p1[sb][r]); ls += p0[sb][r] + p1[sb][r]; }
                lrun[sb] += ls;
                pw[sb][0] = (u32x4){cvtpk(p0[sb][0], p0[sb][1]), cvtpk(p0[sb][2], p0[sb][3]), cvtpk(p0[sb][4], p0[sb][5]), cvtpk(p0[sb][6], p0[sb][7])};
                pw[sb][1] = (u32x4){cvtpk(p0[sb][8], p0[sb][9]), cvtpk(p0[sb][10], p0[sb][11]), cvtpk(p0[sb][12], p0[sb][13]), cvtpk(p0[sb][14], p0[sb][15])};
                pw[sb][2] = (u32x4){cvtpk(p1[sb][0], p1[sb][1]), cvtpk(p1[sb][2], p1[sb][3]), cvtpk(p1[sb][4], p1[sb][5]), cvtpk(p1[sb][6], p1[sb][7])};
                pw[sb][3] = (u32x4){cvtpk(p1[sb][8], p1[sb][9]), cvtpk(p1[sb][10], p1[sb][11]), cvtpk(p1[sb][12], p1[sb][13]), cvtpk(p1[sb][14], p1[sb][15])};
            }
#pragma unroll
            for (int s = 0; s < 4; ++s) {
                const bf16x8 v0 = *(const bf16x8*)(Vb + q32 * 272 + s * 32 + hi * 16);
                const bf16x8 v1 = *(const bf16x8*)(Vb + (32 + q32) * 272 + s * 32 + hi * 16);
#pragma unroll
                for (int sb = 0; sb < 2; ++sb) {
                    const bf16x8 pa = __builtin_bit_cast(bf16x8, pw[sb][s]);
                    o0[sb] = __builtin_amdgcn_mfma_f32_32x32x16_bf16(v0, pa, o0[sb], 0, 0, 0);
                    o1[sb] = __builtin_amdgcn_mfma_f32_32x32x16_bf16(v1, pa, o1[sb], 0, 0, 0);
                }
            }
            }
            if (j + 1 < NT) { const int nb_ = (j + 1) & 1;
                *(u32x4*)(LDS_K(nb_) + kr * 144 + kc * 16) = kreg0; *(u32x4*)(LDS_K(nb_) + (kr + 64) * 144 + kc * 16) = kreg1;
                *(u32x4*)(LDS_V(nb_) + vr * 272 + vc * 16) = vreg0; *(u32x4*)(LDS_V(nb_) + (vr + 32) * 272 + vc * 16) = vreg1; }
            __syncthreads();
        }
#undef LDS_K
#undef LDS_V
#undef KSRC
#pragma unroll
        for (int sb = 0; sb < 2; ++sb) {
            float lt = lrun[sb]; lt += __shfl_xor(lt, 32);
            const float inv = 1.f / lt;
            bf16_t* op = qp + (size_t)sb * 32 * DM;
#pragma unroll
            for (int rg = 0; rg < 4; ++rg) {
                u32x2 w0; w0.x = cvtpk(o0[sb][4 * rg] * inv, o0[sb][4 * rg + 1] * inv); w0.y = cvtpk(o0[sb][4 * rg + 2] * inv, o0[sb][4 * rg + 3] * inv);
                u32x2 w1; w1.x = cvtpk(o1[sb][4 * rg] * inv, o1[sb][4 * rg + 1] * inv); w1.y = cvtpk(o1[sb][4 * rg + 2] * inv, o1[sb][4 * rg + 3] * inv);
                if (!dry) { *(u32x2*)(op + 8 * rg + 4 * hi) = w0; *(u32x2*)(op + 32 + 8 * rg + 4 * hi) = w1; }
            }
        }
    }
}

__global__ void __launch_bounds__(512, 2) fwd_megakernel(Args a) {
    extern __shared__ __attribute__((aligned(16))) unsigned char lds[];
    cg::grid_group grid = cg::this_grid();
    unsigned char* ws = a.ws;
    float* modraw = (float*)(ws + WS_MOD);
    float* ssq = (float*)(ws + WS_SSQ);
    bf16_t* Ap = (bf16_t*)(ws + WS_AP);
    float* hctx = (float*)(ws + WS_HCTX);
    LAS unsigned char* ldsl = (LAS unsigned char*)lds;

    int second = 0; unsigned nbar = 0;
    const int wave_s = __builtin_amdgcn_readfirstlane((int)threadIdx.x >> 6);
    for (int ph = a.ph_lo; ph < a.ph_hi; ++ph) {
        int lid_; asm volatile("v_mbcnt_lo_u32_b32 %0, -1, 0\n\tv_mbcnt_hi_u32_b32 %0, -1, %0" : "=v"(lid_));
        int tid = wave_s * 64 + lid_; asm volatile("" : "+v"(tid));
        const int lane = tid & 63, wave = tid >> 6;
        int kind;
        { const int sp_ = ph < 11 ? ph - 2 : ph - 13;
          kind = (ph == 0 || ph == 1 || ph == 11 || ph == 12) ? 0 : (ph == 22 ? 7 : ((sp_ == 0 || sp_ == 7) ? 1 : ((sp_ == 1 || sp_ == 6 || sp_ == 8) ? 2 : (sp_ == 2 ? 3 : (sp_ == 3 ? 4 : (sp_ == 4 ? 5 : 6)))))); }
        const int dry = (REPEAT_MASK != 0) && ((REPEAT_MASK >> kind) & 1) && !second;
        if (ph == 0 || ph == 11) {
          if (ph == 0) {
            for (int i = blockIdx.x * 512 + tid; i < 6 * TT; i += gridDim.x * 512) ssq[TT + i] = 0.f;
            {
                float* rope = (float*)(ws + WS_ROPE);
                for (int i = blockIdx.x * 512 + tid; i < SEQ * 32; i += gridDim.x * 512) {
                    const int t = i >> 5, j = i & 31, fi = j & 15; const float pos = (float)((j < 16) ? (t >> 6) : (t & 63));
                    const float invf = __builtin_amdgcn_exp2f(-(float)fi * (13.287712379549449f / 16.f));
                    const float ang = pos * invf;
                    rope[2 * i] = __cosf(ang); rope[2 * i + 1] = __sinf(ang);
                }
            }
            {
                float* sc = (float*)lds;
                float* red = (float*)(lds + 69632);
                for (int i = tid; i < 17 * DM; i += 512) { const int mb = i >> 10, k = i & 1023; const float cv = mb < 16 ? a.in[I_C][mb * DM + k] : a.in[I_CCTX][k]; sc[i] = cv * sigm(cv); }
                __syncthreads();
                for (int item = blockIdx.x; item < 288; item += gridDim.x) {
                    const int l = item / 144, n0 = (item - l * 144) * 64;
                    const float* wp = a.in[I_WADA] + ((size_t)l * DM + wave * 128) * NMOD + n0 + lane;
                    float acc[17];
#pragma unroll
                    for (int mb = 0; mb < 17; ++mb) acc[mb] = 0.f;
#pragma unroll 16
                    for (int k = 0; k < 128; ++k) { const float wv = wp[(size_t)k * NMOD];
#pragma unroll
                        for (int mb = 0; mb < 17; ++mb) acc[mb] += sc[mb * DM + wave * 128 + k] * wv; }
#pragma unroll
                    for (int mb = 0; mb < 17; ++mb) red[(wave * 17 + mb) * 64 + lane] = acc[mb];
                    __syncthreads();
                    for (int i = tid; i < 17 * 64; i += 512) { const int mb = i >> 6, col = i & 63; float s = a.in[I_BADA][l * NMOD + n0 + col];
#pragma unroll
                        for (int w8 = 0; w8 < 8; ++w8) s += red[(w8 * 17 + mb) * 64 + col];
                        modraw[((size_t)l * 17 + mb) * NMOD + n0 + col] = s; }
                    __syncthreads();
                }
            }
            __syncthreads();
          }
            convert_weights(tid, a, ph == 0 ? 0 : 1, lds);
        } else if (ph == 1 || ph == 12) {
            const int l = ph == 1 ? 0 : 1;
            compute_biases(tid, a, l, lds);
            if (l == 0) {
                const float* nrm = a.in[I_NFFN1]; const int gw = blockIdx.x * 8 + wave, NGW = gridDim.x * 8;
                for (int R = gw; R < TT; R += NGW) {
                    const float* xr = R < TL ? a.in[I_X] + (size_t)R * DM : a.in[I_CTX] + (size_t)(R - TL) * DM;
                    const int mb = R < TL ? (R >> 11) : 16; const float* scl = modraw + (size_t)mb * NMOD + DM;
                    float ss = 0.f;
#pragma unroll
                    for (int c4 = 0; c4 < 4; ++c4) { const int col = c4 * 256 + lane * 4; const f32x4 v = *(const f32x4*)(xr + col);
                        ss += (v[0] * v[0] + v[1] * v[1]) + (v[2] * v[2] + v[3] * v[3]);
                        const f32x4 g = *(const f32x4*)(nrm + col) * (*(const f32x4*)(scl + col) + 1.f), y = v * g;
                        u32x2 w; w.x = cvtpk(y[0], y[1]); w.y = cvtpk(y[2], y[3]); *(u32x2*)(Ap + (size_t)R * DM + col) = w;
                        u32x2 hw; hw.x = cvtpk(v[0], v[1]); hw.y = cvtpk(v[2], v[3]);
                        *(u32x2*)((R < TL ? (bf16_t*)a.out + (size_t)R * DM : (bf16_t*)hctx + (size_t)(R - TL) * DM) + col) = hw; }
                    ss = wave_sum(ss);
                    if (lane == 0) ssq[R] = ss;
                }
            }
        } else if (ph == 22) {
            const float* fn = a.in[I_FNORM]; const int gw = blockIdx.x * 8 + wave, NGW = gridDim.x * 8;
            for (int R = gw; R < TL; R += NGW) {
                const float r = __builtin_amdgcn_rsqf(ssq[(size_t)6 * TT + R] * (1.f / DM) + EPS);
                const float* hrow = (const float*)(ws + WS_AP) + (size_t)R * DM; float* orow = a.out + (size_t)R * DM;
#pragma unroll
                for (int c4 = 0; c4 < 4; ++c4) { const int col = c4 * 256 + lane * 4; const f32x4 v = *(const f32x4*)(hrow + col) * r * *(const f32x4*)(fn + col); *(f32x4*)(orow + col) = v; }
            }
        } else {
            const int l = ph < 11 ? 0 : 1, sp = ph < 11 ? ph - 2 : ph - 13;
            const float* modl = modraw + (size_t)l * 17 * NMOD;
            const int nMall = TT / 256, nMlat = TL / 256;
            if (sp == 0 || sp == 7) {
                const bool f1 = sp == 0; const int nM = (f1 || l == 0) ? nMall : nMlat;
                pg8::TileSched S = pg8::make_sched(nM, 2 * DFF / 256, DM);
                pg8::EpiSwiGLU E{(bf16_t*)(ws + WS_G), (const float*)(ws + (f1 ? WS_B13A : WS_B13B)), ssq + (size_t)(3 * l + (f1 ? 0 : 2)) * TT};
                pg8::gemm_phase(tid, ldsl, Ap, DM, (const bf16_t*)(ws + (f1 ? WS_W13A : WS_W13B)), DM, S, E);
            } else if (sp == 1 || sp == 8 || sp == 6) {
                if (STAGGER_TICKS > 0) {
                    if (tid == 0) { const unsigned long long t0 = __builtin_amdgcn_s_memrealtime(); const unsigned long long d = (unsigned long long)((blockIdx.x & 7) * STAGGER_TICKS);
                        while (__builtin_amdgcn_s_memrealtime() - t0 < d) __builtin_amdgcn_s_sleep(4); }
                    __syncthreads();
                }
                const int nM = (sp == 1 || l == 0) ? nMall : nMlat;
                const int j = sp == 1 ? 0 : (sp == 6 ? 1 : 2);
                const bool lastg = (l == 1 && sp == 8);
                const int ln = (sp == 8) ? l + 1 : l, jn = (sp == 8) ? 0 : j + 1;
                const float* nrm = lastg ? nullptr : (jn == 0 ? a.in[I_NFFN1] : (jn == 1 ? a.in[I_NMIX] : a.in[I_NFFN2])) + (size_t)ln * DM;
                const float* scl = lastg ? nullptr : modraw + (size_t)ln * 17 * NMOD + (3 * jn + 1) * DM;
                float* ssqn = ssq + (size_t)(3 * l + j + 1) * TT;
                pg8::EpiRes E{(uintptr_t)a.out, (uintptr_t)hctx - (uintptr_t)a.out, lastg ? (float*)(ws + WS_AP) : nullptr, modl + (3 * j + 2) * DM, sp == 6 ? 1.0f : 0.5f, nrm, scl, ssqn, lastg ? nullptr : Ap, dry};
                const bool wo = sp == 6; const int Kd = wo ? DM : DFF;
                pg8::TileSched S = (wo || nM != nMall) ? pg8::make_sched(nM, DM / 256, Kd) : pg8::make_ctxtail(Kd, (float*)(ws + WS_P), (unsigned*)(ws + WS_CTL) + 64, (unsigned)(ph + 1));
                if (XCD_OFFSET) pg8::add_xcd_offset(S, Kd, (float*)(ws + (wo ? WS_G : WS_P)));
                pg8::gemm_phase(tid, ldsl, (const bf16_t*)(ws + (wo ? WS_P : WS_G)), Kd, (const bf16_t*)(ws + (wo ? WS_WOUT : (sp == 1 ? WS_W2A : WS_W2B))), Kd, S, E);
            } else if (sp == 2) {
                pg8::TileSched S = pg8::make_sched(l == 0 ? nMall : nMlat, NIN / 256, DM);
                if (l == 1) { S.n2 = TC / 256; S.pm0_2 = nMlat; S.pn0_2 = 2; }
                pg8::EpiIn E{(bf16_t*)(ws + WS_P), (bf16_t*)(ws + WS_G), (const float*)(ws + WS_BIN), ssq + (size_t)(3 * l + 1) * TT};
                pg8::gemm_phase(tid, ldsl, Ap, DM, (const bf16_t*)(ws + WS_WIN), DM, S, E);
            } else if (sp == 3) {
                post_phase(tid, a, l, lds);
            } else if (sp == 4) {
                attn_phase(tid, a, l, lds, dry);
            } else if (sp == 5) {
                pg8::TileSched S = pg8::make_sched(l == 0 ? nMall : nMlat, DM / 256, DM);
                S.nb = 3;
                pg8::EpiMerge E{(const bf16_t*)(ws + WS_G), (bf16_t*)(ws + WS_P)};
                pg8::gemm_phase(tid, ldsl, Ap, DM, (const bf16_t*)(ws + WS_WCAT), DM, S, E);
            }
        }
        if (REPEAT_MASK != 0) { if (dry) { second = 1; --ph; __syncthreads(); continue; } second = 0; }
        if (ph + 1 < a.ph_hi) {
            asm volatile("s_waitcnt vmcnt(0) lgkmcnt(0)" ::: "memory");
            __syncthreads();
            if (ph == a.ph_lo) { if (tid == 0) __builtin_amdgcn_fence(__ATOMIC_RELEASE, "agent"); grid.sync(); if (tid == 0) __builtin_amdgcn_fence(__ATOMIC_ACQUIRE, "agent"); }
            else {
              for (int bb = 0; bb <= EXTRA_BAR; ++bb) {
                if (tid == 0) {
                    unsigned* ctl = (unsigned*)(ws + WS_CTL);
                    const unsigned G_ = gridDim.x, g_ = blockIdx.x & 7u, ngrp = G_ < 8u ? G_ : 8u, memb = (G_ - g_ + 7u) >> 3;
                    unsigned* gcnt = ctl + 2304 + 64 * g_; unsigned* ggen = ctl + 2816 + 64 * g_; unsigned* top = ctl + 3328;
                    __builtin_amdgcn_fence(__ATOMIC_RELEASE, "agent");
                    ++nbar;
                    const unsigned old = __hip_atomic_fetch_add(gcnt, 1u, __ATOMIC_RELAXED, __HIP_MEMORY_SCOPE_AGENT);
                    if (old + 1u == nbar * memb) {
                        __hip_atomic_fetch_add(top, 1u, __ATOMIC_RELAXED, __HIP_MEMORY_SCOPE_AGENT);
                        while (__hip_atomic_load(top, __ATOMIC_RELAXED, __HIP_MEMORY_SCOPE_AGENT) < nbar * ngrp) __builtin_amdgcn_s_sleep(1);
                        __hip_atomic_store(ggen, nbar, __ATOMIC_RELAXED, __HIP_MEMORY_SCOPE_AGENT);
                    } else {
                        while (__hip_atomic_load(ggen, __ATOMIC_RELAXED, __HIP_MEMORY_SCOPE_AGENT) < nbar) __builtin_amdgcn_s_sleep(1);
                    }
                    __builtin_amdgcn_fence(__ATOMIC_ACQUIRE, "agent");
                }
                if (EXTRA_BAR) { asm volatile("s_waitcnt vmcnt(0)" ::: "memory"); __syncthreads(); }
              }
            }
            asm volatile("s_waitcnt vmcnt(0)" ::: "memory");
            __syncthreads();
        }
    }
}

extern "C" void kernel_launch(void* const* d_in, const int* in_sizes, int n_in, void* d_out, int out_size, void* d_ws, size_t ws_size, hipStream_t stream) {
    static int grid = 0;
    if (grid == 0) {
        if (n_in != 26 || out_size != TL * DM || ws_size < WS_END) { fprintf(stderr, "kernel_launch: unexpected shapes (n_in %d out %d ws %zu need %zu)\n", n_in, out_size, ws_size, (size_t)WS_END); grid = -1; return; }
        int dev = 0, cus = 0, per_cu = 0;
        if (hipGetDevice(&dev) != hipSuccess || hipDeviceGetAttribute(&cus, hipDeviceAttributeMultiprocessorCount, dev) != hipSuccess) { grid = -1; return; }
        if (hipFuncSetAttribute((const void*)fwd_megakernel, hipFuncAttributeMaxDynamicSharedMemorySize, LDS_BYTES) != hipSuccess) { fprintf(stderr, "kernel_launch: hipFuncSetAttribute failed\n"); grid = -1; return; }
        if (hipOccupancyMaxActiveBlocksPerMultiprocessor(&per_cu, (const void*)fwd_megakernel, 512, LDS_BYTES) != hipSuccess || per_cu < 1) per_cu = 1;
        (void)hipGetLastError();
        grid = cus * per_cu;
    }
    if (grid < 0) return;
    Args a{};
    for (int i = 0; i < 26; ++i) a.in[i] = (const float*)d_in[i];
    a.out = (float*)d_out; a.ws = (unsigned char*)d_ws;
#if MK_ONE_LAUNCH
    a.ph_lo = 0; a.ph_hi = NPHASES;
    if (hipMemsetAsync((char*)d_ws + WS_CTL, 0, 16384, stream) != hipSuccess) { fprintf(stderr, "memset failed\n"); return; }
    void* args[] = {&a};
    hipError_t e = hipLaunchCooperativeKernel((const void*)fwd_megakernel, dim3(grid), dim3(512), args, LDS_BYTES, stream);
    if (e != hipSuccess) fprintf(stderr, "cooperative launch failed: %s (grid %d)\n", hipGetErrorString(e), grid);
#else
    for (int ph = 0; ph < NPHASES; ++ph) {
        a.ph_lo = ph; a.ph_hi = ph + 1;
        hipLaunchKernelGGL(fwd_megakernel, dim3(grid), dim3(512), LDS_BYTES, stream, a);
    }
#endif
}
```

```cpp
#include <hip/hip_runtime.h>
#include <hip/hip_cooperative_groups.h>
#include <cstdio>
#include <cstdint>
namespace cg = cooperative_groups;

#ifndef REPEAT_MASK
#define REPEAT_MASK 0
#endif
#ifndef STAGGER_TICKS
#define STAGGER_TICKS 0
#endif
#ifndef XCD_OFFSET
#define XCD_OFFSET 0
#endif
#ifndef EXTRA_BAR
#define EXTRA_BAR 0
#endif
#ifndef MK_ONE_LAUNCH
#define MK_ONE_LAUNCH 1
#endif

#define LAS __attribute__((address_space(3)))
#define GAS __attribute__((address_space(1)))
typedef unsigned short bf16_t;
typedef short bf16x8 __attribute__((ext_vector_type(8)));
typedef float f32x4 __attribute__((ext_vector_type(4)));
typedef float f32x16 __attribute__((ext_vector_type(16)));
typedef unsigned u32x4 __attribute__((ext_vector_type(4)));
typedef unsigned u32x2 __attribute__((ext_vector_type(2)));
typedef float f32x2_t __attribute__((ext_vector_type(2)));
typedef __bf16 bf16x2_t __attribute__((ext_vector_type(2)));

constexpr int DM = 1024, NBATCH = 16, SEQ = 2048, CTXL = 256;
constexpr int TL = NBATCH * SEQ;
constexpr int TC = NBATCH * CTXL;
constexpr int TT = TL + TC;
constexpr int DFF = 2816, NIN = 4608, NPC = 1536, NGC = 3072, NMOD = 9 * DM;
constexpr int KVPOS = SEQ + CTXL;
constexpr float EPS = 1e-6f;
constexpr float QSCALE = 0.125f * 1.4426950408889634f;

constexpr size_t MiB = 1u << 20;
constexpr size_t al256(size_t x) { return (x + 255) & ~(size_t)255; }
constexpr size_t SZ_W13 = (size_t)2 * DFF * DM * 2, SZ_W2 = (size_t)DM * DFF * 2, SZ_WIN = (size_t)NIN * DM * 2, SZ_WSQ = (size_t)DM * DM * 2;
constexpr size_t WS_W13A = 0;
constexpr size_t WS_W2A = WS_W13A + SZ_W13;
constexpr size_t WS_WIN = WS_W2A + SZ_W2;
constexpr size_t WS_WCAT = WS_WIN + SZ_WIN;
constexpr size_t WS_WOUT = WS_WCAT + SZ_WSQ;
constexpr size_t WS_W13B = WS_WOUT + SZ_WSQ;
constexpr size_t WS_W2B = WS_W13B + SZ_W13;
constexpr size_t WS_SGUW = WS_W2B + SZ_W2;
constexpr size_t WS_MOD = al256(WS_SGUW + 4 * 128 * 128 * 2);
constexpr size_t WS_B13A = al256(WS_MOD + (size_t)2 * 17 * NMOD * 4);
constexpr size_t WS_BIN = al256(WS_B13A + (size_t)17 * 2 * DFF * 4);
constexpr size_t WS_B13B = al256(WS_BIN + (size_t)17 * NIN * 4);
constexpr size_t WS_SSQ = al256(WS_B13B + (size_t)17 * 2 * DFF * 4);
constexpr size_t WS_ROPE = al256(WS_SSQ + (size_t)7 * TT * 4);
constexpr size_t WS_HCTX = al256(WS_ROPE + (size_t)SEQ * 32 * 8);
constexpr size_t WS_AP = al256(WS_HCTX + (size_t)TC * DM * 4);
constexpr size_t WS_KB = al256(WS_AP + (size_t)TT * DM * 2);
constexpr size_t WS_VT = al256(WS_KB + (size_t)TT * 128 * 2);
constexpr size_t WS_P = al256(WS_VT + (size_t)NBATCH * 2 * 64 * KVPOS * 2);
constexpr size_t WS_G = al256(WS_P + (size_t)TT * NPC * 2);
constexpr size_t WS_CTL = al256(WS_G + (size_t)TT * NGC * 2);
constexpr size_t WS_END = WS_CTL + 16384;

constexpr int LDS_BYTES = 147456;
constexpr int NPHASES = 23;

__device__ __forceinline__ unsigned cvtpk(float lo, float hi) { f32x2_t v = {lo, hi}; bf16x2_t b = __builtin_convertvector(v, bf16x2_t); return __builtin_bit_cast(unsigned, b); }
__device__ __forceinline__ float bflo(unsigned u) { return __uint_as_float(u << 16); }
__device__ __forceinline__ float bfhi(unsigned u) { return __uint_as_float(u & 0xffff0000u); }
__device__ __forceinline__ float fexp(float x) { return __builtin_amdgcn_exp2f(x * 1.4426950408889634f); }
__device__ __forceinline__ float frcp(float x) { return __builtin_amdgcn_rcpf(x); }
__device__ __forceinline__ float sigm(float x) { return frcp(1.f + fexp(-x)); }
__device__ __forceinline__ float gelu_t(float x) { const float z = 0.7978845608028654f * (x + 0.044715f * x * x * x); return x * frcp(1.f + fexp(-2.f * z)); }
#define LDS_WAIT() asm volatile("s_waitcnt lgkmcnt(0)" ::: "memory")
__device__ __forceinline__ uintptr_t uni64(uintptr_t v) { const unsigned lo = __builtin_amdgcn_readfirstlane((unsigned)v), hi = __builtin_amdgcn_readfirstlane((unsigned)(v >> 32)); return ((uintptr_t)hi << 32) | lo; }

namespace pg8 {
constexpr int BM = 256, BK = 64, HALF = 128, HTB = HALF * BK * 2, STAGE_BYTES = 8 * HTB, NXCD = 8, WGM = 4;
__device__ __forceinline__ int lds_byte(int r, int c) { const int st = (r >> 4) * 2 + (c >> 5), rr = r & 15, cc = c & 31, ob = rr * 64 + cc * 2; return st * 1024 + (ob ^ (((ob >> 9) & 1) << 5)); }
__device__ __forceinline__ void stage_rc(int b, int& R, int& C) { const int st = b / 1024, sb = b % 1024, swz = sb ^ (((sb >> 9) & 1) << 5); R = (st >> 1) * 16 + swz / 64; C = (st & 1) * 32 + (swz % 64) / 2; }
__device__ __forceinline__ int perm32(int rho) { const int n = rho >> 4, i = rho & 15; return 8 * (i >> 2) + 4 * n + (i & 3); }

struct Unit { int pm, pn, k0, nt, tag, te; };

struct TileSched {
    int c, G, nM1, nN1, n1, pn0_1, n2, pm0_2, pn0_2, nb, ntk;
    int sk, P, R, xo, kx; float* slots; unsigned* flags; unsigned epoch;
    __device__ __forceinline__ void map_tile(int L, int& pm, int& pn) const {
        int wgid; { const int q = n1 / NXCD, r = n1 % NXCD, xcd = L % NXCD, off = L / NXCD; wgid = (xcd < r ? xcd * (q + 1) : r * (q + 1) + (xcd - r) * q) + off; }
        const int nig = WGM * nN1, gid = wgid / nig, fm = gid * WGM, gsz = (nM1 - fm) < WGM ? (nM1 - fm) : WGM;
        pm = fm + ((wgid % nig) % gsz); pn = pn0_1 + (wgid % nig) / gsz;
    }
    __device__ __forceinline__ bool next(int i, Unit& u) const {
        int L = c, k0 = 0, nt = ntk, tag = 0; bool valid, ctxp = false, rect2 = false;
        if (xo) {
            const int nr = sk ? R : (c < n1 ? (n1 - c + G - 1) / G : 0);
            const int extra = (kx > 0 && nr > 0) ? 1 : 0;
            const bool inmain = i < nr + extra, first = (i == 0) && (extra != 0), last = inmain && (i >= nr);
            L = (i == 0 || last) ? c : i * G + c;
            k0 = first ? kx * 128 : 0; nt = first ? ntk - 2 * kx : (last ? 2 * kx : ntk); tag = first ? 4 : (last ? 8 : 0);
            ctxp = (sk != 0) && (i == nr + extra);
            valid = inmain || ctxp;
        } else if (sk) {
            L = i * G + c; ctxp = (i == R); valid = i <= R;
        } else {
            int ti = i, br = 0;
            if (nb == 3) { ti = i / 3; br = i - ti * 3; k0 = br * 256 + (br >> 1) * 256; nt = 4 + 4 * (br & 1); tag = br; }
            L = ti * G + c; rect2 = L >= n1; valid = L < n1 + n2;
        }
        if (!valid) return false;
        int pm, pn;
        map_tile((ctxp || rect2) ? 0 : L, pm, pn);
        if (ctxp) {
            const int x = c & 7, idx = c >> 3, tix = idx >> 2, part = idx & 3, pb = P >> 2, pr = P & 3;
            const int p0 = part * pb + (part < pr ? part : pr), p1 = (part + 1) * pb + (part + 1 < pr ? part + 1 : pr);
            pm = 128 + 2 * x + (tix >> 2); pn = tix & 3; k0 = p0 * 128; nt = 2 * (p1 - p0); tag = part == 0 ? 2 : 1;
        }
        if (rect2) { pm = pm0_2 + (L - n1); pn = pn0_2; }
        u.pm = pm; u.pn = pn; u.k0 = k0; u.nt = nt; u.tag = tag; u.te = 0;
        return true;
    }
};
__device__ __forceinline__ TileSched make_sched(int nM1, int nN1, int K) {
    TileSched s; s.c = blockIdx.x; s.G = gridDim.x; s.nM1 = nM1; s.nN1 = nN1; s.n1 = nM1 * nN1; s.pn0_1 = 0; s.n2 = 0; s.pm0_2 = 0; s.pn0_2 = 0; s.nb = 1;
    s.ntk = K / BK; s.sk = 0; s.P = 1; s.R = 0; s.xo = 0; s.kx = 0; s.slots = nullptr; s.flags = nullptr; s.epoch = 0; return s;
}
__device__ __forceinline__ TileSched make_ctxtail(int K, float* slots, unsigned* flags, unsigned epoch) {
    if (gridDim.x != 256) return make_sched(TT / 256, 4, K);
    TileSched s = make_sched(TL / 256, 4, K);
    s.sk = 1; s.P = K / (2 * BK); s.R = 2; s.slots = slots; s.flags = flags; s.epoch = epoch;
    return s;
}

__device__ __forceinline__ void add_xcd_offset(TileSched& s, int K, float* slots) {
    if (gridDim.x != 256 || s.nb != 1 || s.n2 != 0) return;
    s.xo = 1; s.P = K / (2 * BK); s.kx = ((int)(blockIdx.x & 7) * s.P) >> 3; s.slots = slots;
}
__device__ __forceinline__ int unit_mb(const Unit& u) { return u.pm < 128 ? (u.pm >> 3) : 16; }

struct EpiSwiGLU {
    bf16_t* act; const float* bias; const float* ssq;
    __device__ __forceinline__ void operator()(f32x4 (&acc)[2][2][4][2], const Unit& u, int wr, int wc, int fr, int fq) const {
        const int mb = unit_mb(u);
        const float* bp = bias + (size_t)mb * (2 * DFF) + u.pn * 256 + wc * 32 + 8 * fq;
        f32x4 ba[2], bb[2];
#pragma unroll
        for (int n = 0; n < 2; ++n) { ba[n] = *(const f32x4*)(bp + 4 * n); bb[n] = *(const f32x4*)(bp + 128 + 4 * n); }
        const int row0 = u.pm * 256 + wr * 64 + fr;
        GAS bf16_t* op = (GAS bf16_t*)act + (size_t)row0 * DFF + u.pn * 128 + wc * 32 + 8 * fq;
        float rs[8];
#pragma unroll
        for (int g = 0; g < 8; ++g) rs[g] = ((const GAS float*)ssq)[row0 + (g >> 2) * 128 + (g & 3) * 16];
#pragma unroll
        for (int ai = 0; ai < 2; ++ai)
#pragma unroll
            for (int m = 0; m < 4; ++m) {
                const int ro = ai * 128 + m * 16;
                const float r = __builtin_amdgcn_rsqf(rs[ai * 4 + m] * (1.f / DM) + EPS);
                f32x4 a0 = acc[ai][0][m][0] * r + ba[0], a1 = acc[ai][0][m][1] * r + ba[1], b0 = acc[ai][1][m][0] * r + bb[0], b1 = acc[ai][1][m][1] * r + bb[1];
                f32x4 o0, o1;
#pragma unroll
                for (int i = 0; i < 4; ++i) { o0[i] = a0[i] * b0[i] * sigm(a0[i]); o1[i] = a1[i] * b1[i] * sigm(a1[i]); }
                u32x4 w; w.x = cvtpk(o0[0], o0[1]); w.y = cvtpk(o0[2], o0[3]); w.z = cvtpk(o1[0], o1[1]); w.w = cvtpk(o1[2], o1[3]);
                *(GAS u32x4*)(op + (size_t)ro * DFF) = w;
            }
    }
};
struct EpiIn {
    bf16_t* P; bf16_t* G; const float* bias; const float* ssq;
    __device__ __forceinline__ void operator()(f32x4 (&acc)[2][2][4][2], const Unit& u, int wr, int wc, int fr, int fq) const {
        const int mb = unit_mb(u);
        const int colt = u.pn * 256, cw = wc * 32 + 8 * fq;
        const float* bp = bias + (size_t)mb * NIN + colt + cw;
        f32x4 bv[2][2];
#pragma unroll
        for (int bj = 0; bj < 2; ++bj)
#pragma unroll
            for (int n = 0; n < 2; ++n) bv[bj][n] = *(const f32x4*)(bp + bj * 128 + 4 * n);
        const int row0 = u.pm * 256 + wr * 64 + fr;
        const bool gate = u.pn >= 6;
        GAS bf16_t* base = (GAS bf16_t*)P + (size_t)row0 * NPC + colt + cw;
        GAS unsigned char* gbase = (GAS unsigned char*)G + (size_t)row0 * NGC + (colt - NPC) + cw;
        float rs[8];
#pragma unroll
        for (int g = 0; g < 8; ++g) rs[g] = ((const GAS float*)ssq)[row0 + (g >> 2) * 128 + (g & 3) * 16];
#pragma unroll
        for (int ai = 0; ai < 2; ++ai)
#pragma unroll
            for (int m = 0; m < 4; ++m) {
                const int ro = ai * 128 + m * 16;
                const float r = __builtin_amdgcn_rsqf(rs[ai * 4 + m] * (1.f / DM) + EPS);
#pragma unroll
                for (int bj = 0; bj < 2; ++bj) {
                    f32x4 v0 = acc[ai][bj][m][0] * r + bv[bj][0], v1 = acc[ai][bj][m][1] * r + bv[bj][1];
                    if (gate) {
                        unsigned q0[4], q1[4];
#pragma unroll
                        for (int i = 0; i < 4; ++i) { q0[i] = (unsigned)fminf(fmaxf(sigm(v0[i]) * 255.f + 0.5f, 1.f), 255.f); q1[i] = (unsigned)fminf(fmaxf(sigm(v1[i]) * 255.f + 0.5f, 1.f), 255.f); }
                        u32x2 w; w.x = q0[0] | (q0[1] << 8) | (q0[2] << 16) | (q0[3] << 24); w.y = q1[0] | (q1[1] << 8) | (q1[2] << 16) | (q1[3] << 24);
                        *(GAS u32x2*)(gbase + (size_t)ro * NGC + bj * 128) = w;
                    } else {
                        u32x4 w; w.x = cvtpk(v0[0], v0[1]); w.y = cvtpk(v0[2], v0[3]); w.z = cvtpk(v1[0], v1[1]); w.w = cvtpk(v1[2], v1[3]);
                        *(GAS u32x4*)(base + (size_t)ro * NPC + bj * 128) = w;
                    }
                }
            }
    }
};
struct EpiRes {
    uintptr_t h_l, h_cd; float* out32; const float* gate; float coef; const float* nrm; const float* scl; float* ssq; bf16_t* Ap; int dry;
    __device__ __forceinline__ void operator()(f32x4 (&acc)[2][2][4][2], const Unit& u, int wr, int wc, int fr, int fq) const {
        const int mb = unit_mb(u);
        const bool lat = u.pm < 128;
        uintptr_t h_l = this->h_l, h_cd = this->h_cd; float* out32 = this->out32; const float* gate = this->gate; float coef = this->coef;
        const float* nrm = this->nrm; const float* scl = this->scl; float* ssq = this->ssq; bf16_t* Ap = this->Ap;
        h_l = uni64(h_l); h_cd = uni64(h_cd); out32 = (float*)uni64((uintptr_t)out32); gate = (const float*)uni64((uintptr_t)gate); coef = __uint_as_float(__builtin_amdgcn_readfirstlane(__float_as_uint(coef)));
        nrm = (const float*)uni64((uintptr_t)nrm); scl = (const float*)uni64((uintptr_t)scl); ssq = (float*)uni64((uintptr_t)ssq); Ap = (bf16_t*)uni64((uintptr_t)Ap);
        const int col0 = u.pn * 256 + wc * 32 + 8 * fq, row0 = u.pm * 256 + wr * 64 + fr, rowl = lat ? row0 : row0 - TL;
        GAS bf16_t* hb = (GAS bf16_t*)(h_l + (lat ? (uintptr_t)0 : h_cd)) + (size_t)rowl * DM + col0;
        GAS float* ho = (GAS float*)out32 + (size_t)rowl * DM + col0;
        f32x4 gc[2][2], gs[2][2];
#pragma unroll
        for (int bj = 0; bj < 2; ++bj)
#pragma unroll
            for (int n = 0; n < 2; ++n) {
                gc[bj][n] = *(const GAS f32x4*)(gate + (size_t)mb * NMOD + col0 + 128 * bj + 4 * n) * (dry ? 0.f : coef);
                if (Ap) gs[bj][n] = *(const GAS f32x4*)(nrm + col0 + 128 * bj + 4 * n) * (*(const GAS f32x4*)(scl + (size_t)mb * NMOD + col0 + 128 * bj + 4 * n) + 1.f);
                else gs[bj][n] = (f32x4){0.f, 0.f, 0.f, 0.f};
            }
        u32x4 hq[3][2];
#pragma unroll
        for (int g0 = 0; g0 < 2; ++g0)
#pragma unroll
            for (int bj = 0; bj < 2; ++bj) hq[g0][bj] = *(const GAS u32x4*)(hb + (size_t)((g0 >> 2) * 128 + (g0 & 3) * 16) * DM + 128 * bj);
#pragma unroll
        for (int g = 0; g < 8; ++g) {
            const int ai = g >> 2, m = g & 3;
            if (g < 6) {
#pragma unroll
                for (int bj = 0; bj < 2; ++bj) hq[(g + 2) % 3][bj] = *(const GAS u32x4*)(hb + (size_t)(((g + 2) >> 2) * 128 + ((g + 2) & 3) * 16) * DM + 128 * bj); }
            const int ro = ai * 128 + m * 16; const size_t off = (size_t)ro * DM;
            float ss = 0.f;
#pragma unroll
            for (int bj = 0; bj < 2; ++bj) {
                const u32x4 q = hq[g % 3][bj];
                const f32x4 h0 = (f32x4){bflo(q.x), bfhi(q.x), bflo(q.y), bfhi(q.y)} + gc[bj][0] * acc[ai][bj][m][0];
                const f32x4 h1 = (f32x4){bflo(q.z), bfhi(q.z), bflo(q.w), bfhi(q.w)} + gc[bj][1] * acc[ai][bj][m][1];
                if (out32) { *(GAS f32x4*)(ho + off + 128 * bj) = h0; *(GAS f32x4*)(ho + off + 128 * bj + 4) = h1; }
                else { u32x4 w; w.x = cvtpk(h0[0], h0[1]); w.y = cvtpk(h0[2], h0[3]); w.z = cvtpk(h1[0], h1[1]); w.w = cvtpk(h1[2], h1[3]); *(GAS u32x4*)(hb + off + 128 * bj) = w; }
                ss += (h0[0] * h0[0] + h0[1] * h0[1]) + (h0[2] * h0[2] + h0[3] * h0[3]) + (h1[0] * h1[0] + h1[1] * h1[1]) + (h1[2] * h1[2] + h1[3] * h1[3]);
                if (Ap) { const f32x4 a0 = h0 * gs[bj][0], a1 = h1 * gs[bj][1];
                    u32x4 w; w.x = cvtpk(a0[0], a0[1]); w.y = cvtpk(a0[2], a0[3]); w.z = cvtpk(a1[0], a1[1]); w.w = cvtpk(a1[2], a1[3]);
                    *(GAS u32x4*)((GAS bf16_t*)Ap + (size_t)(row0 + ro) * DM + col0 + 128 * bj) = w; }
            }
            ss += __shfl_xor(ss, 16); ss += __shfl_xor(ss, 32);
            if (fq == 0) (void)__hip_atomic_fetch_add((GAS float*)ssq + row0 + ro, dry ? 0.f : ss, __ATOMIC_RELAXED, __HIP_MEMORY_SCOPE_AGENT);
        }
    }
};
struct EpiMerge {
    const bf16_t* G; bf16_t* Mg;
    __device__ __forceinline__ void operator()(f32x4 (&acc)[2][2][4][2], const Unit& u, int wr, int wc, int fr, int fq) const {
        const int br = u.tag, col0 = u.pn * 256 + wc * 32 + 8 * fq, row0 = u.pm * 256 + wr * 64 + fr;
        const GAS unsigned char* g0 = (const GAS unsigned char*)G + (size_t)row0 * NGC + br * 1024 + col0;
        u32x2 gq[3][2], hq[3][2];
#pragma unroll
        for (int g_ = 0; g_ < 2; ++g_)
#pragma unroll
            for (int bj = 0; bj < 2; ++bj) { const GAS unsigned char* gp = g0 + (size_t)((g_ >> 2) * 128 + (g_ & 3) * 16) * NGC + 128 * bj;
                gq[g_][bj] = *(const GAS u32x2*)gp; hq[g_][bj] = (br < 2) ? *(const GAS u32x2*)(gp + 1024) : (u32x2){0x01010101u, 0x01010101u}; }
#pragma unroll
        for (int g_ = 0; g_ < 8; ++g_) {
            const int ai = g_ >> 2, m = g_ & 3;
            if (g_ < 6) {
#pragma unroll
                for (int bj = 0; bj < 2; ++bj) { const GAS unsigned char* gp = g0 + (size_t)(((g_ + 2) >> 2) * 128 + ((g_ + 2) & 3) * 16) * NGC + 128 * bj;
                    gq[(g_ + 2) % 3][bj] = *(const GAS u32x2*)gp; hq[(g_ + 2) % 3][bj] = (br < 2) ? *(const GAS u32x2*)(gp + 1024) : (u32x2){0x01010101u, 0x01010101u}; } }
            const int row = row0 + ai * 128 + m * 16;
#pragma unroll
            for (int bj = 0; bj < 2; ++bj) {
                const u32x2 g = gq[g_ % 3][bj];
                f32x4 s0, s1;
#pragma unroll
                for (int i = 0; i < 4; ++i) { s0[i] = (float)((g.x >> (8 * i)) & 255u); s1[i] = (float)((g.y >> (8 * i)) & 255u); }
                if (br < 2) {
                    const u32x2 h = hq[g_ % 3][bj];
#pragma unroll
                    for (int i = 0; i < 4; ++i) { s0[i] *= frcp((float)((h.x >> (8 * i)) & 255u)); s1[i] *= frcp((float)((h.y >> (8 * i)) & 255u)); }
                    acc[ai][bj][m][0] *= s0; acc[ai][bj][m][1] *= s1;
                } else {
                    const f32x4 v0 = acc[ai][bj][m][0] * s0 * (1.f / 255.f), v1 = acc[ai][bj][m][1] * s1 * (1.f / 255.f);
                    u32x4 w; w.x = cvtpk(v0[0], v0[1]); w.y = cvtpk(v0[2], v0[3]); w.z = cvtpk(v1[0], v1[1]); w.w = cvtpk(v1[2], v1[3]);
                    *(GAS u32x4*)((GAS bf16_t*)Mg + (size_t)row * DM + col0 + 128 * bj) = w;
                }
            }
        }
    }
};

template <class Epi>
__device__ __forceinline__ void gemm_phase(const int tid, LAS unsigned char* lds, const bf16_t* Ab, int lda, const bf16_t* Bb, int ldb, const TileSched& S, const Epi& E) {
    const int wid = __builtin_amdgcn_readfirstlane(tid >> 6), lane = tid & 63, wr = wid >> 2, wc = wid & 3, fr = lane & 15, fq = lane >> 4;
    unsigned voffA[2], voffB[2];
#pragma unroll
    for (int i = 0; i < 2; ++i) { int R, C; stage_rc(tid * 16 + i * 8192, R, C); const int Rb = (R & ~31) + perm32(R & 31);
        voffA[i] = (unsigned)(R * lda + C) * 2u; voffB[i] = (unsigned)(Rb * ldb + C) * 2u; }
    const size_t kstep = (size_t)(BK * 2);
    const size_t hsA = (size_t)HALF * lda * 2, hsB = (size_t)HALF * ldb * 2;
    const unsigned ldsw = (unsigned)wid * 1024u;
    const int aoff = lds_byte(wr * 64 + fr, fq * 8), boff = lds_byte(wc * 32 + fr, fq * 8);
#define PG8_SA(b, h) (((b) * 2 + (h)) * HTB)
#define PG8_SB(b, h) ((4 + (b) * 2 + (h)) * HTB)
#define PG8_STAGE(bufoff, gbase, voff) do { _Pragma("unroll") for (int _i = 0; _i < 2; ++_i) \
        __builtin_amdgcn_global_load_lds((const unsigned*)((const char*)(gbase) + (voff)[_i]), (LAS unsigned*)(lds + (bufoff) + ldsw + _i * 8192), 16, 0, 0); } while (0)
#define PG8_LDA(dst, b, h) do { _Pragma("unroll") for (int m = 0; m < 4; ++m) _Pragma("unroll") for (int k = 0; k < 2; ++k) dst[m][k] = *(const LAS bf16x8*)(lds + PG8_SA(b, h) + aoff + m * 2048 + k * 1024); } while (0)
#define PG8_LDB(dst, b, h) do { _Pragma("unroll") for (int n = 0; n < 2; ++n) _Pragma("unroll") for (int k = 0; k < 2; ++k) dst[n][k] = *(const LAS bf16x8*)(lds + PG8_SB(b, h) + boff + n * 2048 + k * 1024); } while (0)
#define PG8_MMA(ai, bj, At, Bt) do { __builtin_amdgcn_s_setprio(1); _Pragma("unroll") for (int m = 0; m < 4; ++m) _Pragma("unroll") for (int n = 0; n < 2; ++n) _Pragma("unroll") for (int k = 0; k < 2; ++k) \
        acc[ai][bj][m][n] = __builtin_amdgcn_mfma_f32_16x16x32_bf16(Bt[n][k], At[m][k], acc[ai][bj][m][n], 0, 0, 0); __builtin_amdgcn_s_setprio(0); } while (0)
#define PG8_WAIT_V(n) asm volatile("s_waitcnt vmcnt(" #n ")" ::: "memory")
#define PG8_WAIT_L(n) asm volatile("s_waitcnt lgkmcnt(" #n ")" ::: "memory")
#define PG8_BAR __builtin_amdgcn_s_barrier()
#define PG8_SCHED __builtin_amdgcn_sched_barrier(0)
    Unit cur, nxt; int ui = 0;
    if (!S.next(0, cur)) return;
    f32x4 acc[2][2][4][2];
#pragma unroll
    for (int a = 0; a < 2; ++a)
#pragma unroll
        for (int b = 0; b < 2; ++b)
#pragma unroll
            for (int m = 0; m < 4; ++m)
#pragma unroll
                for (int n = 0; n < 2; ++n) acc[a][b][m][n] = (f32x4){0.f, 0.f, 0.f, 0.f};
    bf16x8 At[4][2], B0[2][2], B1[2][2];
    const char* cA = (const char*)Ab + (size_t)cur.pm * 2 * hsA + (size_t)cur.k0 * 2; const char* cB = (const char*)Bb + (size_t)cur.pn * 2 * hsB + (size_t)cur.k0 * 2;
    PG8_STAGE(PG8_SB(0, 0), cB, voffB); PG8_STAGE(PG8_SB(0, 1), cB + hsB, voffB); PG8_STAGE(PG8_SA(0, 0), cA, voffA); PG8_STAGE(PG8_SA(0, 1), cA + hsA, voffA);
    if (wr == 1) PG8_BAR;
    PG8_WAIT_V(2); PG8_BAR;
    PG8_STAGE(PG8_SB(1, 0), cB + kstep, voffB); PG8_STAGE(PG8_SA(1, 0), cA + kstep, voffA); PG8_STAGE(PG8_SB(1, 1), cB + hsB + kstep, voffB);
    PG8_WAIT_V(6); PG8_BAR;
    for (;;) {
        const bool has_next = S.next(ui + 1, nxt);
        const char* nA = has_next ? (const char*)Ab + (size_t)nxt.pm * 2 * hsA + (size_t)nxt.k0 * 2 : cA;
        const char* nB = has_next ? (const char*)Bb + (size_t)nxt.pn * 2 * hsB + (size_t)nxt.k0 * 2 : cB;
        const int nt = cur.nt;
        for (int t = 0; t < nt; t += 2) {
            const bool last = (t == nt - 2);
            const char* a1 = cA + (size_t)(t + 1) * kstep;
            const char* a2 = last ? nA : cA + (size_t)(t + 2) * kstep; const char* b2 = last ? nB : cB + (size_t)(t + 2) * kstep;
            const char* a3 = a2 + kstep; const char* b3 = b2 + kstep;
            PG8_LDB(B0, 0, 0); PG8_LDB(B1, 0, 1); PG8_SCHED; PG8_LDA(At, 0, 0); PG8_STAGE(PG8_SA(1, 1), a1 + hsA, voffA);
            PG8_WAIT_V(8); PG8_WAIT_L(0); PG8_BAR; PG8_MMA(0, 0, At, B0); PG8_MMA(0, 1, At, B1); PG8_BAR; PG8_SCHED;
            PG8_LDA(At, 0, 1); PG8_STAGE(PG8_SB(0, 0), b2, voffB); PG8_STAGE(PG8_SB(0, 1), b2 + hsB, voffB); PG8_STAGE(PG8_SA(0, 0), a2, voffA);
            PG8_WAIT_V(8); PG8_WAIT_L(0); PG8_BAR; PG8_MMA(1, 0, At, B0); PG8_MMA(1, 1, At, B1); PG8_BAR; PG8_SCHED;
            PG8_LDB(B0, 1, 0); PG8_LDB(B1, 1, 1); PG8_SCHED; PG8_LDA(At, 1, 0); PG8_STAGE(PG8_SA(0, 1), a2 + hsA, voffA);
            PG8_WAIT_V(8); PG8_WAIT_L(0); PG8_BAR; PG8_MMA(0, 0, At, B0); PG8_MMA(0, 1, At, B1); PG8_BAR; PG8_SCHED;
            PG8_LDA(At, 1, 1); PG8_STAGE(PG8_SB(1, 0), b3, voffB); PG8_STAGE(PG8_SB(1, 1), b3 + hsB, voffB); PG8_STAGE(PG8_SA(1, 0), a3, voffA);
            PG8_WAIT_V(8); PG8_WAIT_L(0); PG8_BAR; PG8_MMA(1, 0, At, B0); PG8_MMA(1, 1, At, B1); PG8_BAR; PG8_SCHED;
        }
        if (wr == 0) PG8_BAR;
        const bool xch = S.sk || S.xo;
        if (xch && (cur.tag & 10)) {
            const int np = (cur.tag & 2) ? 3 : 1;
#pragma unroll 1
            for (int pp = 1; pp <= np; ++pp) {
                const int j = (cur.tag & 2) ? S.c + 8 * pp : S.c;
                if (cur.tag & 2) {
                    unsigned* fl = S.flags + j * 8 + wid;
                    if (lane == 0) { while (__hip_atomic_load(fl, __ATOMIC_RELAXED, __HIP_MEMORY_SCOPE_AGENT) != S.epoch) __builtin_amdgcn_s_sleep(1); }
                }
                asm volatile("" ::: "memory");
                const unsigned long long* sp = (const unsigned long long*)(S.slots + (size_t)j * 65536 + wid * 8192) + lane; asm volatile("" : "+v"(sp));
#pragma unroll
                for (int a = 0; a < 2; ++a)
#pragma unroll
                    for (int b = 0; b < 2; ++b)
#pragma unroll
                        for (int m = 0; m < 4; ++m) {
#pragma unroll
                            for (int n = 0; n < 2; ++n) {
                                const unsigned long long v0 = __hip_atomic_load(sp, __ATOMIC_RELAXED, __HIP_MEMORY_SCOPE_AGENT), v1 = __hip_atomic_load(sp + 64, __ATOMIC_RELAXED, __HIP_MEMORY_SCOPE_AGENT);
                                acc[a][b][m][n][0] += __uint_as_float((unsigned)v0); acc[a][b][m][n][1] += __uint_as_float((unsigned)(v0 >> 32));
                                acc[a][b][m][n][2] += __uint_as_float((unsigned)v1); acc[a][b][m][n][3] += __uint_as_float((unsigned)(v1 >> 32));
                                sp += 128; }
                            if (m & 1) asm volatile("" : "+v"(sp) :: "memory");
                        }
            }
        }
        if (xch && (cur.tag & 5)) {
            unsigned long long* sp = (unsigned long long*)(S.slots + (size_t)S.c * 65536 + wid * 8192) + lane; asm volatile("" : "+v"(sp));
#pragma unroll
            for (int a = 0; a < 2; ++a)
#pragma unroll
                for (int b = 0; b < 2; ++b)
#pragma unroll
                    for (int m = 0; m < 4; ++m)
#pragma unroll
                        for (int n = 0; n < 2; ++n) {
                            const f32x4 v = acc[a][b][m][n];
                            __hip_atomic_store(sp, (unsigned long long)__float_as_uint(v[0]) | ((unsigned long long)__float_as_uint(v[1]) << 32), __ATOMIC_RELAXED, __HIP_MEMORY_SCOPE_AGENT);
                            __hip_atomic_store(sp + 64, (unsigned long long)__float_as_uint(v[2]) | ((unsigned long long)__float_as_uint(v[3]) << 32), __ATOMIC_RELAXED, __HIP_MEMORY_SCOPE_AGENT);
                            sp += 128; asm volatile("" : "+v"(sp)); }
            if (cur.tag & 1) { asm volatile("s_waitcnt vmcnt(0)" ::: "memory");
                if (lane == 0) __hip_atomic_store(S.flags + S.c * 8 + wid, S.epoch, __ATOMIC_RELAXED, __HIP_MEMORY_SCOPE_AGENT); }
        } else E(acc, cur, wr, wc, fr, fq);
        if (!has_next) break;
        if (!(S.nb == 3 && nxt.tag != 0)) {
#pragma unroll
        for (int a = 0; a < 2; ++a)
#pragma unroll
            for (int b = 0; b < 2; ++b)
#pragma unroll
                for (int m = 0; m < 4; ++m)
#pragma unroll
                    for (int n = 0; n < 2; ++n) acc[a][b][m][n] = (f32x4){0.f, 0.f, 0.f, 0.f};
        }
        cur = nxt; cA = nA; cB = nB; ++ui;
        if (wr == 1) PG8_BAR;
    }
    PG8_WAIT_V(0);
    PG8_BAR;
#undef PG8_SA
#undef PG8_SB
#undef PG8_STAGE
#undef PG8_LDA
#undef PG8_LDB
#undef PG8_MMA
#undef PG8_WAIT_V
#undef PG8_WAIT_L
#undef PG8_BAR
#undef PG8_SCHED
}
}

struct Args {
    const float* in[26];
    float* out; unsigned char* ws;
    int ph_lo, ph_hi;
};
enum { I_X = 0, I_C, I_CTX, I_CCTX, I_WADA, I_BADA, I_NFFN1, I_F1W13, I_F1W2, I_NMIX, I_WIN, I_QN, I_KN, I_POOLW, I_POOLS, I_SGUN, I_SGUW, I_SGUB,
       I_WBRP, I_WBRA, I_WBRS, I_WOUT, I_NFFN2, I_F2W13, I_F2W2, I_FNORM };

__device__ __forceinline__ float wave_sum(float v) {
#pragma unroll
    for (int o = 1; o < 64; o <<= 1) v += __shfl_xor(v, o);
    return v;
}

__device__ __forceinline__ void tr_item(const float* W, int N, bf16_t* WT, int ldt, int coloff, int mode13, float* scr, int item, int lane) {
    const int nblk = N / 32, kb = item / nblk, nb = item - kb * nblk, k0 = 64 * kb, n0 = 32 * nb;
#pragma unroll 8
    for (int i = 0; i < 32; ++i) { const int kk = 2 * i + (lane >> 5); scr[kk * 33 + (lane & 31)] = W[(size_t)(k0 + kk) * N + n0 + (lane & 31)]; }
    LDS_WAIT();
    int r0 = n0;
    if (mode13) { const int s = n0 / DFF, rem = n0 - s * DFF, t = rem >> 7, j = rem & 127; r0 = 256 * t + 128 * s + j; }
    const int c = lane & 7;
#pragma unroll
    for (int j = 0; j < 4; ++j) { const int n = (lane >> 3) + 8 * j; const float* s = scr + (8 * c) * 33 + n;
        u32x4 o; o.x = cvtpk(s[0 * 33], s[1 * 33]); o.y = cvtpk(s[2 * 33], s[3 * 33]); o.z = cvtpk(s[4 * 33], s[5 * 33]); o.w = cvtpk(s[6 * 33], s[7 * 33]);
        *(u32x4*)(WT + (size_t)(r0 + n) * ldt + coloff + k0 + 8 * c) = o; }
    LDS_WAIT();
}

__device__ __forceinline__ void convert_weights(const int tid, const Args& a, int l, unsigned char* lds) {
    const int lane = tid & 63, wave = tid >> 6;
    float* scr = (float*)(lds + wave * 8704);
    const int gw = blockIdx.x * 8 + wave, NGW = gridDim.x * 8;
    unsigned char* ws = a.ws;
    constexpr int I13 = (DM / 64) * (2 * DFF / 32), I2 = (DFF / 64) * (DM / 32), IIN = (DM / 64) * (NIN / 32), IOUT = (DM / 64) * (DM / 32), IBA = (512 / 64) * (DM / 32), IBS = (256 / 64) * (DM / 32);
    constexpr int NITEMS = 2 * I13 + 2 * I2 + IIN + IOUT + IBA + IBS;
    for (int it = gw; it < NITEMS; it += NGW) {
        int r = it; const float* W; int N; bf16_t* WT; int ldt = DM, coloff = 0, m13 = 0;
        if (r < 2 * I13) { const bool second = r >= I13; r -= second ? I13 : 0; W = a.in[second ? I_F2W13 : I_F1W13] + (size_t)l * DM * 2 * DFF; N = 2 * DFF; WT = (bf16_t*)(ws + (second ? WS_W13B : WS_W13A)); m13 = 1; }
        else if (r < 2 * I13 + 2 * I2) { r -= 2 * I13; const bool second = r >= I2; r -= second ? I2 : 0; W = a.in[second ? I_F2W2 : I_F1W2] + (size_t)l * DFF * DM; N = DM; WT = (bf16_t*)(ws + (second ? WS_W2B : WS_W2A)); ldt = DFF; }
        else if (r < 2 * I13 + 2 * I2 + IIN) { r -= 2 * I13 + 2 * I2; W = a.in[I_WIN] + (size_t)l * DM * NIN; N = NIN; WT = (bf16_t*)(ws + WS_WIN); }
        else if (r < 2 * I13 + 2 * I2 + IIN + IOUT) { r -= 2 * I13 + 2 * I2 + IIN; W = a.in[I_WOUT] + (size_t)l * DM * DM; N = DM; WT = (bf16_t*)(ws + WS_WOUT); }
        else if (r < 2 * I13 + 2 * I2 + IIN + IOUT + IBA) { r -= 2 * I13 + 2 * I2 + IIN + IOUT; W = a.in[I_WBRA] + (size_t)l * 512 * DM; N = DM; WT = (bf16_t*)(ws + WS_WCAT); coloff = 256; }
        else { r -= 2 * I13 + 2 * I2 + IIN + IOUT + IBA; W = a.in[I_WBRS] + (size_t)l * 256 * DM; N = DM; WT = (bf16_t*)(ws + WS_WCAT); coloff = 768; }
        tr_item(W, N, WT, ldt, coloff, m13, scr, r, lane);
    }
    {
        const float* pw = a.in[I_POOLW] + (size_t)l * 4 * 64 * 64; const float* ps = a.in[I_POOLS] + (size_t)l * 256; const float* wb = a.in[I_WBRP] + (size_t)l * 256 * DM;
        bf16_t* wcat = (bf16_t*)(ws + WS_WCAT);
        for (int it = blockIdx.x * 512 + tid; it < 1024 * 32; it += gridDim.x * 512) {
            const int n = it & 1023, kg = it >> 10, g = kg >> 3, c0 = (kg & 7) * 8;
            float s[8];
#pragma unroll
            for (int i = 0; i < 8; ++i) s[i] = 0.f;
            for (int d = 0; d < 64; ++d) {
                const float wv = wb[(size_t)(g * 64 + d) * DM + n] * ps[g * 64 + d];
#pragma unroll
                for (int i = 0; i < 8; ++i) s[i] += pw[(g * 64 + c0 + i) * 64 + d] * wv;
            }
            u32x4 o; o.x = cvtpk(s[0], s[1]); o.y = cvtpk(s[2], s[3]); o.z = cvtpk(s[4], s[5]); o.w = cvtpk(s[6], s[7]);
            *(u32x4*)(wcat + (size_t)n * DM + kg * 8) = o;
        }
    }
    {
        const float* sw = a.in[I_SGUW] + (size_t)l * 4 * 128 * 128; unsigned* dst = (unsigned*)(ws + WS_SGUW);
        for (int it = blockIdx.x * 512 + tid; it < 4 * 128 * 64; it += gridDim.x * 512) dst[it] = cvtpk(sw[2 * it], sw[2 * it + 1]);
    }
}

__device__ __forceinline__ void compute_biases(const int tid, const Args& a, int l, unsigned char* lds) {
    const int lane = tid & 63, wave = tid >> 6;
    float* sh = (float*)lds;
    const float* modl = (const float*)(a.ws + WS_MOD) + (size_t)l * 17 * NMOD;
    const int gw = blockIdx.x * 8 + wave, NGW = gridDim.x * 8;
    for (int j = 0; j < 3; ++j) {
        __syncthreads();
        for (int i = tid; i < 17 * DM; i += 512) sh[i] = modl[(size_t)(i >> 10) * NMOD + (3 * j) * DM + (i & 1023)];
        __syncthreads();
        const bf16_t* Wt = (const bf16_t*)(a.ws + (j == 0 ? WS_W13A : (j == 1 ? WS_WIN : WS_W13B)));
        float* bo = (float*)(a.ws + (j == 0 ? WS_B13A : (j == 1 ? WS_BIN : WS_B13B)));
        const int N = (j == 1) ? NIN : 2 * DFF;
        for (int n = gw; n < N; n += NGW) {
            float w[16];
#pragma unroll
            for (int c = 0; c < 4; ++c) { const u32x2 v = *(const u32x2*)(Wt + (size_t)n * DM + c * 256 + lane * 4); w[4 * c] = bflo(v.x); w[4 * c + 1] = bfhi(v.x); w[4 * c + 2] = bflo(v.y); w[4 * c + 3] = bfhi(v.y); }
            float mine = 0.f;
#pragma unroll 1
            for (int mb = 0; mb < 17; ++mb) {
                float p = 0.f;
#pragma unroll
                for (int c = 0; c < 4; ++c) { const f32x4 s = *(const f32x4*)(sh + mb * DM + c * 256 + lane * 4); p += w[4 * c] * s[0] + w[4 * c + 1] * s[1] + w[4 * c + 2] * s[2] + w[4 * c + 3] * s[3]; }
                p = wave_sum(p);
                if (lane == mb) mine = p;
            }
            if (lane < 17) bo[(size_t)lane * N + n] = mine;
        }
    }
}

__device__ __forceinline__ void post_phase(const int tid, const Args& a, int l, unsigned char* lds) {
    const int lane = tid & 63, wave = tid >> 6;
    unsigned char* ws = a.ws;
    const bf16_t* P = (const bf16_t*)(ws + WS_P);
    bf16_t* Bcat = (bf16_t*)(ws + WS_AP); bf16_t* kbuf = (bf16_t*)(ws + WS_KB); bf16_t* Vt = (bf16_t*)(ws + WS_VT);
    const float* rope = (const float*)(ws + WS_ROPE);
    const float* qn = a.in[I_QN] + l * 64; const float* kn = a.in[I_KN] + l * 64;
    const int nchf = (l == 0) ? 288 : 256;
    const int nSGU = nchf * 2, nPOOL = nchf, nV = 288, nQK = TT / 64, total = nSGU + nPOOL + nV + nQK;
    const int G_ = gridDim.x, c_ = blockIdx.x, nS_ = c_ < nSGU ? (nSGU - c_ + G_ - 1) / G_ : 0;
    for (int k_ = 0;; ++k_) {
        const int it = k_ < nS_ ? c_ + k_ * G_ : nSGU + (G_ - 1 - c_) + (k_ - nS_) * G_;
        if (it >= total) break;
        if (it < nSGU + nPOOL + nV) {
            const int ch = it < nSGU ? (it >> 1) : (it < nSGU + nPOOL ? it - nSGU : it - nSGU - nPOOL);
            const bool lat = ch < 256;
            const int b = lat ? (ch >> 4) : ((ch - 256) >> 1), t0 = lat ? (ch & 15) * 128 : ((ch - 256) & 1) * 128, L = lat ? SEQ : CTXL;
            const int Rb = lat ? b * SEQ : TL + b * CTXL, R0 = Rb + t0;
            if (it < nSGU) {
                const int gp = it & 1;
                bf16_t* vT = (bf16_t*)lds;
                bf16_t* Ws = (bf16_t*)(lds + 34816);
                const float* sn = a.in[I_SGUN] + l * 256;
                {
                    const bf16_t* wsrc = (const bf16_t*)(ws + WS_SGUW) + gp * 2 * 128 * 128;
#pragma unroll 4
                    for (int i2 = tid; i2 < 2 * 128 * 16; i2 += 512) { const int r = i2 >> 4, c = i2 & 15; *(u32x4*)(Ws + r * 136 + c * 8) = *(const u32x4*)(wsrc + r * 128 + c * 8); }
                }
#pragma unroll 2
                for (int i2 = tid; i2 < 128 * 32; i2 += 512) { const int l32 = i2 & 31, tok = i2 >> 5;
                    const u32x4 raw = *(const u32x4*)(P + (size_t)(R0 + tok) * NPC + 1280 + l32 * 8);
                    float x[8] = {bflo(raw.x), bfhi(raw.x), bflo(raw.y), bfhi(raw.y), bflo(raw.z), bfhi(raw.z), bflo(raw.w), bfhi(raw.w)};
                    float ss = 0.f;
#pragma unroll
                    for (int i = 0; i < 8; ++i) { x[i] = gelu_t(x[i]); ss += x[i] * x[i]; }
                    ss += __shfl_xor(ss, 1); ss += __shfl_xor(ss, 2); ss += __shfl_xor(ss, 4); ss += __shfl_xor(ss, 8); ss += __shfl_xor(ss, 16);
                    const float rinv = __builtin_amdgcn_rsqf(ss * (1.f / 256.f) + EPS);
                    if ((l32 >> 4) == gp) { const int cl = (l32 & 15) * 8;
#pragma unroll
                        for (int i = 0; i < 8; i += 2) { const unsigned pk = cvtpk(x[i] * rinv * sn[l32 * 8 + i], x[i + 1] * rinv * sn[l32 * 8 + i + 1]);
                            vT[(cl + i) * 136 + tok] = (bf16_t)(pk & 0xffffu); vT[(cl + i + 1) * 136 + tok] = (bf16_t)(pk >> 16); } }
                }
                __syncthreads();
                const int q32 = lane & 31, hi = lane >> 5, cblk = wave & 1, tblk = wave >> 1;
                const float* sb = a.in[I_SGUB] + (size_t)l * 4 * 128;
                const int tok = tblk * 32 + q32, R = R0 + tok;
#pragma unroll
                for (int g2 = 0; g2 < 2; ++g2) {
                    const int g = gp * 2 + g2;
                    u32x2 ur[4];
#pragma unroll
                    for (int rg = 0; rg < 4; ++rg) ur[rg] = *(const u32x2*)(P + (size_t)R * NPC + 1024 + g * 64 + cblk * 32 + 8 * rg + 4 * hi);
                    const float bias = sb[g * 128 + tok];
                    f32x16 acc;
#pragma unroll
                    for (int r = 0; r < 16; ++r) acc[r] = 0.f;
#pragma unroll
                    for (int ks = 0; ks < 8; ++ks) {
                        const bf16x8 af = *(const bf16x8*)(vT + (g2 * 64 + cblk * 32 + q32) * 136 + ks * 16 + hi * 8);
                        const bf16x8 bf = *(const bf16x8*)(Ws + (g2 * 128 + tblk * 32 + q32) * 136 + ks * 16 + hi * 8);
                        acc = __builtin_amdgcn_mfma_f32_32x32x16_bf16(af, bf, acc, 0, 0, 0);
                    }
#pragma unroll
                    for (int rg = 0; rg < 4; ++rg) {
                        const int c4 = g * 64 + cblk * 32 + 8 * rg + 4 * hi;
                        const float u0 = gelu_t(bflo(ur[rg].x)), u1 = gelu_t(bfhi(ur[rg].x)), u2 = gelu_t(bflo(ur[rg].y)), u3 = gelu_t(bfhi(ur[rg].y));
                        u32x2 w; w.x = cvtpk(u0 * (acc[4 * rg] + bias), u1 * (acc[4 * rg + 1] + bias)); w.y = cvtpk(u2 * (acc[4 * rg + 2] + bias), u3 * (acc[4 * rg + 3] + bias));
                        *(u32x2*)(Bcat + (size_t)R * DM + 768 + c4) = w;
                    }
                }
            } else if (it < nSGU + nPOOL) {
                unsigned* xs = (unsigned*)lds;
#pragma unroll 3
                for (int i2 = tid; i2 < 144 * 32; i2 += 512) { const int rr = i2 >> 5, c = i2 & 31; const int s = t0 - 8 + rr;
                    u32x4 v = (u32x4){0u, 0u, 0u, 0u};
                    if (s >= 0 && s < L) v = *(const u32x4*)(P + (size_t)(Rb + s) * NPC + 768 + c * 8);
                    *(u32x4*)(xs + rr * 128 + c * 4) = v; }
                __syncthreads();
                const int cp = tid & 127, tg = tid >> 7, hw = 1 << (cp >> 5);
                for (int tt = tg * 32; tt < tg * 32 + 32; ++tt) {
                    const int t = t0 + tt; const int lo = (t - hw) < 0 ? 0 : (t - hw), hi = (t + hw) > L ? L : (t + hw);
                    float s0 = 0.f, s1 = 0.f;
                    for (int s = lo; s < hi; ++s) { const unsigned v = xs[(s - t0 + 8) * 128 + cp]; s0 += bflo(v); s1 += bfhi(v); }
                    const float ic = 1.f / (float)(hi - lo); const unsigned xv = xs[(tt + 8) * 128 + cp];
                    *(unsigned*)(Bcat + (size_t)(R0 + tt) * DM + 2 * cp) = cvtpk(s0 * ic - bflo(xv), s1 * ic - bfhi(xv));
                }
            } else {
                bf16_t* vs = (bf16_t*)lds;
#pragma unroll 4
                for (int i2 = tid; i2 < 128 * 16; i2 += 512) { const int tok = i2 >> 4, c = i2 & 15;
                    *(u32x4*)(vs + tok * 136 + c * 8) = *(const u32x4*)(P + (size_t)(R0 + tok) * NPC + 640 + c * 8); }
                __syncthreads();
                const int posbase = lat ? t0 : SEQ + t0;
                for (int i2 = tid; i2 < 128 * 16; i2 += 512) { const int vr = i2 & 127, pg = i2 >> 7;
                    unsigned short e[8];
#pragma unroll
                    for (int i = 0; i < 8; ++i) { const int p = pg * 8 + i; const int kap = (p & ~12) | ((p & 4) << 1) | ((p & 8) >> 1); e[i] = vs[kap * 136 + vr]; }
                    u32x4 w; w.x = e[0] | ((unsigned)e[1] << 16); w.y = e[2] | ((unsigned)e[3] << 16); w.z = e[4] | ((unsigned)e[5] << 16); w.w = e[6] | ((unsigned)e[7] << 16);
                    *(u32x4*)(Vt + ((size_t)(b * 2 + (vr >> 6)) * 64 + (vr & 63)) * KVPOS + posbase + pg * 8) = w; }
            }
            __syncthreads();
        } else {
            const int R0 = (it - (nSGU + nPOOL + nV)) * 64; const bool lat = R0 < TL;
            const bool full = lat || (l == 0);
            const int nh = full ? 10 : 2, hbase = full ? 0 : 8;
#pragma unroll 2
            for (int i2 = tid; i2 < 64 * nh * 8; i2 += 512) {
                const int l8 = i2 & 7, hr = i2 >> 3, tok = hr / nh, hh = hbase + (hr - tok * nh);
                const int R = R0 + tok; const bool isq = hh < 8;
                const bf16_t* src = P + (size_t)R * NPC + (isq ? hh * 64 : 512 + (hh - 8) * 64) + l8 * 8;
                const u32x4 raw = *(const u32x4*)src;
                float x[8] = {bflo(raw.x), bfhi(raw.x), bflo(raw.y), bfhi(raw.y), bflo(raw.z), bfhi(raw.z), bflo(raw.w), bfhi(raw.w)};
                float ss = 0.f;
#pragma unroll
                for (int i = 0; i < 8; ++i) ss += x[i] * x[i];
                ss += __shfl_xor(ss, 1); ss += __shfl_xor(ss, 2); ss += __shfl_xor(ss, 4);
                const float rinv = __builtin_amdgcn_rsqf(ss * (1.f / 64.f) + EPS);
                const float* gn = (isq ? qn : kn) + l8 * 8;
                const f32x4 g0 = *(const f32x4*)gn, g1 = *(const f32x4*)(gn + 4);
                float y[8], o[8];
#pragma unroll
                for (int i = 0; i < 4; ++i) { y[i] = x[i] * rinv * g0[i]; y[4 + i] = x[4 + i] * rinv * g1[i]; }
                const int t = R & (SEQ - 1);
                const int half = l8 >> 2, second = (l8 >> 1) & 1, fi0 = (l8 & 1) * 8;
                const f32x4* rp = (const f32x4*)(rope + ((size_t)t * 32 + half * 16 + fi0) * 2);
                f32x4 cs[4];
                if (lat) {
#pragma unroll
                    for (int i = 0; i < 4; ++i) cs[i] = rp[i];
                }
#pragma unroll
                for (int i = 0; i < 8; ++i) {
                    const float partner = __shfl_xor(y[i], 2);
                    if (lat) { const float cv = cs[i >> 1][(i & 1) * 2], sv = cs[i >> 1][(i & 1) * 2 + 1];
                        o[i] = second ? (y[i] * cv + partner * sv) : (y[i] * cv - partner * sv); }
                    else o[i] = y[i];
                }
                const float sc = isq ? QSCALE : 1.f;
                u32x4 w; w.x = cvtpk(o[0] * sc, o[1] * sc); w.y = cvtpk(o[2] * sc, o[3] * sc); w.z = cvtpk(o[4] * sc, o[5] * sc); w.w = cvtpk(o[6] * sc, o[7] * sc);
                bf16_t* dst = isq ? Bcat + (size_t)R * DM + 256 + hh * 64 + l8 * 8 : kbuf + (size_t)R * 128 + (hh - 8) * 64 + l8 * 8;
                *(u32x4*)dst = w;
            }
        }
    }
}

__device__ __forceinline__ void attn_phase(const int tid, const Args& a, int l, unsigned char* lds, int dry) {
    const int lane = tid & 63, w = tid >> 6, q32 = lane & 31, hi = lane >> 5;
    bf16_t* Bcat = (bf16_t*)(a.ws + WS_AP); const bf16_t* kbuf = (const bf16_t*)(a.ws + WS_KB); const bf16_t* Vt = (const bf16_t*)(a.ws + WS_VT);
    const int G = gridDim.x, c = blockIdx.x;
    const int per = (512 + G - 1) / G;
    const int nlat = (c * per >= 512) ? 0 : ((c + 1) * per > 512 ? 512 - c * per : per);
    const int nctx = (l == 0 && c < 64) ? (64 - c + G - 1) / G : 0;
    const int kr = tid >> 3, kc = tid & 7;
    float sshift;
    { float gq = 0.f, gk = 0.f; const float* qn = a.in[I_QN] + l * 64; const float* kn = a.in[I_KN] + l * 64;
      for (int i = 0; i < 64; ++i) { gq = fmaxf(gq, fabsf(qn[i])); gk = fmaxf(gk, fabsf(kn[i])); }
      const float sbound = QSCALE * 64.f * 1.02f * gq * gk; sshift = sbound > 64.f ? sbound - 64.f : 0.f; }
    const bool use_shift = __builtin_amdgcn_readfirstlane(__float_as_uint(sshift)) != 0u;
    for (int ui = 0; ui < nlat + nctx; ++ui) {
        int b, kvh, qrow0, jt0, NT;
        if (ui < nlat) { const int u = c * per + ui; const int bk = u >> 4, qb = u & 15; b = bk >> 1; kvh = bk & 1; qrow0 = b * SEQ + qb * 128; jt0 = 0; NT = 18; }
        else { const int u = c + (ui - nlat) * G; const int bk = u >> 1, qb = u & 1; b = bk >> 1; kvh = bk & 1; qrow0 = TL + b * CTXL + qb * 128; jt0 = 16; NT = 2; }
        const int head = kvh * 4 + (w >> 1); const int myrow = qrow0 + 64 * (w & 1) + q32;
        bf16_t* qp = Bcat + (size_t)myrow * DM + 256 + head * 64;
        bf16x8 qf[2][4];
#pragma unroll
        for (int sb = 0; sb < 2; ++sb)
#pragma unroll
            for (int ds = 0; ds < 4; ++ds) qf[sb][ds] = *(const bf16x8*)(qp + (size_t)sb * 32 * DM + 16 * ds + hi * 8);
        const int vr = tid >> 4, vc = tid & 15;
        const bf16_t* vsrc = Vt + ((size_t)(b * 2 + kvh) * 64 + vr) * KVPOS + vc * 8;
#define KSRC(jt) (kbuf + (size_t)(((jt) < 16 ? b * SEQ + 128 * (jt) : TL + b * CTXL + 128 * ((jt) - 16)) + kr) * 128 + kvh * 64 + kc * 8)
#define LDS_K(buf) (lds + (buf) * 18432)
#define LDS_V(buf) (lds + 36864 + (buf) * 17408)
        u32x4 kreg0 = *(const u32x4*)KSRC(jt0), kreg1 = *(const u32x4*)(KSRC(jt0) + 64 * 128);
        u32x4 vreg0 = *(const u32x4*)(vsrc + 128 * jt0), vreg1 = *(const u32x4*)(vsrc + 128 * jt0 + (size_t)32 * KVPOS);
        *(u32x4*)(LDS_K(0) + kr * 144 + kc * 16) = kreg0; *(u32x4*)(LDS_K(0) + (kr + 64) * 144 + kc * 16) = kreg1;
        *(u32x4*)(LDS_V(0) + vr * 272 + vc * 16) = vreg0; *(u32x4*)(LDS_V(0) + (vr + 32) * 272 + vc * 16) = vreg1;
        __syncthreads();
        f32x16 o0[2], o1[2];
        float lrun[2];
#pragma unroll
        for (int sb = 0; sb < 2; ++sb) { lrun[sb] = 0.f;
#pragma unroll
            for (int r = 0; r < 16; ++r) { o0[sb][r] = 0.f; o1[sb][r] = 0.f; } }
        for (int j = 0; j < NT; ++j) {
            if (j + 1 < NT) { kreg0 = *(const u32x4*)KSRC(jt0 + j + 1); kreg1 = *(const u32x4*)(KSRC(jt0 + j + 1) + 64 * 128);
                vreg0 = *(const u32x4*)(vsrc + 128 * (jt0 + j + 1)); vreg1 = *(const u32x4*)(vsrc + 128 * (jt0 + j + 1) + (size_t)32 * KVPOS); }
#pragma unroll 1
            for (int h = 0; h < 2; ++h) {
            const unsigned char* Kb = LDS_K(j & 1) + h * 64 * 144; const unsigned char* Vb = LDS_V(j & 1) + h * 128;
            f32x16 p0[2], p1[2];
            const f32x16 czero = {0.f, 0.f, 0.f, 0.f, 0.f, 0.f, 0.f, 0.f, 0.f, 0.f, 0.f, 0.f, 0.f, 0.f, 0.f, 0.f};
#pragma unroll
            for (int ds = 0; ds < 4; ++ds) {
                const bf16x8 k0 = *(const bf16x8*)(Kb + q32 * 144 + ds * 32 + hi * 16);
                const bf16x8 k1 = *(const bf16x8*)(Kb + (32 + q32) * 144 + ds * 32 + hi * 16);
#pragma unroll
                for (int sb = 0; sb < 2; ++sb) {
                    p0[sb] = __builtin_amdgcn_mfma_f32_32x32x16_bf16(k0, qf[sb][ds], ds == 0 ? czero : p0[sb], 0, 0, 0);
                    p1[sb] = __builtin_amdgcn_mfma_f32_32x32x16_bf16(k1, qf[sb][ds], ds == 0 ? czero : p1[sb], 0, 0, 0);
                }
            }
            if (use_shift) {
#pragma unroll
                for (int sb = 0; sb < 2; ++sb)
#pragma unroll
                    for (int r = 0; r < 16; ++r) { p0[sb][r] -= sshift; p1[sb][r] -= sshift; }
            }
            u32x4 pw[2][4];
#pragma unroll
            for (int sb = 0; sb < 2; ++sb) {
                float ls = 0.f;
#pragma unroll
                for (int r = 0; r < 16; ++r) { p0[sb][r] = __builtin_amdgcn_exp2f(p0[sb][r]); p1[sb][r] = __builtin_amdgcn_exp2f(p1[sb][r]); ls += p0[sb][r] + p1[sb][r]; }
                lrun[sb] += ls;
                pw[sb][0] = (u32x4){cvtpk(p0[sb][0], p0[sb][1]), cvtpk(p0[sb][2], p0[sb][3]), cvtpk(p0[sb][4], p0[sb][5]), cvtpk(p0[sb][6], p0[sb][7])};
                pw[sb][1] = (u32x4){cvtpk(p0[sb][8], p0[sb][9]), cvtpk(p0[sb][10], p0[sb][11]), cvtpk(p0[sb][12], p0[sb][13]), cvtpk(p0[sb][14], p0[sb][15])};
                pw[sb][2] = (u32x4){cvtpk(p1[sb][0], p1[sb][1]), cvtpk(p1[sb][2], p1[sb][3]), cvtpk(p1[sb][4], p1[sb][5]), cvtpk(p1[sb][6], p1[sb][7])};
                pw[sb][3] = (u32x4){cvtpk(p1[sb][8], p1[sb][9]), cvtpk(p1[sb][10], p1[sb][11]), cvtpk(p1[sb][12], p1[sb][13]), cvtpk(p1[sb][14], p1[sb][15])};
            }
#pragma unroll
            for (int s = 0; s < 4; ++s) {
                const bf16x8 v0 = *(const bf16x8*)(Vb + q32 * 272 + s * 32 + hi * 16);
                const bf16x8 v1 = *(const bf16x8*)(Vb + (32 + q32) * 272 + s * 32 + hi * 16);
#pragma unroll
                for (int sb = 0; sb < 2; ++sb) {
                    const bf16x8 pa = __builtin_bit_cast(bf16x8, pw[sb][s]);
                    o0[sb] = __builtin_amdgcn_mfma_f32_32x32x16_bf16(v0, pa, o0[sb], 0, 0, 0);
                    o1[sb] = __builtin_amdgcn_mfma_f32_32x32x16_bf16(v1, pa, o1[sb], 0, 0, 0);
                }
            }
            }
            if (j + 1 < NT) { const int nb_ = (j + 1) & 1;
                *(u32x4*)(LDS_K(nb_) + kr * 144 + kc * 16) = kreg0; *(u32x4*)(LDS_K(nb_) + (kr + 64) * 144 + kc * 16) = kreg1;
                *(u32x4*)(LDS_V(nb_) + vr * 272 + vc * 16) = vreg0; *(u32x4*)(LDS_V(nb_) + (vr + 32) * 272 + vc * 16) = vreg1; }
            __syncthreads();
        }
#undef LDS_K
#undef LDS_V
#undef KSRC
#pragma unroll
        for (int sb = 0; sb < 2; ++sb) {
            float lt = lrun[sb]; lt += __shfl_xor(lt, 32);
            const float inv = 1.f / lt;
            bf16_t* op = qp + (size_t)sb * 32 * DM;
#pragma unroll
            for (int rg = 0; rg < 4; ++rg) {
                u32x2 w0; w0.x = cvtpk(o0[sb][4 * rg] * inv, o0[sb][4 * rg + 1] * inv); w0.y = cvtpk(o0[sb][4 * rg + 2] * inv, o0[sb][4 * rg + 3] * inv);
                u32x2 w1; w1.x = cvtpk(o1[sb][4 * rg] * inv, o1[sb][4 * rg + 1] * inv); w1.y = cvtpk(o1[sb][4 * rg + 2] * inv, o1[sb][4 * rg + 3] * inv);
                if (!dry) { *(u32x2*)(op + 8 * rg + 4 * hi) = w0; *(u32x2*)(op + 32 + 8 * rg + 4 * hi) = w1; }
            }
        }
    }
}

__global__ void __launch_bounds__(512, 2) fwd_megakernel(Args a) {
    extern __shared__ __attribute__((aligned(16))) unsigned char lds[];
    cg::grid_group grid = cg::this_grid();
    unsigned char* ws = a.ws;
    float* modraw = (float*)(ws + WS_MOD);
    float* ssq = (float*)(ws + WS_SSQ);
    bf16_t* Ap = (bf16_t*)(ws + WS_AP);
    float* hctx = (float*)(ws + WS_HCTX);
    LAS unsigned char* ldsl = (LAS unsigned char*)lds;

    int second = 0; unsigned nbar = 0;
    const int wave_s = __builtin_amdgcn_readfirstlane((int)threadIdx.x >> 6);
    for (int ph = a.ph_lo; ph < a.ph_hi; ++ph) {
        int lid_; asm volatile("v_mbcnt_lo_u32_b32 %0, -1, 0\n\tv_mbcnt_hi_u32_b32 %0, -1, %0" : "=v"(lid_));
        int tid = wave_s * 64 + lid_; asm volatile("" : "+v"(tid));
        const int lane = tid & 63, wave = tid >> 6;
        int kind;
        { const int sp_ = ph < 11 ? ph - 2 : ph - 13;
          kind = (ph == 0 || ph == 1 || ph == 11 || ph == 12) ? 0 : (ph == 22 ? 7 : ((sp_ == 0 || sp_ == 7) ? 1 : ((sp_ == 1 || sp_ == 6 || sp_ == 8) ? 2 : (sp_ == 2 ? 3 : (sp_ == 3 ? 4 : (sp_ == 4 ? 5 : 6)))))); }
        const int dry = (REPEAT_MASK != 0) && ((REPEAT_MASK >> kind) & 1) && !second;
        if (ph == 0 || ph == 11) {
          if (ph == 0) {
            for (int i = blockIdx.x * 512 + tid; i < 6 * TT; i += gridDim.x * 512) ssq[TT + i] = 0.f;
            {
                float* rope = (float*)(ws + WS_ROPE);
                for (int i = blockIdx.x * 512 + tid; i < SEQ * 32; i += gridDim.x * 512) {
                    const int t = i >> 5, j = i & 31, fi = j & 15; const float pos = (float)((j < 16) ? (t >> 6) : (t & 63));
                    const float invf = __builtin_amdgcn_exp2f(-(float)fi * (13.287712379549449f / 16.f));
                    const float ang = pos * invf;
                    rope[2 * i] = __cosf(ang); rope[2 * i + 1] = __sinf(ang);
                }
            }
            {
                float* sc = (float*)lds;
                float* red = (float*)(lds + 69632);
                for (int i = tid; i < 17 * DM; i += 512) { const int mb = i >> 10, k = i & 1023; const float cv = mb < 16 ? a.in[I_C][mb * DM + k] : a.in[I_CCTX][k]; sc[i] = cv * sigm(cv); }
                __syncthreads();
                for (int item = blockIdx.x; item < 288; item += gridDim.x) {
                    const int l = item / 144, n0 = (item - l * 144) * 64;
                    const float* wp = a.in[I_WADA] + ((size_t)l * DM + wave * 128) * NMOD + n0 + lane;
                    float acc[17];
#pragma unroll
                    for (int mb = 0; mb < 17; ++mb) acc[mb] = 0.f;
#pragma unroll 16
                    for (int k = 0; k < 128; ++k) { const float wv = wp[(size_t)k * NMOD];
#pragma unroll
                        for (int mb = 0; mb < 17; ++mb) acc[mb] += sc[mb * DM + wave * 128 + k] * wv; }
#pragma unroll
                    for (int mb = 0; mb < 17; ++mb) red[(wave * 17 + mb) * 64 + lane] = acc[mb];
                    __syncthreads();
                    for (int i = tid; i < 17 * 64; i += 512) { const int mb = i >> 6, col = i & 63; float s = a.in[I_BADA][l * NMOD + n0 + col];
#pragma unroll
                        for (int w8 = 0; w8 < 8; ++w8) s += red[(w8 * 17 + mb) * 64 + col];
                        modraw[((size_t)l * 17 + mb) * NMOD + n0 + col] = s; }
                    __syncthreads();
                }
            }
            __syncthreads();
          }
            convert_weights(tid, a, ph == 0 ? 0 : 1, lds);
        } else if (ph == 1 || ph == 12) {
            const int l = ph == 1 ? 0 : 1;
            compute_biases(tid, a, l, lds);
            if (l == 0) {
                const float* nrm = a.in[I_NFFN1]; const int gw = blockIdx.x * 8 + wave, NGW = gridDim.x * 8;
                for (int R = gw; R < TT; R += NGW) {
                    const float* xr = R < TL ? a.in[I_X] + (size_t)R * DM : a.in[I_CTX] + (size_t)(R - TL) * DM;
                    const int mb = R < TL ? (R >> 11) : 16; const float* scl = modraw + (size_t)mb * NMOD + DM;
                    float ss = 0.f;
#pragma unroll
                    for (int c4 = 0; c4 < 4; ++c4) { const int col = c4 * 256 + lane * 4; const f32x4 v = *(const f32x4*)(xr + col);
                        ss += (v[0] * v[0] + v[1] * v[1]) + (v[2] * v[2] + v[3] * v[3]);
                        const f32x4 g = *(const f32x4*)(nrm + col) * (*(const f32x4*)(scl + col) + 1.f), y = v * g;
                        u32x2 w; w.x = cvtpk(y[0], y[1]); w.y = cvtpk(y[2], y[3]); *(u32x2*)(Ap + (size_t)R * DM + col) = w;
                        u32x2 hw; hw.x = cvtpk(v[0], v[1]); hw.y = cvtpk(v[2], v[3]);
                        *(u32x2*)((R < TL ? (bf16_t*)a.out + (size_t)R * DM : (bf16_t*)hctx + (size_t)(R - TL) * DM) + col) = hw; }
                    ss = wave_sum(ss);
                    if (lane == 0) ssq[R] = ss;
                }
            }
        } else if (ph == 22) {
            const float* fn = a.in[I_FNORM]; const int gw = blockIdx.x * 8 + wave, NGW = gridDim.x * 8;
            for (int R = gw; R < TL; R += NGW) {
                const float r = __builtin_amdgcn_rsqf(ssq[(size_t)6 * TT + R] * (1.f / DM) + EPS);
                const float* hrow = (const float*)(ws + WS_AP) + (size_t)R * DM; float* orow = a.out + (size_t)R * DM;
#pragma unroll
                for (int c4 = 0; c4 < 4; ++c4) { const int col = c4 * 256 + lane * 4; const f32x4 v = *(const f32x4*)(hrow + col) * r * *(const f32x4*)(fn + col); *(f32x4*)(orow + col) = v; }
            }
        } else {
            const int l = ph < 11 ? 0 : 1, sp = ph < 11 ? ph - 2 : ph - 13;
            const float* modl = modraw + (size_t)l * 17 * NMOD;
            const int nMall = TT / 256, nMlat = TL / 256;
            if (sp == 0 || sp == 7) {
                const bool f1 = sp == 0; const int nM = (f1 || l == 0) ? nMall : nMlat;
                pg8::TileSched S = pg8::make_sched(nM, 2 * DFF / 256, DM);
                pg8::EpiSwiGLU E{(bf16_t*)(ws + WS_G), (const float*)(ws + (f1 ? WS_B13A : WS_B13B)), ssq + (size_t)(3 * l + (f1 ? 0 : 2)) * TT};
                pg8::gemm_phase(tid, ldsl, Ap, DM, (const bf16_t*)(ws + (f1 ? WS_W13A : WS_W13B)), DM, S, E);
            } else if (sp == 1 || sp == 8 || sp == 6) {
                if (STAGGER_TICKS > 0) {
                    if (tid == 0) { const unsigned long long t0 = __builtin_amdgcn_s_memrealtime(); const unsigned long long d = (unsigned long long)((blockIdx.x & 7) * STAGGER_TICKS);
                        while (__builtin_amdgcn_s_memrealtime() - t0 < d) __builtin_amdgcn_s_sleep(4); }
                    __syncthreads();
                }
                const int nM = (sp == 1 || l == 0) ? nMall : nMlat;
                const int j = sp == 1 ? 0 : (sp == 6 ? 1 : 2);
                const bool lastg = (l == 1 && sp == 8);
                const int ln = (sp == 8) ? l + 1 : l, jn = (sp == 8) ? 0 : j + 1;
                const float* nrm = lastg ? nullptr : (jn == 0 ? a.in[I_NFFN1] : (jn == 1 ? a.in[I_NMIX] : a.in[I_NFFN2])) + (size_t)ln * DM;
                const float* scl = lastg ? nullptr : modraw + (size_t)ln * 17 * NMOD + (3 * jn + 1) * DM;
                float* ssqn = ssq + (size_t)(3 * l + j + 1) * TT;
                pg8::EpiRes E{(uintptr_t)a.out, (uintptr_t)hctx - (uintptr_t)a.out, lastg ? (float*)(ws + WS_AP) : nullptr, modl + (3 * j + 2) * DM, sp == 6 ? 1.0f : 0.5f, nrm, scl, ssqn, lastg ? nullptr : Ap, dry};
                const bool wo = sp == 6; const int Kd = wo ? DM : DFF;
                pg8::TileSched S = (wo || nM != nMall) ? pg8::make_sched(nM, DM / 256, Kd) : pg8::make_ctxtail(Kd, (float*)(ws + WS_P), (unsigned*)(ws + WS_CTL) + 64, (unsigned)(ph + 1));
                if (XCD_OFFSET) pg8::add_xcd_offset(S, Kd, (float*)(ws + (wo ? WS_G : WS_P)));
                pg8::gemm_phase(tid, ldsl, (const bf16_t*)(ws + (wo ? WS_P : WS_G)), Kd, (const bf16_t*)(ws + (wo ? WS_WOUT : (sp == 1 ? WS_W2A : WS_W2B))), Kd, S, E);
            } else if (sp == 2) {
                pg8::TileSched S = pg8::make_sched(l == 0 ? nMall : nMlat, NIN / 256, DM);
                if (l == 1) { S.n2 = TC / 256; S.pm0_2 = nMlat; S.pn0_2 = 2; }
                pg8::EpiIn E{(bf16_t*)(ws + WS_P), (bf16_t*)(ws + WS_G), (const float*)(ws + WS_BIN), ssq + (size_t)(3 * l + 1) * TT};
                pg8::gemm_phase(tid, ldsl, Ap, DM, (const bf16_t*)(ws + WS_WIN), DM, S, E);
            } else if (sp == 3) {
                post_phase(tid, a, l, lds);
            } else if (sp == 4) {
                attn_phase(tid, a, l, lds, dry);
            } else if (sp == 5) {
                pg8::TileSched S = pg8::make_sched(l == 0 ? nMall : nMlat, DM / 256, DM);
                S.nb = 3;
                pg8::EpiMerge E{(const bf16_t*)(ws + WS_G), (bf16_t*)(ws + WS_P)};
                pg8::gemm_phase(tid, ldsl, Ap, DM, (const bf16_t*)(ws + WS_WCAT), DM, S, E);
            }
        }
        if (REPEAT_MASK != 0) { if (dry) { second = 1; --ph; __syncthreads(); continue; } second = 0; }
        if (ph + 1 < a.ph_hi) {
            asm volatile("s_waitcnt vmcnt(0) lgkmcnt(0)" ::: "memory");
            __syncthreads();
            if (ph == a.ph_lo) { if (tid == 0) __builtin_amdgcn_fence(__ATOMIC_RELEASE, "agent"); grid.sync(); if (tid == 0) __builtin_amdgcn_fence(__ATOMIC_ACQUIRE, "agent"); }
            else {
              for (int bb = 0; bb <= EXTRA_BAR; ++bb) {
                if (tid == 0) {
                    unsigned* ctl = (unsigned*)(ws + WS_CTL);
                    const unsigned G_ = gridDim.x, g_ = blockIdx.x & 7u, ngrp = G_ < 8u ? G_ : 8u, memb = (G_ - g_ + 7u) >> 3;
                    unsigned* gcnt = ctl + 2304 + 64 * g_; unsigned* ggen = ctl + 2816 + 64 * g_; unsigned* top = ctl + 3328;
                    __builtin_amdgcn_fence(__ATOMIC_RELEASE, "agent");
                    ++nbar;
                    const unsigned old = __hip_atomic_fetch_add(gcnt, 1u, __ATOMIC_RELAXED, __HIP_MEMORY_SCOPE_AGENT);
                    if (old + 1u == nbar * memb) {
                        __hip_atomic_fetch_add(top, 1u, __ATOMIC_RELAXED, __HIP_MEMORY_SCOPE_AGENT);
                        while (__hip_atomic_load(top, __ATOMIC_RELAXED, __HIP_MEMORY_SCOPE_AGENT) < nbar * ngrp) __builtin_amdgcn_s_sleep(1);
                        __hip_atomic_store(ggen, nbar, __ATOMIC_RELAXED, __HIP_MEMORY_SCOPE_AGENT);
                    } else {
                        while (__hip_atomic_load(ggen, __ATOMIC_RELAXED, __HIP_MEMORY_SCOPE_AGENT) < nbar) __builtin_amdgcn_s_sleep(1);
                    }
                    __builtin_amdgcn_fence(__ATOMIC_ACQUIRE, "agent");
                }
                if (EXTRA_BAR) { asm volatile("s_waitcnt vmcnt(0)" ::: "memory"); __syncthreads(); }
              }
            }
            asm volatile("s_waitcnt vmcnt(0)" ::: "memory");
            __syncthreads();
        }
    }
}

extern "C" void kernel_launch(void* const* d_in, const int* in_sizes, int n_in, void* d_out, int out_size, void* d_ws, size_t ws_size, hipStream_t stream) {
    static int grid = 0;
    if (grid == 0) {
        if (n_in != 26 || out_size != TL * DM || ws_size < WS_END) { fprintf(stderr, "kernel_launch: unexpected shapes (n_in %d out %d ws %zu need %zu)\n", n_in, out_size, ws_size, (size_t)WS_END); grid = -1; return; }
        int dev = 0, cus = 0, per_cu = 0;
        if (hipGetDevice(&dev) != hipSuccess || hipDeviceGetAttribute(&cus, hipDeviceAttributeMultiprocessorCount, dev) != hipSuccess) { grid = -1; return; }
        if (hipFuncSetAttribute((const void*)fwd_megakernel, hipFuncAttributeMaxDynamicSharedMemorySize, LDS_BYTES) != hipSuccess) { fprintf(stderr, "kernel_launch: hipFuncSetAttribute failed\n"); grid = -1; return; }
        if (hipOccupancyMaxActiveBlocksPerMultiprocessor(&per_cu, (const void*)fwd_megakernel, 512, LDS_BYTES) != hipSuccess || per_cu < 1) per_cu = 1;
        (void)hipGetLastError();
        grid = cus * per_cu;
    }
    if (grid < 0) return;
    Args a{};
    for (int i = 0; i < 26; ++i) a.in[i] = (const float*)d_in[i];
    a.out = (float*)d_out; a.ws = (unsigned char*)d_ws;
#if MK_ONE_LAUNCH
    a.ph_lo = 0; a.ph_hi = NPHASES;
    if (hipMemsetAsync((char*)d_ws + WS_CTL, 0, 16384, stream) != hipSuccess) { fprintf(stderr, "memset failed\n"); return; }
    void* args[] = {&a};
    hipError_t e = hipLaunchCooperativeKernel((const void*)fwd_megakernel, dim3(grid), dim3(512), args, LDS_BYTES, stream);
    if (e != hipSuccess) fprintf(stderr, "cooperative launch failed: %s (grid %d)\n", hipGetErrorString(e), grid);
#else
    for (int ph = 0; ph < NPHASES; ++ph) {
        a.ph_lo = ph; a.ph_hi = ph + 1;
        hipLaunchKernelGGL(fwd_megakernel, dim3(grid), dim3(512), LDS_BYTES, stream, a);
    }
#endif
}
```

```cpp
#include <hip/hip_runtime.h>
#include <hip/hip_cooperative_groups.h>
#include <cstdio>
#include <cstdint>
namespace cg = cooperative_groups;

#ifndef REPEAT_MASK
#define REPEAT_MASK 0
#endif
#ifndef STAGGER_TICKS
#define STAGGER_TICKS 0
#endif
#ifndef XCD_OFFSET
#define XCD_OFFSET 0
#endif
#ifndef EXTRA_BAR
#define EXTRA_BAR 0
#endif
#ifndef MK_ONE_LAUNCH
#define MK_ONE_LAUNCH 1
#endif

#define LAS __attribute__((address_space(3)))
#define GAS __attribute__((address_space(1)))
typedef unsigned short bf16_t;
typedef short bf16x8 __attribute__((ext_vector_type(8)));
typedef float f32x4 __attribute__((ext_vector_type(4)));
typedef float f32x16 __attribute__((ext_vector_type(16)));
typedef unsigned u32x4 __attribute__((ext_vector_type(4)));
typedef unsigned u32x2 __attribute__((ext_vector_type(2)));
typedef float f32x2_t __attribute__((ext_vector_type(2)));
typedef __bf16 bf16x2_t __attribute__((ext_vector_type(2)));

constexpr int DM = 1024, NBATCH = 16, SEQ = 2048, CTXL = 256;
constexpr int TL = NBATCH * SEQ;
constexpr int TC = NBATCH * CTXL;
constexpr int TT = TL + TC;
constexpr int DFF = 2816, NIN = 4608, NPC = 1536, NGC = 3072, NMOD = 9 * DM;
constexpr int KVPOS = SEQ + CTXL;
constexpr float EPS = 1e-6f;
constexpr float QSCALE = 0.125f * 1.4426950408889634f;

constexpr size_t MiB = 1u << 20;
constexpr size_t al256(size_t x) { return (x + 255) & ~(size_t)255; }
constexpr size_t SZ_W13 = (size_t)2 * DFF * DM * 2, SZ_W2 = (size_t)DM * DFF * 2, SZ_WIN = (size_t)NIN * DM * 2, SZ_WSQ = (size_t)DM * DM * 2;
constexpr size_t WS_W13A = 0;
constexpr size_t WS_W2A = WS_W13A + SZ_W13;
constexpr size_t WS_WIN = WS_W2A + SZ_W2;
constexpr size_t WS_WCAT = WS_WIN + SZ_WIN;
constexpr size_t WS_WOUT = WS_WCAT + SZ_WSQ;
constexpr size_t WS_W13B = WS_WOUT + SZ_WSQ;
constexpr size_t WS_W2B = WS_W13B + SZ_W13;
constexpr size_t WS_SGUW = WS_W2B + SZ_W2;
constexpr size_t WS_MOD = al256(WS_SGUW + 4 * 128 * 128 * 2);
constexpr size_t WS_B13A = al256(WS_MOD + (size_t)2 * 17 * NMOD * 4);
constexpr size_t WS_BIN = al256(WS_B13A + (size_t)17 * 2 * DFF * 4);
constexpr size_t WS_B13B = al256(WS_BIN + (size_t)17 * NIN * 4);
constexpr size_t WS_SSQ = al256(WS_B13B + (size_t)17 * 2 * DFF * 4);
constexpr size_t WS_ROPE = al256(WS_SSQ + (size_t)7 * TT * 4);
constexpr size_t WS_HCTX = al256(WS_ROPE + (size_t)SEQ * 32 * 8);
constexpr size_t WS_AP = al256(WS_HCTX + (size_t)TC * DM * 4);
constexpr size_t WS_KB = al256(WS_AP + (size_t)TT * DM * 2);
constexpr size_t WS_VT = al256(WS_KB + (size_t)TT * 128 * 2);
constexpr size_t WS_P = al256(WS_VT + (size_t)NBATCH * 2 * 64 * KVPOS * 2);
constexpr size_t WS_G = al256(WS_P + (size_t)TT * NPC * 2);
constexpr size_t WS_CTL = al256(WS_G + (size_t)TT * NGC * 2);
constexpr size_t WS_END = WS_CTL + 16384;

constexpr int LDS_BYTES = 147456;
constexpr int NPHASES = 23;

__device__ __forceinline__ unsigned cvtpk(float lo, float hi) { f32x2_t v = {lo, hi}; bf16x2_t b = __builtin_convertvector(v, bf16x2_t); return __builtin_bit_cast(unsigned, b); }
__device__ __forceinline__ float bflo(unsigned u) { return __uint_as_float(u << 16); }
__device__ __forceinline__ float bfhi(unsigned u) { return __uint_as_float(u & 0xffff0000u); }
__device__ __forceinline__ float fexp(float x) { return __builtin_amdgcn_exp2f(x * 1.4426950408889634f); }
__device__ __forceinline__ float frcp(float x) { return __builtin_amdgcn_rcpf(x); }
__device__ __forceinline__ float sigm(float x) { return frcp(1.f + fexp(-x)); }
__device__ __forceinline__ float gelu_t(float x) { const float z = 0.7978845608028654f * (x + 0.044715f * x * x * x); return x * frcp(1.f + fexp(-2.f * z)); }
#define LDS_WAIT() asm volatile("s_waitcnt lgkmcnt(0)" ::: "memory")
__device__ __forceinline__ uintptr_t uni64(uintptr_t v) { const unsigned lo = __builtin_amdgcn_readfirstlane((unsigned)v), hi = __builtin_amdgcn_readfirstlane((unsigned)(v >> 32)); return ((uintptr_t)hi << 32) | lo; }

namespace pg8 {
constexpr int BM = 256, BK = 64, HALF = 128, HTB = HALF * BK * 2, STAGE_BYTES = 8 * HTB, NXCD = 8, WGM = 4;
__device__ __forceinline__ int lds_byte(int r, int c) { const int st = (r >> 4) * 2 + (c >> 5), rr = r & 15, cc = c & 31, ob = rr * 64 + cc * 2; return st * 1024 + (ob ^ (((ob >> 9) & 1) << 5)); }
__device__ __forceinline__ void stage_rc(int b, int& R, int& C) { const int st = b / 1024, sb = b % 1024, swz = sb ^ (((sb >> 9) & 1) << 5); R = (st >> 1) * 16 + swz / 64; C = (st & 1) * 32 + (swz % 64) / 2; }
__device__ __forceinline__ int perm32(int rho) { const int n = rho >> 4, i = rho & 15; return 8 * (i >> 2) + 4 * n + (i & 3); }

struct Unit { int pm, pn, k0, nt, tag, te; };

struct TileSched {
    int c, G, nM1, nN1, n1, pn0_1, n2, pm0_2, pn0_2, nb, ntk;
    int sk, P, R, xo, kx; float* slots; unsigned* flags; unsigned epoch;
    __device__ __forceinline__ void map_tile(int L, int& pm, int& pn) const {
        int wgid; { const int q = n1 / NXCD, r = n1 % NXCD, xcd = L % NXCD, off = L / NXCD; wgid = (xcd < r ? xcd * (q + 1) : r * (q + 1) + (xcd - r) * q) + off; }
        const int nig = WGM * nN1, gid = wgid / nig, fm = gid * WGM, gsz = (nM1 - fm) < WGM ? (nM1 - fm) : WGM;
        pm = fm + ((wgid % nig) % gsz); pn = pn0_1 + (wgid % nig) / gsz;
    }
    __device__ __forceinline__ bool next(int i, Unit& u) const {
        int L = c, k0 = 0, nt = ntk, tag = 0; bool valid, ctxp = false, rect2 = false;
        if (xo) {
            const int nr = sk ? R : (c < n1 ? (n1 - c + G - 1) / G : 0);
            const int extra = (kx > 0 && nr > 0) ? 1 : 0;
            const bool inmain = i < nr + extra, first = (i == 0) && (extra != 0), last = inmain && (i >= nr);
            L = (i == 0 || last) ? c : i * G + c;
            k0 = first ? kx * 128 : 0; nt = first ? ntk - 2 * kx : (last ? 2 * kx : ntk); tag = first ? 4 : (last ? 8 : 0);
            ctxp = (sk != 0) && (i == nr + extra);
            valid = inmain || ctxp;
        } else if (sk) {
            L = i * G + c; ctxp = (i == R); valid = i <= R;
        } else {
            int ti = i, br = 0;
            if (nb == 3) { ti = i / 3; br = i - ti * 3; k0 = br * 256 + (br >> 1) * 256; nt = 4 + 4 * (br & 1); tag = br; }
            L = ti * G + c; rect2 = L >= n1; valid = L < n1 + n2;
        }
        if (!valid) return false;
        int pm, pn;
        map_tile((ctxp || rect2) ? 0 : L, pm, pn);
        if (ctxp) {
            const int x = c & 7, idx = c >> 3, tix = idx >> 2, part = idx & 3, pb = P >> 2, pr = P & 3;
            const int p0 = part * pb + (part < pr ? part : pr), p1 = (part + 1) * pb + (part + 1 < pr ? part + 1 : pr);
            pm = 128 + 2 * x + (tix >> 2); pn = tix & 3; k0 = p0 * 128; nt = 2 * (p1 - p0); tag = part == 0 ? 2 : 1;
        }
        if (rect2) { pm = pm0_2 + (L - n1); pn = pn0_2; }
        u.pm = pm; u.pn = pn; u.k0 = k0; u.nt = nt; u.tag = tag; u.te = 0;
        return true;
    }
};
__device__ __forceinline__ TileSched make_sched(int nM1, int nN1, int K) {
    TileSched s; s.c = blockIdx.x; s.G = gridDim.x; s.nM1 = nM1; s.nN1 = nN1; s.n1 = nM1 * nN1; s.pn0_1 = 0; s.n2 = 0; s.pm0_2 = 0; s.pn0_2 = 0; s.nb = 1;
    s.ntk = K / BK; s.sk = 0; s.P = 1; s.R = 0; s.xo = 0; s.kx = 0; s.slots = nullptr; s.flags = nullptr; s.epoch = 0; return s;
}
__device__ __forceinline__ TileSched make_ctxtail(int K, float* slots, unsigned* flags, unsigned epoch) {
    if (gridDim.x != 256) return make_sched(TT / 256, 4, K);
    TileSched s = make_sched(TL / 256, 4, K);
    s.sk = 1; s.P = K / (2 * BK); s.R = 2; s.slots = slots; s.flags = flags; s.epoch = epoch;
    return s;
}

__device__ __forceinline__ void add_xcd_offset(TileSched& s, int K, float* slots) {
    if (gridDim.x != 256 || s.nb != 1 || s.n2 != 0) return;
    s.xo = 1; s.P = K / (2 * BK); s.kx = ((int)(blockIdx.x & 7) * s.P) >> 3; s.slots = slots;
}
__device__ __forceinline__ int unit_mb(const Unit& u) { return u.pm < 128 ? (u.pm >> 3) : 16; }

struct EpiSwiGLU {
    bf16_t* act; const float* bias; const float* ssq;
    __device__ __forceinline__ void operator()(f32x4 (&acc)[2][2][4][2], const Unit& u, int wr, int wc, int fr, int fq) const {
        const int mb = unit_mb(u);
        const float* bp = bias + (size_t)mb * (2 * DFF) + u.pn * 256 + wc * 32 + 8 * fq;
        f32x4 ba[2], bb[2];
#pragma unroll
        for (int n = 0; n < 2; ++n) { ba[n] = *(const f32x4*)(bp + 4 * n); bb[n] = *(const f32x4*)(bp + 128 + 4 * n); }
        const int row0 = u.pm * 256 + wr * 64 + fr;
        GAS bf16_t* op = (GAS bf16_t*)act + (size_t)row0 * DFF + u.pn * 128 + wc * 32 + 8 * fq;
        float rs[8];
#pragma unroll
        for (int g = 0; g < 8; ++g) rs[g] = ((const GAS float*)ssq)[row0 + (g >> 2) * 128 + (g & 3) * 16];
#pragma unroll
        for (int ai = 0; ai < 2; ++ai)
#pragma unroll
            for (int m = 0; m < 4; ++m) {
                const int ro = ai * 128 + m * 16;
                const float r = __builtin_amdgcn_rsqf(rs[ai * 4 + m] * (1.f / DM) + EPS);
                f32x4 a0 = acc[ai][0][m][0] * r + ba[0], a1 = acc[ai][0][m][1] * r + ba[1], b0 = acc[ai][1][m][0] * r + bb[0], b1 = acc[ai][1][m][1] * r + bb[1];
                f32x4 o0, o1;
#pragma unroll
                for (int i = 0; i < 4; ++i) { o0[i] = a0[i] * b0[i] * sigm(a0[i]); o1[i] = a1[i] * b1[i] * sigm(a1[i]); }
                u32x4 w; w.x = cvtpk(o0[0], o0[1]); w.y = cvtpk(o0[2], o0[3]); w.z = cvtpk(o1[0], o1[1]); w.w = cvtpk(o1[2], o1[3]);
                *(GAS u32x4*)(op + (size_t)ro * DFF) = w;
            }
    }
};
struct EpiIn {
    bf16_t* P; bf16_t* G; const float* bias; const float* ssq;
    __device__ __forceinline__ void operator()(f32x4 (&acc)[2][2][4][2], const Unit& u, int wr, int wc, int fr, int fq) const {
        const int mb = unit_mb(u);
        const int colt = u.pn * 256, cw = wc * 32 + 8 * fq;
        const float* bp = bias + (size_t)mb * NIN + colt + cw;
        f32x4 bv[2][2];
#pragma unroll
        for (int bj = 0; bj < 2; ++bj)
#pragma unroll
            for (int n = 0; n < 2; ++n) bv[bj][n] = *(const f32x4*)(bp + bj * 128 + 4 * n);
        const int row0 = u.pm * 256 + wr * 64 + fr;
        const bool gate = u.pn >= 6;
        GAS bf16_t* base = (GAS bf16_t*)P + (size_t)row0 * NPC + colt + cw;
        GAS unsigned char* gbase = (GAS unsigned char*)G + (size_t)row0 * NGC + (colt - NPC) + cw;
        float rs[8];
#pragma unroll
        for (int g = 0; g < 8; ++g) rs[g] = ((const GAS float*)ssq)[row0 + (g >> 2) * 128 + (g & 3) * 16];
#pragma unroll
        for (int ai = 0; ai < 2; ++ai)
#pragma unroll
            for (int m = 0; m < 4; ++m) {
                const int ro = ai * 128 + m * 16;
                const float r = __builtin_amdgcn_rsqf(rs[ai * 4 + m] * (1.f / DM) + EPS);
#pragma unroll
                for (int bj = 0; bj < 2; ++bj) {
                    f32x4 v0 = acc[ai][bj][m][0] * r + bv[bj][0], v1 = acc[ai][bj][m][1] * r + bv[bj][1];
                    if (gate) {
                        unsigned q0[4], q1[4];
#pragma unroll
                        for (int i = 0; i < 4; ++i) { q0[i] = (unsigned)fminf(fmaxf(sigm(v0[i]) * 255.f + 0.5f, 1.f), 255.f); q1[i] = (unsigned)fminf(fmaxf(sigm(v1[i]) * 255.f + 0.5f, 1.f), 255.f); }
                        u32x2 w; w.x = q0[0] | (q0[1] << 8) | (q0[2] << 16) | (q0[3] << 24); w.y = q1[0] | (q1[1] << 8) | (q1[2] << 16) | (q1[3] << 24);
                        *(GAS u32x2*)(gbase + (size_t)ro * NGC + bj * 128) = w;
                    } else {
                        u32x4 w; w.x = cvtpk(v0[0], v0[1]); w.y = cvtpk(v0[2], v0[3]); w.z = cvtpk(v1[0], v1[1]); w.w = cvtpk(v1[2], v1[3]);
                        *(GAS u32x4*)(base + (size_t)ro * NPC + bj * 128) = w;
                    }
                }
            }
    }
};
struct EpiRes {
    bf16_t* Ap; float* out32; const float* gate; float coef; const float* nrc; const float* scc; const float* nrm; const float* scl; float* ssq; int dry;
    __device__ __forceinline__ void operator()(f32x4 (&acc)[2][2][4][2], const Unit& u, int wr, int wc, int fr, int fq) const {
        const int mb = unit_mb(u);
        bf16_t* Ap = this->Ap; float* out32 = this->out32; const float* gate = this->gate; float coef = this->coef;
        const float* nrc = this->nrc; const float* scc = this->scc; const float* nrm = this->nrm; const float* scl = this->scl; float* ssq = this->ssq;
        Ap = (bf16_t*)uni64((uintptr_t)Ap); out32 = (float*)uni64((uintptr_t)out32); gate = (const float*)uni64((uintptr_t)gate); coef = __uint_as_float(__builtin_amdgcn_readfirstlane(__float_as_uint(coef)));
        nrc = (const float*)uni64((uintptr_t)nrc); scc = (const float*)uni64((uintptr_t)scc);
        nrm = (const float*)uni64((uintptr_t)nrm); scl = (const float*)uni64((uintptr_t)scl); ssq = (float*)uni64((uintptr_t)ssq);
        const int col0 = u.pn * 256 + wc * 32 + 8 * fq, row0 = u.pm * 256 + wr * 64 + fr;
        GAS bf16_t* hb = (GAS bf16_t*)Ap + (size_t)row0 * DM + col0;
        GAS float* ho = (GAS float*)out32 + (size_t)row0 * DM + col0;
        f32x4 gc[2][2], gs[2][2], gi[2][2];
#pragma unroll
        for (int bj = 0; bj < 2; ++bj)
#pragma unroll
            for (int n = 0; n < 2; ++n) {
                gc[bj][n] = *(const GAS f32x4*)(gate + (size_t)mb * NMOD + col0 + 128 * bj + 4 * n) * (dry ? 0.f : coef);
                const f32x4 gcur = *(const GAS f32x4*)(nrc + col0 + 128 * bj + 4 * n) * (*(const GAS f32x4*)(scc + (size_t)mb * NMOD + col0 + 128 * bj + 4 * n) + 1.f);
#pragma unroll
                for (int i = 0; i < 4; ++i) gi[bj][n][i] = gcur[i] != 0.f ? 1.f / gcur[i] : 0.f;
                if (!out32) gs[bj][n] = *(const GAS f32x4*)(nrm + col0 + 128 * bj + 4 * n) * (*(const GAS f32x4*)(scl + (size_t)mb * NMOD + col0 + 128 * bj + 4 * n) + 1.f);
                else gs[bj][n] = (f32x4){0.f, 0.f, 0.f, 0.f};
            }
        u32x4 hq[3][2];
#pragma unroll
        for (int g0 = 0; g0 < 2; ++g0)
#pragma unroll
            for (int bj = 0; bj < 2; ++bj) hq[g0][bj] = *(const GAS u32x4*)(hb + (size_t)((g0 >> 2) * 128 + (g0 & 3) * 16) * DM + 128 * bj);
#pragma unroll
        for (int g = 0; g < 8; ++g) {
            const int ai = g >> 2, m = g & 3;
            if (g < 6) {
#pragma unroll
                for (int bj = 0; bj < 2; ++bj) hq[(g + 2) % 3][bj] = *(const GAS u32x4*)(hb + (size_t)(((g + 2) >> 2) * 128 + ((g + 2) & 3) * 16) * DM + 128 * bj); }
            const int ro = ai * 128 + m * 16; const size_t off = (size_t)ro * DM;
            float ss = 0.f;
#pragma unroll
            for (int bj = 0; bj < 2; ++bj) {
                const u32x4 q = hq[g % 3][bj];
                const f32x4 h0 = (f32x4){bflo(q.x), bfhi(q.x), bflo(q.y), bfhi(q.y)} * gi[bj][0] + gc[bj][0] * acc[ai][bj][m][0];
                const f32x4 h1 = (f32x4){bflo(q.z), bfhi(q.z), bflo(q.w), bfhi(q.w)} * gi[bj][1] + gc[bj][1] * acc[ai][bj][m][1];
                ss += (h0[0] * h0[0] + h0[1] * h0[1]) + (h0[2] * h0[2] + h0[3] * h0[3]) + (h1[0] * h1[0] + h1[1] * h1[1]) + (h1[2] * h1[2] + h1[3] * h1[3]);
                if (out32) { *(GAS f32x4*)(ho + off + 128 * bj) = h0; *(GAS f32x4*)(ho + off + 128 * bj + 4) = h1; }
                else if (!dry) { const f32x4 a0 = h0 * gs[bj][0], a1 = h1 * gs[bj][1];
                    u32x4 w; w.x = cvtpk(a0[0], a0[1]); w.y = cvtpk(a0[2], a0[3]); w.z = cvtpk(a1[0], a1[1]); w.w = cvtpk(a1[2], a1[3]);
                    *(GAS u32x4*)(hb + off + 128 * bj) = w; }
            }
            ss += __shfl_xor(ss, 16); ss += __shfl_xor(ss, 32);
            if (fq == 0) (void)__hip_atomic_fetch_add((GAS float*)ssq + row0 + ro, dry ? 0.f : ss, __ATOMIC_RELAXED, __HIP_MEMORY_SCOPE_AGENT);
        }
    }
};
struct EpiMerge {
    const bf16_t* G; bf16_t* Mg;
    __device__ __forceinline__ void operator()(f32x4 (&acc)[2][2][4][2], const Unit& u, int wr, int wc, int fr, int fq) const {
        const int br = u.tag, col0 = u.pn * 256 + wc * 32 + 8 * fq, row0 = u.pm * 256 + wr * 64 + fr;
        const GAS unsigned char* g0 = (const GAS unsigned char*)G + (size_t)row0 * NGC + br * 1024 + col0;
        u32x2 gq[3][2], hq[3][2];
#pragma unroll
        for (int g_ = 0; g_ < 2; ++g_)
#pragma unroll
            for (int bj = 0; bj < 2; ++bj) { const GAS unsigned char* gp = g0 + (size_t)((g_ >> 2) * 128 + (g_ & 3) * 16) * NGC + 128 * bj;
                gq[g_][bj] = *(const GAS u32x2*)gp; hq[g_][bj] = (br < 2) ? *(const GAS u32x2*)(gp + 1024) : (u32x2){0x01010101u, 0x01010101u}; }
#pragma unroll
        for (int g_ = 0; g_ < 8; ++g_) {
            const int ai = g_ >> 2, m = g_ & 3;
            if (g_ < 6) {
#pragma unroll
                for (int bj = 0; bj < 2; ++bj) { const GAS unsigned char* gp = g0 + (size_t)(((g_ + 2) >> 2) * 128 + ((g_ + 2) & 3) * 16) * NGC + 128 * bj;
                    gq[(g_ + 2) % 3][bj] = *(const GAS u32x2*)gp; hq[(g_ + 2) % 3][bj] = (br < 2) ? *(const GAS u32x2*)(gp + 1024) : (u32x2){0x01010101u, 0x01010101u}; } }
            const int row = row0 + ai * 128 + m * 16;
#pragma unroll
            for (int bj = 0; bj < 2; ++bj) {
                const u32x2 g = gq[g_ % 3][bj];
                f32x4 s0, s1;
#pragma unroll
                for (int i = 0; i < 4; ++i) { s0[i] = (float)((g.x >> (8 * i)) & 255u); s1[i] = (float)((g.y >> (8 * i)) & 255u); }
                if (br < 2) {
                    const u32x2 h = hq[g_ % 3][bj];
#pragma unroll
                    for (int i = 0; i < 4; ++i) { s0[i] *= frcp((float)((h.x >> (8 * i)) & 255u)); s1[i] *= frcp((float)((h.y >> (8 * i)) & 255u)); }
                    acc[ai][bj][m][0] *= s0; acc[ai][bj][m][1] *= s1;
                } else {
                    const f32x4 v0 = acc[ai][bj][m][0] * s0 * (1.f / 255.f), v1 = acc[ai][bj][m][1] * s1 * (1.f / 255.f);
                    u32x4 w; w.x = cvtpk(v0[0], v0[1]); w.y = cvtpk(v0[2], v0[3]); w.z = cvtpk(v1[0], v1[1]); w.w = cvtpk(v1[2], v1[3]);
                    *(GAS u32x4*)((GAS bf16_t*)Mg + (size_t)row * DM + col0 + 128 * bj) = w;
                }
            }
        }
    }
};

template <class Epi>
__device__ __forceinline__ void gemm_phase(const int tid, LAS unsigned char* lds, const bf16_t* Ab, int lda, const bf16_t* Bb, int ldb, const TileSched& S, const Epi& E) {
    const int wid = __builtin_amdgcn_readfirstlane(tid >> 6), lane = tid & 63, wr = wid >> 2, wc = wid & 3, fr = lane & 15, fq = lane >> 4;
    unsigned voffA[2], voffB[2];
#pragma unroll
    for (int i = 0; i < 2; ++i) { int R, C; stage_rc(tid * 16 + i * 8192, R, C); const int Rb = (R & ~31) + perm32(R & 31);
        voffA[i] = (unsigned)(R * lda + C) * 2u; voffB[i] = (unsigned)(Rb * ldb + C) * 2u; }
    const size_t kstep = (size_t)(BK * 2);
    const size_t hsA = (size_t)HALF * lda * 2, hsB = (size_t)HALF * ldb * 2;
    const unsigned ldsw = (unsigned)wid * 1024u;
    const int aoff = lds_byte(wr * 64 + fr, fq * 8), boff = lds_byte(wc * 32 + fr, fq * 8);
#define PG8_SA(b, h) (((b) * 2 + (h)) * HTB)
#define PG8_SB(b, h) ((4 + (b) * 2 + (h)) * HTB)
#define PG8_STAGE(bufoff, gbase, voff) do { _Pragma("unroll") for (int _i = 0; _i < 2; ++_i) \
        __builtin_amdgcn_global_load_lds((const unsigned*)((const char*)(gbase) + (voff)[_i]), (LAS unsigned*)(lds + (bufoff) + ldsw + _i * 8192), 16, 0, 0); } while (0)
#define PG8_LDA(dst, b, h) do { _Pragma("unroll") for (int m = 0; m < 4; ++m) _Pragma("unroll") for (int k = 0; k < 2; ++k) dst[m][k] = *(const LAS bf16x8*)(lds + PG8_SA(b, h) + aoff + m * 2048 + k * 1024); } while (0)
#define PG8_LDB(dst, b, h) do { _Pragma("unroll") for (int n = 0; n < 2; ++n) _Pragma("unroll") for (int k = 0; k < 2; ++k) dst[n][k] = *(const LAS bf16x8*)(lds + PG8_SB(b, h) + boff + n * 2048 + k * 1024); } while (0)
#define PG8_MMA(ai, bj, At, Bt) do { __builtin_amdgcn_s_setprio(1); _Pragma("unroll") for (int m = 0; m < 4; ++m) _Pragma("unroll") for (int n = 0; n < 2; ++n) _Pragma("unroll") for (int k = 0; k < 2; ++k) \
        acc[ai][bj][m][n] = __builtin_amdgcn_mfma_f32_16x16x32_bf16(Bt[n][k], At[m][k], acc[ai][bj][m][n], 0, 0, 0); __builtin_amdgcn_s_setprio(0); } while (0)
#define PG8_WAIT_V(n) asm volatile("s_waitcnt vmcnt(" #n ")" ::: "memory")
#define PG8_WAIT_L(n) asm volatile("s_waitcnt lgkmcnt(" #n ")" ::: "memory")
#define PG8_BAR __builtin_amdgcn_s_barrier()
#define PG8_SCHED __builtin_amdgcn_sched_barrier(0)
    Unit cur, nxt; int ui = 0;
    if (!S.next(0, cur)) return;
    f32x4 acc[2][2][4][2];
#pragma unroll
    for (int a = 0; a < 2; ++a)
#pragma unroll
        for (int b = 0; b < 2; ++b)
#pragma unroll
            for (int m = 0; m < 4; ++m)
#pragma unroll
                for (int n = 0; n < 2; ++n) acc[a][b][m][n] = (f32x4){0.f, 0.f, 0.f, 0.f};
    bf16x8 At[4][2], B0[2][2], B1[2][2];
    const char* cA = (const char*)Ab + (size_t)cur.pm * 2 * hsA + (size_t)cur.k0 * 2; const char* cB = (const char*)Bb + (size_t)cur.pn * 2 * hsB + (size_t)cur.k0 * 2;
    PG8_STAGE(PG8_SB(0, 0), cB, voffB); PG8_STAGE(PG8_SB(0, 1), cB + hsB, voffB); PG8_STAGE(PG8_SA(0, 0), cA, voffA); PG8_STAGE(PG8_SA(0, 1), cA + hsA, voffA);
    if (wr == 1) PG8_BAR;
    PG8_WAIT_V(2); PG8_BAR;
    PG8_STAGE(PG8_SB(1, 0), cB + kstep, voffB); PG8_STAGE(PG8_SA(1, 0), cA + kstep, voffA); PG8_STAGE(PG8_SB(1, 1), cB + hsB + kstep, voffB);
    PG8_WAIT_V(6); PG8_BAR;
    for (;;) {
        const bool has_next = S.next(ui + 1, nxt);
        const char* nA = has_next ? (const char*)Ab + (size_t)nxt.pm * 2 * hsA + (size_t)nxt.k0 * 2 : cA;
        const char* nB = has_next ? (const char*)Bb + (size_t)nxt.pn * 2 * hsB + (size_t)nxt.k0 * 2 : cB;
        const int nt = cur.nt;
        for (int t = 0; t < nt; t += 2) {
            const bool last = (t == nt - 2);
            const char* a1 = cA + (size_t)(t + 1) * kstep;
            const char* a2 = last ? nA : cA + (size_t)(t + 2) * kstep; const char* b2 = last ? nB : cB + (size_t)(t + 2) * kstep;
            const char* a3 = a2 + kstep; const char* b3 = b2 + kstep;
            PG8_LDB(B0, 0, 0); PG8_LDB(B1, 0, 1); PG8_SCHED; PG8_LDA(At, 0, 0); PG8_STAGE(PG8_SA(1, 1), a1 + hsA, voffA);
            PG8_WAIT_V(8); PG8_WAIT_L(0); PG8_BAR; PG8_MMA(0, 0, At, B0); PG8_MMA(0, 1, At, B1); PG8_BAR; PG8_SCHED;
            PG8_LDA(At, 0, 1); PG8_STAGE(PG8_SB(0, 0), b2, voffB); PG8_STAGE(PG8_SB(0, 1), b2 + hsB, voffB); PG8_STAGE(PG8_SA(0, 0), a2, voffA);
            PG8_WAIT_V(8); PG8_WAIT_L(0); PG8_BAR; PG8_MMA(1, 0, At, B0); PG8_MMA(1, 1, At, B1); PG8_BAR; PG8_SCHED;
            PG8_LDB(B0, 1, 0); PG8_LDB(B1, 1, 1); PG8_SCHED; PG8_LDA(At, 1, 0); PG8_STAGE(PG8_SA(0, 1), a2 + hsA, voffA);
            PG8_WAIT_V(8); PG8_WAIT_L(0); PG8_BAR; PG8_MMA(0, 0, At, B0); PG8_MMA(0, 1, At, B1); PG8_BAR; PG8_SCHED;
            PG8_LDA(At, 1, 1); PG8_STAGE(PG8_SB(1, 0), b3, voffB); PG8_STAGE(PG8_SB(1, 1), b3 + hsB, voffB); PG8_STAGE(PG8_SA(1, 0), a3, voffA);
            PG8_WAIT_V(8); PG8_WAIT_L(0); PG8_BAR; PG8_MMA(1, 0, At, B0); PG8_MMA(1, 1, At, B1); PG8_BAR; PG8_SCHED;
        }
        if (wr == 0) PG8_BAR;
        const bool xch = S.sk || S.xo;
        if (xch && (cur.tag & 10)) {
            const int np = (cur.tag & 2) ? 3 : 1;
#pragma unroll 1
            for (int pp = 1; pp <= np; ++pp) {
                const int j = (cur.tag & 2) ? S.c + 8 * pp : S.c;
                if (cur.tag & 2) {
                    unsigned* fl = S.flags + j * 8 + wid;
                    if (lane == 0) { while (__hip_atomic_load(fl, __ATOMIC_RELAXED, __HIP_MEMORY_SCOPE_AGENT) != S.epoch) __builtin_amdgcn_s_sleep(1); }
                }
                asm volatile("" ::: "memory");
                const unsigned long long* sp = (const unsigned long long*)(S.slots + (size_t)j * 65536 + wid * 8192) + lane; asm volatile("" : "+v"(sp));
#pragma unroll
                for (int a = 0; a < 2; ++a)
#pragma unroll
                    for (int b = 0; b < 2; ++b)
#pragma unroll
                        for (int m = 0; m < 4; ++m) {
#pragma unroll
                            for (int n = 0; n < 2; ++n) {
                                const unsigned long long v0 = __hip_atomic_load(sp, __ATOMIC_RELAXED, __HIP_MEMORY_SCOPE_AGENT), v1 = __hip_atomic_load(sp + 64, __ATOMIC_RELAXED, __HIP_MEMORY_SCOPE_AGENT);
                                acc[a][b][m][n][0] += __uint_as_float((unsigned)v0); acc[a][b][m][n][1] += __uint_as_float((unsigned)(v0 >> 32));
                                acc[a][b][m][n][2] += __uint_as_float((unsigned)v1); acc[a][b][m][n][3] += __uint_as_float((unsigned)(v1 >> 32));
                                sp += 128; }
                            if (m & 1) asm volatile("" : "+v"(sp) :: "memory");
                        }
            }
        }
        if (xch && (cur.tag & 5)) {
            unsigned long long* sp = (unsigned long long*)(S.slots + (size_t)S.c * 65536 + wid * 8192) + lane; asm volatile("" : "+v"(sp));
#pragma unroll
            for (int a = 0; a < 2; ++a)
#pragma unroll
                for (int b = 0; b < 2; ++b)
#pragma unroll
                    for (int m = 0; m < 4; ++m)
#pragma unroll
                        for (int n = 0; n < 2; ++n) {
                            const f32x4 v = acc[a][b][m][n];
                            __hip_atomic_store(sp, (unsigned long long)__float_as_uint(v[0]) | ((unsigned long long)__float_as_uint(v[1]) << 32), __ATOMIC_RELAXED, __HIP_MEMORY_SCOPE_AGENT);
                            __hip_atomic_store(sp + 64, (unsigned long long)__float_as_uint(v[2]) | ((unsigned long long)__float_as_uint(v[3]) << 32), __ATOMIC_RELAXED, __HIP_MEMORY_SCOPE_AGENT);
                            sp += 128; asm volatile("" : "+v"(sp)); }
            if (cur.tag & 1) { asm volatile("s_waitcnt vmcnt(0)" ::: "memory");
                if (lane == 0) __hip_atomic_store(S.flags + S.c * 8 + wid, S.epoch, __ATOMIC_RELAXED, __HIP_MEMORY_SCOPE_AGENT); }
        } else E(acc, cur, wr, wc, fr, fq);
        if (!has_next) break;
        if (!(S.nb == 3 && nxt.tag != 0)) {
#pragma unroll
        for (int a = 0; a < 2; ++a)
#pragma unroll
            for (int b = 0; b < 2; ++b)
#pragma unroll
                for (int m = 0; m < 4; ++m)
#pragma unroll
                    for (int n = 0; n < 2; ++n) acc[a][b][m][n] = (f32x4){0.f, 0.f, 0.f, 0.f};
        }
        cur = nxt; cA = nA; cB = nB; ++ui;
        if (wr == 1) PG8_BAR;
    }
    PG8_WAIT_V(0);
    PG8_BAR;
#undef PG8_SA
#undef PG8_SB
#undef PG8_STAGE
#undef PG8_LDA
#undef PG8_LDB
#undef PG8_MMA
#undef PG8_WAIT_V
#undef PG8_WAIT_L
#undef PG8_BAR
#undef PG8_SCHED
}
}

struct Args {
    const float* in[26];
    float* out; unsigned char* ws;
    int ph_lo, ph_hi;
};
enum { I_X = 0, I_C, I_CTX, I_CCTX, I_WADA, I_BADA, I_NFFN1, I_F1W13, I_F1W2, I_NMIX, I_WIN, I_QN, I_KN, I_POOLW, I_POOLS, I_SGUN, I_SGUW, I_SGUB,
       I_WBRP, I_WBRA, I_WBRS, I_WOUT, I_NFFN2, I_F2W13, I_F2W2, I_FNORM };

__device__ __forceinline__ float wave_sum(float v) {
#pragma unroll
    for (int o = 1; o < 64; o <<= 1) v += __shfl_xor(v, o);
    return v;
}

__device__ __forceinline__ void tr_item(const float* W, int N, bf16_t* WT, int ldt, int coloff, int mode13, float* scr, int item, int lane) {
    const int nblk = N / 32, kb = item / nblk, nb = item - kb * nblk, k0 = 64 * kb, n0 = 32 * nb;
#pragma unroll 8
    for (int i = 0; i < 32; ++i) { const int kk = 2 * i + (lane >> 5); scr[kk * 33 + (lane & 31)] = W[(size_t)(k0 + kk) * N + n0 + (lane & 31)]; }
    LDS_WAIT();
    int r0 = n0;
    if (mode13) { const int s = n0 / DFF, rem = n0 - s * DFF, t = rem >> 7, j = rem & 127; r0 = 256 * t + 128 * s + j; }
    const int c = lane & 7;
#pragma unroll
    for (int j = 0; j < 4; ++j) { const int n = (lane >> 3) + 8 * j; const float* s = scr + (8 * c) * 33 + n;
        u32x4 o; o.x = cvtpk(s[0 * 33], s[1 * 33]); o.y = cvtpk(s[2 * 33], s[3 * 33]); o.z = cvtpk(s[4 * 33], s[5 * 33]); o.w = cvtpk(s[6 * 33], s[7 * 33]);
        *(u32x4*)(WT + (size_t)(r0 + n) * ldt + coloff + k0 + 8 * c) = o; }
    LDS_WAIT();
}

__device__ __forceinline__ void convert_weights(const int tid, const Args& a, int l, unsigned char* lds) {
    const int lane = tid & 63, wave = tid >> 6;
    float* scr = (float*)(lds + wave * 8704);
    const int gw = blockIdx.x * 8 + wave, NGW = gridDim.x * 8;
    unsigned char* ws = a.ws;
    constexpr int I13 = (DM / 64) * (2 * DFF / 32), I2 = (DFF / 64) * (DM / 32), IIN = (DM / 64) * (NIN / 32), IOUT = (DM / 64) * (DM / 32), IBA = (512 / 64) * (DM / 32), IBS = (256 / 64) * (DM / 32);
    constexpr int NITEMS = 2 * I13 + 2 * I2 + IIN + IOUT + IBA + IBS;
    for (int it = gw; it < NITEMS; it += NGW) {
        int r = it; const float* W; int N; bf16_t* WT; int ldt = DM, coloff = 0, m13 = 0;
        if (r < 2 * I13) { const bool second = r >= I13; r -= second ? I13 : 0; W = a.in[second ? I_F2W13 : I_F1W13] + (size_t)l * DM * 2 * DFF; N = 2 * DFF; WT = (bf16_t*)(ws + (second ? WS_W13B : WS_W13A)); m13 = 1; }
        else if (r < 2 * I13 + 2 * I2) { r -= 2 * I13; const bool second = r >= I2; r -= second ? I2 : 0; W = a.in[second ? I_F2W2 : I_F1W2] + (size_t)l * DFF * DM; N = DM; WT = (bf16_t*)(ws + (second ? WS_W2B : WS_W2A)); ldt = DFF; }
        else if (r < 2 * I13 + 2 * I2 + IIN) { r -= 2 * I13 + 2 * I2; W = a.in[I_WIN] + (size_t)l * DM * NIN; N = NIN; WT = (bf16_t*)(ws + WS_WIN); }
        else if (r < 2 * I13 + 2 * I2 + IIN + IOUT) { r -= 2 * I13 + 2 * I2 + IIN; W = a.in[I_WOUT] + (size_t)l * DM * DM; N = DM; WT = (bf16_t*)(ws + WS_WOUT); }
        else if (r < 2 * I13 + 2 * I2 + IIN + IOUT + IBA) { r -= 2 * I13 + 2 * I2 + IIN + IOUT; W = a.in[I_WBRA] + (size_t)l * 512 * DM; N = DM; WT = (bf16_t*)(ws + WS_WCAT); coloff = 256; }
        else { r -= 2 * I13 + 2 * I2 + IIN + IOUT + IBA; W = a.in[I_WBRS] + (size_t)l * 256 * DM; N = DM; WT = (bf16_t*)(ws + WS_WCAT); coloff = 768; }
        tr_item(W, N, WT, ldt, coloff, m13, scr, r, lane);
    }
    {
        const float* pw = a.in[I_POOLW] + (size_t)l * 4 * 64 * 64; const float* ps = a.in[I_POOLS] + (size_t)l * 256; const float* wb = a.in[I_WBRP] + (size_t)l * 256 * DM;
        bf16_t* wcat = (bf16_t*)(ws + WS_WCAT);
        for (int it = blockIdx.x * 512 + tid; it < 1024 * 32; it += gridDim.x * 512) {
            const int n = it & 1023, kg = it >> 10, g = kg >> 3, c0 = (kg & 7) * 8;
            float s[8];
#pragma unroll
            for (int i = 0; i < 8; ++i) s[i] = 0.f;
            for (int d = 0; d < 64; ++d) {
                const float wv = wb[(size_t)(g * 64 + d) * DM + n] * ps[g * 64 + d];
#pragma unroll
                for (int i = 0; i < 8; ++i) s[i] += pw[(g * 64 + c0 + i) * 64 + d] * wv;
            }
            u32x4 o; o.x = cvtpk(s[0], s[1]); o.y = cvtpk(s[2], s[3]); o.z = cvtpk(s[4], s[5]); o.w = cvtpk(s[6], s[7]);
            *(u32x4*)(wcat + (size_t)n * DM + kg * 8) = o;
        }
    }
    {
        const float* sw = a.in[I_SGUW] + (size_t)l * 4 * 128 * 128; unsigned* dst = (unsigned*)(ws + WS_SGUW);
        for (int it = blockIdx.x * 512 + tid; it < 4 * 128 * 64; it += gridDim.x * 512) dst[it] = cvtpk(sw[2 * it], sw[2 * it + 1]);
    }
}

__device__ __forceinline__ void compute_biases(const int tid, const Args& a, int l, unsigned char* lds) {
    const int lane = tid & 63, wave = tid >> 6;
    float* sh = (float*)lds;
    const float* modl = (const float*)(a.ws + WS_MOD) + (size_t)l * 17 * NMOD;
    const int gw = blockIdx.x * 8 + wave, NGW = gridDim.x * 8;
    for (int j = 0; j < 3; ++j) {
        __syncthreads();
        for (int i = tid; i < 17 * DM; i += 512) sh[i] = modl[(size_t)(i >> 10) * NMOD + (3 * j) * DM + (i & 1023)];
        __syncthreads();
        const bf16_t* Wt = (const bf16_t*)(a.ws + (j == 0 ? WS_W13A : (j == 1 ? WS_WIN : WS_W13B)));
        float* bo = (float*)(a.ws + (j == 0 ? WS_B13A : (j == 1 ? WS_BIN : WS_B13B)));
        const int N = (j == 1) ? NIN : 2 * DFF;
        for (int n = gw; n < N; n += NGW) {
            float w[16];
#pragma unroll
            for (int c = 0; c < 4; ++c) { const u32x2 v = *(const u32x2*)(Wt + (size_t)n * DM + c * 256 + lane * 4); w[4 * c] = bflo(v.x); w[4 * c + 1] = bfhi(v.x); w[4 * c + 2] = bflo(v.y); w[4 * c + 3] = bfhi(v.y); }
            float mine = 0.f;
#pragma unroll 1
            for (int mb = 0; mb < 17; ++mb) {
                float p = 0.f;
#pragma unroll
                for (int c = 0; c < 4; ++c) { const f32x4 s = *(const f32x4*)(sh + mb * DM + c * 256 + lane * 4); p += w[4 * c] * s[0] + w[4 * c + 1] * s[1] + w[4 * c + 2] * s[2] + w[4 * c + 3] * s[3]; }
                p = wave_sum(p);
                if (lane == mb) mine = p;
            }
            if (lane < 17) bo[(size_t)lane * N + n] = mine;
        }
    }
}

__device__ __forceinline__ void post_phase(const int tid, const Args& a, int l, unsigned char* lds) {
    const int lane = tid & 63, wave = tid >> 6;
    unsigned char* ws = a.ws;
    const bf16_t* P = (const bf16_t*)(ws + WS_P);
    bf16_t* Bcat = (bf16_t*)a.out; bf16_t* kbuf = (bf16_t*)(ws + WS_KB); bf16_t* Vt = (bf16_t*)(ws + WS_VT);
    const float* rope = (const float*)(ws + WS_ROPE);
    const float* qn = a.in[I_QN] + l * 64; const float* kn = a.in[I_KN] + l * 64;
    const int nchf = (l == 0) ? 288 : 256;
    const int nSGU = nchf * 2, nPOOL = nchf, nV = 288, nQK = TT / 64, total = nSGU + nPOOL + nV + nQK;
    const int G_ = gridDim.x, c_ = blockIdx.x, nS_ = c_ < nSGU ? (nSGU - c_ + G_ - 1) / G_ : 0;
    for (int k_ = 0;; ++k_) {
        const int it = k_ < nS_ ? c_ + k_ * G_ : nSGU + (G_ - 1 - c_) + (k_ - nS_) * G_;
        if (it >= total) break;
        if (it < nSGU + nPOOL + nV) {
            const int ch = it < nSGU ? (it >> 1) : (it < nSGU + nPOOL ? it - nSGU : it - nSGU - nPOOL);
            const bool lat = ch < 256;
            const int b = lat ? (ch >> 4) : ((ch - 256) >> 1), t0 = lat ? (ch & 15) * 128 : ((ch - 256) & 1) * 128, L = lat ? SEQ : CTXL;
            const int Rb = lat ? b * SEQ : TL + b * CTXL, R0 = Rb + t0;
            if (it < nSGU) {
                const int gp = it & 1;
                bf16_t* vT = (bf16_t*)lds;
                bf16_t* Ws = (bf16_t*)(lds + 34816);
                const float* sn = a.in[I_SGUN] + l * 256;
                {
                    const bf16_t* wsrc = (const bf16_t*)(ws + WS_SGUW) + gp * 2 * 128 * 128;
#pragma unroll 4
                    for (int i2 = tid; i2 < 2 * 128 * 16; i2 += 512) { const int r = i2 >> 4, c = i2 & 15; *(u32x4*)(Ws + r * 136 + c * 8) = *(const u32x4*)(wsrc + r * 128 + c * 8); }
                }
#pragma unroll 2
                for (int i2 = tid; i2 < 128 * 32; i2 += 512) { const int l32 = i2 & 31, tok = i2 >> 5;
                    const u32x4 raw = *(const u32x4*)(P + (size_t)(R0 + tok) * NPC + 1280 + l32 * 8);
                    float x[8] = {bflo(raw.x), bfhi(raw.x), bflo(raw.y), bfhi(raw.y), bflo(raw.z), bfhi(raw.z), bflo(raw.w), bfhi(raw.w)};
                    float ss = 0.f;
#pragma unroll
                    for (int i = 0; i < 8; ++i) { x[i] = gelu_t(x[i]); ss += x[i] * x[i]; }
                    ss += __shfl_xor(ss, 1); ss += __shfl_xor(ss, 2); ss += __shfl_xor(ss, 4); ss += __shfl_xor(ss, 8); ss += __shfl_xor(ss, 16);
                    const float rinv = __builtin_amdgcn_rsqf(ss * (1.f / 256.f) + EPS);
                    if ((l32 >> 4) == gp) { const int cl = (l32 & 15) * 8;
#pragma unroll
                        for (int i = 0; i < 8; i += 2) { const unsigned pk = cvtpk(x[i] * rinv * sn[l32 * 8 + i], x[i + 1] * rinv * sn[l32 * 8 + i + 1]);
                            vT[(cl + i) * 136 + tok] = (bf16_t)(pk & 0xffffu); vT[(cl + i + 1) * 136 + tok] = (bf16_t)(pk >> 16); } }
                }
                __syncthreads();
                const int q32 = lane & 31, hi = lane >> 5, cblk = wave & 1, tblk = wave >> 1;
                const float* sb = a.in[I_SGUB] + (size_t)l * 4 * 128;
                const int tok = tblk * 32 + q32, R = R0 + tok;
#pragma unroll
                for (int g2 = 0; g2 < 2; ++g2) {
                    const int g = gp * 2 + g2;
                    u32x2 ur[4];
#pragma unroll
                    for (int rg = 0; rg < 4; ++rg) ur[rg] = *(const u32x2*)(P + (size_t)R * NPC + 1024 + g * 64 + cblk * 32 + 8 * rg + 4 * hi);
                    const float bias = sb[g * 128 + tok];
                    f32x16 acc;
#pragma unroll
                    for (int r = 0; r < 16; ++r) acc[r] = 0.f;
#pragma unroll
                    for (int ks = 0; ks < 8; ++ks) {
                        const bf16x8 af = *(const bf16x8*)(vT + (g2 * 64 + cblk * 32 + q32) * 136 + ks * 16 + hi * 8);
                        const bf16x8 bf = *(const bf16x8*)(Ws + (g2 * 128 + tblk * 32 + q32) * 136 + ks * 16 + hi * 8);
                        acc = __builtin_amdgcn_mfma_f32_32x32x16_bf16(af, bf, acc, 0, 0, 0);
                    }
#pragma unroll
                    for (int rg = 0; rg < 4; ++rg) {
                        const int c4 = g * 64 + cblk * 32 + 8 * rg + 4 * hi;
                        const float u0 = gelu_t(bflo(ur[rg].x)), u1 = gelu_t(bfhi(ur[rg].x)), u2 = gelu_t(bflo(ur[rg].y)), u3 = gelu_t(bfhi(ur[rg].y));
                        u32x2 w; w.x = cvtpk(u0 * (acc[4 * rg] + bias), u1 * (acc[4 * rg + 1] + bias)); w.y = cvtpk(u2 * (acc[4 * rg + 2] + bias), u3 * (acc[4 * rg + 3] + bias));
                        *(u32x2*)(Bcat + (size_t)R * DM + 768 + c4) = w;
                    }
                }
            } else if (it < nSGU + nPOOL) {
                unsigned* xs = (unsigned*)lds;
#pragma unroll 3
                for (int i2 = tid; i2 < 144 * 32; i2 += 512) { const int rr = i2 >> 5, c = i2 & 31; const int s = t0 - 8 + rr;
                    u32x4 v = (u32x4){0u, 0u, 0u, 0u};
                    if (s >= 0 && s < L) v = *(const u32x4*)(P + (size_t)(Rb + s) * NPC + 768 + c * 8);
                    *(u32x4*)(xs + rr * 128 + c * 4) = v; }
                __syncthreads();
                const int cp = tid & 127, tg = tid >> 7, hw = 1 << (cp >> 5);
                for (int tt = tg * 32; tt < tg * 32 + 32; ++tt) {
                    const int t = t0 + tt; const int lo = (t - hw) < 0 ? 0 : (t - hw), hi = (t + hw) > L ? L : (t + hw);
                    float s0 = 0.f, s1 = 0.f;
                    for (int s = lo; s < hi; ++s) { const unsigned v = xs[(s - t0 + 8) * 128 + cp]; s0 += bflo(v); s1 += bfhi(v); }
                    const float ic = 1.f / (float)(hi - lo); const unsigned xv = xs[(tt + 8) * 128 + cp];
                    *(unsigned*)(Bcat + (size_t)(R0 + tt) * DM + 2 * cp) = cvtpk(s0 * ic - bflo(xv), s1 * ic - bfhi(xv));
                }
            } else {
                bf16_t* vs = (bf16_t*)lds;
#pragma unroll 4
                for (int i2 = tid; i2 < 128 * 16; i2 += 512) { const int tok = i2 >> 4, c = i2 & 15;
                    *(u32x4*)(vs + tok * 136 + c * 8) = *(const u32x4*)(P + (size_t)(R0 + tok) * NPC + 640 + c * 8); }
                __syncthreads();
                const int posbase = lat ? t0 : SEQ + t0;
                for (int i2 = tid; i2 < 128 * 16; i2 += 512) { const int vr = i2 & 127, pg = i2 >> 7;
                    unsigned short e[8];
#pragma unroll
                    for (int i = 0; i < 8; ++i) { const int p = pg * 8 + i; const int kap = (p & ~12) | ((p & 4) << 1) | ((p & 8) >> 1); e[i] = vs[kap * 136 + vr]; }
                    u32x4 w; w.x = e[0] | ((unsigned)e[1] << 16); w.y = e[2] | ((unsigned)e[3] << 16); w.z = e[4] | ((unsigned)e[5] << 16); w.w = e[6] | ((unsigned)e[7] << 16);
                    *(u32x4*)(Vt + ((size_t)(b * 2 + (vr >> 6)) * 64 + (vr & 63)) * KVPOS + posbase + pg * 8) = w; }
            }
            __syncthreads();
        } else {
            const int R0 = (it - (nSGU + nPOOL + nV)) * 64; const bool lat = R0 < TL;
            const bool full = lat || (l == 0);
            const int nh = full ? 10 : 2, hbase = full ? 0 : 8;
#pragma unroll 2
            for (int i2 = tid; i2 < 64 * nh * 8; i2 += 512) {
                const int l8 = i2 & 7, hr = i2 >> 3, tok = hr / nh, hh = hbase + (hr - tok * nh);
                const int R = R0 + tok; const bool isq = hh < 8;
                const bf16_t* src = P + (size_t)R * NPC + (isq ? hh * 64 : 512 + (hh - 8) * 64) + l8 * 8;
                const u32x4 raw = *(const u32x4*)src;
                float x[8] = {bflo(raw.x), bfhi(raw.x), bflo(raw.y), bfhi(raw.y), bflo(raw.z), bfhi(raw.z), bflo(raw.w), bfhi(raw.w)};
                float ss = 0.f;
#pragma unroll
                for (int i = 0; i < 8; ++i) ss += x[i] * x[i];
                ss += __shfl_xor(ss, 1); ss += __shfl_xor(ss, 2); ss += __shfl_xor(ss, 4);
                const float rinv = __builtin_amdgcn_rsqf(ss * (1.f / 64.f) + EPS);
                const float* gn = (isq ? qn : kn) + l8 * 8;
                const f32x4 g0 = *(const f32x4*)gn, g1 = *(const f32x4*)(gn + 4);
                float y[8], o[8];
#pragma unroll
                for (int i = 0; i < 4; ++i) { y[i] = x[i] * rinv * g0[i]; y[4 + i] = x[4 + i] * rinv * g1[i]; }
                const int t = R & (SEQ - 1);
                const int half = l8 >> 2, second = (l8 >> 1) & 1, fi0 = (l8 & 1) * 8;
                const f32x4* rp = (const f32x4*)(rope + ((size_t)t * 32 + half * 16 + fi0) * 2);
                f32x4 cs[4];
                if (lat) {
#pragma unroll
                    for (int i = 0; i < 4; ++i) cs[i] = rp[i];
                }
#pragma unroll
                for (int i = 0; i < 8; ++i) {
                    const float partner = __shfl_xor(y[i], 2);
                    if (lat) { const float cv = cs[i >> 1][(i & 1) * 2], sv = cs[i >> 1][(i & 1) * 2 + 1];
                        o[i] = second ? (y[i] * cv + partner * sv) : (y[i] * cv - partner * sv); }
                    else o[i] = y[i];
                }
                const float sc = isq ? QSCALE : 1.f;
                u32x4 w; w.x = cvtpk(o[0] * sc, o[1] * sc); w.y = cvtpk(o[2] * sc, o[3] * sc); w.z = cvtpk(o[4] * sc, o[5] * sc); w.w = cvtpk(o[6] * sc, o[7] * sc);
                bf16_t* dst = isq ? Bcat + (size_t)R * DM + 256 + hh * 64 + l8 * 8 : kbuf + (size_t)R * 128 + (hh - 8) * 64 + l8 * 8;
                *(u32x4*)dst = w;
            }
        }
    }
}

__device__ __forceinline__ void attn_phase(const int tid, const Args& a, int l, unsigned char* lds, int dry) {
    const int lane = tid & 63, w = tid >> 6, q32 = lane & 31, hi = lane >> 5;
    bf16_t* Bcat = (bf16_t*)a.out; const bf16_t* kbuf = (const bf16_t*)(a.ws + WS_KB); const bf16_t* Vt = (const bf16_t*)(a.ws + WS_VT);
    const int G = gridDim.x, c = blockIdx.x;
    const int per = (512 + G - 1) / G;
    const int nlat = (c * per >= 512) ? 0 : ((c + 1) * per > 512 ? 512 - c * per : per);
    const int nctx = (l == 0 && c < 64) ? (64 - c + G - 1) / G : 0;
    const int kr = tid >> 3, kc = tid & 7;
    float sshift;
    { float gq = 0.f, gk = 0.f; const float* qn = a.in[I_QN] + l * 64; const float* kn = a.in[I_KN] + l * 64;
      for (int i = 0; i < 64; ++i) { gq = fmaxf(gq, fabsf(qn[i])); gk = fmaxf(gk, fabsf(kn[i])); }
      const float sbound = QSCALE * 64.f * 1.02f * gq * gk; sshift = sbound > 64.f ? sbound - 64.f : 0.f; }
    const bool use_shift = __builtin_amdgcn_readfirstlane(__float_as_uint(sshift)) != 0u;
    for (int ui = 0; ui < nlat + nctx; ++ui) {
        int b, kvh, qrow0, jt0, NT;
        if (ui < nlat) { const int u = c * per + ui; const int bk = u >> 4, qb = u & 15; b = bk >> 1; kvh = bk & 1; qrow0 = b * SEQ + qb * 128; jt0 = 0; NT = 18; }
        else { const int u = c + (ui - nlat) * G; const int bk = u >> 1, qb = u & 1; b = bk >> 1; kvh = bk & 1; qrow0 = TL + b * CTXL + qb * 128; jt0 = 16; NT = 2; }
        const int head = kvh * 4 + (w >> 1); const int myrow = qrow0 + 64 * (w & 1) + q32;
        bf16_t* qp = Bcat + (size_t)myrow * DM + 256 + head * 64;
        bf16x8 qf[2][4];
#pragma unroll
        for (int sb = 0; sb < 2; ++sb)
#pragma unroll
            for (int ds = 0; ds < 4; ++ds) qf[sb][ds] = *(const bf16x8*)(qp + (size_t)sb * 32 * DM + 16 * ds + hi * 8);
        const int vr = tid >> 4, vc = tid & 15;
        const bf16_t* vsrc = Vt + ((size_t)(b * 2 + kvh) * 64 + vr) * KVPOS + vc * 8;
#define KSRC(jt) (kbuf + (size_t)(((jt) < 16 ? b * SEQ + 128 * (jt) : TL + b * CTXL + 128 * ((jt) - 16)) + kr) * 128 + kvh * 64 + kc * 8)
#define LDS_K(buf) (lds + (buf) * 18432)
#define LDS_V(buf) (lds + 36864 + (buf) * 17408)
        u32x4 kreg0 = *(const u32x4*)KSRC(jt0), kreg1 = *(const u32x4*)(KSRC(jt0) + 64 * 128);
        u32x4 vreg0 = *(const u32x4*)(vsrc + 128 * jt0), vreg1 = *(const u32x4*)(vsrc + 128 * jt0 + (size_t)32 * KVPOS);
        *(u32x4*)(LDS_K(0) + kr * 144 + kc * 16) = kreg0; *(u32x4*)(LDS_K(0) + (kr + 64) * 144 + kc * 16) = kreg1;
        *(u32x4*)(LDS_V(0) + vr * 272 + vc * 16) = vreg0; *(u32x4*)(LDS_V(0) + (vr + 32) * 272 + vc * 16) = vreg1;
        __syncthreads();
        f32x16 o0[2], o1[2];
        float lrun[2];
#pragma unroll
        for (int sb = 0; sb < 2; ++sb) { lrun[sb] = 0.f;
#pragma unroll
            for (int r = 0; r < 16; ++r) { o0[sb][r] = 0.f; o1[sb][r] = 0.f; } }
        for (int j = 0; j < NT; ++j) {
            if (j + 1 < NT) { kreg0 = *(const u32x4*)KSRC(jt0 + j + 1); kreg1 = *(const u32x4*)(KSRC(jt0 + j + 1) + 64 * 128);
                vreg0 = *(const u32x4*)(vsrc + 128 * (jt0 + j + 1)); vreg1 = *(const u32x4*)(vsrc + 128 * (jt0 + j + 1) + (size_t)32 * KVPOS); }
#pragma unroll 1
            for (int h = 0; h < 2; ++h) {
            const unsigned char* Kb = LDS_K(j & 1) + h * 64 * 144; const unsigned char* Vb = LDS_V(j & 1) + h * 128;
            f32x16 p0[2], p1[2];
            const f32x16 czero = {0.f, 0.f, 0.f, 0.f, 0.f, 0.f, 0.f, 0.f, 0.f, 0.f, 0.f, 0.f, 0.f, 0.f, 0.f, 0.f};
#pragma unroll
            for (int ds = 0; ds < 4; ++ds) {
                const bf16x8 k0 = *(const bf16x8*)(Kb + q32 * 144 + ds * 32 + hi * 16);
                const bf16x8 k1 = *(const bf16x8*)(Kb + (32 + q32) * 144 + ds * 32 + hi * 16);
#pragma unroll
                for (int sb = 0; sb < 2; ++sb) {
                    p0[sb] = __builtin_amdgcn_mfma_f32_32x32x16_bf16(k0, qf[sb][ds], ds == 0 ? czero : p0[sb], 0, 0, 0);
                    p1[sb] = __builtin_amdgcn_mfma_f32_32x32x16_bf16(k1, qf[sb][ds], ds == 0 ? czero : p1[sb], 0, 0, 0);
                }
            }
            if (use_shift) {
#pragma unroll
                for (int sb = 0; sb < 2; ++sb)
#pragma unroll
                    for (int r = 0; r < 16; ++r) { p0[sb][r] -= sshift; p1[sb][r] -= sshift; }
            }
            u32x4 pw[2][4];
#pragma unroll
            for (int sb = 0; sb < 2; ++sb) {
                float ls = 0.f;
#pragma unroll
                for (int r = 0; r < 16; ++r) { p0[sb][r] = __builtin_amdgcn_exp2f(p0[sb][r]); p1[sb][r] = __builtin_amdgcn_exp2f(p1[sb][r]); ls += p0[sb][r] + p1[sb][r]; }
                lrun[sb] += ls;
                pw[sb][0] = (u32x4){cvtpk(p0[sb][0], p0[sb][1]), cvtpk(p0[sb][2], p0[sb][3]), cvtpk(p0[sb][4], p0[sb][5]), cvtpk(p0[sb][6], p0[sb][7])};
                pw[sb][1] = (u32x4){cvtpk(p0[sb][8], p0[sb][9]), cvtpk(p0[sb][10], p0[sb][11]), cvtpk(p0[sb][12], p0[sb][13]), cvtpk(p0[sb][14], p0[sb][15])};
                pw[sb][2] = (u32x4){cvtpk(p1[sb][0], p1[sb][1]), cvtpk(p1[sb][2], p1[sb][3]), cvtpk(p1[sb][4], p1[sb][5]), cvtpk(p1[sb][6], p1[sb][7])};
                pw[sb][3] = (u32x4){cvtpk(p1[sb][8], p1[sb][9]), cvtpk(p1[sb][10], p1[sb][11]), cvtpk(p1[sb][12], p1[sb][13]), cvtpk(p1[sb][14], p1[sb][15])};
            }
#pragma unroll
            for (int s = 0; s < 4; ++s) {
                const bf16x8 v0 = *(const bf16x8*)(Vb + q32 * 272 + s * 32 + hi * 16);
                const bf16x8 v1 = *(const bf16x8*)(Vb + (32 + q32) * 272 + s * 32 + hi * 16);
#pragma unroll
                for (int sb = 0; sb < 2; ++sb) {
                    const bf16x8 pa = __builtin_bit_cast(bf16x8, pw[sb][s]);
                    o0[sb] = __builtin_amdgcn_mfma_f32_32x32x16_bf16(v0, pa, o0[sb], 0, 0, 0);
                    o1[sb] = __builtin_amdgcn_mfma_f32_32x32x16_bf16(v1, pa, o1[sb], 0, 0, 0);
                }
            }
            }
            if (j + 1 < NT) { const int nb_ = (j + 1) & 1;
                *(u32x4*)(LDS_K(nb_) + kr * 144 + kc * 16) = kreg0; *(u32x4*)(LDS_K(nb_) + (kr + 64) * 144 + kc * 16) = kreg1;
                *(u32x4*)(LDS_V(nb_) + vr * 272 + vc * 16) = vreg0; *(u32x4*)(LDS_V(nb_) + (vr + 32) * 272 + vc * 16) = vreg1; }
            __syncthreads();
        }
#undef LDS_K
#undef LDS_V
#undef KSRC
#pragma unroll
        for (int sb = 0; sb < 2; ++sb) {
            float lt = lrun[sb]; lt += __shfl_xor(lt, 32);
            const float inv = 1.f / lt;
            bf16_t* op = qp + (size_t)sb * 32 * DM;
#pragma unroll
            for (int rg = 0; rg < 4; ++rg) {
                u32x2 w0; w0.x = cvtpk(o0[sb][4 * rg] * inv, o0[sb][4 * rg + 1] * inv); w0.y = cvtpk(o0[sb][4 * rg + 2] * inv, o0[sb][4 * rg + 3] * inv);
                u32x2 w1; w1.x = cvtpk(o1[sb][4 * rg] * inv, o1[sb][4 * rg + 1] * inv); w1.y = cvtpk(o1[sb][4 * rg + 2] * inv, o1[sb][4 * rg + 3] * inv);
                if (!dry) { *(u32x2*)(op + 8 * rg + 4 * hi) = w0; *(u32x2*)(op + 32 + 8 * rg + 4 * hi) = w1; }
            }
        }
    }
}

__global__ void __launch_bounds__(512, 2) fwd_megakernel(Args a) {
    extern __shared__ __attribute__((aligned(16))) unsigned char lds[];
    cg::grid_group grid = cg::this_grid();
    unsigned char* ws = a.ws;
    float* modraw = (float*)(ws + WS_MOD);
    float* ssq = (float*)(ws + WS_SSQ);
    bf16_t* Ap = (bf16_t*)(ws + WS_AP);
    float* hctx = (float*)(ws + WS_HCTX);
    LAS unsigned char* ldsl = (LAS unsigned char*)lds;

    int second = 0; unsigned nbar = 0;
    const int wave_s = __builtin_amdgcn_readfirstlane((int)threadIdx.x >> 6);
    for (int ph = a.ph_lo; ph < a.ph_hi; ++ph) {
        int lid_; asm volatile("v_mbcnt_lo_u32_b32 %0, -1, 0\n\tv_mbcnt_hi_u32_b32 %0, -1, %0" : "=v"(lid_));
        int tid = wave_s * 64 + lid_; asm volatile("" : "+v"(tid));
        const int lane = tid & 63, wave = tid >> 6;
        int kind;
        { const int sp_ = ph < 11 ? ph - 2 : ph - 13;
          kind = (ph == 0 || ph == 1 || ph == 11 || ph == 12) ? 0 : (ph == 22 ? 7 : ((sp_ == 0 || sp_ == 7) ? 1 : ((sp_ == 1 || sp_ == 6 || sp_ == 8) ? 2 : (sp_ == 2 ? 3 : (sp_ == 3 ? 4 : (sp_ == 4 ? 5 : 6)))))); }
        const int dry = (REPEAT_MASK != 0) && ((REPEAT_MASK >> kind) & 1) && !second;
        if (ph == 0 || ph == 11) {
          if (ph == 0) {
            for (int i = blockIdx.x * 512 + tid; i < 6 * TT; i += gridDim.x * 512) ssq[TT + i] = 0.f;
            {
                float* rope = (float*)(ws + WS_ROPE);
                for (int i = blockIdx.x * 512 + tid; i < SEQ * 32; i += gridDim.x * 512) {
                    const int t = i >> 5, j = i & 31, fi = j & 15; const float pos = (float)((j < 16) ? (t >> 6) : (t & 63));
                    const float invf = __builtin_amdgcn_exp2f(-(float)fi * (13.287712379549449f / 16.f));
                    const float ang = pos * invf;
                    rope[2 * i] = __cosf(ang); rope[2 * i + 1] = __sinf(ang);
                }
            }
            {
                float* sc = (float*)lds;
                float* red = (float*)(lds + 69632);
                for (int i = tid; i < 17 * DM; i += 512) { const int mb = i >> 10, k = i & 1023; const float cv = mb < 16 ? a.in[I_C][mb * DM + k] : a.in[I_CCTX][k]; sc[i] = cv * sigm(cv); }
                __syncthreads();
                for (int item = blockIdx.x; item < 288; item += gridDim.x) {
                    const int l = item / 144, n0 = (item - l * 144) * 64;
                    const float* wp = a.in[I_WADA] + ((size_t)l * DM + wave * 128) * NMOD + n0 + lane;
                    float acc[17];
#pragma unroll
                    for (int mb = 0; mb < 17; ++mb) acc[mb] = 0.f;
#pragma unroll 16
                    for (int k = 0; k < 128; ++k) { const float wv = wp[(size_t)k * NMOD];
#pragma unroll
                        for (int mb = 0; mb < 17; ++mb) acc[mb] += sc[mb * DM + wave * 128 + k] * wv; }
#pragma unroll
                    for (int mb = 0; mb < 17; ++mb) red[(wave * 17 + mb) * 64 + lane] = acc[mb];
                    __syncthreads();
                    for (int i = tid; i < 17 * 64; i += 512) { const int mb = i >> 6, col = i & 63; float s = a.in[I_BADA][l * NMOD + n0 + col];
#pragma unroll
                        for (int w8 = 0; w8 < 8; ++w8) s += red[(w8 * 17 + mb) * 64 + col];
                        modraw[((size_t)l * 17 + mb) * NMOD + n0 + col] = s; }
                    __syncthreads();
                }
            }
            __syncthreads();
          }
            convert_weights(tid, a, ph == 0 ? 0 : 1, lds);
        } else if (ph == 1 || ph == 12) {
            const int l = ph == 1 ? 0 : 1;
            compute_biases(tid, a, l, lds);
            if (l == 0) {
                const float* nrm = a.in[I_NFFN1]; const int gw = blockIdx.x * 8 + wave, NGW = gridDim.x * 8;
                for (int R = gw; R < TT; R += NGW) {
                    const float* xr = R < TL ? a.in[I_X] + (size_t)R * DM : a.in[I_CTX] + (size_t)(R - TL) * DM;
                    const int mb = R < TL ? (R >> 11) : 16; const float* scl = modraw + (size_t)mb * NMOD + DM;
                    float ss = 0.f;
#pragma unroll
                    for (int c4 = 0; c4 < 4; ++c4) { const int col = c4 * 256 + lane * 4; const f32x4 v = *(const f32x4*)(xr + col);
                        ss += (v[0] * v[0] + v[1] * v[1]) + (v[2] * v[2] + v[3] * v[3]);
                        const f32x4 g = *(const f32x4*)(nrm + col) * (*(const f32x4*)(scl + col) + 1.f), y = v * g;
                        u32x2 w; w.x = cvtpk(y[0], y[1]); w.y = cvtpk(y[2], y[3]); *(u32x2*)(Ap + (size_t)R * DM + col) = w; }
                    ss = wave_sum(ss);
                    if (lane == 0) ssq[R] = ss;
                }
            }
        } else if (ph == 22) {
            const float* fn = a.in[I_FNORM]; const int gw = blockIdx.x * 8 + wave, NGW = gridDim.x * 8;
            for (int R = gw; R < TL; R += NGW) {
                const float r = __builtin_amdgcn_rsqf(ssq[(size_t)6 * TT + R] * (1.f / DM) + EPS);
                const float* hrow = a.out + (size_t)R * DM; float* orow = a.out + (size_t)R * DM;
#pragma unroll
                for (int c4 = 0; c4 < 4; ++c4) { const int col = c4 * 256 + lane * 4; const f32x4 v = *(const f32x4*)(hrow + col) * r * *(const f32x4*)(fn + col); *(f32x4*)(orow + col) = v; }
            }
        } else {
            const int l = ph < 11 ? 0 : 1, sp = ph < 11 ? ph - 2 : ph - 13;
            const float* modl = modraw + (size_t)l * 17 * NMOD;
            const int nMall = TT / 256, nMlat = TL / 256;
            if (sp == 0 || sp == 7) {
                const bool f1 = sp == 0; const int nM = (f1 || l == 0) ? nMall : nMlat;
                pg8::TileSched S = pg8::make_sched(nM, 2 * DFF / 256, DM);
                pg8::EpiSwiGLU E{(bf16_t*)(ws + WS_G), (const float*)(ws + (f1 ? WS_B13A : WS_B13B)), ssq + (size_t)(3 * l + (f1 ? 0 : 2)) * TT};
                pg8::gemm_phase(tid, ldsl, Ap, DM, (const bf16_t*)(ws + (f1 ? WS_W13A : WS_W13B)), DM, S, E);
            } else if (sp == 1 || sp == 8 || sp == 6) {
                if (STAGGER_TICKS > 0) {
                    if (tid == 0) { const unsigned long long t0 = __builtin_amdgcn_s_memrealtime(); const unsigned long long d = (unsigned long long)((blockIdx.x & 7) * STAGGER_TICKS);
                        while (__builtin_amdgcn_s_memrealtime() - t0 < d) __builtin_amdgcn_s_sleep(4); }
                    __syncthreads();
                }
                const int nM = (sp == 1 || l == 0) ? nMall : nMlat;
                const int j = sp == 1 ? 0 : (sp == 6 ? 1 : 2);
                const bool lastg = (l == 1 && sp == 8);
                const int ln = (sp == 8) ? l + 1 : l, jn = (sp == 8) ? 0 : j + 1;
                const float* nrm = lastg ? a.in[I_NFFN1] : (jn == 0 ? a.in[I_NFFN1] : (jn == 1 ? a.in[I_NMIX] : a.in[I_NFFN2])) + (size_t)ln * DM;
                const float* scl = lastg ? modraw : modraw + (size_t)ln * 17 * NMOD + (3 * jn + 1) * DM;
                const float* nrc = (j == 0 ? a.in[I_NFFN1] : (j == 1 ? a.in[I_NMIX] : a.in[I_NFFN2])) + (size_t)l * DM;
                const float* scc = modl + (3 * j + 1) * DM;
                float* ssqn = ssq + (size_t)(3 * l + j + 1) * TT;
                pg8::EpiRes E{Ap, lastg ? a.out : nullptr, modl + (3 * j + 2) * DM, sp == 6 ? 1.0f : 0.5f, nrc, scc, nrm, scl, ssqn, dry};
                const bool wo = sp == 6; const int Kd = wo ? DM : DFF;
                pg8::TileSched S = (wo || nM != nMall) ? pg8::make_sched(nM, DM / 256, Kd) : pg8::make_ctxtail(Kd, (float*)(ws + WS_P), (unsigned*)(ws + WS_CTL) + 64, (unsigned)(ph + 1));
                if (XCD_OFFSET) pg8::add_xcd_offset(S, Kd, (float*)(ws + (wo ? WS_G : WS_P)));
                pg8::gemm_phase(tid, ldsl, (const bf16_t*)(ws + (wo ? WS_P : WS_G)), Kd, (const bf16_t*)(ws + (wo ? WS_WOUT : (sp == 1 ? WS_W2A : WS_W2B))), Kd, S, E);
            } else if (sp == 2) {
                pg8::TileSched S = pg8::make_sched(l == 0 ? nMall : nMlat, NIN / 256, DM);
                if (l == 1) { S.n2 = TC / 256; S.pm0_2 = nMlat; S.pn0_2 = 2; }
                pg8::EpiIn E{(bf16_t*)(ws + WS_P), (bf16_t*)(ws + WS_G), (const float*)(ws + WS_BIN), ssq + (size_t)(3 * l + 1) * TT};
                pg8::gemm_phase(tid, ldsl, Ap, DM, (const bf16_t*)(ws + WS_WIN), DM, S, E);
            } else if (sp == 3) {
                post_phase(tid, a, l, lds);
            } else if (sp == 4) {
                attn_phase(tid, a, l, lds, dry);
            } else if (sp == 5) {
                pg8::TileSched S = pg8::make_sched(l == 0 ? nMall : nMlat, DM / 256, DM);
                S.nb = 3;
                pg8::EpiMerge E{(const bf16_t*)(ws + WS_G), (bf16_t*)(ws + WS_P)};
                pg8::gemm_phase(tid, ldsl, (const bf16_t*)a.out, DM, (const bf16_t*)(ws + WS_WCAT), DM, S, E);
            }
        }
        if (REPEAT_MASK != 0) { if (dry) { second = 1; --ph; __syncthreads(); continue; } second = 0; }
        if (ph + 1 < a.ph_hi) {
            asm volatile("s_waitcnt vmcnt(0) lgkmcnt(0)" ::: "memory");
            __syncthreads();
            if (ph == a.ph_lo) { if (tid == 0) __builtin_amdgcn_fence(__ATOMIC_RELEASE, "agent"); grid.sync(); if (tid == 0) __builtin_amdgcn_fence(__ATOMIC_ACQUIRE, "agent"); }
            else {
              for (int bb = 0; bb <= EXTRA_BAR; ++bb) {
                if (tid == 0) {
                    unsigned* ctl = (unsigned*)(ws + WS_CTL);
                    const unsigned G_ = gridDim.x, g_ = blockIdx.x & 7u, ngrp = G_ < 8u ? G_ : 8u, memb = (G_ - g_ + 7u) >> 3;
                    unsigned* gcnt = ctl + 2304 + 64 * g_; unsigned* ggen = ctl + 2816 + 64 * g_; unsigned* top = ctl + 3328;
                    __builtin_amdgcn_fence(__ATOMIC_RELEASE, "agent");
                    ++nbar;
                    const unsigned old = __hip_atomic_fetch_add(gcnt, 1u, __ATOMIC_RELAXED, __HIP_MEMORY_SCOPE_AGENT);
                    if (old + 1u == nbar * memb) {
                        __hip_atomic_fetch_add(top, 1u, __ATOMIC_RELAXED, __HIP_MEMORY_SCOPE_AGENT);
                        while (__hip_atomic_load(top, __ATOMIC_RELAXED, __HIP_MEMORY_SCOPE_AGENT) < nbar * ngrp) __builtin_amdgcn_s_sleep(1);
                        __hip_atomic_store(ggen, nbar, __ATOMIC_RELAXED, __HIP_MEMORY_SCOPE_AGENT);
                    } else {
                        while (__hip_atomic_load(ggen, __ATOMIC_RELAXED, __HIP_MEMORY_SCOPE_AGENT) < nbar) __builtin_amdgcn_s_sleep(1);
                    }
                    __builtin_amdgcn_fence(__ATOMIC_ACQUIRE, "agent");
                }
                if (EXTRA_BAR) { asm volatile("s_waitcnt vmcnt(0)" ::: "memory"); __syncthreads(); }
              }
            }
            asm volatile("s_waitcnt vmcnt(0)" ::: "memory");
            __syncthreads();
        }
    }
}

extern "C" void kernel_launch(void* const* d_in, const int* in_sizes, int n_in, void* d_out, int out_size, void* d_ws, size_t ws_size, hipStream_t stream) {
    static int grid = 0;
    if (grid == 0) {
        if (n_in != 26 || out_size != TL * DM || ws_size < WS_END) { fprintf(stderr, "kernel_launch: unexpected shapes (n_in %d out %d ws %zu need %zu)\n", n_in, out_size, ws_size, (size_t)WS_END); grid = -1; return; }
        int dev = 0, cus = 0, per_cu = 0;
        if (hipGetDevice(&dev) != hipSuccess || hipDeviceGetAttribute(&cus, hipDeviceAttributeMultiprocessorCount, dev) != hipSuccess) { grid = -1; return; }
        if (hipFuncSetAttribute((const void*)fwd_megakernel, hipFuncAttributeMaxDynamicSharedMemorySize, LDS_BYTES) != hipSuccess) { fprintf(stderr, "kernel_launch: hipFuncSetAttribute failed\n"); grid = -1; return; }
        if (hipOccupancyMaxActiveBlocksPerMultiprocessor(&per_cu, (const void*)fwd_megakernel, 512, LDS_BYTES) != hipSuccess || per_cu < 1) per_cu = 1;
        (void)hipGetLastError();
        grid = cus * per_cu;
    }
    if (grid < 0) return;
    Args a{};
    for (int i = 0; i < 26; ++i) a.in[i] = (const float*)d_in[i];
    a.out = (float*)d_out; a.ws = (unsigned char*)d_ws;
#if MK_ONE_LAUNCH
    a.ph_lo = 0; a.ph_hi = NPHASES;
    if (hipMemsetAsync((char*)d_ws + WS_CTL, 0, 16384, stream) != hipSuccess) { fprintf(stderr, "memset failed\n"); return; }
    void* args[] = {&a};
    hipError_t e = hipLaunchCooperativeKernel((const void*)fwd_megakernel, dim3(grid), dim3(512), args, LDS_BYTES, stream);
    if (e != hipSuccess) fprintf(stderr, "cooperative launch failed: %s (grid %d)\n", hipGetErrorString(e), grid);
#else
    for (int ph = 0; ph < NPHASES; ++ph) {
        a.ph_lo = ph; a.ph_hi = ph + 1;
        hipLaunchKernelGGL(fwd_megakernel, dim3(grid), dim3(512), LDS_BYTES, stream, a);
    }
#endif
}
```

```cpp
#include <hip/hip_runtime.h>
#include <hip/hip_cooperative_groups.h>
#include <cstdio>
#include <cstdint>
namespace cg = cooperative_groups;

#ifndef REPEAT_MASK
#define REPEAT_MASK 0
#endif
#ifndef STAGGER_TICKS
#define STAGGER_TICKS 0
#endif
#ifndef XCD_OFFSET
#define XCD_OFFSET 0
#endif
#ifndef EXTRA_BAR
#define EXTRA_BAR 0
#endif
#ifndef MK_ONE_LAUNCH
#define MK_ONE_LAUNCH 1
#endif

#define LAS __attribute__((address_space(3)))
#define GAS __attribute__((address_space(1)))
typedef unsigned short bf16_t;
typedef short bf16x8 __attribute__((ext_vector_type(8)));
typedef float f32x4 __attribute__((ext_vector_type(4)));
typedef float f32x16 __attribute__((ext_vector_type(16)));
typedef unsigned u32x4 __attribute__((ext_vector_type(4)));
typedef unsigned u32x2 __attribute__((ext_vector_type(2)));
typedef float f32x2_t __attribute__((ext_vector_type(2)));
typedef __bf16 bf16x2_t __attribute__((ext_vector_type(2)));

constexpr int DM = 1024, NBATCH = 16, SEQ = 2048, CTXL = 256;
constexpr int TL = NBATCH * SEQ;
constexpr int TC = NBATCH * CTXL;
constexpr int TT = TL + TC;
constexpr int DFF = 2816, NIN = 4608, NPC = 1536, NGC = 3072, NMOD = 9 * DM;
constexpr int KVPOS = SEQ + CTXL;
constexpr float EPS = 1e-6f;
constexpr float QSCALE = 0.125f * 1.4426950408889634f;

constexpr size_t MiB = 1u << 20;
constexpr size_t al256(size_t x) { return (x + 255) & ~(size_t)255; }
constexpr size_t SZ_W13 = (size_t)2 * DFF * DM * 2, SZ_W2 = (size_t)DM * DFF * 2, SZ_WIN = (size_t)NIN * DM * 2, SZ_WSQ = (size_t)DM * DM * 2;
constexpr size_t WS_W13A = 0;
constexpr size_t WS_W2A = WS_W13A + SZ_W13;
constexpr size_t WS_WIN = WS_W2A + SZ_W2;
constexpr size_t WS_WCAT = WS_WIN + SZ_WIN;
constexpr size_t WS_WOUT = WS_WCAT + SZ_WSQ;
constexpr size_t WS_W13B = WS_WOUT + SZ_WSQ;
constexpr size_t WS_W2B = WS_W13B + SZ_W13;
constexpr size_t WS_SGUW = WS_W2B + SZ_W2;
constexpr size_t WS_MOD = al256(WS_SGUW + 4 * 128 * 128 * 2);
constexpr size_t WS_B13A = al256(WS_MOD + (size_t)2 * 17 * NMOD * 4);
constexpr size_t WS_BIN = al256(WS_B13A + (size_t)17 * 2 * DFF * 4);
constexpr size_t WS_B13B = al256(WS_BIN + (size_t)17 * NIN * 4);
constexpr size_t WS_SSQ = al256(WS_B13B + (size_t)17 * 2 * DFF * 4);
constexpr size_t WS_ROPE = al256(WS_SSQ + (size_t)7 * TT * 4);
constexpr size_t WS_HCTX = al256(WS_ROPE + (size_t)SEQ * 32 * 8);
constexpr size_t WS_AP = al256(WS_HCTX + (size_t)TC * DM * 4);
constexpr size_t WS_KB = al256(WS_AP + (size_t)TT * DM * 2);
constexpr size_t WS_VT = al256(WS_KB + (size_t)TT * 128 * 2);
constexpr size_t WS_P = al256(WS_VT + (size_t)NBATCH * 2 * 64 * KVPOS * 2);
constexpr size_t WS_G = al256(WS_P + (size_t)TT * NPC * 2);
constexpr size_t WS_CTL = al256(WS_G + (size_t)TT * NGC * 2);
constexpr size_t WS_END = WS_CTL + 16384;

constexpr int LDS_BYTES = 147456;
constexpr int NPHASES = 23;

__device__ __forceinline__ unsigned cvtpk(float lo, float hi) { f32x2_t v = {lo, hi}; bf16x2_t b = __builtin_convertvector(v, bf16x2_t); return __builtin_bit_cast(unsigned, b); }
__device__ __forceinline__ float bflo(unsigned u) { return __uint_as_float(u << 16); }
__device__ __forceinline__ float bfhi(unsigned u) { return __uint_as_float(u & 0xffff0000u); }
__device__ __forceinline__ float fexp(float x) { return __builtin_amdgcn_exp2f(x * 1.4426950408889634f); }
__device__ __forceinline__ float frcp(float x) { return __builtin_amdgcn_rcpf(x); }
__device__ __forceinline__ float sigm(float x) { return frcp(1.f + fexp(-x)); }
__device__ __forceinline__ float gelu_t(float x) { const float z = 0.7978845608028654f * (x + 0.044715f * x * x * x); return x * frcp(1.f + fexp(-2.f * z)); }
#define LDS_WAIT() asm volatile("s_waitcnt lgkmcnt(0)" ::: "memory")
__device__ __forceinline__ uintptr_t uni64(uintptr_t v) { const unsigned lo = __builtin_amdgcn_readfirstlane((unsigned)v), hi = __builtin_amdgcn_readfirstlane((unsigned)(v >> 32)); return ((uintptr_t)hi << 32) | lo; }

namespace pg8 {
constexpr int BM = 256, BK = 64, HALF = 128, HTB = HALF * BK * 2, STAGE_BYTES = 8 * HTB, NXCD = 8, WGM = 4;
__device__ __forceinline__ int lds_byte(int r, int c) { const int st = (r >> 4) * 2 + (c >> 5), rr = r & 15, cc = c & 31, ob = rr * 64 + cc * 2; return st * 1024 + (ob ^ (((ob >> 9) & 1) << 5)); }
__device__ __forceinline__ void stage_rc(int b, int& R, int& C) { const int st = b / 1024, sb = b % 1024, swz = sb ^ (((sb >> 9) & 1) << 5); R = (st >> 1) * 16 + swz / 64; C = (st & 1) * 32 + (swz % 64) / 2; }
__device__ __forceinline__ int perm32(int rho) { const int n = rho >> 4, i = rho & 15; return 8 * (i >> 2) + 4 * n + (i & 3); }

struct Unit { int pm, pn, k0, nt, tag, te; };

struct TileSched {
    int c, G, nM1, nN1, n1, pn0_1, n2, pm0_2, pn0_2, nb, ntk;
    int sk, P, R, xo, kx; float* slots; unsigned* flags; unsigned epoch;
    __device__ __forceinline__ void map_tile(int L, int& pm, int& pn) const {
        int wgid; { const int q = n1 / NXCD, r = n1 % NXCD, xcd = L % NXCD, off = L / NXCD; wgid = (xcd < r ? xcd * (q + 1) : r * (q + 1) + (xcd - r) * q) + off; }
        const int nig = WGM * nN1, gid = wgid / nig, fm = gid * WGM, gsz = (nM1 - fm) < WGM ? (nM1 - fm) : WGM;
        pm = fm + ((wgid % nig) % gsz); pn = pn0_1 + (wgid % nig) / gsz;
    }
    __device__ __forceinline__ bool next(int i, Unit& u) const {
        int L = c, k0 = 0, nt = ntk, tag = 0; bool valid, ctxp = false, rect2 = false;
        if (xo) {
            const int nr = sk ? R : (c < n1 ? (n1 - c + G - 1) / G : 0);
            const int extra = (kx > 0 && nr > 0) ? 1 : 0;
            const bool inmain = i < nr + extra, first = (i == 0) && (extra != 0), last = inmain && (i >= nr);
            L = (i == 0 || last) ? c : i * G + c;
            k0 = first ? kx * 128 : 0; nt = first ? ntk - 2 * kx : (last ? 2 * kx : ntk); tag = first ? 4 : (last ? 8 : 0);
            ctxp = (sk != 0) && (i == nr + extra);
            valid = inmain || ctxp;
        } else if (sk) {
            L = i * G + c; ctxp = (i == R); valid = i <= R;
        } else {
            int ti = i, br = 0;
            if (nb == 3) { ti = i / 3; br = i - ti * 3; k0 = br * 256 + (br >> 1) * 256; nt = 4 + 4 * (br & 1); tag = br; }
            L = ti * G + c; rect2 = L >= n1; valid = L < n1 + n2;
        }
        if (!valid) return false;
        int pm, pn;
        map_tile((ctxp || rect2) ? 0 : L, pm, pn);
        if (ctxp) {
            const int x = c & 7, idx = c >> 3, tix = idx >> 2, part = idx & 3, pb = P >> 2, pr = P & 3;
            const int p0 = part * pb + (part < pr ? part : pr), p1 = (part + 1) * pb + (part + 1 < pr ? part + 1 : pr);
            pm = 128 + 2 * x + (tix >> 2); pn = tix & 3; k0 = p0 * 128; nt = 2 * (p1 - p0); tag = part == 0 ? 2 : 1;
        }
        if (rect2) { pm = pm0_2 + (L - n1); pn = pn0_2; }
        u.pm = pm; u.pn = pn; u.k0 = k0; u.nt = nt; u.tag = tag; u.te = 0;
        return true;
    }
};
__device__ __forceinline__ TileSched make_sched(int nM1, int nN1, int K) {
    TileSched s; s.c = blockIdx.x; s.G = gridDim.x; s.nM1 = nM1; s.nN1 = nN1; s.n1 = nM1 * nN1; s.pn0_1 = 0; s.n2 = 0; s.pm0_2 = 0; s.pn0_2 = 0; s.nb = 1;
    s.ntk = K / BK; s.sk = 0; s.P = 1; s.R = 0; s.xo = 0; s.kx = 0; s.slots = nullptr; s.flags = nullptr; s.epoch = 0; return s;
}
__device__ __forceinline__ TileSched make_ctxtail(int K, float* slots, unsigned* flags, unsigned epoch) {
    if (gridDim.x != 256) return make_sched(TT / 256, 4, K);
    TileSched s = make_sched(TL / 256, 4, K);
    s.sk = 1; s.P = K / (2 * BK); s.R = 2; s.slots = slots; s.flags = flags; s.epoch = epoch;
    return s;
}

__device__ __forceinline__ void add_xcd_offset(TileSched& s, int K, float* slots) {
    if (gridDim.x != 256 || s.nb != 1 || s.n2 != 0) return;
    s.xo = 1; s.P = K / (2 * BK); s.kx = ((int)(blockIdx.x & 7) * s.P) >> 3; s.slots = slots;
}
__device__ __forceinline__ int unit_mb(const Unit& u) { return u.pm < 128 ? (u.pm >> 3) : 16; }

struct EpiSwiGLU {
    bf16_t* act; const float* bias; const float* ssq;
    __device__ __forceinline__ void operator()(f32x4 (&acc)[2][2][4][2], const Unit& u, int wr, int wc, int fr, int fq) const {
        const int mb = unit_mb(u);
        const float* bp = bias + (size_t)mb * (2 * DFF) + u.pn * 256 + wc * 32 + 8 * fq;
        f32x4 ba[2], bb[2];
#pragma unroll
        for (int n = 0; n < 2; ++n) { ba[n] = *(const f32x4*)(bp + 4 * n); bb[n] = *(const f32x4*)(bp + 128 + 4 * n); }
        const int row0 = u.pm * 256 + wr * 64 + fr;
        GAS bf16_t* op = (GAS bf16_t*)act + (size_t)row0 * DFF + u.pn * 128 + wc * 32 + 8 * fq;
        float rs[8];
#pragma unroll
        for (int g = 0; g < 8; ++g) rs[g] = ((const GAS float*)ssq)[row0 + (g >> 2) * 128 + (g & 3) * 16];
#pragma unroll
        for (int ai = 0; ai < 2; ++ai)
#pragma unroll
            for (int m = 0; m < 4; ++m) {
                const int ro = ai * 128 + m * 16;
                const float r = __builtin_amdgcn_rsqf(rs[ai * 4 + m] * (1.f / DM) + EPS);
                f32x4 a0 = acc[ai][0][m][0] * r + ba[0], a1 = acc[ai][0][m][1] * r + ba[1], b0 = acc[ai][1][m][0] * r + bb[0], b1 = acc[ai][1][m][1] * r + bb[1];
                f32x4 o0, o1;
#pragma unroll
                for (int i = 0; i < 4; ++i) { o0[i] = a0[i] * b0[i] * sigm(a0[i]); o1[i] = a1[i] * b1[i] * sigm(a1[i]); }
                u32x4 w; w.x = cvtpk(o0[0], o0[1]); w.y = cvtpk(o0[2], o0[3]); w.z = cvtpk(o1[0], o1[1]); w.w = cvtpk(o1[2], o1[3]);
                *(GAS u32x4*)(op + (size_t)ro * DFF) = w;
            }
    }
};
struct EpiIn {
    bf16_t* P; bf16_t* G; const float* bias; const float* ssq;
    __device__ __forceinline__ void operator()(f32x4 (&acc)[2][2][4][2], const Unit& u, int wr, int wc, int fr, int fq) const {
        const int mb = unit_mb(u);
        const int colt = u.pn * 256, cw = wc * 32 + 8 * fq;
        const float* bp = bias + (size_t)mb * NIN + colt + cw;
        f32x4 bv[2][2];
#pragma unroll
        for (int bj = 0; bj < 2; ++bj)
#pragma unroll
            for (int n = 0; n < 2; ++n) bv[bj][n] = *(const f32x4*)(bp + bj * 128 + 4 * n);
        const int row0 = u.pm * 256 + wr * 64 + fr;
        const bool gate = u.pn >= 6;
        GAS bf16_t* base = (GAS bf16_t*)P + (size_t)row0 * NPC + colt + cw;
        GAS unsigned char* gbase = (GAS unsigned char*)G + (size_t)row0 * NGC + (colt - NPC) + cw;
        float rs[8];
#pragma unroll
        for (int g = 0; g < 8; ++g) rs[g] = ((const GAS float*)ssq)[row0 + (g >> 2) * 128 + (g & 3) * 16];
#pragma unroll
        for (int ai = 0; ai < 2; ++ai)
#pragma unroll
            for (int m = 0; m < 4; ++m) {
                const int ro = ai * 128 + m * 16;
                const float r = __builtin_amdgcn_rsqf(rs[ai * 4 + m] * (1.f / DM) + EPS);
#pragma unroll
                for (int bj = 0; bj < 2; ++bj) {
                    f32x4 v0 = acc[ai][bj][m][0] * r + bv[bj][0], v1 = acc[ai][bj][m][1] * r + bv[bj][1];
                    if (gate) {
                        unsigned q0[4], q1[4];
#pragma unroll
                        for (int i = 0; i < 4; ++i) { q0[i] = (unsigned)fminf(fmaxf(sigm(v0[i]) * 255.f + 0.5f, 1.f), 255.f); q1[i] = (unsigned)fminf(fmaxf(sigm(v1[i]) * 255.f + 0.5f, 1.f), 255.f); }
                        u32x2 w; w.x = q0[0] | (q0[1] << 8) | (q0[2] << 16) | (q0[3] << 24); w.y = q1[0] | (q1[1] << 8) | (q1[2] << 16) | (q1[3] << 24);
                        *(GAS u32x2*)(gbase + (size_t)ro * NGC + bj * 128) = w;
                    } else {
                        u32x4 w; w.x = cvtpk(v0[0], v0[1]); w.y = cvtpk(v0[2], v0[3]); w.z = cvtpk(v1[0], v1[1]); w.w = cvtpk(v1[2], v1[3]);
                        *(GAS u32x4*)(base + (size_t)ro * NPC + bj * 128) = w;
                    }
                }
            }
    }
};
struct EpiRes {
    bf16_t* Ap; float* out32; const float* gate; float coef; const float* nrc; const float* scc; const float* nrm; const float* scl; float* ssq; int dry;
    __device__ __forceinline__ void operator()(f32x4 (&acc)[2][2][4][2], const Unit& u, int wr, int wc, int fr, int fq) const {
        const int mb = unit_mb(u);
        bf16_t* Ap = this->Ap; float* out32 = this->out32; const float* gate = this->gate; float coef = this->coef;
        const float* nrc = this->nrc; const float* scc = this->scc; const float* nrm = this->nrm; const float* scl = this->scl; float* ssq = this->ssq;
        Ap = (bf16_t*)uni64((uintptr_t)Ap); out32 = (float*)uni64((uintptr_t)out32); gate = (const float*)uni64((uintptr_t)gate); coef = __uint_as_float(__builtin_amdgcn_readfirstlane(__float_as_uint(coef)));
        nrc = (const float*)uni64((uintptr_t)nrc); scc = (const float*)uni64((uintptr_t)scc);
        nrm = (const float*)uni64((uintptr_t)nrm); scl = (const float*)uni64((uintptr_t)scl); ssq = (float*)uni64((uintptr_t)ssq);
        const int col0 = u.pn * 256 + wc * 32 + 8 * fq, row0 = u.pm * 256 + wr * 64 + fr;
        GAS bf16_t* hb = (GAS bf16_t*)Ap + (size_t)row0 * DM + col0;
        GAS float* ho = (GAS float*)out32 + (size_t)row0 * DM + col0;
        f32x4 gc[2][2], gs[2][2], gi[2][2];
#pragma unroll
        for (int bj = 0; bj < 2; ++bj)
#pragma unroll
            for (int n = 0; n < 2; ++n) {
                gc[bj][n] = *(const GAS f32x4*)(gate + (size_t)mb * NMOD + col0 + 128 * bj + 4 * n) * (dry ? 0.f : coef);
                const f32x4 gcur = *(const GAS f32x4*)(nrc + col0 + 128 * bj + 4 * n) * (*(const GAS f32x4*)(scc + (size_t)mb * NMOD + col0 + 128 * bj + 4 * n) + 1.f);
#pragma unroll
                for (int i = 0; i < 4; ++i) gi[bj][n][i] = gcur[i] != 0.f ? frcp(gcur[i]) : 0.f;
                if (!out32) gs[bj][n] = *(const GAS f32x4*)(nrm + col0 + 128 * bj + 4 * n) * (*(const GAS f32x4*)(scl + (size_t)mb * NMOD + col0 + 128 * bj + 4 * n) + 1.f);
                else gs[bj][n] = (f32x4){0.f, 0.f, 0.f, 0.f};
            }
        u32x4 hq[3][2];
#pragma unroll
        for (int g0 = 0; g0 < 2; ++g0)
#pragma unroll
            for (int bj = 0; bj < 2; ++bj) hq[g0][bj] = *(const GAS u32x4*)(hb + (size_t)((g0 >> 2) * 128 + (g0 & 3) * 16) * DM + 128 * bj);
#pragma unroll
        for (int g = 0; g < 8; ++g) {
            const int ai = g >> 2, m = g & 3;
            if (g < 6) {
#pragma unroll
                for (int bj = 0; bj < 2; ++bj) hq[(g + 2) % 3][bj] = *(const GAS u32x4*)(hb + (size_t)(((g + 2) >> 2) * 128 + ((g + 2) & 3) * 16) * DM + 128 * bj); }
            const int ro = ai * 128 + m * 16; const size_t off = (size_t)ro * DM;
            float ss = 0.f;
#pragma unroll
            for (int bj = 0; bj < 2; ++bj) {
                const u32x4 q = hq[g % 3][bj];
                const f32x4 h0 = (f32x4){bflo(q.x), bfhi(q.x), bflo(q.y), bfhi(q.y)} * gi[bj][0] + gc[bj][0] * acc[ai][bj][m][0];
                const f32x4 h1 = (f32x4){bflo(q.z), bfhi(q.z), bflo(q.w), bfhi(q.w)} * gi[bj][1] + gc[bj][1] * acc[ai][bj][m][1];
                ss += (h0[0] * h0[0] + h0[1] * h0[1]) + (h0[2] * h0[2] + h0[3] * h0[3]) + (h1[0] * h1[0] + h1[1] * h1[1]) + (h1[2] * h1[2] + h1[3] * h1[3]);
                if (out32) { *(GAS f32x4*)(ho + off + 128 * bj) = h0; *(GAS f32x4*)(ho + off + 128 * bj + 4) = h1; }
                else if (!dry) { const f32x4 a0 = h0 * gs[bj][0], a1 = h1 * gs[bj][1];
                    u32x4 w; w.x = cvtpk(a0[0], a0[1]); w.y = cvtpk(a0[2], a0[3]); w.z = cvtpk(a1[0], a1[1]); w.w = cvtpk(a1[2], a1[3]);
                    *(GAS u32x4*)(hb + off + 128 * bj) = w; }
            }
            ss += __shfl_xor(ss, 16); ss += __shfl_xor(ss, 32);
            if (fq == 0) (void)__hip_atomic_fetch_add((GAS float*)ssq + row0 + ro, dry ? 0.f : ss, __ATOMIC_RELAXED, __HIP_MEMORY_SCOPE_AGENT);
        }
    }
};
struct EpiMerge {
    const bf16_t* G; bf16_t* Mg;
    __device__ __forceinline__ void operator()(f32x4 (&acc)[2][2][4][2], const Unit& u, int wr, int wc, int fr, int fq) const {
        const int br = u.tag, col0 = u.pn * 256 + wc * 32 + 8 * fq, row0 = u.pm * 256 + wr * 64 + fr;
        const GAS unsigned char* g0 = (const GAS unsigned char*)G + (size_t)row0 * NGC + br * 1024 + col0;
        u32x2 gq[3][2], hq[3][2];
#pragma unroll
        for (int g_ = 0; g_ < 2; ++g_)
#pragma unroll
            for (int bj = 0; bj < 2; ++bj) { const GAS unsigned char* gp = g0 + (size_t)((g_ >> 2) * 128 + (g_ & 3) * 16) * NGC + 128 * bj;
                gq[g_][bj] = *(const GAS u32x2*)gp; hq[g_][bj] = (br < 2) ? *(const GAS u32x2*)(gp + 1024) : (u32x2){0x01010101u, 0x01010101u}; }
#pragma unroll
        for (int g_ = 0; g_ < 8; ++g_) {
            const int ai = g_ >> 2, m = g_ & 3;
            if (g_ < 6) {
#pragma unroll
                for (int bj = 0; bj < 2; ++bj) { const GAS unsigned char* gp = g0 + (size_t)(((g_ + 2) >> 2) * 128 + ((g_ + 2) & 3) * 16) * NGC + 128 * bj;
                    gq[(g_ + 2) % 3][bj] = *(const GAS u32x2*)gp; hq[(g_ + 2) % 3][bj] = (br < 2) ? *(const GAS u32x2*)(gp + 1024) : (u32x2){0x01010101u, 0x01010101u}; } }
            const int row = row0 + ai * 128 + m * 16;
#pragma unroll
            for (int bj = 0; bj < 2; ++bj) {
                const u32x2 g = gq[g_ % 3][bj];
                f32x4 s0, s1;
#pragma unroll
                for (int i = 0; i < 4; ++i) { s0[i] = (float)((g.x >> (8 * i)) & 255u); s1[i] = (float)((g.y >> (8 * i)) & 255u); }
                if (br < 2) {
                    const u32x2 h = hq[g_ % 3][bj];
#pragma unroll
                    for (int i = 0; i < 4; ++i) { s0[i] *= frcp((float)((h.x >> (8 * i)) & 255u)); s1[i] *= frcp((float)((h.y >> (8 * i)) & 255u)); }
                    acc[ai][bj][m][0] *= s0; acc[ai][bj][m][1] *= s1;
                } else {
                    const f32x4 v0 = acc[ai][bj][m][0] * s0 * (1.f / 255.f), v1 = acc[ai][bj][m][1] * s1 * (1.f / 255.f);
                    u32x4 w; w.x = cvtpk(v0[0], v0[1]); w.y = cvtpk(v0[2], v0[3]); w.z = cvtpk(v1[0], v1[1]); w.w = cvtpk(v1[2], v1[3]);
                    *(GAS u32x4*)((GAS bf16_t*)Mg + (size_t)row * DM + col0 + 128 * bj) = w;
                }
            }
        }
    }
};

template <class Epi>
__device__ __forceinline__ void gemm_phase(const int tid, LAS unsigned char* lds, const bf16_t* Ab, int lda, const bf16_t* Bb, int ldb, const TileSched& S, const Epi& E) {
    const int wid = __builtin_amdgcn_readfirstlane(tid >> 6), lane = tid & 63, wr = wid >> 2, wc = wid & 3, fr = lane & 15, fq = lane >> 4;
    unsigned voffA[2], voffB[2];
#pragma unroll
    for (int i = 0; i < 2; ++i) { int R, C; stage_rc(tid * 16 + i * 8192, R, C); const int Rb = (R & ~31) + perm32(R & 31);
        voffA[i] = (unsigned)(R * lda + C) * 2u; voffB[i] = (unsigned)(Rb * ldb + C) * 2u; }
    const size_t kstep = (size_t)(BK * 2);
    const size_t hsA = (size_t)HALF * lda * 2, hsB = (size_t)HALF * ldb * 2;
    const unsigned ldsw = (unsigned)wid * 1024u;
    const int aoff = lds_byte(wr * 64 + fr, fq * 8), boff = lds_byte(wc * 32 + fr, fq * 8);
#define PG8_SA(b, h) (((b) * 2 + (h)) * HTB)
#define PG8_SB(b, h) ((4 + (b) * 2 + (h)) * HTB)
#define PG8_STAGE(bufoff, gbase, voff) do { _Pragma("unroll") for (int _i = 0; _i < 2; ++_i) \
        __builtin_amdgcn_global_load_lds((const unsigned*)((const char*)(gbase) + (voff)[_i]), (LAS unsigned*)(lds + (bufoff) + ldsw + _i * 8192), 16, 0, 0); } while (0)
#define PG8_LDA(dst, b, h) do { _Pragma("unroll") for (int m = 0; m < 4; ++m) _Pragma("unroll") for (int k = 0; k < 2; ++k) dst[m][k] = *(const LAS bf16x8*)(lds + PG8_SA(b, h) + aoff + m * 2048 + k * 1024); } while (0)
#define PG8_LDB(dst, b, h) do { _Pragma("unroll") for (int n = 0; n < 2; ++n) _Pragma("unroll") for (int k = 0; k < 2; ++k) dst[n][k] = *(const LAS bf16x8*)(lds + PG8_SB(b, h) + boff + n * 2048 + k * 1024); } while (0)
#define PG8_MMA(ai, bj, At, Bt) do { __builtin_amdgcn_s_setprio(1); _Pragma("unroll") for (int m = 0; m < 4; ++m) _Pragma("unroll") for (int n = 0; n < 2; ++n) _Pragma("unroll") for (int k = 0; k < 2; ++k) \
        acc[ai][bj][m][n] = __builtin_amdgcn_mfma_f32_16x16x32_bf16(Bt[n][k], At[m][k], acc[ai][bj][m][n], 0, 0, 0); __builtin_amdgcn_s_setprio(0); } while (0)
#define PG8_WAIT_V(n) asm volatile("s_waitcnt vmcnt(" #n ")" ::: "memory")
#define PG8_WAIT_L(n) asm volatile("s_waitcnt lgkmcnt(" #n ")" ::: "memory")
#define PG8_BAR __builtin_amdgcn_s_barrier()
#define PG8_SCHED __builtin_amdgcn_sched_barrier(0)
    Unit cur, nxt; int ui = 0;
    if (!S.next(0, cur)) return;
    f32x4 acc[2][2][4][2];
#pragma unroll
    for (int a = 0; a < 2; ++a)
#pragma unroll
        for (int b = 0; b < 2; ++b)
#pragma unroll
            for (int m = 0; m < 4; ++m)
#pragma unroll
                for (int n = 0; n < 2; ++n) acc[a][b][m][n] = (f32x4){0.f, 0.f, 0.f, 0.f};
    bf16x8 At[4][2], B0[2][2], B1[2][2];
    const char* cA = (const char*)Ab + (size_t)cur.pm * 2 * hsA + (size_t)cur.k0 * 2; const char* cB = (const char*)Bb + (size_t)cur.pn * 2 * hsB + (size_t)cur.k0 * 2;
    PG8_STAGE(PG8_SB(0, 0), cB, voffB); PG8_STAGE(PG8_SB(0, 1), cB + hsB, voffB); PG8_STAGE(PG8_SA(0, 0), cA, voffA); PG8_STAGE(PG8_SA(0, 1), cA + hsA, voffA);
    if (wr == 1) PG8_BAR;
    PG8_WAIT_V(2); PG8_BAR;
    PG8_STAGE(PG8_SB(1, 0), cB + kstep, voffB); PG8_STAGE(PG8_SA(1, 0), cA + kstep, voffA); PG8_STAGE(PG8_SB(1, 1), cB + hsB + kstep, voffB);
    PG8_WAIT_V(6); PG8_BAR;
    for (;;) {
        const bool has_next = S.next(ui + 1, nxt);
        const char* nA = has_next ? (const char*)Ab + (size_t)nxt.pm * 2 * hsA + (size_t)nxt.k0 * 2 : cA;
        const char* nB = has_next ? (const char*)Bb + (size_t)nxt.pn * 2 * hsB + (size_t)nxt.k0 * 2 : cB;
        const int nt = cur.nt;
        for (int t = 0; t < nt; t += 2) {
            const bool last = (t == nt - 2);
            const char* a1 = cA + (size_t)(t + 1) * kstep;
            const char* a2 = last ? nA : cA + (size_t)(t + 2) * kstep; const char* b2 = last ? nB : cB + (size_t)(t + 2) * kstep;
            const char* a3 = a2 + kstep; const char* b3 = b2 + kstep;
            PG8_LDB(B0, 0, 0); PG8_LDB(B1, 0, 1); PG8_SCHED; PG8_LDA(At, 0, 0); PG8_STAGE(PG8_SA(1, 1), a1 + hsA, voffA);
            PG8_WAIT_V(8); PG8_WAIT_L(0); PG8_BAR; PG8_MMA(0, 0, At, B0); PG8_MMA(0, 1, At, B1); PG8_BAR; PG8_SCHED;
            PG8_LDA(At, 0, 1); PG8_STAGE(PG8_SB(0, 0), b2, voffB); PG8_STAGE(PG8_SB(0, 1), b2 + hsB, voffB); PG8_STAGE(PG8_SA(0, 0), a2, voffA);
            PG8_WAIT_V(8); PG8_WAIT_L(0); PG8_BAR; PG8_MMA(1, 0, At, B0); PG8_MMA(1, 1, At, B1); PG8_BAR; PG8_SCHED;
            PG8_LDB(B0, 1, 0); PG8_LDB(B1, 1, 1); PG8_SCHED; PG8_LDA(At, 1, 0); PG8_STAGE(PG8_SA(0, 1), a2 + hsA, voffA);
            PG8_WAIT_V(8); PG8_WAIT_L(0); PG8_BAR; PG8_MMA(0, 0, At, B0); PG8_MMA(0, 1, At, B1); PG8_BAR; PG8_SCHED;
            PG8_LDA(At, 1, 1); PG8_STAGE(PG8_SB(1, 0), b3, voffB); PG8_STAGE(PG8_SB(1, 1), b3 + hsB, voffB); PG8_STAGE(PG8_SA(1, 0), a3, voffA);
            PG8_WAIT_V(8); PG8_WAIT_L(0); PG8_BAR; PG8_MMA(1, 0, At, B0); PG8_MMA(1, 1, At, B1); PG8_BAR; PG8_SCHED;
        }
        if (wr == 0) PG8_BAR;
        const bool xch = S.sk || S.xo;
        if (xch && (cur.tag & 10)) {
            const int np = (cur.tag & 2) ? 3 : 1;
#pragma unroll 1
            for (int pp = 1; pp <= np; ++pp) {
                const int j = (cur.tag & 2) ? S.c + 8 * pp : S.c;
                if (cur.tag & 2) {
                    unsigned* fl = S.flags + j * 8 + wid;
                    if (lane == 0) { while (__hip_atomic_load(fl, __ATOMIC_RELAXED, __HIP_MEMORY_SCOPE_AGENT) != S.epoch) __builtin_amdgcn_s_sleep(1); }
                }
                asm volatile("" ::: "memory");
                const unsigned long long* sp = (const unsigned long long*)(S.slots + (size_t)j * 65536 + wid * 8192) + lane; asm volatile("" : "+v"(sp));
#pragma unroll
                for (int a = 0; a < 2; ++a)
#pragma unroll
                    for (int b = 0; b < 2; ++b)
#pragma unroll
                        for (int m = 0; m < 4; ++m) {
#pragma unroll
                            for (int n = 0; n < 2; ++n) {
                                const unsigned long long v0 = __hip_atomic_load(sp, __ATOMIC_RELAXED, __HIP_MEMORY_SCOPE_AGENT), v1 = __hip_atomic_load(sp + 64, __ATOMIC_RELAXED, __HIP_MEMORY_SCOPE_AGENT);
                                acc[a][b][m][n][0] += __uint_as_float((unsigned)v0); acc[a][b][m][n][1] += __uint_as_float((unsigned)(v0 >> 32));
                                acc[a][b][m][n][2] += __uint_as_float((unsigned)v1); acc[a][b][m][n][3] += __uint_as_float((unsigned)(v1 >> 32));
                                sp += 128; }
                            if (m & 1) asm volatile("" : "+v"(sp) :: "memory");
                        }
            }
        }
        if (xch && (cur.tag & 5)) {
            unsigned long long* sp = (unsigned long long*)(S.slots + (size_t)S.c * 65536 + wid * 8192) + lane; asm volatile("" : "+v"(sp));
#pragma unroll
            for (int a = 0; a < 2; ++a)
#pragma unroll
                for (int b = 0; b < 2; ++b)
#pragma unroll
                    for (int m = 0; m < 4; ++m)
#pragma unroll
                        for (int n = 0; n < 2; ++n) {
                            const f32x4 v = acc[a][b][m][n];
                            __hip_atomic_store(sp, (unsigned long long)__float_as_uint(v[0]) | ((unsigned long long)__float_as_uint(v[1]) << 32), __ATOMIC_RELAXED, __HIP_MEMORY_SCOPE_AGENT);
                            __hip_atomic_store(sp + 64, (unsigned long long)__float_as_uint(v[2]) | ((unsigned long long)__float_as_uint(v[3]) << 32), __ATOMIC_RELAXED, __HIP_MEMORY_SCOPE_AGENT);
                            sp += 128; asm volatile("" : "+v"(sp)); }
            if (cur.tag & 1) { asm volatile("s_waitcnt vmcnt(0)" ::: "memory");
                if (lane == 0) __hip_atomic_store(S.flags + S.c * 8 + wid, S.epoch, __ATOMIC_RELAXED, __HIP_MEMORY_SCOPE_AGENT); }
        } else E(acc, cur, wr, wc, fr, fq);
        if (!has_next) break;
        if (!(S.nb == 3 && nxt.tag != 0)) {
#pragma unroll
        for (int a = 0; a < 2; ++a)
#pragma unroll
            for (int b = 0; b < 2; ++b)
#pragma unroll
                for (int m = 0; m < 4; ++m)
#pragma unroll
                    for (int n = 0; n < 2; ++n) acc[a][b][m][n] = (f32x4){0.f, 0.f, 0.f, 0.f};
        }
        cur = nxt; cA = nA; cB = nB; ++ui;
        if (wr == 1) PG8_BAR;
    }
    PG8_WAIT_V(0);
    PG8_BAR;
#undef PG8_SA
#undef PG8_SB
#undef PG8_STAGE
#undef PG8_LDA
#undef PG8_LDB
#undef PG8_MMA
#undef PG8_WAIT_V
#undef PG8_WAIT_L
#undef PG8_BAR
#undef PG8_SCHED
}
}

struct Args {
    const float* in[26];
    float* out; unsigned char* ws;
    int ph_lo, ph_hi;
};
enum { I_X = 0, I_C, I_CTX, I_CCTX, I_WADA, I_BADA, I_NFFN1, I_F1W13, I_F1W2, I_NMIX, I_WIN, I_QN, I_KN, I_POOLW, I_POOLS, I_SGUN, I_SGUW, I_SGUB,
       I_WBRP, I_WBRA, I_WBRS, I_WOUT, I_NFFN2, I_F2W13, I_F2W2, I_FNORM };

__device__ __forceinline__ float wave_sum(float v) {
#pragma unroll
    for (int o = 1; o < 64; o <<= 1) v += __shfl_xor(v, o);
    return v;
}

__device__ __forceinline__ void tr_item(const float* W, int N, bf16_t* WT, int ldt, int coloff, int mode13, float* scr, int item, int lane) {
    const int nblk = N / 32, kb = item / nblk, nb = item - kb * nblk, k0 = 64 * kb, n0 = 32 * nb;
#pragma unroll 8
    for (int i = 0; i < 32; ++i) { const int kk = 2 * i + (lane >> 5); scr[kk * 33 + (lane & 31)] = W[(size_t)(k0 + kk) * N + n0 + (lane & 31)]; }
    LDS_WAIT();
    int r0 = n0;
    if (mode13) { const int s = n0 / DFF, rem = n0 - s * DFF, t = rem >> 7, j = rem & 127; r0 = 256 * t + 128 * s + j; }
    const int c = lane & 7;
#pragma unroll
    for (int j = 0; j < 4; ++j) { const int n = (lane >> 3) + 8 * j; const float* s = scr + (8 * c) * 33 + n;
        u32x4 o; o.x = cvtpk(s[0 * 33], s[1 * 33]); o.y = cvtpk(s[2 * 33], s[3 * 33]); o.z = cvtpk(s[4 * 33], s[5 * 33]); o.w = cvtpk(s[6 * 33], s[7 * 33]);
        *(u32x4*)(WT + (size_t)(r0 + n) * ldt + coloff + k0 + 8 * c) = o; }
    LDS_WAIT();
}

__device__ __forceinline__ void convert_weights(const int tid, const Args& a, int l, unsigned char* lds) {
    const int lane = tid & 63, wave = tid >> 6;
    float* scr = (float*)(lds + wave * 8704);
    const int gw = blockIdx.x * 8 + wave, NGW = gridDim.x * 8;
    unsigned char* ws = a.ws;
    constexpr int I13 = (DM / 64) * (2 * DFF / 32), I2 = (DFF / 64) * (DM / 32), IIN = (DM / 64) * (NIN / 32), IOUT = (DM / 64) * (DM / 32), IBA = (512 / 64) * (DM / 32), IBS = (256 / 64) * (DM / 32);
    constexpr int NITEMS = 2 * I13 + 2 * I2 + IIN + IOUT + IBA + IBS;
    for (int it = gw; it < NITEMS; it += NGW) {
        int r = it; const float* W; int N; bf16_t* WT; int ldt = DM, coloff = 0, m13 = 0;
        if (r < 2 * I13) { const bool second = r >= I13; r -= second ? I13 : 0; W = a.in[second ? I_F2W13 : I_F1W13] + (size_t)l * DM * 2 * DFF; N = 2 * DFF; WT = (bf16_t*)(ws + (second ? WS_W13B : WS_W13A)); m13 = 1; }
        else if (r < 2 * I13 + 2 * I2) { r -= 2 * I13; const bool second = r >= I2; r -= second ? I2 : 0; W = a.in[second ? I_F2W2 : I_F1W2] + (size_t)l * DFF * DM; N = DM; WT = (bf16_t*)(ws + (second ? WS_W2B : WS_W2A)); ldt = DFF; }
        else if (r < 2 * I13 + 2 * I2 + IIN) { r -= 2 * I13 + 2 * I2; W = a.in[I_WIN] + (size_t)l * DM * NIN; N = NIN; WT = (bf16_t*)(ws + WS_WIN); }
        else if (r < 2 * I13 + 2 * I2 + IIN + IOUT) { r -= 2 * I13 + 2 * I2 + IIN; W = a.in[I_WOUT] + (size_t)l * DM * DM; N = DM; WT = (bf16_t*)(ws + WS_WOUT); }
        else if (r < 2 * I13 + 2 * I2 + IIN + IOUT + IBA) { r -= 2 * I13 + 2 * I2 + IIN + IOUT; W = a.in[I_WBRA] + (size_t)l * 512 * DM; N = DM; WT = (bf16_t*)(ws + WS_WCAT); coloff = 256; }
        else { r -= 2 * I13 + 2 * I2 + IIN + IOUT + IBA; W = a.in[I_WBRS] + (size_t)l * 256 * DM; N = DM; WT = (bf16_t*)(ws + WS_WCAT); coloff = 768; }
        tr_item(W, N, WT, ldt, coloff, m13, scr, r, lane);
    }
    {
        const float* pw = a.in[I_POOLW] + (size_t)l * 4 * 64 * 64; const float* ps = a.in[I_POOLS] + (size_t)l * 256; const float* wb = a.in[I_WBRP] + (size_t)l * 256 * DM;
        bf16_t* wcat = (bf16_t*)(ws + WS_WCAT);
        for (int it = blockIdx.x * 512 + tid; it < 1024 * 32; it += gridDim.x * 512) {
            const int n = it & 1023, kg = it >> 10, g = kg >> 3, c0 = (kg & 7) * 8;
            float s[8];
#pragma unroll
            for (int i = 0; i < 8; ++i) s[i] = 0.f;
            for (int d = 0; d < 64; ++d) {
                const float wv = wb[(size_t)(g * 64 + d) * DM + n] * ps[g * 64 + d];
#pragma unroll
                for (int i = 0; i < 8; ++i) s[i] += pw[(g * 64 + c0 + i) * 64 + d] * wv;
            }
            u32x4 o; o.x = cvtpk(s[0], s[1]); o.y = cvtpk(s[2], s[3]); o.z = cvtpk(s[4], s[5]); o.w = cvtpk(s[6], s[7]);
            *(u32x4*)(wcat + (size_t)n * DM + kg * 8) = o;
        }
    }
    {
        const float* sw = a.in[I_SGUW] + (size_t)l * 4 * 128 * 128; unsigned* dst = (unsigned*)(ws + WS_SGUW);
        for (int it = blockIdx.x * 512 + tid; it < 4 * 128 * 64; it += gridDim.x * 512) dst[it] = cvtpk(sw[2 * it], sw[2 * it + 1]);
    }
}

__device__ __forceinline__ void compute_biases(const int tid, const Args& a, int l, unsigned char* lds) {
    const int lane = tid & 63, wave = tid >> 6;
    float* sh = (float*)lds;
    const float* modl = (const float*)(a.ws + WS_MOD) + (size_t)l * 17 * NMOD;
    const int gw = blockIdx.x * 8 + wave, NGW = gridDim.x * 8;
    for (int j = 0; j < 3; ++j) {
        __syncthreads();
        for (int i = tid; i < 17 * DM; i += 512) sh[i] = modl[(size_t)(i >> 10) * NMOD + (3 * j) * DM + (i & 1023)];
        __syncthreads();
        const bf16_t* Wt = (const bf16_t*)(a.ws + (j == 0 ? WS_W13A : (j == 1 ? WS_WIN : WS_W13B)));
        float* bo = (float*)(a.ws + (j == 0 ? WS_B13A : (j == 1 ? WS_BIN : WS_B13B)));
        const int N = (j == 1) ? NIN : 2 * DFF;
        for (int n = gw; n < N; n += NGW) {
            float w[16];
#pragma unroll
            for (int c = 0; c < 4; ++c) { const u32x2 v = *(const u32x2*)(Wt + (size_t)n * DM + c * 256 + lane * 4); w[4 * c] = bflo(v.x); w[4 * c + 1] = bfhi(v.x); w[4 * c + 2] = bflo(v.y); w[4 * c + 3] = bfhi(v.y); }
            float mine = 0.f;
#pragma unroll 1
            for (int mb = 0; mb < 17; ++mb) {
                float p = 0.f;
#pragma unroll
                for (int c = 0; c < 4; ++c) { const f32x4 s = *(const f32x4*)(sh + mb * DM + c * 256 + lane * 4); p += w[4 * c] * s[0] + w[4 * c + 1] * s[1] + w[4 * c + 2] * s[2] + w[4 * c + 3] * s[3]; }
                p = wave_sum(p);
                if (lane == mb) mine = p;
            }
            if (lane < 17) bo[(size_t)lane * N + n] = mine;
        }
    }
}

__device__ __forceinline__ void post_phase(const int tid, const Args& a, int l, unsigned char* lds) {
    const int lane = tid & 63, wave = tid >> 6;
    unsigned char* ws = a.ws;
    const bf16_t* P = (const bf16_t*)(ws + WS_P);
    bf16_t* Bcat = (bf16_t*)a.out; bf16_t* kbuf = (bf16_t*)(ws + WS_KB); bf16_t* Vt = (bf16_t*)(ws + WS_VT);
    const float* rope = (const float*)(ws + WS_ROPE);
    const float* qn = a.in[I_QN] + l * 64; const float* kn = a.in[I_KN] + l * 64;
    const int nchf = (l == 0) ? 288 : 256;
    const int nSGU = nchf * 2, nPOOL = nchf, nV = 288, nQK = TT / 64, total = nSGU + nPOOL + nV + nQK;
    const int G_ = gridDim.x, c_ = blockIdx.x, nS_ = c_ < nSGU ? (nSGU - c_ + G_ - 1) / G_ : 0;
    for (int k_ = 0;; ++k_) {
        const int it = k_ < nS_ ? c_ + k_ * G_ : nSGU + (G_ - 1 - c_) + (k_ - nS_) * G_;
        if (it >= total) break;
        if (it < nSGU + nPOOL + nV) {
            const int ch = it < nSGU ? (it >> 1) : (it < nSGU + nPOOL ? it - nSGU : it - nSGU - nPOOL);
            const bool lat = ch < 256;
            const int b = lat ? (ch >> 4) : ((ch - 256) >> 1), t0 = lat ? (ch & 15) * 128 : ((ch - 256) & 1) * 128, L = lat ? SEQ : CTXL;
            const int Rb = lat ? b * SEQ : TL + b * CTXL, R0 = Rb + t0;
            if (it < nSGU) {
                const int gp = it & 1;
                bf16_t* vT = (bf16_t*)lds;
                bf16_t* Ws = (bf16_t*)(lds + 34816);
                const float* sn = a.in[I_SGUN] + l * 256;
                {
                    const bf16_t* wsrc = (const bf16_t*)(ws + WS_SGUW) + gp * 2 * 128 * 128;
#pragma unroll 4
                    for (int i2 = tid; i2 < 2 * 128 * 16; i2 += 512) { const int r = i2 >> 4, c = i2 & 15; *(u32x4*)(Ws + r * 136 + c * 8) = *(const u32x4*)(wsrc + r * 128 + c * 8); }
                }
#pragma unroll 2
                for (int i2 = tid; i2 < 128 * 32; i2 += 512) { const int l32 = i2 & 31, tok = i2 >> 5;
                    const u32x4 raw = *(const u32x4*)(P + (size_t)(R0 + tok) * NPC + 1280 + l32 * 8);
                    float x[8] = {bflo(raw.x), bfhi(raw.x), bflo(raw.y), bfhi(raw.y), bflo(raw.z), bfhi(raw.z), bflo(raw.w), bfhi(raw.w)};
                    float ss = 0.f;
#pragma unroll
                    for (int i = 0; i < 8; ++i) { x[i] = gelu_t(x[i]); ss += x[i] * x[i]; }
                    ss += __shfl_xor(ss, 1); ss += __shfl_xor(ss, 2); ss += __shfl_xor(ss, 4); ss += __shfl_xor(ss, 8); ss += __shfl_xor(ss, 16);
                    const float rinv = __builtin_amdgcn_rsqf(ss * (1.f / 256.f) + EPS);
                    if ((l32 >> 4) == gp) { const int cl = (l32 & 15) * 8;
#pragma unroll
                        for (int i = 0; i < 8; i += 2) { const unsigned pk = cvtpk(x[i] * rinv * sn[l32 * 8 + i], x[i + 1] * rinv * sn[l32 * 8 + i + 1]);
                            vT[(cl + i) * 136 + tok] = (bf16_t)(pk & 0xffffu); vT[(cl + i + 1) * 136 + tok] = (bf16_t)(pk >> 16); } }
                }
                __syncthreads();
                const int q32 = lane & 31, hi = lane >> 5, cblk = wave & 1, tblk = wave >> 1;
                const float* sb = a.in[I_SGUB] + (size_t)l * 4 * 128;
                const int tok = tblk * 32 + q32, R = R0 + tok;
#pragma unroll
                for (int g2 = 0; g2 < 2; ++g2) {
                    const int g = gp * 2 + g2;
                    u32x2 ur[4];
#pragma unroll
                    for (int rg = 0; rg < 4; ++rg) ur[rg] = *(const u32x2*)(P + (size_t)R * NPC + 1024 + g * 64 + cblk * 32 + 8 * rg + 4 * hi);
                    const float bias = sb[g * 128 + tok];
                    f32x16 acc;
#pragma unroll
                    for (int r = 0; r < 16; ++r) acc[r] = 0.f;
#pragma unroll
                    for (int ks = 0; ks < 8; ++ks) {
                        const bf16x8 af = *(const bf16x8*)(vT + (g2 * 64 + cblk * 32 + q32) * 136 + ks * 16 + hi * 8);
                        const bf16x8 bf = *(const bf16x8*)(Ws + (g2 * 128 + tblk * 32 + q32) * 136 + ks * 16 + hi * 8);
                        acc = __builtin_amdgcn_mfma_f32_32x32x16_bf16(af, bf, acc, 0, 0, 0);
                    }
#pragma unroll
                    for (int rg = 0; rg < 4; ++rg) {
                        const int c4 = g * 64 + cblk * 32 + 8 * rg + 4 * hi;
                        const float u0 = gelu_t(bflo(ur[rg].x)), u1 = gelu_t(bfhi(ur[rg].x)), u2 = gelu_t(bflo(ur[rg].y)), u3 = gelu_t(bfhi(ur[rg].y));
                        u32x2 w; w.x = cvtpk(u0 * (acc[4 * rg] + bias), u1 * (acc[4 * rg + 1] + bias)); w.y = cvtpk(u2 * (acc[4 * rg + 2] + bias), u3 * (acc[4 * rg + 3] + bias));
                        *(u32x2*)(Bcat + (size_t)R * DM + 768 + c4) = w;
                    }
                }
            } else if (it < nSGU + nPOOL) {
                unsigned* xs = (unsigned*)lds;
#pragma unroll 3
                for (int i2 = tid; i2 < 144 * 32; i2 += 512) { const int rr = i2 >> 5, c = i2 & 31; const int s = t0 - 8 + rr;
                    u32x4 v = (u32x4){0u, 0u, 0u, 0u};
                    if (s >= 0 && s < L) v = *(const u32x4*)(P + (size_t)(Rb + s) * NPC + 768 + c * 8);
                    *(u32x4*)(xs + rr * 128 + c * 4) = v; }
                __syncthreads();
                const int cp = tid & 127, tg = tid >> 7, hw = 1 << (cp >> 5);
                for (int tt = tg * 32; tt < tg * 32 + 32; ++tt) {
                    const int t = t0 + tt; const int lo = (t - hw) < 0 ? 0 : (t - hw), hi = (t + hw) > L ? L : (t + hw);
                    float s0 = 0.f, s1 = 0.f;
                    for (int s = lo; s < hi; ++s) { const unsigned v = xs[(s - t0 + 8) * 128 + cp]; s0 += bflo(v); s1 += bfhi(v); }
                    const float ic = 1.f / (float)(hi - lo); const unsigned xv = xs[(tt + 8) * 128 + cp];
                    *(unsigned*)(Bcat + (size_t)(R0 + tt) * DM + 2 * cp) = cvtpk(s0 * ic - bflo(xv), s1 * ic - bfhi(xv));
                }
            } else {
                bf16_t* vs = (bf16_t*)lds;
#pragma unroll 4
                for (int i2 = tid; i2 < 128 * 16; i2 += 512) { const int tok = i2 >> 4, c = i2 & 15;
                    *(u32x4*)(vs + tok * 136 + c * 8) = *(const u32x4*)(P + (size_t)(R0 + tok) * NPC + 640 + c * 8); }
                __syncthreads();
                const int posbase = lat ? t0 : SEQ + t0;
                for (int i2 = tid; i2 < 128 * 16; i2 += 512) { const int vr = i2 & 127, pg = i2 >> 7;
                    unsigned short e[8];
#pragma unroll
                    for (int i = 0; i < 8; ++i) { const int p = pg * 8 + i; const int kap = (p & ~12) | ((p & 4) << 1) | ((p & 8) >> 1); e[i] = vs[kap * 136 + vr]; }
                    u32x4 w; w.x = e[0] | ((unsigned)e[1] << 16); w.y = e[2] | ((unsigned)e[3] << 16); w.z = e[4] | ((unsigned)e[5] << 16); w.w = e[6] | ((unsigned)e[7] << 16);
                    *(u32x4*)(Vt + ((size_t)(b * 2 + (vr >> 6)) * 64 + (vr & 63)) * KVPOS + posbase + pg * 8) = w; }
            }
            __syncthreads();
        } else {
            const int R0 = (it - (nSGU + nPOOL + nV)) * 64; const bool lat = R0 < TL;
            const bool full = lat || (l == 0);
            const int nh = full ? 10 : 2, hbase = full ? 0 : 8;
#pragma unroll 2
            for (int i2 = tid; i2 < 64 * nh * 8; i2 += 512) {
                const int l8 = i2 & 7, hr = i2 >> 3, tok = hr / nh, hh = hbase + (hr - tok * nh);
                const int R = R0 + tok; const bool isq = hh < 8;
                const bf16_t* src = P + (size_t)R * NPC + (isq ? hh * 64 : 512 + (hh - 8) * 64) + l8 * 8;
                const u32x4 raw = *(const u32x4*)src;
                float x[8] = {bflo(raw.x), bfhi(raw.x), bflo(raw.y), bfhi(raw.y), bflo(raw.z), bfhi(raw.z), bflo(raw.w), bfhi(raw.w)};
                float ss = 0.f;
#pragma unroll
                for (int i = 0; i < 8; ++i) ss += x[i] * x[i];
                ss += __shfl_xor(ss, 1); ss += __shfl_xor(ss, 2); ss += __shfl_xor(ss, 4);
                const float rinv = __builtin_amdgcn_rsqf(ss * (1.f / 64.f) + EPS);
                const float* gn = (isq ? qn : kn) + l8 * 8;
                const f32x4 g0 = *(const f32x4*)gn, g1 = *(const f32x4*)(gn + 4);
                float y[8], o[8];
#pragma unroll
                for (int i = 0; i < 4; ++i) { y[i] = x[i] * rinv * g0[i]; y[4 + i] = x[4 + i] * rinv * g1[i]; }
                const int t = R & (SEQ - 1);
                const int half = l8 >> 2, second = (l8 >> 1) & 1, fi0 = (l8 & 1) * 8;
                const f32x4* rp = (const f32x4*)(rope + ((size_t)t * 32 + half * 16 + fi0) * 2);
                f32x4 cs[4];
                if (lat) {
#pragma unroll
                    for (int i = 0; i < 4; ++i) cs[i] = rp[i];
                }
#pragma unroll
                for (int i = 0; i < 8; ++i) {
                    const float partner = __shfl_xor(y[i], 2);
                    if (lat) { const float cv = cs[i >> 1][(i & 1) * 2], sv = cs[i >> 1][(i & 1) * 2 + 1];
                        o[i] = second ? (y[i] * cv + partner * sv) : (y[i] * cv - partner * sv); }
                    else o[i] = y[i];
                }
                const float sc = isq ? QSCALE : 1.f;
                u32x4 w; w.x = cvtpk(o[0] * sc, o[1] * sc); w.y = cvtpk(o[2] * sc, o[3] * sc); w.z = cvtpk(o[4] * sc, o[5] * sc); w.w = cvtpk(o[6] * sc, o[7] * sc);
                bf16_t* dst = isq ? Bcat + (size_t)R * DM + 256 + hh * 64 + l8 * 8 : kbuf + (size_t)R * 128 + (hh - 8) * 64 + l8 * 8;
                *(u32x4*)dst = w;
            }
        }
    }
}

__device__ __forceinline__ void attn_phase(const int tid, const Args& a, int l, unsigned char* lds, int dry) {
    const int lane = tid & 63, w = tid >> 6, q32 = lane & 31, hi = lane >> 5;
    bf16_t* Bcat = (bf16_t*)a.out; const bf16_t* kbuf = (const bf16_t*)(a.ws + WS_KB); const bf16_t* Vt = (const bf16_t*)(a.ws + WS_VT);
    const int G = gridDim.x, c = blockIdx.x;
    const int per = (512 + G - 1) / G;
    const int nlat = (c * per >= 512) ? 0 : ((c + 1) * per > 512 ? 512 - c * per : per);
    const int nctx = (l == 0 && c < 64) ? (64 - c + G - 1) / G : 0;
    const int kr = tid >> 3, kc = tid & 7;
    float sshift;
    { float gq = 0.f, gk = 0.f; const float* qn = a.in[I_QN] + l * 64; const float* kn = a.in[I_KN] + l * 64;
      for (int i = 0; i < 64; ++i) { gq = fmaxf(gq, fabsf(qn[i])); gk = fmaxf(gk, fabsf(kn[i])); }
      const float sbound = QSCALE * 64.f * 1.02f * gq * gk; sshift = sbound > 64.f ? sbound - 64.f : 0.f; }
    const bool use_shift = __builtin_amdgcn_readfirstlane(__float_as_uint(sshift)) != 0u;
    for (int ui = 0; ui < nlat + nctx; ++ui) {
        int b, kvh, qrow0, jt0, NT;
        if (ui < nlat) { const int u = c * per + ui; const int bk = u >> 4, qb = u & 15; b = bk >> 1; kvh = bk & 1; qrow0 = b * SEQ + qb * 128; jt0 = 0; NT = 18; }
        else { const int u = c + (ui - nlat) * G; const int bk = u >> 1, qb = u & 1; b = bk >> 1; kvh = bk & 1; qrow0 = TL + b * CTXL + qb * 128; jt0 = 16; NT = 2; }
        const int head = kvh * 4 + (w >> 1); const int myrow = qrow0 + 64 * (w & 1) + q32;
        bf16_t* qp = Bcat + (size_t)myrow * DM + 256 + head * 64;
        bf16x8 qf[2][4];
#pragma unroll
        for (int sb = 0; sb < 2; ++sb)
#pragma unroll
            for (int ds = 0; ds < 4; ++ds) qf[sb][ds] = *(const bf16x8*)(qp + (size_t)sb * 32 * DM + 16 * ds + hi * 8);
        const int vr = tid >> 4, vc = tid & 15;
        const bf16_t* vsrc = Vt + ((size_t)(b * 2 + kvh) * 64 + vr) * KVPOS + vc * 8;
#define KSRC(jt) (kbuf + (size_t)(((jt) < 16 ? b * SEQ + 128 * (jt) : TL + b * CTXL + 128 * ((jt) - 16)) + kr) * 128 + kvh * 64 + kc * 8)
#define LDS_K(buf) (lds + (buf) * 18432)
#define LDS_V(buf) (lds + 36864 + (buf) * 17408)
        u32x4 kreg0 = *(const u32x4*)KSRC(jt0), kreg1 = *(const u32x4*)(KSRC(jt0) + 64 * 128);
        u32x4 vreg0 = *(const u32x4*)(vsrc + 128 * jt0), vreg1 = *(const u32x4*)(vsrc + 128 * jt0 + (size_t)32 * KVPOS);
        *(u32x4*)(LDS_K(0) + kr * 144 + kc * 16) = kreg0; *(u32x4*)(LDS_K(0) + (kr + 64) * 144 + kc * 16) = kreg1;
        *(u32x4*)(LDS_V(0) + vr * 272 + vc * 16) = vreg0; *(u32x4*)(LDS_V(0) + (vr + 32) * 272 + vc * 16) = vreg1;
        __syncthreads();
        f32x16 o0[2], o1[2];
        float lrun[2];
#pragma unroll
        for (int sb = 0; sb < 2; ++sb) { lrun[sb] = 0.f;
#pragma unroll
            for (int r = 0; r < 16; ++r) { o0[sb][r] = 0.f; o1[sb][r] = 0.f; } }
        for (int j = 0; j < NT; ++j) {
            if (j + 1 < NT) { kreg0 = *(const u32x4*)KSRC(jt0 + j + 1); kreg1 = *(const u32x4*)(KSRC(jt0 + j + 1) + 64 * 128);
                vreg0 = *(const u32x4*)(vsrc + 128 * (jt0 + j + 1)); vreg1 = *(const u32x4*)(vsrc + 128 * (jt0 + j + 1) + (size_t)32 * KVPOS); }
#pragma unroll 1
            for (int h = 0; h < 2; ++h) {
            const unsigned char* Kb = LDS_K(j & 1) + h * 64 * 144; const unsigned char* Vb = LDS_V(j & 1) + h * 128;
            f32x16 p0[2], p1[2];
            const f32x16 czero = {0.f, 0.f, 0.f, 0.f, 0.f, 0.f, 0.f, 0.f, 0.f, 0.f, 0.f, 0.f, 0.f, 0.f, 0.f, 0.f};
#pragma unroll
            for (int ds = 0; ds < 4; ++ds) {
                const bf16x8 k0 = *(const bf16x8*)(Kb + q32 * 144 + ds * 32 + hi * 16);
                const bf16x8 k1 = *(const bf16x8*)(Kb + (32 + q32) * 144 + ds * 32 + hi * 16);
#pragma unroll
                for (int sb = 0; sb < 2; ++sb) {
                    p0[sb] = __builtin_amdgcn_mfma_f32_32x32x16_bf16(k0, qf[sb][ds], ds == 0 ? czero : p0[sb], 0, 0, 0);
                    p1[sb] = __builtin_amdgcn_mfma_f32_32x32x16_bf16(k1, qf[sb][ds], ds == 0 ? czero : p1[sb], 0, 0, 0);
                }
            }
            if (use_shift) {
#pragma unroll
                for (int sb = 0; sb < 2; ++sb)
#pragma unroll
                    for (int r = 0; r < 16; ++r) { p0[sb][r] -= sshift; p1[sb][r] -= sshift; }
            }
            u32x4 pw[2][4];
#pragma unroll
            for (int sb = 0; sb < 2; ++sb) {
                float ls = 0.f;
#pragma unroll
                for (int r = 0; r < 16; ++r) { p0[sb][r] = __builtin_amdgcn_exp2f(p0[sb][r]); p1[sb][r] = __builtin_amdgcn_exp2f(p1[sb][r]); ls += p0[sb][r] + p1[sb][r]; }
                lrun[sb] += ls;
                pw[sb][0] = (u32x4){cvtpk(p0[sb][0], p0[sb][1]), cvtpk(p0[sb][2], p0[sb][3]), cvtpk(p0[sb][4], p0[sb][5]), cvtpk(p0[sb][6], p0[sb][7])};
                pw[sb][1] = (u32x4){cvtpk(p0[sb][8], p0[sb][9]), cvtpk(p0[sb][10], p0[sb][11]), cvtpk(p0[sb][12], p0[sb][13]), cvtpk(p0[sb][14], p0[sb][15])};
                pw[sb][2] = (u32x4){cvtpk(p1[sb][0], p1[sb][1]), cvtpk(p1[sb][2], p1[sb][3]), cvtpk(p1[sb][4], p1[sb][5]), cvtpk(p1[sb][6], p1[sb][7])};
                pw[sb][3] = (u32x4){cvtpk(p1[sb][8], p1[sb][9]), cvtpk(p1[sb][10], p1[sb][11]), cvtpk(p1[sb][12], p1[sb][13]), cvtpk(p1[sb][14], p1[sb][15])};
            }
#pragma unroll
            for (int s = 0; s < 4; ++s) {
                const bf16x8 v0 = *(const bf16x8*)(Vb + q32 * 272 + s * 32 + hi * 16);
                const bf16x8 v1 = *(const bf16x8*)(Vb + (32 + q32) * 272 + s * 32 + hi * 16);
#pragma unroll
                for (int sb = 0; sb < 2; ++sb) {
                    const bf16x8 pa = __builtin_bit_cast(bf16x8, pw[sb][s]);
                    o0[sb] = __builtin_amdgcn_mfma_f32_32x32x16_bf16(v0, pa, o0[sb], 0, 0, 0);
                    o1[sb] = __builtin_amdgcn_mfma_f32_32x32x16_bf16(v1, pa, o1[sb], 0, 0, 0);
                }
            }
            }
            if (j + 1 < NT) { const int nb_ = (j + 1) & 1;
                *(u32x4*)(LDS_K(nb_) + kr * 144 + kc * 16) = kreg0; *(u32x4*)(LDS_K(nb_) + (kr + 64) * 144 + kc * 16) = kreg1;
                *(u32x4*)(LDS_V(nb_) + vr * 272 + vc * 16) = vreg0; *(u32x4*)(LDS_V(nb_) + (vr + 32) * 272 + vc * 16) = vreg1; }
            __syncthreads();
        }
#undef LDS_K
#undef LDS_V
#undef KSRC
#pragma unroll
        for (int sb = 0; sb < 2; ++sb) {
            float lt = lrun[sb]; lt += __shfl_xor(lt, 32);
            const float inv = 1.f / lt;
            bf16_t* op = qp + (size_t)sb * 32 * DM;
#pragma unroll
            for (int rg = 0; rg < 4; ++rg) {
                u32x2 w0; w0.x = cvtpk(o0[sb][4 * rg] * inv, o0[sb][4 * rg + 1] * inv); w0.y = cvtpk(o0[sb][4 * rg + 2] * inv, o0[sb][4 * rg + 3] * inv);
                u32x2 w1; w1.x = cvtpk(o1[sb][4 * rg] * inv, o1[sb][4 * rg + 1] * inv); w1.y = cvtpk(o1[sb][4 * rg + 2] * inv, o1[sb][4 * rg + 3] * inv);
                if (!dry) { *(u32x2*)(op + 8 * rg + 4 * hi) = w0; *(u32x2*)(op + 32 + 8 * rg + 4 * hi) = w1; }
            }
        }
    }
}

__global__ void __launch_bounds__(512, 2) fwd_megakernel(Args a) {
    extern __shared__ __attribute__((aligned(16))) unsigned char lds[];
    cg::grid_group grid = cg::this_grid();
    unsigned char* ws = a.ws;
    float* modraw = (float*)(ws + WS_MOD);
    float* ssq = (float*)(ws + WS_SSQ);
    bf16_t* Ap = (bf16_t*)(ws + WS_AP);
    float* hctx = (float*)(ws + WS_HCTX);
    LAS unsigned char* ldsl = (LAS unsigned char*)lds;

    int second = 0; unsigned nbar = 0;
    const int wave_s = __builtin_amdgcn_readfirstlane((int)threadIdx.x >> 6);
    for (int ph = a.ph_lo; ph < a.ph_hi; ++ph) {
        int lid_; asm volatile("v_mbcnt_lo_u32_b32 %0, -1, 0\n\tv_mbcnt_hi_u32_b32 %0, -1, %0" : "=v"(lid_));
        int tid = wave_s * 64 + lid_; asm volatile("" : "+v"(tid));
        const int lane = tid & 63, wave = tid >> 6;
        int kind;
        { const int sp_ = ph < 11 ? ph - 2 : ph - 13;
          kind = (ph == 0 || ph == 1 || ph == 11 || ph == 12) ? 0 : (ph == 22 ? 7 : ((sp_ == 0 || sp_ == 7) ? 1 : ((sp_ == 1 || sp_ == 6 || sp_ == 8) ? 2 : (sp_ == 2 ? 3 : (sp_ == 3 ? 4 : (sp_ == 4 ? 5 : 6)))))); }
        const int dry = (REPEAT_MASK != 0) && ((REPEAT_MASK >> kind) & 1) && !second;
        if (ph == 0 || ph == 11) {
          if (ph == 0) {
            for (int i = blockIdx.x * 512 + tid; i < 6 * TT; i += gridDim.x * 512) ssq[TT + i] = 0.f;
            {
                float* rope = (float*)(ws + WS_ROPE);
                for (int i = blockIdx.x * 512 + tid; i < SEQ * 32; i += gridDim.x * 512) {
                    const int t = i >> 5, j = i & 31, fi = j & 15; const float pos = (float)((j < 16) ? (t >> 6) : (t & 63));
                    const float invf = __builtin_amdgcn_exp2f(-(float)fi * (13.287712379549449f / 16.f));
                    const float ang = pos * invf;
                    rope[2 * i] = __cosf(ang); rope[2 * i + 1] = __sinf(ang);
                }
            }
            {
                float* sc = (float*)lds;
                float* red = (float*)(lds + 69632);
                for (int i = tid; i < 17 * DM; i += 512) { const int mb = i >> 10, k = i & 1023; const float cv = mb < 16 ? a.in[I_C][mb * DM + k] : a.in[I_CCTX][k]; sc[i] = cv * sigm(cv); }
                __syncthreads();
                for (int item = blockIdx.x; item < 288; item += gridDim.x) {
                    const int l = item / 144, n0 = (item - l * 144) * 64;
                    const float* wp = a.in[I_WADA] + ((size_t)l * DM + wave * 128) * NMOD + n0 + lane;
                    float acc[17];
#pragma unroll
                    for (int mb = 0; mb < 17; ++mb) acc[mb] = 0.f;
#pragma unroll 16
                    for (int k = 0; k < 128; ++k) { const float wv = wp[(size_t)k * NMOD];
#pragma unroll
                        for (int mb = 0; mb < 17; ++mb) acc[mb] += sc[mb * DM + wave * 128 + k] * wv; }
#pragma unroll
                    for (int mb = 0; mb < 17; ++mb) red[(wave * 17 + mb) * 64 + lane] = acc[mb];
                    __syncthreads();
                    for (int i = tid; i < 17 * 64; i += 512) { const int mb = i >> 6, col = i & 63; float s = a.in[I_BADA][l * NMOD + n0 + col];
#pragma unroll
                        for (int w8 = 0; w8 < 8; ++w8) s += red[(w8 * 17 + mb) * 64 + col];
                        modraw[((size_t)l * 17 + mb) * NMOD + n0 + col] = s; }
                    __syncthreads();
                }
            }
            __syncthreads();
          }
            convert_weights(tid, a, ph == 0 ? 0 : 1, lds);
        } else if (ph == 1 || ph == 12) {
            const int l = ph == 1 ? 0 : 1;
            compute_biases(tid, a, l, lds);
            if (l == 0) {
                const float* nrm = a.in[I_NFFN1]; const int gw = blockIdx.x * 8 + wave, NGW = gridDim.x * 8;
                for (int R = gw; R < TT; R += NGW) {
                    const float* xr = R < TL ? a.in[I_X] + (size_t)R * DM : a.in[I_CTX] + (size_t)(R - TL) * DM;
                    const int mb = R < TL ? (R >> 11) : 16; const float* scl = modraw + (size_t)mb * NMOD + DM;
                    float ss = 0.f;
#pragma unroll
                    for (int c4 = 0; c4 < 4; ++c4) { const int col = c4 * 256 + lane * 4; const f32x4 v = *(const f32x4*)(xr + col);
                        ss += (v[0] * v[0] + v[1] * v[1]) + (v[2] * v[2] + v[3] * v[3]);
                        const f32x4 g = *(const f32x4*)(nrm + col) * (*(const f32x4*)(scl + col) + 1.f), y = v * g;
                        u32x2 w; w.x = cvtpk(y[0], y[1]); w.y = cvtpk(y[2], y[3]); *(u32x2*)(Ap + (size_t)R * DM + col) = w; }
                    ss = wave_sum(ss);
                    if (lane == 0) ssq[R] = ss;
                }
            }
        } else if (ph == 22) {
            const float* fn = a.in[I_FNORM]; const int gw = blockIdx.x * 8 + wave, NGW = gridDim.x * 8;
            for (int R = gw; R < TL; R += NGW) {
                const float r = __builtin_amdgcn_rsqf(ssq[(size_t)6 * TT + R] * (1.f / DM) + EPS);
                const float* hrow = a.out + (size_t)R * DM; float* orow = a.out + (size_t)R * DM;
#pragma unroll
                for (int c4 = 0; c4 < 4; ++c4) { const int col = c4 * 256 + lane * 4; const f32x4 v = *(const f32x4*)(hrow + col) * r * *(const f32x4*)(fn + col); *(f32x4*)(orow + col) = v; }
            }
        } else {
            const int l = ph < 11 ? 0 : 1, sp = ph < 11 ? ph - 2 : ph - 13;
            const float* modl = modraw + (size_t)l * 17 * NMOD;
            const int nMall = TT / 256, nMlat = TL / 256;
            if (sp == 0 || sp == 7) {
                const bool f1 = sp == 0; const int nM = (f1 || l == 0) ? nMall : nMlat;
                pg8::TileSched S = pg8::make_sched(nM, 2 * DFF / 256, DM);
                pg8::EpiSwiGLU E{(bf16_t*)(ws + WS_G), (const float*)(ws + (f1 ? WS_B13A : WS_B13B)), ssq + (size_t)(3 * l + (f1 ? 0 : 2)) * TT};
                pg8::gemm_phase(tid, ldsl, Ap, DM, (const bf16_t*)(ws + (f1 ? WS_W13A : WS_W13B)), DM, S, E);
            } else if (sp == 1 || sp == 8 || sp == 6) {
                if (STAGGER_TICKS > 0) {
                    if (tid == 0) { const unsigned long long t0 = __builtin_amdgcn_s_memrealtime(); const unsigned long long d = (unsigned long long)((blockIdx.x & 7) * STAGGER_TICKS);
                        while (__builtin_amdgcn_s_memrealtime() - t0 < d) __builtin_amdgcn_s_sleep(4); }
                    __syncthreads();
                }
                const int nM = (sp == 1 || l == 0) ? nMall : nMlat;
                const int j = sp == 1 ? 0 : (sp == 6 ? 1 : 2);
                const bool lastg = (l == 1 && sp == 8);
                const int ln = (sp == 8) ? l + 1 : l, jn = (sp == 8) ? 0 : j + 1;
                const float* nrm = lastg ? a.in[I_NFFN1] : (jn == 0 ? a.in[I_NFFN1] : (jn == 1 ? a.in[I_NMIX] : a.in[I_NFFN2])) + (size_t)ln * DM;
                const float* scl = lastg ? modraw : modraw + (size_t)ln * 17 * NMOD + (3 * jn + 1) * DM;
                const float* nrc = (j == 0 ? a.in[I_NFFN1] : (j == 1 ? a.in[I_NMIX] : a.in[I_NFFN2])) + (size_t)l * DM;
                const float* scc = modl + (3 * j + 1) * DM;
                float* ssqn = ssq + (size_t)(3 * l + j + 1) * TT;
                pg8::EpiRes E{Ap, lastg ? a.out : nullptr, modl + (3 * j + 2) * DM, sp == 6 ? 1.0f : 0.5f, nrc, scc, nrm, scl, ssqn, dry};
                const bool wo = sp == 6; const int Kd = wo ? DM : DFF;
                pg8::TileSched S = (wo || nM != nMall) ? pg8::make_sched(nM, DM / 256, Kd) : pg8::make_ctxtail(Kd, (float*)(ws + WS_P), (unsigned*)(ws + WS_CTL) + 64, (unsigned)(ph + 1));
                if (XCD_OFFSET) pg8::add_xcd_offset(S, Kd, (float*)(ws + (wo ? WS_G : WS_P)));
                pg8::gemm_phase(tid, ldsl, (const bf16_t*)(ws + (wo ? WS_P : WS_G)), Kd, (const bf16_t*)(ws + (wo ? WS_WOUT : (sp == 1 ? WS_W2A : WS_W2B))), Kd, S, E);
            } else if (sp == 2) {
                pg8::TileSched S = pg8::make_sched(l == 0 ? nMall : nMlat, NIN / 256, DM);
                if (l == 1) { S.n2 = TC / 256; S.pm0_2 = nMlat; S.pn0_2 = 2; }
                pg8::EpiIn E{(bf16_t*)(ws + WS_P), (bf16_t*)(ws + WS_G), (const float*)(ws + WS_BIN), ssq + (size_t)(3 * l + 1) * TT};
                pg8::gemm_phase(tid, ldsl, Ap, DM, (const bf16_t*)(ws + WS_WIN), DM, S, E);
            } else if (sp == 3) {
                post_phase(tid, a, l, lds);
            } else if (sp == 4) {
                attn_phase(tid, a, l, lds, dry);
            } else if (sp == 5) {
                pg8::TileSched S = pg8::make_sched(l == 0 ? nMall : nMlat, DM / 256, DM);
                S.nb = 3;
                pg8::EpiMerge E{(const bf16_t*)(ws + WS_G), (bf16_t*)(ws + WS_P)};
                pg8::gemm_phase(tid, ldsl, (const bf16_t*)a.out, DM, (const bf16_t*)(ws + WS_WCAT), DM, S, E);
            }
        }
        if (REPEAT_MASK != 0) { if (dry) { second = 1; --ph; __syncthreads(); continue; } second = 0; }
        if (ph + 1 < a.ph_hi) {
            asm volatile("s_waitcnt vmcnt(0) lgkmcnt(0)" ::: "memory");
            __syncthreads();
            if (ph == a.ph_lo) { if (tid == 0) __builtin_amdgcn_fence(__ATOMIC_RELEASE, "agent"); grid.sync(); if (tid == 0) __builtin_amdgcn_fence(__ATOMIC_ACQUIRE, "agent"); }
            else {
              for (int bb = 0; bb <= EXTRA_BAR; ++bb) {
                if (tid == 0) {
                    unsigned* ctl = (unsigned*)(ws + WS_CTL);
                    const unsigned G_ = gridDim.x, g_ = blockIdx.x & 7u, ngrp = G_ < 8u ? G_ : 8u, memb = (G_ - g_ + 7u) >> 3;
                    unsigned* gcnt = ctl + 2304 + 64 * g_; unsigned* ggen = ctl + 2816 + 64 * g_; unsigned* top = ctl + 3328;
                    __builtin_amdgcn_fence(__ATOMIC_RELEASE, "agent");
                    ++nbar;
                    const unsigned old = __hip_atomic_fetch_add(gcnt, 1u, __ATOMIC_RELAXED, __HIP_MEMORY_SCOPE_AGENT);
                    if (old + 1u == nbar * memb) {
                        __hip_atomic_fetch_add(top, 1u, __ATOMIC_RELAXED, __HIP_MEMORY_SCOPE_AGENT);
                        while (__hip_atomic_load(top, __ATOMIC_RELAXED, __HIP_MEMORY_SCOPE_AGENT) < nbar * ngrp) __builtin_amdgcn_s_sleep(1);
                        __hip_atomic_store(ggen, nbar, __ATOMIC_RELAXED, __HIP_MEMORY_SCOPE_AGENT);
                    } else {
                        while (__hip_atomic_load(ggen, __ATOMIC_RELAXED, __HIP_MEMORY_SCOPE_AGENT) < nbar) __builtin_amdgcn_s_sleep(1);
                    }
                    __builtin_amdgcn_fence(__ATOMIC_ACQUIRE, "agent");
                }
                if (EXTRA_BAR) { asm volatile("s_waitcnt vmcnt(0)" ::: "memory"); __syncthreads(); }
              }
            }
            asm volatile("s_waitcnt vmcnt(0)" ::: "memory");
            __syncthreads();
        }
    }
}

extern "C" void kernel_launch(void* const* d_in, const int* in_sizes, int n_in, void* d_out, int out_size, void* d_ws, size_t ws_size, hipStream_t stream) {
    static int grid = 0;
    if (grid == 0) {
        if (n_in != 26 || out_size != TL * DM || ws_size < WS_END) { fprintf(stderr, "kernel_launch: unexpected shapes (n_in %d out %d ws %zu need %zu)\n", n_in, out_size, ws_size, (size_t)WS_END); grid = -1; return; }
        int dev = 0, cus = 0, per_cu = 0;
        if (hipGetDevice(&dev) != hipSuccess || hipDeviceGetAttribute(&cus, hipDeviceAttributeMultiprocessorCount, dev) != hipSuccess) { grid = -1; return; }
        if (hipFuncSetAttribute((const void*)fwd_megakernel, hipFuncAttributeMaxDynamicSharedMemorySize, LDS_BYTES) != hipSuccess) { fprintf(stderr, "kernel_launch: hipFuncSetAttribute failed\n"); grid = -1; return; }
        if (hipOccupancyMaxActiveBlocksPerMultiprocessor(&per_cu, (const void*)fwd_megakernel, 512, LDS_BYTES) != hipSuccess || per_cu < 1) per_cu = 1;
        (void)hipGetLastError();
        grid = cus * per_cu;
    }
    if (grid < 0) return;
    Args a{};
    for (int i = 0; i < 26; ++i) a.in[i] = (const float*)d_in[i];
    a.out = (float*)d_out; a.ws = (unsigned char*)d_ws;
#if MK_ONE_LAUNCH
    a.ph_lo = 0; a.ph_hi = NPHASES;
    if (hipMemsetAsync((char*)d_ws + WS_CTL, 0, 16384, stream) != hipSuccess) { fprintf(stderr, "memset failed\n"); return; }
    void* args[] = {&a};
    hipError_t e = hipLaunchCooperativeKernel((const void*)fwd_megakernel, dim3(grid), dim3(512), args, LDS_BYTES, stream);
    if (e != hipSuccess) fprintf(stderr, "cooperative launch failed: %s (grid %d)\n", hipGetErrorString(e), grid);
#else
    for (int ph = 0; ph < NPHASES; ++ph) {
        a.ph_lo = ph; a.ph_hi = ph + 1;
        hipLaunchKernelGGL(fwd_megakernel, dim3(grid), dim3(512), LDS_BYTES, stream, a);
    }
#endif
}
```
